# Optimizing an MI355X kernel written in HIP

```python
import jax, jax.numpy as jnp
from jax import lax
import numpy as np

D_MODEL = 2048
BATCH = 4
SEQ = 2048
DEPTH = 2

HEAD_DIM = 64
N_MIXERS = 4
GROUP_WIDTH = D_MODEL // N_MIXERS
N_GROUP_HEADS = GROUP_WIDTH // HEAD_DIM
D_MIX = N_MIXERS * GROUP_WIDTH
FNET_W = GROUP_WIDTH
GMLP_W = GROUP_WIDTH
CHUNK = 128
SWA_HEADS = N_GROUP_HEADS
SWA_KV_HEADS = 2
SWA_HALF_WINDOW = 128
DIL_HEADS = N_GROUP_HEADS
DIL_CONFIGS = ((128, 1), (512, 4), (2048, 16))
ROPE_THETA = 500000.0
ROPE_DIM = HEAD_DIM // 4
N_EXPERTS = 16
EXPERT_FF = D_MODEL // 2
EC_FACTOR = 2
D_IN = FNET_W + 2 * GMLP_W + (SWA_HEADS + 2 * SWA_KV_HEADS) * HEAD_DIM + 3 * DIL_HEADS * HEAD_DIM
EPS = 1e-6
NEG_INF = -1e30

kernel_name = 'hybrid_parallel_mixers_ec_moe_encoder'


def rmsnorm(x, g):
    xf = x.astype(jnp.float32)
    y = xf * lax.rsqrt(jnp.mean(xf * xf, axis=-1, keepdims=True) + EPS)
    return (y * g.astype(jnp.float32)).astype(x.dtype)


def modulate(h, shift, scale):
    return h * (1 + scale[:, None, :]) + shift[:, None, :]


def split_points():
    sizes = (FNET_W, 2 * GMLP_W, SWA_HEADS * HEAD_DIM, SWA_KV_HEADS * HEAD_DIM,
             SWA_KV_HEADS * HEAD_DIM, DIL_HEADS * HEAD_DIM, DIL_HEADS * HEAD_DIM,
             DIL_HEADS * HEAD_DIM)
    return [int(v) for v in np.cumsum(sizes)[:-1]]


def rope(x, positions):
    half = ROPE_DIM // 2
    inv = jnp.power(jnp.float32(ROPE_THETA), -jnp.arange(0, ROPE_DIM, 2, dtype=jnp.float32) / ROPE_DIM)
    ang = positions.astype(jnp.float32)[..., None] * inv
    cos = jnp.cos(ang)[:, :, None, :]
    sin = jnp.sin(ang)[:, :, None, :]
    xr = x[..., :ROPE_DIM].astype(jnp.float32)
    x1, x2 = xr[..., :half], xr[..., half:]
    rot = jnp.concatenate([x1 * cos - x2 * sin, x2 * cos + x1 * sin], axis=-1)
    return jnp.concatenate([rot.astype(x.dtype), x[..., ROPE_DIM:]], axis=-1)


def banded_attention(q, k, v, half_window, sink=None):
    n, L, h, dh = q.shape
    hk = k.shape[2]
    g = h // hk
    w = half_window
    nb = -(-L // w)
    lp = nb * w
    pad = lp - L
    qp = jnp.pad(q, ((0, 0), (0, pad), (0, 0), (0, 0)))
    kp = jnp.pad(k, ((0, 0), (w, pad + w), (0, 0), (0, 0)))
    vp = jnp.pad(v, ((0, 0), (w, pad + w), (0, 0), (0, 0)))

    def neighbour_blocks(t):
        tb = t.reshape(n, nb + 2, w, hk, dh)
        return jnp.concatenate([tb[:, :-2], tb[:, 1:-1], tb[:, 2:]], axis=2)

    kb = neighbour_blocks(kp)
    vb = neighbour_blocks(vp)
    qb = qp.reshape(n, nb, w, hk, g, dh)
    s = jnp.einsum('nbqhgd,nbkhd->nbhgqk', qb, kb,
                   preferred_element_type=jnp.float32) * (dh ** -0.5)
    qpos = jnp.arange(nb)[:, None] * w + jnp.arange(w)[None, :]
    kpos = (jnp.arange(nb)[:, None] - 1) * w + jnp.arange(3 * w)[None, :]
    kp3 = kpos[:, None, :]
    valid = (jnp.abs(kp3 - qpos[:, :, None]) <= w) & (kp3 >= 0) & (kp3 < L)
    s = jnp.where(valid[None, :, None, None, :, :], s, NEG_INF)
    if sink is None:
        lse = jax.nn.logsumexp(s, axis=-1)
    else:
        sk = jnp.broadcast_to(sink.astype(jnp.float32).reshape(hk, g)[None, None, :, :, None, None],
                              s.shape[:-1] + (1,))
        lse = jax.nn.logsumexp(jnp.concatenate([s, sk], axis=-1), axis=-1)
    p = jnp.exp(s - lse[..., None])
    out = jnp.einsum('nbhgqk,nbkhd->nbqhgd', p.astype(v.dtype), vb)
    out = out.reshape(n, lp, h, dh)[:, :L]
    lse = lse.transpose(0, 1, 4, 2, 3).reshape(n, lp, h)[:, :L]
    return out, lse


def dilated_attention(q, k, v):
    b, s, h, dh = q.shape
    outs, lses = [], []
    for window, dilation in DIL_CONFIGS:
        steps = window // (2 * dilation)
        ls = s // dilation

        def gather(t):
            return t.reshape(b, ls, dilation, h, dh).transpose(0, 2, 1, 3, 4).reshape(b * dilation, ls, h, dh)

        o, lse = banded_attention(gather(q), gather(k), gather(v), steps)
        outs.append(o.reshape(b, dilation, ls, h, dh).transpose(0, 2, 1, 3, 4).reshape(b, s, h, dh))
        lses.append(lse.reshape(b, dilation, ls, h).transpose(0, 2, 1, 3).reshape(b, s, h))
    wts = jax.nn.softmax(jnp.stack(lses, axis=0), axis=0)
    return jnp.einsum('cbsh,cbshd->bshd', wts.astype(q.dtype), jnp.stack(outs, axis=0))


def fourier_mix(xa, fnet_w):
    b, s, _ = xa.shape
    xg = xa.reshape(b, s, N_GROUP_HEADS, HEAD_DIM).astype(jnp.float32)
    f = jnp.fft.fft2(xg, axes=(1, 3), norm='ortho').real.astype(xa.dtype)
    return jnp.einsum('bshc,hcd->bshd', f, fnet_w).reshape(b, s, FNET_W)


def spatial_gating(uv, sgu_norm, sgu_w, sgu_b):
    uv = jax.nn.gelu(uv)
    u, v = jnp.split(uv, 2, axis=-1)
    v = rmsnorm(v, sgu_norm)
    b, s, _ = v.shape
    vc = v.reshape(b, s // CHUNK, CHUNK, N_GROUP_HEADS, HEAD_DIM)
    z = jnp.einsum('hpq,bnqhc->bnphc', sgu_w, vc) + sgu_b.T[None, None, :, :, None]
    return u * z.reshape(b, s, GMLP_W)


def expert_choice_ffn(h, router_w, w_gate, w_up, w_down):
    b, s, d = h.shape
    cap = max(1, EC_FACTOR * s // N_EXPERTS)
    aff = jax.nn.softmax(jnp.einsum('bsd,de->bse', h, router_w,
                                    preferred_element_type=jnp.float32), axis=-1)
    gate, idx = lax.top_k(aff.transpose(0, 2, 1), cap)
    bidx = jnp.arange(b)[:, None, None]
    xe = h[bidx, idx]
    a = jnp.einsum('becd,edf->becf', xe, w_gate)
    u = jnp.einsum('becd,edf->becf', xe, w_up)
    o = jnp.einsum('becf,efd->becd', jax.nn.silu(a) * u, w_down)
    o = o * gate[..., None].astype(o.dtype)
    return jnp.zeros_like(h).at[bidx, idx].add(o)


def hybrid_layer(x, c, positions, ada_w, ada_b, norm_mix, w_in, fnet_w, sgu_norm, sgu_w,
                 sgu_b, swa_sink, group_norm, w_out, norm_ffn, router_w, exp_w_gate,
                 exp_w_up, exp_w_down):
    b, s, _ = x.shape
    mod = jnp.dot(jax.nn.silu(c), ada_w) + ada_b
    shift_m, scale_m, gate_m, shift_f, scale_f, gate_f = jnp.split(mod, 6, axis=-1)

    h = modulate(rmsnorm(x, norm_mix), shift_m, scale_m)
    proj = jnp.einsum('bsd,de->bse', h, w_in)
    xa, uv, qc, kc, vc, qd, kd, vd = jnp.split(proj, split_points(), axis=-1)

    def heads(t, n):
        return t.reshape(b, s, n, HEAD_DIM)

    y_a = fourier_mix(xa, fnet_w)
    y_b = spatial_gating(uv, sgu_norm, sgu_w, sgu_b)
    y_c, _ = banded_attention(rope(heads(qc, SWA_HEADS), positions),
                              rope(heads(kc, SWA_KV_HEADS), positions),
                              heads(vc, SWA_KV_HEADS), SWA_HALF_WINDOW, swa_sink)
    y_d = dilated_attention(rope(heads(qd, DIL_HEADS), positions),
                            rope(heads(kd, DIL_HEADS), positions),
                            heads(vd, DIL_HEADS))
    y = jnp.concatenate([y_a, y_b, y_c.reshape(b, s, -1), y_d.reshape(b, s, -1)], axis=-1)
    y = rmsnorm(y.reshape(b, s, N_MIXERS, GROUP_WIDTH),
                group_norm.reshape(N_MIXERS, GROUP_WIDTH)).reshape(b, s, D_MIX)
    x = x + gate_m[:, None, :] * jnp.einsum('bse,ed->bsd', y, w_out)

    h = modulate(rmsnorm(x, norm_ffn), shift_f, scale_f)
    x = x + gate_f[:, None, :] * expert_choice_ffn(h, router_w, exp_w_gate, exp_w_up, exp_w_down)
    return x


def setup_inputs(seed: int = 0) -> dict:
    key = jax.random.key(seed)
    ks = jax.random.split(key, 24)
    f32 = jnp.float32

    def nrm(k, shape, scale):
        return jax.random.normal(k, shape, f32) * scale

    def gain(k, shape):
        return 1.0 + 0.02 * jax.random.normal(k, shape, f32)

    L = DEPTH
    return {
        'x': nrm(ks[0], (BATCH, SEQ, D_MODEL), 1.0),
        'c': nrm(ks[1], (BATCH, D_MODEL), 1.0),
        'positions': jnp.arange(SEQ, dtype=jnp.int32)[None, :]
                     + jax.random.randint(ks[2], (BATCH, 1), 0, 1024, dtype=jnp.int32),
        'ada_w': nrm(ks[3], (L, D_MODEL, 6 * D_MODEL), 0.5 * D_MODEL ** -0.5),
        'ada_b': nrm(ks[4], (L, 6 * D_MODEL), 0.02),
        'norm_mix': gain(ks[5], (L, D_MODEL)),
        'w_in': nrm(ks[6], (L, D_MODEL, D_IN), D_MODEL ** -0.5),
        'fnet_w': nrm(ks[7], (L, N_GROUP_HEADS, HEAD_DIM, HEAD_DIM), HEAD_DIM ** -0.5),
        'sgu_norm': gain(ks[8], (L, GMLP_W)),
        'sgu_w': nrm(ks[9], (L, N_GROUP_HEADS, CHUNK, CHUNK), 0.5 * CHUNK ** -0.5),
        'sgu_b': 1.0 + nrm(ks[10], (L, N_GROUP_HEADS, CHUNK), 0.1),
        'swa_sink': nrm(ks[11], (L, SWA_HEADS), 0.5),
        'group_norm': gain(ks[12], (L, D_MIX)),
        'w_out': nrm(ks[13], (L, D_MIX, D_MODEL), D_MIX ** -0.5),
        'norm_ffn': gain(ks[14], (L, D_MODEL)),
        'router_w': nrm(ks[15], (L, D_MODEL, N_EXPERTS), D_MODEL ** -0.5),
        'exp_w_gate': nrm(ks[16], (L, N_EXPERTS, D_MODEL, EXPERT_FF), D_MODEL ** -0.5),
        'exp_w_up': nrm(ks[17], (L, N_EXPERTS, D_MODEL, EXPERT_FF), D_MODEL ** -0.5),
        'exp_w_down': nrm(ks[18], (L, N_EXPERTS, EXPERT_FF, D_MODEL), EXPERT_FF ** -0.5),
        'final_norm': gain(ks[19], (D_MODEL,)),
    }


def reference(x, c, positions, ada_w, ada_b, norm_mix, w_in, fnet_w, sgu_norm, sgu_w, sgu_b,
              swa_sink, group_norm, w_out, norm_ffn, router_w, exp_w_gate, exp_w_up,
              exp_w_down, final_norm):
    for l in range(DEPTH):
        x = hybrid_layer(x, c, positions, ada_w[l], ada_b[l], norm_mix[l], w_in[l], fnet_w[l],
                         sgu_norm[l], sgu_w[l], sgu_b[l], swa_sink[l], group_norm[l], w_out[l],
                         norm_ffn[l], router_w[l], exp_w_gate[l], exp_w_up[l], exp_w_down[l])
    return rmsnorm(x, final_norm)
```

```cpp
#include <hip/hip_runtime.h>
#include <cstdio>
#include <cstdint>

#define LAS __attribute__((address_space(3)))
typedef unsigned short bf16_t;
typedef short bf16x8 __attribute__((ext_vector_type(8)));
typedef float f32x4 __attribute__((ext_vector_type(4)));
typedef float f32x2 __attribute__((ext_vector_type(2)));
typedef unsigned u32x4 __attribute__((ext_vector_type(4)));
typedef unsigned u32x2 __attribute__((ext_vector_type(2)));
typedef float f32x16 __attribute__((ext_vector_type(16)));

constexpr int NB = 4, SEQ = 2048, NT = NB * SEQ, DM = 2048, DIN = 3840, NPROJ = 3328, NE = 16, FF = 1024, CAP = 256;
constexpr float EPS = 1e-6f;
constexpr int PC_U = 0, PC_V = 512, PC_QC = 1024, PC_KC = 1536, PC_VC = 1664, PC_QD = 1792, PC_KD = 2304, PC_VD = 2816;

constexpr size_t MiB = (size_t)1 << 20;
constexpr size_t WS_CTL = 0;
constexpr size_t WS_MOD = 1 * MiB;
constexpr size_t WS_ROPE = WS_MOD + 512 * 1024;
constexpr size_t WS_DFT = 2 * MiB;
constexpr size_t WS_WIN = 18 * MiB;
constexpr size_t WS_WPQ = 44 * MiB;
constexpr size_t WS_WOUT = 52 * MiB;
constexpr size_t WS_WGU = 68 * MiB;
constexpr size_t WS_WD = 324 * MiB;
constexpr size_t WS_X = 452 * MiB;
constexpr size_t WS_X2 = 516 * MiB;
constexpr size_t WS_H = 580 * MiB;
constexpr size_t WS_PROJ = 612 * MiB;
constexpr size_t WS_PQT = 664 * MiB;
constexpr size_t WS_YA = 680 * MiB;
constexpr size_t WS_YB = 712 * MiB;
constexpr size_t WS_YC = 720 * MiB;
constexpr size_t WS_YD = 728 * MiB;
constexpr size_t WS_LSE = 752 * MiB;
constexpr size_t WS_YN = 753 * MiB;
constexpr size_t WS_AFF = 785 * MiB;
constexpr size_t WS_IDX = 786 * MiB;
constexpr size_t WS_XE = 787 * MiB;
constexpr size_t WS_ACT = 851 * MiB;
constexpr size_t WS_EO = 883 * MiB;
constexpr size_t WS_SGUW = 947 * MiB;
constexpr size_t WS_WRT = WS_SGUW + 512 * 1024;
constexpr size_t WS_ABT = WS_WRT + 128 * 1024;
constexpr size_t WS_END = 948 * MiB;

constexpr int LDS_BYTES = 147456;
constexpr int MISC_OFF = 131072;

struct Params { const float* in[20]; float* out; unsigned char* ws; int ph_lo, ph_hi; };

__device__ __forceinline__ unsigned pk2(float lo, float hi) { unsigned r; asm("v_cvt_pk_bf16_f32 %0, %1, %2" : "=v"(r) : "v"(lo), "v"(hi)); return r; }
__device__ __forceinline__ float bflo(unsigned u) { return __uint_as_float(u << 16); }
__device__ __forceinline__ float bfhi(unsigned u) { return __uint_as_float(u & 0xffff0000u); }
__device__ __forceinline__ float wave_sum(float v) {
#pragma unroll
    for (int o = 1; o < 64; o <<= 1) v += __shfl_xor(v, o);
    return v;
}
__device__ __forceinline__ float gelu_tanh(float x) { const float u = 0.7978845608f * (x + 0.044715f * x * x * x); return x * __builtin_amdgcn_rcpf(1.f + __builtin_amdgcn_exp2f(-2.885390082f * u)); }
__device__ __forceinline__ float silu_f(float x) { return x * __builtin_amdgcn_rcpf(1.f + __builtin_amdgcn_exp2f(-1.442695041f * x)); }

__device__ __forceinline__ int opaque_tid() { int t = threadIdx.x; asm volatile("" : "+v"(t)); return t; }
#define XB_TMO      128
#define XB_XCNT(j)  (256  + 64 * (j))
#define XB_XSUB(j)  (1280 + 64 * (j))
#define XB_XGEN(j)  (2304 + 64 * (j))
#define XB_TOP      3328
#define XB_TOPGEN   3392
#define XCD_BAR_WORDS 3456
#define XB_SPIN_CAP (1u << 18)
__device__ __forceinline__ unsigned xb_ld(unsigned* p)              { return __hip_atomic_load(p, __ATOMIC_RELAXED, __HIP_MEMORY_SCOPE_AGENT); }
__device__ __forceinline__ unsigned xb_add(unsigned* p, unsigned v) { return __hip_atomic_fetch_add(p, v, __ATOMIC_RELAXED, __HIP_MEMORY_SCOPE_AGENT); }
__device__ __forceinline__ unsigned xb_xcc_id() { return (unsigned)__builtin_amdgcn_s_getreg((3 << 11) | 20) & 0xFu; }
#define XB_SPIN(cond, bar) do { unsigned _sp = 0; while (cond) { __builtin_amdgcn_s_sleep(1); \
    if ((++_sp & 255u) == 0u) { if (xb_ld(&(bar)[XB_TMO])) break; if (_sp > XB_SPIN_CAP) { atomicAdd(&(bar)[XB_TMO], 1u); break; } } } } while (0)
struct XcdBarrier { unsigned* bar; unsigned x; volatile LAS unsigned* st; };
__device__ __forceinline__ XcdBarrier xcd_barrier_post(unsigned* bar, volatile LAS unsigned* st) {
    XcdBarrier b; b.bar = bar; b.x = xb_xcc_id(); b.st = st;
    if (threadIdx.x == 0) (void)xb_add(&bar[XB_XCNT(b.x)], 1u);
    return b;
}
__device__ __forceinline__ void xcd_barrier_complete(unsigned* bar, unsigned x, unsigned& nloc, unsigned& nx) {
    const unsigned G = gridDim.x * gridDim.y * gridDim.z;
    unsigned sum, cnt, mine, sp = 0u;
    for (;;) {
        sum = 0u; cnt = 0u; mine = 0u;
#pragma unroll
        for (unsigned j = 0; j < 16; ++j) { const unsigned c = xb_ld(&bar[XB_XCNT(j)]); sum += c; cnt += (c > 0u) ? 1u : 0u; mine = (j == x) ? c : mine; }
        if (sum == G) break;
        __builtin_amdgcn_s_sleep(1);
        if ((++sp & 255u) == 0u) { if (xb_ld(&bar[XB_TMO])) break; if (sp > XB_SPIN_CAP) { atomicAdd(&bar[XB_TMO], 1u); break; } }
    }
    nloc = mine > 0u ? mine : 1u; nx = cnt > 0u ? cnt : 1u;
}
__device__ __forceinline__ void xcd_barrier(const XcdBarrier& b) {
    asm volatile("s_waitcnt vmcnt(0)" ::: "memory");
    __syncthreads();
    if (threadIdx.x == 0) {
        unsigned* bar = b.bar;
        __builtin_amdgcn_s_waitcnt(0);
        unsigned nloc = b.st[0], nx = b.st[1];
        if (nloc == 0u) { xcd_barrier_complete(bar, b.x, nloc, nx); b.st[0] = nloc; b.st[1] = nx; }
        const unsigned old = xb_add(&bar[XB_XSUB(b.x)], 1u);
        const unsigned gen = old / nloc;
        if (old + 1u == (gen + 1u) * nloc) {
            __builtin_amdgcn_fence(__ATOMIC_RELEASE, "agent");
            asm volatile("s_waitcnt vmcnt(0)" ::: "memory");
            const unsigned og = xb_add(&bar[XB_TOP], 1u);
            const unsigned tg = og / nx;
            if (og + 1u == (tg + 1u) * nx) xb_add(&bar[XB_TOPGEN], 1u);
            else XB_SPIN(xb_ld(&bar[XB_TOPGEN]) == tg, bar);
            __builtin_amdgcn_fence(__ATOMIC_ACQUIRE, "agent");
            xb_add(&bar[XB_XGEN(b.x)], 1u);
            asm volatile("s_waitcnt vmcnt(0)" ::: "memory");
        } else {
            XB_SPIN(xb_ld(&bar[XB_XGEN(b.x)]) == gen, bar);
            __builtin_amdgcn_fence(__ATOMIC_ACQUIRE, "agent");
            asm volatile("s_waitcnt vmcnt(0)" ::: "memory");
        }
    }
    __syncthreads();
}

namespace pg8 {
constexpr int BM = 256, BK = 64, HALF = 128, HTB = HALF * BK * 2, STAGE_BYTES = 8 * HTB;
__host__ __device__ __forceinline__ int lds_byte(int r, int c) { const int st = (r >> 4) * 2 + (c >> 5), rr = r & 15, cc = c & 31, ob = rr * 64 + cc * 2; return st * 1024 + (ob ^ (((ob >> 9) & 1) << 5)); }
__host__ __device__ __forceinline__ void stage_rc(int b, int& R, int& C) { const int st = b / 1024, sb = b % 1024, swz = sb ^ (((sb >> 9) & 1) << 5); R = (st >> 1) * 16 + swz / 64; C = (st & 1) * 32 + (swz % 64) / 2; }
__host__ __device__ __forceinline__ int perm32(int rho) { const int n = rho >> 4, i = rho & 15; return 8 * (i >> 2) + 4 * n + (i & 3); }

struct GUnit { const char* a; const char* b; int pm, pn, z; };

__device__ __forceinline__ void dense_map(int L, int nM, int nN, int& pm, int& pn) {
    const int nwg = nM * nN;
    int wgid = L; { const int q = nwg / 8, r = nwg % 8, xcd = wgid % 8, off = wgid / 8; wgid = (xcd < r ? xcd * (q + 1) : r * (q + 1) + (xcd - r) * q) + off; }
    const int nig = 8 * nN, gid = wgid / nig, fm = gid * 8, gsz = (nM - fm) < 8 ? (nM - fm) : 8;
    pm = fm + ((wgid % nig) % gsz); pn = (wgid % nig) / gsz;
}

template <class Epi, class Sched, bool GATHER = false>
__device__ __forceinline__ void gemm_phase(LAS unsigned char* lds, const int lda, const int ldb, const int K, const Sched& S, const Epi& E, const int* gidx = nullptr) {
    int tid_ = threadIdx.x; asm volatile("" : "+v"(tid_));
    const int tid = tid_, wid = __builtin_amdgcn_readfirstlane(tid >> 6), lane = tid & 63, wr = wid >> 2, wc = wid & 3, fr = lane & 15, fq = lane >> 4;
    const int nt = K / BK;
    unsigned voffB[2]; int RA[2]; unsigned CA2[2];
#pragma unroll
    for (int i = 0; i < 2; ++i) { int R, C; stage_rc(tid * 16 + i * 8192, R, C); const int Rb = Epi::PERM ? ((R & ~31) + perm32(R & 31)) : R;
        RA[i] = R; CA2[i] = (unsigned)C * 2u; voffB[i] = (unsigned)(Rb * ldb + C) * 2u; }
    const size_t kstep = (size_t)(BK * 2);
    const size_t hstepB = (size_t)HALF * ldb * 2;
    const unsigned ldsw = (unsigned)wid * 1024u;
    const int aoff = lds_byte(wr * 64 + fr, fq * 8), boff = lds_byte(wc * 32 + fr, fq * 8);
#define PG8_AOFF(of, u) do { _Pragma("unroll") for (int hh_ = 0; hh_ < 2; ++hh_) _Pragma("unroll") for (int i_ = 0; i_ < 2; ++i_) { \
        if constexpr (GATHER) of[hh_][i_] = (unsigned)gidx[(u).pm * 256 + hh_ * 128 + RA[i_]] * (unsigned)(lda * 2) + CA2[i_]; \
        else of[hh_][i_] = (unsigned)((hh_ * HALF + RA[i_]) * lda) * 2u + CA2[i_]; } } while (0)
#define PG8_SA(b, h) (((b) * 2 + (h)) * HTB)
#define PG8_SB(b, h) ((4 + (b) * 2 + (h)) * HTB)
#define PG8_STAGE(bufoff, gbase, voff) do { _Pragma("unroll") for (int _i = 0; _i < 2; ++_i) \
        __builtin_amdgcn_global_load_lds((const unsigned*)((const char*)(gbase) + (voff)[_i]), (LAS unsigned*)(lds + (bufoff) + ldsw + _i * 8192), 16, 0, 0); } while (0)
#define PG8_LDA(dst, b, h) do { _Pragma("unroll") for (int m = 0; m < 4; ++m) _Pragma("unroll") for (int k = 0; k < 2; ++k) dst[m][k] = *(const LAS bf16x8*)(lds + PG8_SA(b, h) + aoff + m * 2048 + k * 1024); } while (0)
#define PG8_LDB(dst, b, h) do { _Pragma("unroll") for (int n = 0; n < 2; ++n) _Pragma("unroll") for (int k = 0; k < 2; ++k) dst[n][k] = *(const LAS bf16x8*)(lds + PG8_SB(b, h) + boff + n * 2048 + k * 1024); } while (0)
#define PG8_MMA(ai, bj, At, Bt) do { __builtin_amdgcn_s_setprio(1); _Pragma("unroll") for (int m = 0; m < 4; ++m) _Pragma("unroll") for (int n = 0; n < 2; ++n) _Pragma("unroll") for (int k = 0; k < 2; ++k) \
        acc[ai][bj][m][n] = __builtin_amdgcn_mfma_f32_16x16x32_bf16(Bt[n][k], At[m][k], acc[ai][bj][m][n], 0, 0, 0); __builtin_amdgcn_s_setprio(0); } while (0)
#define PG8_WAIT_V(n) asm volatile("s_waitcnt vmcnt(" #n ")" ::: "memory")
#define PG8_WAIT_L(n) asm volatile("s_waitcnt lgkmcnt(" #n ")" ::: "memory")
#define PG8_BAR __builtin_amdgcn_s_barrier()
#define PG8_SCHED __builtin_amdgcn_sched_barrier(0)
    GUnit cur, nxt; int ui = 0;
    if (!S.next(0, cur)) return;
    f32x4 acc[2][2][4][2];
#pragma unroll
    for (int a = 0; a < 2; ++a)
#pragma unroll
        for (int b = 0; b < 2; ++b)
#pragma unroll
            for (int m = 0; m < 4; ++m)
#pragma unroll
                for (int n = 0; n < 2; ++n) acc[a][b][m][n] = (f32x4){0.f, 0.f, 0.f, 0.f};
    bf16x8 At[4][2], B0[2][2], B1[2][2];
    unsigned ofc[2][2], ofn[2][2];
    PG8_AOFF(ofc, cur);
#pragma unroll
    for (int hh = 0; hh < 2; ++hh)
#pragma unroll
        for (int i = 0; i < 2; ++i) ofn[hh][i] = ofc[hh][i];
    const char* cA = cur.a; const char* cB = cur.b;
    PG8_STAGE(PG8_SB(0, 0), cB, voffB); PG8_STAGE(PG8_SB(0, 1), cB + hstepB, voffB); PG8_STAGE(PG8_SA(0, 0), cA, ofc[0]); PG8_STAGE(PG8_SA(0, 1), cA, ofc[1]);
    if (wr == 1) PG8_BAR;
    PG8_WAIT_V(2); PG8_BAR;
    PG8_STAGE(PG8_SB(1, 0), cB + kstep, voffB); PG8_STAGE(PG8_SA(1, 0), cA + kstep, ofc[0]); PG8_STAGE(PG8_SB(1, 1), cB + hstepB + kstep, voffB);
    PG8_WAIT_V(6); PG8_BAR;
    for (;;) {
        const bool has_next = S.next(ui + 1, nxt);
        const char* nA = has_next ? nxt.a : cA; const char* nB = has_next ? nxt.b : cB;
        for (int t = 0; t < nt; t += 2) {
            const bool last = (t == nt - 2);
            if constexpr (GATHER) { if (last && has_next) PG8_AOFF(ofn, nxt); }
            const char* a1 = cA + (size_t)(t + 1) * kstep;
            const char* a2 = last ? nA : cA + (size_t)(t + 2) * kstep; const char* b2 = last ? nB : cB + (size_t)(t + 2) * kstep;
            const char* a3 = a2 + kstep; const char* b3 = b2 + kstep;
            unsigned o2[2][2];
#pragma unroll
            for (int hh = 0; hh < 2; ++hh)
#pragma unroll
                for (int i = 0; i < 2; ++i) { if constexpr (GATHER) o2[hh][i] = last ? ofn[hh][i] : ofc[hh][i]; else o2[hh][i] = ofc[hh][i]; }
            PG8_LDB(B0, 0, 0); PG8_LDB(B1, 0, 1); PG8_SCHED; PG8_LDA(At, 0, 0); PG8_STAGE(PG8_SA(1, 1), a1, ofc[1]);
            PG8_WAIT_V(8); PG8_WAIT_L(0); PG8_BAR; PG8_MMA(0, 0, At, B0); PG8_MMA(0, 1, At, B1); PG8_BAR; PG8_SCHED;
            PG8_LDA(At, 0, 1); PG8_STAGE(PG8_SB(0, 0), b2, voffB); PG8_STAGE(PG8_SB(0, 1), b2 + hstepB, voffB); PG8_STAGE(PG8_SA(0, 0), a2, o2[0]);
            PG8_WAIT_V(8); PG8_WAIT_L(0); PG8_BAR; PG8_MMA(1, 0, At, B0); PG8_MMA(1, 1, At, B1); PG8_BAR; PG8_SCHED;
            PG8_LDB(B0, 1, 0); PG8_LDB(B1, 1, 1); PG8_SCHED; PG8_LDA(At, 1, 0); PG8_STAGE(PG8_SA(0, 1), a2, o2[1]);
            PG8_WAIT_V(8); PG8_WAIT_L(0); PG8_BAR; PG8_MMA(0, 0, At, B0); PG8_MMA(0, 1, At, B1); PG8_BAR; PG8_SCHED;
            PG8_LDA(At, 1, 1); PG8_STAGE(PG8_SB(1, 0), b3, voffB); PG8_STAGE(PG8_SB(1, 1), b3 + hstepB, voffB); PG8_STAGE(PG8_SA(1, 0), a3, o2[0]);
            PG8_WAIT_V(8); PG8_WAIT_L(0); PG8_BAR; PG8_MMA(1, 0, At, B0); PG8_MMA(1, 1, At, B1); PG8_BAR; PG8_SCHED;
        }
        if (wr == 0) PG8_BAR;
        E(acc, cur, wr, wc, fr, fq);
        if (!has_next) break;
#pragma unroll
        for (int a = 0; a < 2; ++a)
#pragma unroll
            for (int b = 0; b < 2; ++b)
#pragma unroll
                for (int m = 0; m < 4; ++m)
#pragma unroll
                    for (int n = 0; n < 2; ++n) acc[a][b][m][n] = (f32x4){0.f, 0.f, 0.f, 0.f};
        cur = nxt; cA = nA; cB = nB; ++ui;
        if constexpr (GATHER) {
#pragma unroll
            for (int hh = 0; hh < 2; ++hh)
#pragma unroll
                for (int i = 0; i < 2; ++i) ofc[hh][i] = ofn[hh][i];
        }
        if (wr == 1) PG8_BAR;
    }
    PG8_WAIT_V(0);
    PG8_BAR;
#undef PG8_AOFF
#undef PG8_SA
#undef PG8_SB
#undef PG8_STAGE
#undef PG8_LDA
#undef PG8_LDB
#undef PG8_MMA
#undef PG8_WAIT_V
#undef PG8_WAIT_L
#undef PG8_BAR
#undef PG8_SCHED
}
}
using pg8::GUnit;

struct SchedProj {
    const char* H; const char* WIN; const char* WPQ; int G, c;
    __device__ __forceinline__ bool next(int i, GUnit& u) const {
        const int L = i * G + c; if (L >= 480) return false;
        if (L < 416) { int pm, pn; pg8::dense_map(L, 32, 13, pm, pn); u.pm = pm; u.pn = pn; u.z = 0; u.a = H + (size_t)pm * 256 * 2048 * 2; u.b = WIN + (size_t)pn * 256 * 2048 * 2; }
        else { int pm, pn; pg8::dense_map(L - 416, 2, 32, pm, pn); u.pm = pm; u.pn = pn; u.z = 1; u.a = WPQ + (size_t)pm * 256 * 2048 * 2; u.b = H + (size_t)pn * 256 * 2048 * 2; }
        return true;
    }
};
struct SchedDft {
    const char* DFT; const char* XAT; int G, c;
    __device__ __forceinline__ bool next(int i, GUnit& u) const {
        const int L = i * G + c; if (L >= 256) return false;
        const int Lp = (L & 7) * 32 + (L >> 3);
        const int ks = Lp & 1, pn = (Lp >> 1) & 1, pm = (Lp >> 2) & 15, b = Lp >> 6;
        u.pm = b * 16 + pm; u.pn = pn; u.z = ks;
        u.a = DFT + ((size_t)pm * 256 * 2048 + ks * 1024) * 2; u.b = XAT + (((size_t)b * 512 + pn * 256) * 2048 + ks * 1024) * 2;
        return true;
    }
};
struct SchedDense {
    const char* A; const char* B; int nM, nN, K, G, c;
    __device__ __forceinline__ bool next(int i, GUnit& u) const {
        const int L = i * G + c; if (L >= nM * nN) return false;
        int pm, pn; pg8::dense_map(L, nM, nN, pm, pn); u.pm = pm; u.pn = pn; u.z = 0;
        u.a = A + (size_t)pm * 256 * K * 2; u.b = B + (size_t)pn * 256 * K * 2; return true;
    }
};
struct SchedMoeG {
    const char* A; const char* B; int K, G, c;
    __device__ __forceinline__ bool next(int i, GUnit& u) const {
        const int L = i * G + c; if (L >= 512) return false;
        const int Lp = (L & 7) * 64 + (L >> 3);
        const int e = Lp >> 5, r = Lp & 31, pm = r & 3, pn = r >> 2;
        u.pm = e * 4 + pm; u.pn = pn; u.z = e;
        u.a = A; u.b = B + ((size_t)e * 2048 + pn * 256) * K * 2; return true;
    }
};
struct SchedMoe {
    const char* A; const char* B; int K, G, c;
    __device__ __forceinline__ bool next(int i, GUnit& u) const {
        const int L = i * G + c; if (L >= 512) return false;
        const int Lp = (L & 7) * 64 + (L >> 3);
        const int e = Lp >> 5, r = Lp & 31, pm = r & 3, pn = r >> 2;
        u.pm = e * 4 + pm; u.pn = pn; u.z = e;
        u.a = A + ((size_t)e * 1024 + pm * 256) * K * 2; u.b = B + ((size_t)e * 2048 + pn * 256) * K * 2; return true;
    }
};

typedef f32x4 AccT[2][2][4][2];
struct EpiProj {
    static constexpr bool PERM = true;
    bf16_t* PROJ; bf16_t* PQT; const float* ropec; const float* ropes;
    __device__ __forceinline__ void operator()(const AccT& acc, const GUnit& u, int wr, int wc, int fr, int fq) const {
        if (u.z == 0) {
            const int pn = u.pn;
            const int row0 = u.pm * 256 + wr * 64 + fr;
#pragma unroll
            for (int ai = 0; ai < 2; ++ai)
#pragma unroll
                for (int m = 0; m < 4; ++m) {
                    const int row = row0 + ai * 128 + m * 16;
#pragma unroll
                    for (int bj = 0; bj < 2; ++bj) {
                        f32x4 v0 = acc[ai][bj][m][0], v1 = acc[ai][bj][m][1];
                        const int colt = pn * 256 + bj * 128;
                        if (pn < 4) {
#pragma unroll
                            for (int j = 0; j < 4; ++j) { v0[j] = gelu_tanh(v0[j]); v1[j] = gelu_tanh(v1[j]); }
                        } else {
                            const bool isq = (colt >= PC_QC && colt < PC_KC) || (colt >= PC_QD && colt < PC_KD);
                            const bool isk = (colt >= PC_KC && colt < PC_VC) || (colt >= PC_KD && colt < PC_VD);
                            if (isq || isk) {
                                if ((wc & 1) == 0) {
                                    f32x4 o0, o1;
#pragma unroll
                                    for (int j = 0; j < 4; ++j) { o0[j] = __shfl_xor(v0[j], 16); o1[j] = __shfl_xor(v1[j], 16); }
                                    if (fq < 2) {
                                        const f32x4 c0 = *(const f32x4*)(ropec + (size_t)row * 8), c1 = *(const f32x4*)(ropec + (size_t)row * 8 + 4);
                                        const f32x4 s0 = *(const f32x4*)(ropes + (size_t)row * 8), s1 = *(const f32x4*)(ropes + (size_t)row * 8 + 4);
                                        const float sg = fq == 0 ? -1.f : 1.f;
#pragma unroll
                                        for (int j = 0; j < 4; ++j) { v0[j] = v0[j] * c0[j] + sg * o0[j] * s0[j]; v1[j] = v1[j] * c1[j] + sg * o1[j] * s1[j]; }
                                    }
                                }
                                if (isq) { v0 = v0 * 0.125f; v1 = v1 * 0.125f; }
                            }
                        }
                        u32x4 w; w.x = pk2(v0[0], v0[1]); w.y = pk2(v0[2], v0[3]); w.z = pk2(v1[0], v1[1]); w.w = pk2(v1[2], v1[3]);
                        *(u32x4*)(PROJ + (size_t)row * NPROJ + colt + wc * 32 + 8 * fq) = w;
                    }
                }
        } else {
#pragma unroll
            for (int ai = 0; ai < 2; ++ai)
#pragma unroll
                for (int m = 0; m < 4; ++m) {
                    const int c = u.pm * 256 + ai * 128 + wr * 64 + m * 16 + fr;
#pragma unroll
                    for (int bj = 0; bj < 2; ++bj) {
                        const int t = u.pn * 256 + bj * 128 + wc * 32 + 8 * fq, b = t >> 11, s = t & 2047;
                        const f32x4 v0 = acc[ai][bj][m][0], v1 = acc[ai][bj][m][1];
                        u32x4 w; w.x = pk2(v0[0], v0[1]); w.y = pk2(v0[2], v0[3]); w.z = pk2(v1[0], v1[1]); w.w = pk2(v1[2], v1[3]);
                        *(u32x4*)(PQT + (((size_t)b * 512 + c) * 2048 + s)) = w;
                    }
                }
        }
    }
};
struct EpiBf16Plain {
    static constexpr bool PERM = true;
    bf16_t* O; int ldc; size_t zstride;
    __device__ __forceinline__ void operator()(const AccT& acc, const GUnit& u, int wr, int wc, int fr, int fq) const {
        bf16_t* base = O + (size_t)u.z * zstride;
#pragma unroll
        for (int ai = 0; ai < 2; ++ai)
#pragma unroll
            for (int m = 0; m < 4; ++m) {
                const int row = u.pm * 256 + ai * 128 + wr * 64 + m * 16 + fr;
#pragma unroll
                for (int bj = 0; bj < 2; ++bj) {
                    const f32x4 v0 = acc[ai][bj][m][0], v1 = acc[ai][bj][m][1];
                    u32x4 w; w.x = pk2(v0[0], v0[1]); w.y = pk2(v0[2], v0[3]); w.z = pk2(v1[0], v1[1]); w.w = pk2(v1[2], v1[3]);
                    *(u32x4*)(base + (size_t)row * ldc + u.pn * 256 + bj * 128 + wc * 32 + 8 * fq) = w;
                }
            }
    }
};
struct EpiWout {
    static constexpr bool PERM = true;
    const float* base32; const bf16_t* base16; bf16_t* X2; const float* gate;
    __device__ __forceinline__ void operator()(const AccT& acc, const GUnit& u, int wr, int wc, int fr, int fq) const {
        const int b = u.pm >> 3;
        const int col0 = u.pn * 256 + wc * 32 + 8 * fq;
        f32x4 g[2][2];
#pragma unroll
        for (int bj = 0; bj < 2; ++bj)
#pragma unroll
            for (int n = 0; n < 2; ++n) g[bj][n] = *(const f32x4*)(gate + (size_t)b * 12288 + col0 + bj * 128 + n * 4);
#pragma unroll
        for (int ai = 0; ai < 2; ++ai)
#pragma unroll
            for (int m = 0; m < 4; ++m) {
                const size_t ro = (size_t)(u.pm * 256 + ai * 128 + wr * 64 + m * 16 + fr) * DM + col0;
#pragma unroll
                for (int bj = 0; bj < 2; ++bj) {
                    f32x4 x0, x1;
                    if (base32) { x0 = *(const f32x4*)(base32 + ro + bj * 128); x1 = *(const f32x4*)(base32 + ro + bj * 128 + 4); }
                    else { const u32x4 w = *(const u32x4*)(base16 + ro + bj * 128); x0 = (f32x4){bflo(w.x), bfhi(w.x), bflo(w.y), bfhi(w.y)}; x1 = (f32x4){bflo(w.z), bfhi(w.z), bflo(w.w), bfhi(w.w)}; }
                    const f32x4 v0 = x0 + g[bj][0] * acc[ai][bj][m][0], v1 = x1 + g[bj][1] * acc[ai][bj][m][1];
                    u32x4 o; o.x = pk2(v0[0], v0[1]); o.y = pk2(v0[2], v0[3]); o.z = pk2(v1[0], v1[1]); o.w = pk2(v1[2], v1[3]);
                    *(u32x4*)(X2 + ro + bj * 128) = o;
                }
            }
    }
};
struct EpiGU {
    static constexpr bool PERM = true;
    bf16_t* ACT;
    __device__ __forceinline__ void operator()(const AccT& acc, const GUnit& u, int wr, int wc, int fr, int fq) const {
#pragma unroll
        for (int ai = 0; ai < 2; ++ai)
#pragma unroll
            for (int m = 0; m < 4; ++m) {
                const int row = u.pm * 256 + ai * 128 + wr * 64 + m * 16 + fr;
                f32x4 v0, v1;
#pragma unroll
                for (int j = 0; j < 4; ++j) { v0[j] = silu_f(acc[ai][0][m][0][j]) * acc[ai][1][m][0][j]; v1[j] = silu_f(acc[ai][0][m][1][j]) * acc[ai][1][m][1][j]; }
                u32x4 w; w.x = pk2(v0[0], v0[1]); w.y = pk2(v0[2], v0[3]); w.z = pk2(v1[0], v1[1]); w.w = pk2(v1[2], v1[3]);
                *(u32x4*)(ACT + (size_t)row * FF + u.pn * 128 + wc * 32 + 8 * fq) = w;
            }
    }
};
struct EpiDown {
    static constexpr bool PERM = true;
    bf16_t* EO; const float* gate;
    __device__ __forceinline__ void operator()(const AccT& acc, const GUnit& u, int wr, int wc, int fr, int fq) const {
#pragma unroll
        for (int ai = 0; ai < 2; ++ai)
#pragma unroll
            for (int m = 0; m < 4; ++m) {
                const int row = u.pm * 256 + ai * 128 + wr * 64 + m * 16 + fr;
                const float g = gate[row];
#pragma unroll
                for (int bj = 0; bj < 2; ++bj) {
                    const f32x4 v0 = acc[ai][bj][m][0] * g, v1 = acc[ai][bj][m][1] * g;
                    u32x4 w; w.x = pk2(v0[0], v0[1]); w.y = pk2(v0[2], v0[3]); w.z = pk2(v1[0], v1[1]); w.w = pk2(v1[2], v1[3]);
                    *(u32x4*)(EO + (size_t)row * DM + u.pn * 256 + bj * 128 + wc * 32 + 8 * fq) = w;
                }
            }
    }
};

__device__ __forceinline__ void ph_mod(const Params& p, LAS unsigned char* lds) {
    LAS float* sl = (LAS float*)lds;
    LAS float* red = (LAS float*)(lds + 32768);
    const int tid = opaque_tid();
    const float* c = p.in[1];
    float* mod = (float*)(p.ws + WS_MOD);
    for (int i = tid; i < 8192; i += 512) { const float v = c[i]; sl[i] = v / (1.f + expf(-v)); }
    __syncthreads();
    const int cl = tid & 31, ks = tid >> 5;
    for (int u = blockIdx.x; u < 192; u += gridDim.x) {
        const int l = u / 96, cc = u % 96;
        const float* W = p.in[3] + (size_t)l * 2048 * 12288 + cc * 128 + cl * 4;
        float acc[4][4];
#pragma unroll
        for (int b = 0; b < 4; ++b)
#pragma unroll
            for (int j = 0; j < 4; ++j) acc[b][j] = 0.f;
#pragma unroll 8
        for (int k = ks; k < 2048; k += 16) {
            const f32x4 w = __builtin_nontemporal_load((const f32x4*)(W + (size_t)k * 12288));
#pragma unroll
            for (int b = 0; b < 4; ++b) { const float s = sl[b * 2048 + k];
#pragma unroll
                for (int j = 0; j < 4; ++j) acc[b][j] += s * w[j]; }
        }
#pragma unroll
        for (int b = 0; b < 4; ++b)
#pragma unroll
            for (int j = 0; j < 4; ++j) red[((b * 4 + j) * 16 + ks) * 32 + cl] = acc[b][j];
        __syncthreads();
        { const int b = tid >> 7, col = tid & 127; float s = 0.f;
#pragma unroll
          for (int q = 0; q < 16; ++q) s += red[((b * 4 + (col & 3)) * 16 + q) * 32 + (col >> 2)];
          mod[(size_t)(l * 4 + b) * 12288 + cc * 128 + col] = s + p.in[4][(size_t)l * 12288 + cc * 128 + col]; }
        __syncthreads();
    }
}
__device__ __forceinline__ void ph_tables(const Params& p) {
    const int gt = blockIdx.x * 512 + opaque_tid(), ngt = gridDim.x * 512;
    float* rc = (float*)(p.ws + WS_ROPE); float* rs = rc + NT * 8;
    const int* pos = (const int*)p.in[2];
    for (int i = gt; i < NT * 8; i += ngt) {
        const int t = i >> 3, j = i & 7;
        float inv;
        switch (j) { case 0: inv = 1.0f; break; case 1: inv = 0.1939227432012558f; break; case 2: inv = 0.03760603070259094f; break; case 3: inv = 0.007292664609849453f; break;
                     case 4: inv = 0.0014142135623842478f; break; case 5: inv = 0.00027424818836152554f; break; case 6: inv = 5.318296098266728e-05f; break; default: inv = 1.0313386155758053e-05f; break; }
        const float ang = (float)pos[t] * inv;
        double r = (double)ang * 0.15915494309189535; r -= floor(r);
        const float a = (float)(2.0 * r);
        rc[i] = cospif(a); rs[i] = sinpif(a);
    }
    { bf16_t* sw = (bf16_t*)(p.ws + WS_SGUW);
      for (int i = gt; i < 2 * 8 * 128 * 128 / 4; i += ngt) { const f32x4 w = *(const f32x4*)(p.in[9] + (size_t)i * 4); u32x2 o; o.x = pk2(w[0], w[1]); o.y = pk2(w[2], w[3]); *(u32x2*)(sw + (size_t)i * 4) = o; } }
    { bf16_t* wrt = (bf16_t*)(p.ws + WS_WRT);
      for (int i = gt; i < 2 * 16 * 2048; i += ngt) { const int l = i >> 15, e = (i >> 11) & 15, k = i & 2047; wrt[i] = (bf16_t)(pk2(p.in[15][((size_t)l * 2048 + k) * 16 + e], 0.f) & 0xffffu); } }
    { bf16_t* abt = (bf16_t*)(p.ws + WS_ABT);
      for (int i = gt; i < 2 * 8 * 64 * 128; i += ngt) { const int k = i & 127, d = (i >> 7) & 63, lh = i >> 13, c = k & 63; const float* fw = p.in[7] + (size_t)lh * 4096;
          float sacc = 0.f;
          for (int cp = 0; cp < 64; ++cp) { const float a = (float)((c * cp) & 63) * (1.f / 32.f); sacc += ((k < 64) ? cospif(a) : sinpif(a)) * fw[cp * 64 + d]; }
          abt[i] = (bf16_t)(pk2(sacc * 0.125f, 0.f) & 0xffffu); } }
    bf16_t* dft = (bf16_t*)(p.ws + WS_DFT);
    for (int i = gt; i < 2048 * 512; i += ngt) {
        const int sp = i >> 9, k8 = (i & 511) * 8;
        float v[8];
#pragma unroll
        for (int e = 0; e < 8; ++e) { const int k = k8 + e, part = k >> 11, s = k & 2047, m = (s * sp) & 2047; const float a = (float)m * (1.f / 1024.f);
            v[e] = (part ? -sinpif(a) : cospif(a)) * 0.022097086912079608f; }
        u32x4 w; w.x = pk2(v[0], v[1]); w.y = pk2(v[2], v[3]); w.z = pk2(v[4], v[5]); w.w = pk2(v[6], v[7]);
        *(u32x4*)(dft + (size_t)sp * 4096 + k8) = w;
    }
}
struct TDesc { const float* src; bf16_t* dst; const float* ksc; int lds_, ldd; };
__device__ __forceinline__ bool tdecode(const Params& p, int it, TDesc& d) {
    if (it >= 2 * 6880) return false;
    const int l = it / 6880; int r = it % 6880;
    d.ksc = nullptr;
    if (r < 480) { const int kt = r / 30, nt = r % 30;
        d.src = p.in[6] + ((size_t)l * 2048 + kt * 128) * DIN + nt * 128; d.lds_ = DIN;
        d.dst = (nt < 4 ? (bf16_t*)(p.ws + WS_WPQ) + ((size_t)l * 512 + nt * 128) * 2048 : (bf16_t*)(p.ws + WS_WIN) + ((size_t)l * NPROJ + (nt - 4) * 128) * 2048) + kt * 128; d.ldd = 2048; return true; }
    r -= 480;
    if (r < 256) { const int kt = r / 16, nt = r % 16;
        d.src = p.in[13] + ((size_t)l * 2048 + kt * 128) * 2048 + nt * 128; d.lds_ = 2048; d.ksc = p.in[12] + (size_t)l * 2048 + kt * 128;
        d.dst = (bf16_t*)(p.ws + WS_WOUT) + ((size_t)l * 2048 + nt * 128) * 2048 + kt * 128; d.ldd = 2048; return true; }
    r -= 256;
    if (r < 4096) { const int isup = r / 2048, r2 = r % 2048, e = r2 / 128, kt = (r2 % 128) / 8, nt = r2 % 8;
        d.src = p.in[isup ? 17 : 16] + (((size_t)l * 16 + e) * 2048 + kt * 128) * 1024 + nt * 128; d.lds_ = 1024;
        d.dst = (bf16_t*)(p.ws + WS_WGU) + (((size_t)l * 16 + e) * 2048 + nt * 256 + isup * 128) * 2048 + kt * 128; d.ldd = 2048; return true; }
    r -= 4096;
    { const int e = r / 128, kt = (r % 128) / 16, nt = r % 16;
        d.src = p.in[18] + (((size_t)l * 16 + e) * 1024 + kt * 128) * 2048 + nt * 128; d.lds_ = 2048;
        d.dst = (bf16_t*)(p.ws + WS_WD) + (((size_t)l * 16 + e) * 2048 + nt * 128) * 1024 + kt * 128; d.ldd = 1024; return true; }
}
__device__ __forceinline__ void ph_weights(const Params& p, LAS unsigned char* lds, const int p0, const int p1, const int wi, const int wn) {
    const int tid = opaque_tid();
    LAS unsigned* l32 = (LAS unsigned*)lds;
    LAS bf16_t* l16 = (LAS bf16_t*)lds;
    TDesc dA0, dA1, dB0, dB1; f32x4 a0[8], a1[8], b0[8], b1[8];
#define PW_LOAD(pi, D0, D1, V0, V1, HAVE) do { HAVE = (pi) < p1; if (HAVE) { tdecode(p, 2 * (pi), D0); tdecode(p, 2 * (pi) + 1, D1); \
        _Pragma("unroll") for (int i = 0; i < 8; ++i) { const int f = tid + 512 * i, k = f >> 5, c4 = f & 31; \
            V0[i] = __builtin_nontemporal_load((const f32x4*)(D0.src + (size_t)k * D0.lds_ + c4 * 4)); V1[i] = __builtin_nontemporal_load((const f32x4*)(D1.src + (size_t)k * D1.lds_ + c4 * 4)); } } } while (0)
#define PW_TOLDS(D0, V0, V1) do { _Pragma("unroll") for (int i = 0; i < 8; ++i) { const int f = tid + 512 * i, k = f >> 5, c4 = f & 31; const float sc = D0.ksc ? D0.ksc[k] : 1.f; \
        const int sw = ((k >> 3) & 15) * 2; u32x2 w; w.x = pk2(V0[i][0] * sc, V0[i][1] * sc); w.y = pk2(V0[i][2] * sc, V0[i][3] * sc); \
        *(LAS u32x2*)(l32 + k * 64 + ((2 * c4) ^ sw)) = w; \
        u32x2 w2; w2.x = pk2(V1[i][0] * sc, V1[i][1] * sc); w2.y = pk2(V1[i][2] * sc, V1[i][3] * sc); \
        *(LAS u32x2*)(l32 + 8192 + k * 64 + ((2 * c4) ^ sw)) = w2; } } while (0)
#define PW_STORE(DS0, DS1) do { _Pragma("unroll") for (int i = 0; i < 4; ++i) { \
        const int n = (tid >> 4) + 32 * i, kc = tid & 15, cd = (n >> 1) ^ (2 * kc), hf = n & 1; \
        unsigned short e[8], g[8]; \
        _Pragma("unroll") for (int q = 0; q < 8; ++q) { e[q] = l16[((8 * kc + q) * 64 + cd) * 2 + hf]; g[q] = l16[16384 + ((8 * kc + q) * 64 + cd) * 2 + hf]; } \
        u32x4 w; w.x = e[0] | ((unsigned)e[1] << 16); w.y = e[2] | ((unsigned)e[3] << 16); w.z = e[4] | ((unsigned)e[5] << 16); w.w = e[6] | ((unsigned)e[7] << 16); \
        __builtin_nontemporal_store(w, (u32x4*)(DS0.dst + (size_t)n * DS0.ldd + 8 * kc)); \
        u32x4 w2; w2.x = g[0] | ((unsigned)g[1] << 16); w2.y = g[2] | ((unsigned)g[3] << 16); w2.z = g[4] | ((unsigned)g[5] << 16); w2.w = g[6] | ((unsigned)g[7] << 16); \
        __builtin_nontemporal_store(w2, (u32x4*)(DS1.dst + (size_t)n * DS1.ldd + 8 * kc)); } } while (0)
    int pi = p0 + wi; bool hA, hB;
    PW_LOAD(pi, dA0, dA1, a0, a1, hA);
    PW_LOAD(pi + wn, dB0, dB1, b0, b1, hB);
    while (hA) {
        { PW_TOLDS(dA0, a0, a1); __syncthreads(); const TDesc s0 = dA0, s1 = dA1; PW_LOAD(pi + 2 * wn, dA0, dA1, a0, a1, hA); PW_STORE(s0, s1); __syncthreads(); }
        if (!hB) break;
        { PW_TOLDS(dB0, b0, b1); __syncthreads(); const TDesc s0 = dB0, s1 = dB1; PW_LOAD(pi + 3 * wn, dB0, dB1, b0, b1, hB); PW_STORE(s0, s1); __syncthreads(); }
        pi += 2 * wn;
    }
#undef PW_LOAD
#undef PW_TOLDS
#undef PW_STORE
}

__device__ __forceinline__ void ph_norm1(const Params& p, int mode) {
    const int tid = opaque_tid(), lane = tid & 63, wv = tid >> 6;
    const float* mod = (const float*)(p.ws + WS_MOD);
    const int* slot_of = (const int*)(p.ws + WS_IDX + 131072);
    const bf16_t* EO = (const bf16_t*)(p.ws + WS_EO);
    for (int t = blockIdx.x * 8 + wv; t < NT; t += gridDim.x * 8) {
        const int b = t >> 11;
        f32x4 v[8];
        if (mode == 0) { const float* xr = p.in[0] + (size_t)t * DM;
#pragma unroll
            for (int j = 0; j < 8; ++j) v[j] = *(const f32x4*)(xr + 4 * lane + 256 * j);
        } else { const bf16_t* xr = (const bf16_t*)(p.ws + WS_X2) + (size_t)t * DM;
#pragma unroll
            for (int j = 0; j < 8; ++j) { const u32x2 w = *(const u32x2*)(xr + 4 * lane + 256 * j); v[j] = (f32x4){bflo(w.x), bfhi(w.x), bflo(w.y), bfhi(w.y)}; }
        }
        if (mode != 0) {
            f32x4 macc[8];
#pragma unroll
            for (int j = 0; j < 8; ++j) macc[j] = (f32x4){0.f, 0.f, 0.f, 0.f};
            const int myslot = slot_of[(size_t)(lane & 15) * NT + t];
            unsigned m = (unsigned)(__ballot(myslot >= 0) & 0xffffull);
            while (m) {
                const int e0 = __builtin_ctz(m); m &= m - 1u;
                const bool two = m != 0u; const int e1 = two ? __builtin_ctz(m) : e0; if (two) m &= m - 1u;
                const int s0 = __builtin_amdgcn_readlane(myslot, e0), s1 = __builtin_amdgcn_readlane(myslot, e1);
                const float w1 = two ? 1.f : 0.f;
                const bf16_t* r0 = EO + (size_t)s0 * DM; const bf16_t* r1 = EO + (size_t)s1 * DM;
                u32x2 a[8], c[8];
#pragma unroll
                for (int j = 0; j < 8; ++j) { a[j] = *(const u32x2*)(r0 + 4 * lane + 256 * j); c[j] = *(const u32x2*)(r1 + 4 * lane + 256 * j); }
#pragma unroll
                for (int j = 0; j < 8; ++j) {
                    macc[j][0] += bflo(a[j].x) + w1 * bflo(c[j].x); macc[j][1] += bfhi(a[j].x) + w1 * bfhi(c[j].x);
                    macc[j][2] += bflo(a[j].y) + w1 * bflo(c[j].y); macc[j][3] += bfhi(a[j].y) + w1 * bfhi(c[j].y); }
            }
            const float* gf = mod + ((size_t)(mode - 1) * 4 + b) * 12288 + 5 * 2048;
#pragma unroll
            for (int j = 0; j < 8; ++j) { const f32x4 g = *(const f32x4*)(gf + 4 * lane + 256 * j); v[j] = v[j] + g * macc[j]; }
            if (mode == 1) {
                bf16_t* xo = (bf16_t*)(p.ws + WS_X) + (size_t)t * DM;
#pragma unroll
                for (int j = 0; j < 8; ++j) { u32x2 w; w.x = pk2(v[j][0], v[j][1]); w.y = pk2(v[j][2], v[j][3]); *(u32x2*)(xo + 4 * lane + 256 * j) = w;
                    v[j] = (f32x4){bflo(w.x), bfhi(w.x), bflo(w.y), bfhi(w.y)}; }
            }
        }
        float ss = 0.f;
#pragma unroll
        for (int j = 0; j < 8; ++j) ss += v[j][0] * v[j][0] + v[j][1] * v[j][1] + v[j][2] * v[j][2] + v[j][3] * v[j][3];
        const float r = 1.0f / sqrtf(wave_sum(ss) * (1.f / DM) + EPS);
        if (mode == 2) {
            float* o = p.out + (size_t)t * DM;
#pragma unroll
            for (int j = 0; j < 8; ++j) { const f32x4 g = *(const f32x4*)(p.in[19] + 4 * lane + 256 * j); *(f32x4*)(o + 4 * lane + 256 * j) = v[j] * r * g; }
        } else {
            const int l = mode;
            const float* g1 = p.in[5] + (size_t)l * DM;
            const float* sh = mod + ((size_t)l * 4 + b) * 12288;
            const float* sc = sh + 2048;
            bf16_t* ho = (bf16_t*)(p.ws + WS_H) + (size_t)t * DM;
#pragma unroll
            for (int j = 0; j < 8; ++j) {
                const f32x4 g = *(const f32x4*)(g1 + 4 * lane + 256 * j), s1 = *(const f32x4*)(sc + 4 * lane + 256 * j), s0 = *(const f32x4*)(sh + 4 * lane + 256 * j);
                const f32x4 h = (v[j] * r * g) * (s1 + 1.f) + s0;
                u32x2 w; w.x = pk2(h[0], h[1]); w.y = pk2(h[2], h[3]);
                *(u32x2*)(ho + 4 * lane + 256 * j) = w;
            }
        }
    }
}


__device__ __forceinline__ void ph_norm2_router_mfma(const Params& p, int l, LAS unsigned char* lds) {
    const int tid = opaque_tid(), lane = tid & 63, wv = tid >> 6, r = lane & 31, h = lane >> 5;
    LAS float* part = (LAS float*)lds;
    LAS float* lgs = (LAS float*)(lds + 8 * 32 * 17 * 4);
    const float* mod = (const float*)(p.ws + WS_MOD);
    const float* g2 = p.in[14] + (size_t)l * DM;
    const bf16_t* WRT = (const bf16_t*)(p.ws + WS_WRT) + (size_t)l * 16 * 2048;
    bf16_t* Hb = (bf16_t*)(p.ws + WS_H);
    float* aff = (float*)(p.ws + WS_AFF);
    for (int blk = blockIdx.x; blk < NT / 32; blk += gridDim.x) {
        const int t0 = blk * 32, b = t0 >> 11;
        const float* sh = mod + ((size_t)l * 4 + b) * 12288 + 3 * 2048;
        const float* sc = sh + 2048;
#pragma unroll 1
        for (int half = 0; half < 2; ++half) {
            const int ta = t0 + 4 * wv + 2 * half;
            const bf16_t* xa = (const bf16_t*)(p.ws + WS_X2) + (size_t)ta * DM;
            f32x4 va[8], vb[8];
#pragma unroll
            for (int j = 0; j < 8; ++j) { const u32x2 wa = *(const u32x2*)(xa + 4 * lane + 256 * j), wb = *(const u32x2*)(xa + DM + 4 * lane + 256 * j);
                va[j] = (f32x4){bflo(wa.x), bfhi(wa.x), bflo(wa.y), bfhi(wa.y)}; vb[j] = (f32x4){bflo(wb.x), bfhi(wb.x), bflo(wb.y), bfhi(wb.y)}; }
            float sa = 0.f, sb = 0.f;
#pragma unroll
            for (int j = 0; j < 8; ++j) { sa += va[j][0] * va[j][0] + va[j][1] * va[j][1] + va[j][2] * va[j][2] + va[j][3] * va[j][3]; sb += vb[j][0] * vb[j][0] + vb[j][1] * vb[j][1] + vb[j][2] * vb[j][2] + vb[j][3] * vb[j][3]; }
#pragma unroll
            for (int o = 1; o < 64; o <<= 1) { sa += __shfl_xor(sa, o); sb += __shfl_xor(sb, o); }
            const float ra = 1.0f / sqrtf(sa * (1.f / DM) + EPS), rb = 1.0f / sqrtf(sb * (1.f / DM) + EPS);
            bf16_t* ho = Hb + (size_t)ta * DM;
#pragma unroll
            for (int j = 0; j < 8; ++j) {
                const f32x4 g = *(const f32x4*)(g2 + 4 * lane + 256 * j), s1 = *(const f32x4*)(sc + 4 * lane + 256 * j), s0 = *(const f32x4*)(sh + 4 * lane + 256 * j);
                const f32x4 gg = g * (s1 + 1.f);
                const f32x4 ha = (va[j] * ra) * gg + s0, hb = (vb[j] * rb) * gg + s0;
                u32x2 wa; wa.x = pk2(ha[0], ha[1]); wa.y = pk2(ha[2], ha[3]);
                u32x2 wb; wb.x = pk2(hb[0], hb[1]); wb.y = pk2(hb[2], hb[3]);
                *(u32x2*)(ho + 4 * lane + 256 * j) = wa; *(u32x2*)(ho + DM + 4 * lane + 256 * j) = wb;
            }
        }
        asm volatile("s_waitcnt vmcnt(0)" ::: "memory");
        __syncthreads();
        {
            f32x16 acc;
#pragma unroll
            for (int q = 0; q < 16; ++q) acc[q] = 0.f;
            const bf16_t* bp = Hb + (size_t)(t0 + r) * DM + 256 * wv + 8 * h;
            const bf16_t* ap = WRT + (size_t)(r & 15) * 2048 + 256 * wv + 8 * h;
            bf16x8 bfr[16], afr[16];
#pragma unroll
            for (int s = 0; s < 16; ++s) { bfr[s] = *(const bf16x8*)(bp + 16 * s); afr[s] = *(const bf16x8*)(ap + 16 * s); }
#pragma unroll
            for (int s = 0; s < 16; ++s) { const bf16x8 a = (r < 16) ? afr[s] : (bf16x8){0, 0, 0, 0, 0, 0, 0, 0}; acc = __builtin_amdgcn_mfma_f32_32x32x16_bf16(a, bfr[s], acc, 0, 0, 0); }
#pragma unroll
            for (int q = 0; q < 8; ++q) { const int e = (q & 3) + 8 * (q >> 2) + 4 * h; part[(wv * 32 + r) * 17 + e] = acc[q]; }
        }
        __syncthreads();
        const int e = tid >> 5, tk = tid & 31;
        { float s = 0.f;
#pragma unroll
          for (int w = 0; w < 8; ++w) s += part[(w * 32 + tk) * 17 + e];
          lgs[e * 32 + tk] = s; }
        __syncthreads();
        { float lg[16]; float mx = -1e30f;
#pragma unroll
          for (int q = 0; q < 16; ++q) { lg[q] = lgs[q * 32 + tk]; mx = fmaxf(mx, lg[q]); }
          float den = 0.f, mine = 0.f;
#pragma unroll
          for (int q = 0; q < 16; ++q) { const float ex = expf(lg[q] - mx); den += ex; mine = (q == e) ? ex : mine; }
          aff[((size_t)b * 16 + e) * 2048 + (t0 & 2047) + tk] = mine / den; }
        __syncthreads();
    }
}

__device__ __forceinline__ unsigned block_excl_scan(unsigned cnt, LAS unsigned* wsum, int tid) {
    const int lane = tid & 63, wv = tid >> 6;
    unsigned inc = cnt;
#pragma unroll
    for (int o = 1; o < 64; o <<= 1) { const unsigned t = __shfl_up(inc, o); if (lane >= o) inc += t; }
    if (lane == 63) wsum[wv] = inc;
    __syncthreads();
    unsigned base = 0;
#pragma unroll
    for (int w = 0; w < 8; ++w) base += (w < wv) ? wsum[w] : 0u;
    __syncthreads();
    return base + inc - cnt;
}
__device__ __forceinline__ void ph_topk(const Params& p, LAS unsigned char* lds) {
    const int tid = opaque_tid();
    LAS unsigned* hist = (LAS unsigned*)lds;
    LAS unsigned* misc = hist + 256;
    LAS unsigned* wsum = hist + 320;
    const float* aff = (const float*)(p.ws + WS_AFF);
    int* idx = (int*)(p.ws + WS_IDX); float* gate = (float*)(p.ws + WS_IDX + 65536); int* slot_of = (int*)(p.ws + WS_IDX + 131072);
    for (int u = blockIdx.x; u < 64; u += gridDim.x) {
        const int b = u >> 4, e = u & 15;
        const f32x4 a = *(const f32x4*)(aff + (size_t)u * 2048 + 4 * tid);
        unsigned k[4];
#pragma unroll
        for (int i = 0; i < 4; ++i) k[i] = __float_as_uint(a[i]);
        unsigned prefix = 0, krem = CAP;
#pragma unroll 1
        for (int pass = 0; pass < 4; ++pass) {
            const int shift = 24 - 8 * pass;
            if (tid < 256) hist[tid] = 0;
            __syncthreads();
#pragma unroll
            for (int i = 0; i < 4; ++i) if (pass == 0 || (k[i] >> (shift + 8)) == prefix) __hip_atomic_fetch_add(&hist[(k[i] >> shift) & 255u], 1u, __ATOMIC_RELAXED, __HIP_MEMORY_SCOPE_WORKGROUP);
            __syncthreads();
            { const unsigned cnt = (tid < 256) ? hist[255 - tid] : 0u;
              const unsigned Sn = block_excl_scan(cnt, wsum, tid), S = Sn + cnt;
              if (tid < 256 && S >= krem && Sn < krem) { misc[0] = (prefix << 8) | (unsigned)(255 - tid); misc[1] = krem - Sn; } }
            __syncthreads();
            prefix = misc[0]; krem = misc[1];
            __syncthreads();
        }
        unsigned neq = 0;
#pragma unroll
        for (int i = 0; i < 4; ++i) neq += (k[i] == prefix) ? 1u : 0u;
        unsigned eqbase = block_excl_scan(neq, wsum, tid);
        unsigned sel[4]; unsigned nsel = 0;
#pragma unroll
        for (int i = 0; i < 4; ++i) { const bool eq = k[i] == prefix; sel[i] = (k[i] > prefix || (eq && eqbase < krem)) ? 1u : 0u; eqbase += eq ? 1u : 0u; nsel += sel[i]; }
        unsigned sb = block_excl_scan(nsel, wsum, tid);
#pragma unroll
        for (int i = 0; i < 4; ++i) {
            const int s = 4 * tid + i, t = b * 2048 + s;
            if (sel[i]) { const int row = e * 1024 + b * 256 + (int)sb; idx[row] = t; gate[row] = a[i]; slot_of[(size_t)e * NT + t] = row; ++sb; }
            else slot_of[(size_t)e * NT + t] = -1;
        }
        __syncthreads();
    }
}

__device__ __forceinline__ bf16x8 pack8(float a0, float a1, float a2, float a3, float a4, float a5, float a6, float a7) {
    u32x4 p;
    asm volatile("v_cvt_pk_bf16_f32 %0, %4, %5\n\tv_cvt_pk_bf16_f32 %1, %6, %7\n\tv_cvt_pk_bf16_f32 %2, %8, %9\n\tv_cvt_pk_bf16_f32 %3, %10, %11\n\ts_nop 1"
                 : "=&v"(p[0]), "=&v"(p[1]), "=&v"(p[2]), "=&v"(p[3]) : "v"(a0), "v"(a1), "v"(a2), "v"(a3), "v"(a4), "v"(a5), "v"(a6), "v"(a7));
    return __builtin_bit_cast(bf16x8, p);
}
template <int CH>
__device__ __forceinline__ void attn_prefetch(const bf16_t* qp, const bf16_t* kb, const size_t kst, const int lk0, const int ls, const int r, bf16x8 (&qf)[4], bf16x8 (&kf0)[CH][4]) {
#pragma unroll
    for (int s = 0; s < 4; ++s) qf[s] = *(const bf16x8*)(qp + 16 * s);
#pragma unroll
    for (int i = 0; i < CH; ++i) {
        int lkr = lk0 + 32 * i + r; lkr = lkr < 0 ? 0 : (lkr >= ls ? ls - 1 : lkr);
        const bf16_t* kp = kb + (size_t)lkr * kst;
#pragma unroll
        for (int s = 0; s < 4; ++s) kf0[i][s] = *(const bf16x8*)(kp + 16 * s);
    }
}
template <int NTILES, int CH>
__device__ __forceinline__ void attn_wave(const bf16x8 (&qf)[4], const bf16x8 (&kf0)[CH][4], const bf16_t* kb, const size_t kst, const int lk0, const int ls, const LAS bf16_t* vt, const int vts,
                                          float m_run, float l_run, f32x16& O0, f32x16& O1, float& m_out, float& l_out, const int r, const int h) {
#pragma unroll
    for (int i = 0; i < 16; ++i) { O0[i] = 0.f; O1[i] = 0.f; }
#pragma unroll
    for (int c0 = 0; c0 < NTILES; c0 += CH) {
        constexpr int dummy = 0; (void)dummy;
        f32x16 S[CH];
#pragma unroll
        for (int ii = 0; ii < CH; ++ii) {
            const int i = c0 + ii;
            if (i < NTILES) {
                int lkr = lk0 + 32 * i + r; lkr = lkr < 0 ? 0 : (lkr >= ls ? ls - 1 : lkr);
                const bf16_t* kp = kb + (size_t)lkr * kst;
                f32x16 a;
#pragma unroll
                for (int q = 0; q < 16; ++q) a[q] = 0.f;
#pragma unroll
                for (int s = 0; s < 4; ++s) {
                    bf16x8 kf;
                    if (c0 == 0) kf = kf0[ii][s]; else kf = *(const bf16x8*)(kp + 16 * s);
                    a = __builtin_amdgcn_mfma_f32_32x32x16_bf16(kf, qf[s], a, 0, 0, 0);
                }
                S[ii] = a;
            }
        }
        float mx = m_run;
#pragma unroll
        for (int ii = 0; ii < CH; ++ii) {
            const int i = c0 + ii;
            if (i < NTILES) {
                const bool edge = (lk0 + 32 * i < 0) || (lk0 + 32 * i + 32 > ls);
                if (edge || i == 0 || i == NTILES - 1) {
#pragma unroll
                    for (int q = 0; q < 16; ++q) {
                        const int row = (q & 3) + 8 * (q >> 2) + 4 * h;
                        const int lk = lk0 + 32 * i + row;
                        bool valid = (lk >= 0) && (lk < ls);
                        if (i == 0) valid = valid && (row >= r);
                        if (i == NTILES - 1) valid = valid && (row <= r);
                        const float sv = valid ? S[ii][q] : -1e30f;
                        S[ii][q] = sv;
                        mx = fmaxf(mx, sv);
                    }
                } else {
#pragma unroll
                    for (int q = 0; q < 16; ++q) mx = fmaxf(mx, S[ii][q]);
                }
            }
        }
        mx = fmaxf(mx, __shfl_xor(mx, 32));
        const float corr = __builtin_amdgcn_exp2f((m_run - mx) * 1.442695041f);
        float psum = 0.f;
#pragma unroll
        for (int ii = 0; ii < CH; ++ii) {
            const int i = c0 + ii;
            if (i < NTILES) {
#pragma unroll
                for (int q = 0; q < 16; ++q) { const float pv = __builtin_amdgcn_exp2f((S[ii][q] - mx) * 1.442695041f); S[ii][q] = pv; psum += pv; }
            }
        }
        psum += __shfl_xor(psum, 32);
        l_run = l_run * corr + psum;
        m_run = mx;
        if (c0 > 0) {
#pragma unroll
            for (int q = 0; q < 16; ++q) { O0[q] *= corr; O1[q] *= corr; }
        } else __syncthreads();
#pragma unroll
        for (int ii = 0; ii < CH; ++ii) {
            const int i = c0 + ii;
            if (i < NTILES) {
#pragma unroll
                for (int sp = 0; sp < 2; ++sp) {
                    const bf16x8 pf = pack8(S[ii][8 * sp + 0], S[ii][8 * sp + 1], S[ii][8 * sp + 2], S[ii][8 * sp + 3], S[ii][8 * sp + 4], S[ii][8 * sp + 5], S[ii][8 * sp + 6], S[ii][8 * sp + 7]);
                    const LAS bf16_t* v0 = vt + 32 * i + 16 * sp;
                    { const u32x2 a0 = *(const LAS u32x2*)(v0), a1 = *(const LAS u32x2*)(v0 + 8);
                      const u32x4 vw = (u32x4){a0.x, a0.y, a1.x, a1.y};
                      O0 = __builtin_amdgcn_mfma_f32_32x32x16_bf16(__builtin_bit_cast(bf16x8, vw), pf, O0, 0, 0, 0); }
                    { const u32x2 a0 = *(const LAS u32x2*)(v0 + 32 * vts), a1 = *(const LAS u32x2*)(v0 + 32 * vts + 8);
                      const u32x4 vw = (u32x4){a0.x, a0.y, a1.x, a1.y};
                      O1 = __builtin_amdgcn_mfma_f32_32x32x16_bf16(__builtin_bit_cast(bf16x8, vw), pf, O1, 0, 0, 0); }
                }
            }
        }
    }
    m_out = m_run; l_out = l_run;
}
__device__ __forceinline__ void ph_dilated_mfma(const Params& p, LAS unsigned char* lds) {
    const int tid = opaque_tid(), lane = tid & 63, wv = tid >> 6, hw = wv >> 2, w4 = wv & 3, tl = tid & 255, r = lane & 31, h = lane >> 5;
    constexpr int VTS = 260;
    LAS bf16_t* Vt = (LAS bf16_t*)lds + hw * (64 * VTS);
    LAS unsigned* Vt32 = (LAS unsigned*)Vt;
    const bf16_t* PROJ = (const bf16_t*)(p.ws + WS_PROJ);
    int ufirst, ucount, ustep;
    if (gridDim.x == 256) { if (blockIdx.x < 128) { ufirst = blockIdx.x * 2; ucount = 2; } else { ufirst = 256 + (blockIdx.x - 128) * 4; ucount = 4; } ustep = 1; }
    else { ufirst = blockIdx.x; ustep = gridDim.x; ucount = (768 - (int)blockIdx.x + (int)gridDim.x - 1) / (int)gridDim.x; }
    for (int ui = 0; ui < ucount; ++ui) {
        const int u = ufirst + ui * ustep;
        const int cfg = u >> 8, r8 = u & 255, b = r8 >> 6, head = (r8 >> 3) & 7, blk = (r8 & 7) * 2 + hw;
        const int dsh = 2 * cfg, dil = 1 << dsh, ls = SEQ >> dsh, nblk = ls >> 7;
        const int res = blk / nblk, l0 = (blk % nblk) * 128;
        const bf16_t* base = PROJ + ((size_t)b * SEQ + res) * NPROJ;
        const size_t kst = (size_t)dil * NPROJ;
        u32x4 va[4], vb[4];
#pragma unroll
        for (int i = 0; i < 4; ++i) {
            const int task = tl + 256 * i, kp = task & 127, dc = task >> 7;
            int lkA = l0 - 64 + 2 * kp; lkA = lkA < 0 ? 0 : (lkA > ls - 2 ? ls - 2 : lkA);
            va[i] = *(const u32x4*)(base + (size_t)lkA * kst + PC_VD + head * 64 + 8 * dc);
            vb[i] = *(const u32x4*)(base + (size_t)(lkA + 1) * kst + PC_VD + head * 64 + 8 * dc);
        }
        const int lq = l0 + 32 * w4 + r;
        const int lk0 = l0 + 32 * w4 - 64;
        const bf16_t* kb = base + PC_KD + head * 64 + 8 * h;
        bf16x8 qf[4], kf0[5][4];
        attn_prefetch<5>(base + (size_t)lq * kst + PC_QD + head * 64 + 8 * h, kb, kst, lk0, ls, r, qf, kf0);
#pragma unroll
        for (int i = 0; i < 4; ++i) {
            const int task = tl + 256 * i, kp = task & 127, dc = task >> 7;
            LAS unsigned* o = Vt32 + (8 * dc) * (VTS / 2) + kp;
            o[0 * (VTS / 2)] = (va[i].x & 0xffffu) | (vb[i].x << 16); o[1 * (VTS / 2)] = (va[i].x >> 16) | (vb[i].x & 0xffff0000u);
            o[2 * (VTS / 2)] = (va[i].y & 0xffffu) | (vb[i].y << 16); o[3 * (VTS / 2)] = (va[i].y >> 16) | (vb[i].y & 0xffff0000u);
            o[4 * (VTS / 2)] = (va[i].z & 0xffffu) | (vb[i].z << 16); o[5 * (VTS / 2)] = (va[i].z >> 16) | (vb[i].z & 0xffff0000u);
            o[6 * (VTS / 2)] = (va[i].w & 0xffffu) | (vb[i].w << 16); o[7 * (VTS / 2)] = (va[i].w >> 16) | (vb[i].w & 0xffff0000u);
        }
        {
            const LAS bf16_t* vt = Vt + r * VTS + 32 * w4 + 4 * h;
            f32x16 O0, O1; float m, l;
            attn_wave<5, 5>(qf, kf0, kb, kst, lk0, ls, vt, VTS, -1e30f, 0.f, O0, O1, m, l, r, h);
            const float inv = 1.f / l;
            const size_t tq = (size_t)b * SEQ + (size_t)lq * dil + res;
            bf16_t* o = (bf16_t*)(p.ws + WS_YD) + ((size_t)cfg * NT + tq) * 512 + head * 64 + 4 * h;
#pragma unroll
            for (int g = 0; g < 4; ++g) {
                u32x2 w0; w0.x = pk2(O0[4 * g] * inv, O0[4 * g + 1] * inv); w0.y = pk2(O0[4 * g + 2] * inv, O0[4 * g + 3] * inv);
                u32x2 w1; w1.x = pk2(O1[4 * g] * inv, O1[4 * g + 1] * inv); w1.y = pk2(O1[4 * g + 2] * inv, O1[4 * g + 3] * inv);
                *(u32x2*)(o + 8 * g) = w0; *(u32x2*)(o + 32 + 8 * g) = w1;
            }
            if (h == 0) ((float*)(p.ws + WS_LSE))[((size_t)cfg * NT + tq) * 8 + head] = m + __logf(l);
        }
        __syncthreads();
    }
}

__device__ __forceinline__ void ph_swa_mfma(const Params& p, int l, LAS unsigned char* lds) {
    const int tid = opaque_tid(), lane = tid & 63, wv = tid >> 6, g = wv >> 1, ph = wv & 1, r = lane & 31, h = lane >> 5;
    constexpr int VTS = 324;
    LAS bf16_t* Vt = (LAS bf16_t*)lds;
    LAS unsigned* Vt32 = (LAS unsigned*)lds;
    const bf16_t* PROJ = (const bf16_t*)(p.ws + WS_PROJ);
    for (int u = blockIdx.x; u < 256; u += gridDim.x) {
        const int b = u >> 6, kvh = (u >> 5) & 1, q0 = (u & 31) * 64;
        const bf16_t* base = PROJ + (size_t)b * SEQ * NPROJ;
        u32x4 va[3], vb[3];
#pragma unroll
        for (int i = 0; i < 3; ++i) {
            const int task = tid + 512 * i;
            if (task < 1280) {
                const int kp = task % 160, dc = task / 160;
                int kA = q0 - 128 + 2 * kp; kA = kA < 0 ? 0 : (kA > SEQ - 2 ? SEQ - 2 : kA);
                va[i] = *(const u32x4*)(base + (size_t)kA * NPROJ + PC_VC + kvh * 64 + 8 * dc);
                vb[i] = *(const u32x4*)(base + (size_t)(kA + 1) * NPROJ + PC_VC + kvh * 64 + 8 * dc);
            }
        }
        const int head = kvh * 4 + g;
        const int qpos = q0 + 32 * ph + r;
        const int lk0 = q0 + 32 * ph - 128;
        const bf16_t* kb = base + PC_KC + kvh * 64 + 8 * h;
        bf16x8 qf[4], kf0[5][4];
        attn_prefetch<5>(base + (size_t)qpos * NPROJ + PC_QC + head * 64 + 8 * h, kb, (size_t)NPROJ, lk0, SEQ, r, qf, kf0);
#pragma unroll
        for (int i = 0; i < 3; ++i) {
            const int task = tid + 512 * i;
            if (task < 1280) {
                const int kp = task % 160, dc = task / 160;
                LAS unsigned* o = Vt32 + (8 * dc) * (VTS / 2) + kp;
                o[0 * (VTS / 2)] = (va[i].x & 0xffffu) | (vb[i].x << 16); o[1 * (VTS / 2)] = (va[i].x >> 16) | (vb[i].x & 0xffff0000u);
                o[2 * (VTS / 2)] = (va[i].y & 0xffffu) | (vb[i].y << 16); o[3 * (VTS / 2)] = (va[i].y >> 16) | (vb[i].y & 0xffff0000u);
                o[4 * (VTS / 2)] = (va[i].z & 0xffffu) | (vb[i].z << 16); o[5 * (VTS / 2)] = (va[i].z >> 16) | (vb[i].z & 0xffff0000u);
                o[6 * (VTS / 2)] = (va[i].w & 0xffffu) | (vb[i].w << 16); o[7 * (VTS / 2)] = (va[i].w >> 16) | (vb[i].w & 0xffff0000u);
            }
        }
        {
            const LAS bf16_t* vt = Vt + r * VTS + 32 * ph + 4 * h;
            f32x16 O0, O1; float m, lsum;
            attn_wave<9, 5>(qf, kf0, kb, (size_t)NPROJ, lk0, SEQ, vt, VTS, p.in[11][l * 8 + head], 1.f, O0, O1, m, lsum, r, h);
            const float inv = 1.f / lsum;
            bf16_t* o = (bf16_t*)(p.ws + WS_YC) + ((size_t)b * SEQ + qpos) * 512 + head * 64 + 4 * h;
#pragma unroll
            for (int gg = 0; gg < 4; ++gg) {
                u32x2 w0; w0.x = pk2(O0[4 * gg] * inv, O0[4 * gg + 1] * inv); w0.y = pk2(O0[4 * gg + 2] * inv, O0[4 * gg + 3] * inv);
                u32x2 w1; w1.x = pk2(O1[4 * gg] * inv, O1[4 * gg + 1] * inv); w1.y = pk2(O1[4 * gg + 2] * inv, O1[4 * gg + 3] * inv);
                *(u32x2*)(o + 8 * gg) = w0; *(u32x2*)(o + 32 + 8 * gg) = w1;
            }
        }
        __syncthreads();
    }
}

__device__ __forceinline__ void ph_gmlp_mfma(const Params& p, int l, LAS unsigned char* lds) {
    const int tid = opaque_tid(), lane = tid & 63, wv = tid >> 6, hh = wv >> 1, ph = wv & 1, r = lane & 31, h = lane >> 5;
    constexpr int VTS = 136;
    LAS bf16_t* Vt = (LAS bf16_t*)lds;
    LAS unsigned* Vt32 = (LAS unsigned*)lds;
    LAS float* rv = (LAS float*)(lds + 256 * VTS * 2);
    const bf16_t* PROJ = (const bf16_t*)(p.ws + WS_PROJ); bf16_t* YB = (bf16_t*)(p.ws + WS_YB);
    const bf16_t* SW = (const bf16_t*)(p.ws + WS_SGUW) + (size_t)l * 8 * 128 * 128;
    const float* sn = p.in[8] + (size_t)l * 512;
    for (int u = blockIdx.x; u < 128; u += gridDim.x) {
        const int hg = u & 1, t0 = (u >> 1) * 128;
        { u32x4 w[16]; float ss[16];
#pragma unroll
          for (int q = 0; q < 16; ++q) w[q] = *(const u32x4*)(PROJ + (size_t)(t0 + wv * 16 + q) * NPROJ + PC_V + 8 * lane);
#pragma unroll
          for (int q = 0; q < 16; ++q) ss[q] = bflo(w[q].x) * bflo(w[q].x) + bfhi(w[q].x) * bfhi(w[q].x) + bflo(w[q].y) * bflo(w[q].y) + bfhi(w[q].y) * bfhi(w[q].y) + bflo(w[q].z) * bflo(w[q].z) + bfhi(w[q].z) * bfhi(w[q].z) + bflo(w[q].w) * bflo(w[q].w) + bfhi(w[q].w) * bfhi(w[q].w);
#pragma unroll
          for (int o = 1; o < 64; o <<= 1)
#pragma unroll
              for (int q = 0; q < 16; ++q) ss[q] += __shfl_xor(ss[q], o);
          float mine = 0.f;
#pragma unroll
          for (int q = 0; q < 16; ++q) mine = (lane == q) ? ss[q] : mine;
          if (lane < 16) rv[wv * 16 + lane] = 1.0f / sqrtf(mine * (1.f / 512.f) + EPS); }
        __syncthreads();
#pragma unroll
        for (int i = 0; i < 4; ++i) {
            const int task = tid + 512 * i, kp = task & 63, dc = task >> 6;
            const bf16_t* src = PROJ + (size_t)(t0 + 2 * kp) * NPROJ + PC_V + hg * 256 + 8 * dc;
            const u32x4 va = *(const u32x4*)src, vb = *(const u32x4*)(src + NPROJ);
            const float ra = rv[2 * kp], rb = rv[2 * kp + 1];
            const f32x4 g0 = *(const f32x4*)(sn + hg * 256 + 8 * dc), g1 = *(const f32x4*)(sn + hg * 256 + 8 * dc + 4);
            LAS unsigned* o = Vt32 + (8 * dc) * (VTS / 2) + kp;
            o[0 * (VTS / 2)] = pk2(bflo(va.x) * ra * g0[0], bflo(vb.x) * rb * g0[0]); o[1 * (VTS / 2)] = pk2(bfhi(va.x) * ra * g0[1], bfhi(vb.x) * rb * g0[1]);
            o[2 * (VTS / 2)] = pk2(bflo(va.y) * ra * g0[2], bflo(vb.y) * rb * g0[2]); o[3 * (VTS / 2)] = pk2(bfhi(va.y) * ra * g0[3], bfhi(vb.y) * rb * g0[3]);
            o[4 * (VTS / 2)] = pk2(bflo(va.z) * ra * g1[0], bflo(vb.z) * rb * g1[0]); o[5 * (VTS / 2)] = pk2(bfhi(va.z) * ra * g1[1], bfhi(vb.z) * rb * g1[1]);
            o[6 * (VTS / 2)] = pk2(bflo(va.w) * ra * g1[2], bflo(vb.w) * rb * g1[2]); o[7 * (VTS / 2)] = pk2(bfhi(va.w) * ra * g1[3], bfhi(vb.w) * rb * g1[3]);
        }
        __syncthreads();
        {
            const int habs = hg * 4 + hh;
            f32x16 acc[2][2];
#pragma unroll
            for (int ct = 0; ct < 2; ++ct)
#pragma unroll
                for (int pt = 0; pt < 2; ++pt)
#pragma unroll
                    for (int q = 0; q < 16; ++q) acc[ct][pt][q] = 0.f;
            const bf16_t* wp = SW + ((size_t)habs * 128 + 64 * ph + r) * 128 + 8 * h;
            const LAS bf16_t* ap = Vt + (hh * 64 + r) * VTS + 8 * h;
#pragma unroll
            for (int s = 0; s < 8; ++s) {
                bf16x8 bfr[2], afr[2];
#pragma unroll
                for (int pt = 0; pt < 2; ++pt) bfr[pt] = *(const bf16x8*)(wp + (size_t)pt * 32 * 128 + 16 * s);
#pragma unroll
                for (int ct = 0; ct < 2; ++ct) afr[ct] = *(const LAS bf16x8*)(ap + ct * 32 * VTS + 16 * s);
#pragma unroll
                for (int ct = 0; ct < 2; ++ct)
#pragma unroll
                    for (int pt = 0; pt < 2; ++pt) acc[ct][pt] = __builtin_amdgcn_mfma_f32_32x32x16_bf16(afr[ct], bfr[pt], acc[ct][pt], 0, 0, 0);
            }
#pragma unroll
            for (int pt = 0; pt < 2; ++pt) {
                const int pp = 64 * ph + 32 * pt + r;
                const float bias = p.in[10][((size_t)l * 8 + habs) * 128 + pp];
                const bf16_t* us = PROJ + (size_t)(t0 + pp) * NPROJ + PC_U + habs * 64 + 4 * h;
                bf16_t* o = YB + (size_t)(t0 + pp) * 512 + habs * 64 + 4 * h;
#pragma unroll
                for (int ct = 0; ct < 2; ++ct)
#pragma unroll
                    for (int gg = 0; gg < 4; ++gg) {
                        const u32x2 uw = *(const u32x2*)(us + 32 * ct + 8 * gg);
                        u32x2 w; w.x = pk2(bflo(uw.x) * (acc[ct][pt][4 * gg] + bias), bfhi(uw.x) * (acc[ct][pt][4 * gg + 1] + bias));
                        w.y = pk2(bflo(uw.y) * (acc[ct][pt][4 * gg + 2] + bias), bfhi(uw.y) * (acc[ct][pt][4 * gg + 3] + bias));
                        *(u32x2*)(o + 32 * ct + 8 * gg) = w;
                    }
            }
        }
        __syncthreads();
    }
}

__device__ __forceinline__ void ph_merge(const Params& p, int l, LAS unsigned char* lds) {
    const int tid = opaque_tid(), lane = tid & 63, wv = tid >> 6, r = lane & 31, h2 = lane >> 5;
    LAS float* ssA = (LAS float*)lds;
    const bf16_t* UV = (const bf16_t*)(p.ws + WS_YA); const bf16_t* YB = (const bf16_t*)(p.ws + WS_YB); const bf16_t* YC = (const bf16_t*)(p.ws + WS_YC); const bf16_t* YD = (const bf16_t*)(p.ws + WS_YD);
    const float* LSE = (const float*)(p.ws + WS_LSE); bf16_t* YN = (bf16_t*)(p.ws + WS_YN);
    const bf16_t* ABT = (const bf16_t*)(p.ws + WS_ABT) + ((size_t)l * 8 + wv) * 64 * 128;
    for (int blk = blockIdx.x; blk < NT / 32; blk += gridDim.x) {
        const int t0 = blk * 32, b = t0 >> 11, s0 = t0 & 2047;
        f32x16 O0, O1;
        {
#pragma unroll
            for (int q = 0; q < 16; ++q) { O0[q] = 0.f; O1[q] = 0.f; }
            const size_t row = ((size_t)b * 4096 + 2 * (s0 + r)) * 512 + wv * 64 + 8 * h2;
            u32x4 u0[8], u1[8];
#pragma unroll
            for (int s = 0; s < 8; ++s) { const size_t o = row + (s >> 2) * 512 + 16 * (s & 3); u0[s] = *(const u32x4*)(UV + o); u1[s] = *(const u32x4*)(UV + (size_t)4 * 4096 * 512 + o); }
            bf16x8 af0[8], af1[8];
#pragma unroll
            for (int s = 0; s < 8; ++s) { af0[s] = *(const bf16x8*)(ABT + (size_t)r * 128 + 16 * s + 8 * h2); af1[s] = *(const bf16x8*)(ABT + (size_t)(32 + r) * 128 + 16 * s + 8 * h2); }
#pragma unroll
            for (int s = 0; s < 8; ++s) {
                const bf16x8 bfr = pack8(bflo(u0[s].x) + bflo(u1[s].x), bfhi(u0[s].x) + bfhi(u1[s].x), bflo(u0[s].y) + bflo(u1[s].y), bfhi(u0[s].y) + bfhi(u1[s].y),
                                         bflo(u0[s].z) + bflo(u1[s].z), bfhi(u0[s].z) + bfhi(u1[s].z), bflo(u0[s].w) + bflo(u1[s].w), bfhi(u0[s].w) + bfhi(u1[s].w));
                O0 = __builtin_amdgcn_mfma_f32_32x32x16_bf16(af0[s], bfr, O0, 0, 0, 0);
                O1 = __builtin_amdgcn_mfma_f32_32x32x16_bf16(af1[s], bfr, O1, 0, 0, 0);
            }
            float ss = 0.f;
#pragma unroll
            for (int q = 0; q < 16; ++q) ss += O0[q] * O0[q] + O1[q] * O1[q];
            ss += __shfl_xor(ss, 32);
            if (h2 == 0) ssA[wv * 32 + r] = ss;
        }
#pragma unroll 1
        for (int i = 0; i < 4; ++i) {
            const int t = t0 + 4 * wv + i;
            float y[3][8];
            { const u32x4 w = *(const u32x4*)(YB + (size_t)t * 512 + 8 * lane);
                y[0][0] = bflo(w.x); y[0][1] = bfhi(w.x); y[0][2] = bflo(w.y); y[0][3] = bfhi(w.y); y[0][4] = bflo(w.z); y[0][5] = bfhi(w.z); y[0][6] = bflo(w.w); y[0][7] = bfhi(w.w); }
            { const u32x4 w = *(const u32x4*)(YC + (size_t)t * 512 + 8 * lane);
                y[1][0] = bflo(w.x); y[1][1] = bfhi(w.x); y[1][2] = bflo(w.y); y[1][3] = bfhi(w.y); y[1][4] = bflo(w.z); y[1][5] = bfhi(w.z); y[1][6] = bflo(w.w); y[1][7] = bfhi(w.w); }
            { const int head = lane >> 3;
              const float l0 = LSE[(size_t)t * 8 + head], l1 = LSE[((size_t)NT + t) * 8 + head], l2 = LSE[((size_t)2 * NT + t) * 8 + head];
              const float mx = fmaxf(l0, fmaxf(l1, l2)); float w0 = __expf(l0 - mx), w1 = __expf(l1 - mx), w2 = __expf(l2 - mx); const float iv = 1.f / (w0 + w1 + w2); w0 *= iv; w1 *= iv; w2 *= iv;
              const u32x4 a = *(const u32x4*)(YD + (size_t)t * 512 + 8 * lane), bq = *(const u32x4*)(YD + ((size_t)NT + t) * 512 + 8 * lane), c = *(const u32x4*)(YD + ((size_t)2 * NT + t) * 512 + 8 * lane);
              y[2][0] = w0 * bflo(a.x) + w1 * bflo(bq.x) + w2 * bflo(c.x); y[2][1] = w0 * bfhi(a.x) + w1 * bfhi(bq.x) + w2 * bfhi(c.x);
              y[2][2] = w0 * bflo(a.y) + w1 * bflo(bq.y) + w2 * bflo(c.y); y[2][3] = w0 * bfhi(a.y) + w1 * bfhi(bq.y) + w2 * bfhi(c.y);
              y[2][4] = w0 * bflo(a.z) + w1 * bflo(bq.z) + w2 * bflo(c.z); y[2][5] = w0 * bfhi(a.z) + w1 * bfhi(bq.z) + w2 * bfhi(c.z);
              y[2][6] = w0 * bflo(a.w) + w1 * bflo(bq.w) + w2 * bflo(c.w); y[2][7] = w0 * bfhi(a.w) + w1 * bfhi(bq.w) + w2 * bfhi(c.w); }
#pragma unroll
            for (int g = 0; g < 3; ++g) {
                float ss = 0.f;
#pragma unroll
                for (int q = 0; q < 8; ++q) ss += y[g][q] * y[g][q];
                const float rr = 1.0f / sqrtf(wave_sum(ss) * (1.f / 512.f) + EPS);
                u32x4 w; w.x = pk2(y[g][0] * rr, y[g][1] * rr); w.y = pk2(y[g][2] * rr, y[g][3] * rr); w.z = pk2(y[g][4] * rr, y[g][5] * rr); w.w = pk2(y[g][6] * rr, y[g][7] * rr);
                *(u32x4*)(YN + (size_t)t * DM + (g + 1) * 512 + 8 * lane) = w;
            }
        }
        __syncthreads();
        {
            float tot = 0.f;
#pragma unroll
            for (int w = 0; w < 8; ++w) tot += ssA[w * 32 + r];
            const float rr = 1.0f / sqrtf(tot * (1.f / 512.f) + EPS);
            bf16_t* o = YN + (size_t)(t0 + r) * DM + wv * 64 + 4 * h2;
#pragma unroll
            for (int g = 0; g < 4; ++g) {
                u32x2 w0; w0.x = pk2(O0[4 * g] * rr, O0[4 * g + 1] * rr); w0.y = pk2(O0[4 * g + 2] * rr, O0[4 * g + 3] * rr);
                u32x2 w1; w1.x = pk2(O1[4 * g] * rr, O1[4 * g + 1] * rr); w1.y = pk2(O1[4 * g + 2] * rr, O1[4 * g + 3] * rr);
                *(u32x2*)(o + 8 * g) = w0; *(u32x2*)(o + 32 + 8 * g) = w1;
            }
        }
        __syncthreads();
    }
}

#ifndef PHASE_MASK
#define PHASE_MASK 0xFFFFFFu
#endif
#define EN(k) (((PHASE_MASK) >> (k)) & 1u)
#ifndef REP_MASK
#define REP_MASK 0u
#endif
#define REP(k) _Pragma("unroll") for (int rep_ = 0; rep_ < 1 + (int)(((REP_MASK) >> (k)) & 1u); ++rep_)
constexpr int MIX_GW = 128, MIX_A = 4400;
constexpr int NPHASE = 22;
__global__ void __launch_bounds__(512, 2) mk_fwd(Params p) {
    extern __shared__ __attribute__((aligned(16))) unsigned char lds_raw[];
    LAS unsigned char* lds = (LAS unsigned char*)lds_raw;
    const int tid = threadIdx.x, G = gridDim.x, bx = blockIdx.x;
    volatile LAS unsigned* misc = (volatile LAS unsigned*)(lds + MISC_OFF);
    if (tid < 16) misc[tid] = 0u;
    __syncthreads();
    const int lo = p.ph_lo, hi = p.ph_hi;
    XcdBarrier bar; bar.bar = (unsigned*)(p.ws + WS_CTL); bar.x = 0; bar.st = misc + 8;
    if (hi - lo > 1) bar = xcd_barrier_post((unsigned*)(p.ws + WS_CTL), misc + 8);
#define IN(k) (lo <= (k) && (k) < hi)
#define SEAM(k) do { if (IN(k) && IN((k) + 1)) xcd_barrier(bar); } while (0)
    if (IN(0)) { if (EN(0)) REP(0) ph_mod(p, lds); if (EN(1)) REP(1) ph_tables(p); if (EN(2)) REP(2) ph_weights(p, lds, 0, G == 256 ? 240 : 6880, bx, G); }
    SEAM(0);
    for (int l = 0; l < 2; ++l) {
        const int pb = 1 + 10 * l;
        const char* H = (const char*)(p.ws + WS_H);
        if (EN(3) && IN(pb + 0)) REP(3) { ph_norm1(p, l); }
        SEAM(pb + 0);
        if (EN(4) && IN(pb + 1)) REP(4) {
            SchedProj S{H, (const char*)(p.ws + WS_WIN) + (size_t)l * NPROJ * 2048 * 2, (const char*)(p.ws + WS_WPQ) + (size_t)l * 512 * 2048 * 2, G, bx};
            EpiProj E{(bf16_t*)(p.ws + WS_PROJ), (bf16_t*)(p.ws + WS_PQT), (const float*)(p.ws + WS_ROPE), (const float*)(p.ws + WS_ROPE) + NT * 8};
            if (l == 0 && G == 256 && EN(2)) {
                if (bx < MIX_GW) { SchedProj S2{S.H, S.WIN, S.WPQ, MIX_GW, bx}; pg8::gemm_phase<EpiProj, SchedProj>(lds, 2048, 2048, 2048, S2, E); }
                else ph_weights(p, lds, 240, 240 + MIX_A, bx - MIX_GW, G - MIX_GW);
                __syncthreads();
                ph_weights(p, lds, 240 + MIX_A, 6880, bx, G);
            } else
            pg8::gemm_phase<EpiProj, SchedProj>(lds, 2048, 2048, 2048, S, E);
        }
        SEAM(pb + 1);
        if (IN(pb + 2)) {
            if (EN(5)) REP(5) { SchedDft S{(const char*)(p.ws + WS_DFT), (const char*)(p.ws + WS_PQT), G, bx};
              EpiBf16Plain E{(bf16_t*)(p.ws + WS_YA), 512, (size_t)4 * 4096 * 512};
              pg8::gemm_phase<EpiBf16Plain, SchedDft>(lds, 2048, 2048, 1024, S, E); }
            __syncthreads();
            if (EN(6)) REP(6) ph_gmlp_mfma(p, l, lds);
            if (EN(7)) REP(7) ph_swa_mfma(p, l, lds);
            if (EN(8)) REP(8) ph_dilated_mfma(p, lds);
        }
        SEAM(pb + 2);
        if (EN(9) && IN(pb + 3)) REP(9) { ph_merge(p, l, lds); }
        SEAM(pb + 3);
        if (EN(10) && IN(pb + 4)) REP(10) {
            SchedDense S{(const char*)(p.ws + WS_YN), (const char*)(p.ws + WS_WOUT) + (size_t)l * 2048 * 2048 * 2, 32, 8, 2048, G, bx};
            EpiWout E{l == 0 ? p.in[0] : nullptr, (const bf16_t*)(p.ws + WS_X), (bf16_t*)(p.ws + WS_X2), (const float*)(p.ws + WS_MOD) + (size_t)l * 4 * 12288 + 2 * 2048};
            pg8::gemm_phase<EpiWout, SchedDense>(lds, 2048, 2048, 2048, S, E);
        }
        SEAM(pb + 4);
        if (EN(11) && IN(pb + 5)) REP(11) { ph_norm2_router_mfma(p, l, lds); }
        SEAM(pb + 5);
        if (EN(12) && IN(pb + 6)) REP(12) { ph_topk(p, lds); }
        SEAM(pb + 6);
        if (EN(14) && IN(pb + 8)) REP(14) {
            SchedMoeG S{H, (const char*)(p.ws + WS_WGU) + (size_t)l * 16 * 2048 * 2048 * 2, 2048, G, bx};
            EpiGU E{(bf16_t*)(p.ws + WS_ACT)};
            pg8::gemm_phase<EpiGU, SchedMoeG, true>(lds, 2048, 2048, 2048, S, E, (const int*)(p.ws + WS_IDX));
        }
        SEAM(pb + 8);
        if (EN(15) && IN(pb + 9)) REP(15) {
            SchedMoe S{(const char*)(p.ws + WS_ACT), (const char*)(p.ws + WS_WD) + (size_t)l * 16 * 2048 * 1024 * 2, 1024, G, bx};
            EpiDown E{(bf16_t*)(p.ws + WS_EO), (const float*)(p.ws + WS_IDX + 65536)};
            pg8::gemm_phase<EpiDown, SchedMoe>(lds, 1024, 1024, 1024, S, E);
        }
        SEAM(pb + 9);
    }
    if (EN(16) && IN(21)) REP(16) { ph_norm1(p, 2); }
#undef IN
#undef SEAM
}

extern "C" void kernel_launch(void* const* d_in, const int* in_sizes, int n_in, void* d_out, int out_size, void* d_ws, size_t ws_size, hipStream_t stream) {
    static int grid = 0;
    if (grid == 0) {
        if (n_in != 20 || out_size != NT * DM || ws_size < WS_END) { fprintf(stderr, "kernel_launch: unexpected shapes (n_in %d out %d ws %zu)\n", n_in, out_size, ws_size); grid = -1; return; }
        int dev = 0, cus = 0, per_cu = 0;
        if (hipGetDevice(&dev) != hipSuccess || hipDeviceGetAttribute(&cus, hipDeviceAttributeMultiprocessorCount, dev) != hipSuccess) { grid = -1; return; }
        if (hipFuncSetAttribute((const void*)mk_fwd, hipFuncAttributeMaxDynamicSharedMemorySize, LDS_BYTES) != hipSuccess) { fprintf(stderr, "kernel_launch: hipFuncSetAttribute failed\n"); grid = -1; return; }
        if (hipOccupancyMaxActiveBlocksPerMultiprocessor(&per_cu, (const void*)mk_fwd, 512, LDS_BYTES) != hipSuccess || per_cu < 1) { fprintf(stderr, "kernel_launch: occupancy query says %d\n", per_cu); }
        (void)hipGetLastError();
        grid = cus;
    }
    if (grid < 0) return;
    (void)hipMemsetAsync((char*)d_ws + WS_CTL, 0, 64 * 1024, stream);
    Params p{};
    for (int i = 0; i < 20; ++i) p.in[i] = (const float*)d_in[i];
    p.out = (float*)d_out; p.ws = (unsigned char*)d_ws;
#if defined(MK_MULTI)
    for (int ph = 0; ph < NPHASE; ++ph) { p.ph_lo = ph; p.ph_hi = ph + 1; hipLaunchKernelGGL(mk_fwd, dim3(grid), dim3(512), LDS_BYTES, stream, p); }
#else
    p.ph_lo = 0; p.ph_hi = NPHASE; hipLaunchKernelGGL(mk_fwd, dim3(grid), dim3(512), LDS_BYTES, stream, p);
#endif
}
```

```cpp
#include <hip/hip_runtime.h>
#include <cstdio>
#include <cstdint>

#define LAS __attribute__((address_space(3)))
typedef unsigned short bf16_t;
typedef short bf16x8 __attribute__((ext_vector_type(8)));
typedef float f32x4 __attribute__((ext_vector_type(4)));
typedef float f32x2 __attribute__((ext_vector_type(2)));
typedef unsigned u32x4 __attribute__((ext_vector_type(4)));
typedef unsigned u32x2 __attribute__((ext_vector_type(2)));
typedef float f32x16 __attribute__((ext_vector_type(16)));

constexpr int NB = 4, SEQ = 2048, NT = NB * SEQ, DM = 2048, DIN = 3840, NPROJ = 3328, NE = 16, FF = 1024, CAP = 256;
constexpr float EPS = 1e-6f;
constexpr int PC_U = 0, PC_V = 512, PC_QC = 1024, PC_KC = 1536, PC_VC = 1664, PC_QD = 1792, PC_KD = 2304, PC_VD = 2816;

constexpr size_t MiB = (size_t)1 << 20;
constexpr size_t WS_CTL = 0;
constexpr size_t WS_MOD = 1 * MiB;
constexpr size_t WS_ROPE = WS_MOD + 512 * 1024;
constexpr size_t WS_DFT = 2 * MiB;
constexpr size_t WS_WIN = 18 * MiB;
constexpr size_t WS_WPQ = 44 * MiB;
constexpr size_t WS_WOUT = 52 * MiB;
constexpr size_t WS_WGU = 68 * MiB;
constexpr size_t WS_WD = 324 * MiB;
constexpr size_t WS_X = 452 * MiB;
constexpr size_t WS_X2 = 516 * MiB;
constexpr size_t WS_H = 580 * MiB;
constexpr size_t WS_PROJ = 612 * MiB;
constexpr size_t WS_PQT = 664 * MiB;
constexpr size_t WS_YA = 680 * MiB;
constexpr size_t WS_YB = 712 * MiB;
constexpr size_t WS_YC = 720 * MiB;
constexpr size_t WS_YD = 728 * MiB;
constexpr size_t WS_LSE = 752 * MiB;
constexpr size_t WS_YN = 753 * MiB;
constexpr size_t WS_AFF = 785 * MiB;
constexpr size_t WS_IDX = 786 * MiB;
constexpr size_t WS_XE = 787 * MiB;
constexpr size_t WS_ACT = 851 * MiB;
constexpr size_t WS_EO = 883 * MiB;
constexpr size_t WS_SGUW = 947 * MiB;
constexpr size_t WS_WRT = WS_SGUW + 512 * 1024;
constexpr size_t WS_ABT = WS_WRT + 128 * 1024;
constexpr size_t WS_END = 948 * MiB;

constexpr int LDS_BYTES = 147456;
constexpr int MISC_OFF = LDS_BYTES - 256;

struct Params { const float* in[20]; float* out; unsigned char* ws; int ph_lo, ph_hi; };

__device__ __forceinline__ unsigned pk2(float lo, float hi) { unsigned r; asm("v_cvt_pk_bf16_f32 %0, %1, %2" : "=v"(r) : "v"(lo), "v"(hi)); return r; }
__device__ __forceinline__ float bflo(unsigned u) { return __uint_as_float(u << 16); }
__device__ __forceinline__ float bfhi(unsigned u) { return __uint_as_float(u & 0xffff0000u); }
__device__ __forceinline__ float wave_sum(float v) {
#pragma unroll
    for (int o = 1; o < 64; o <<= 1) v += __shfl_xor(v, o);
    return v;
}
__device__ __forceinline__ float gelu_tanh(float x) { const float u = 0.7978845608f * (x + 0.044715f * x * x * x); return x * __builtin_amdgcn_rcpf(1.f + __builtin_amdgcn_exp2f(-2.885390082f * u)); }
__device__ __forceinline__ float silu_f(float x) { return x * __builtin_amdgcn_rcpf(1.f + __builtin_amdgcn_exp2f(-1.442695041f * x)); }

__device__ __forceinline__ int opaque_tid() { int t = threadIdx.x; asm volatile("" : "+v"(t)); return t; }
#define XB_TMO      128
#define XB_XCNT(j)  (256  + 64 * (j))
#define XB_XSUB(j)  (1280 + 64 * (j))
#define XB_XGEN(j)  (2304 + 64 * (j))
#define XB_TOP      3328
#define XB_TOPGEN   3392
#define XCD_BAR_WORDS 3456
#define XB_SPIN_CAP (1u << 18)
__device__ __forceinline__ unsigned xb_ld(unsigned* p)              { return __hip_atomic_load(p, __ATOMIC_RELAXED, __HIP_MEMORY_SCOPE_AGENT); }
__device__ __forceinline__ unsigned xb_add(unsigned* p, unsigned v) { return __hip_atomic_fetch_add(p, v, __ATOMIC_RELAXED, __HIP_MEMORY_SCOPE_AGENT); }
__device__ __forceinline__ unsigned xb_xcc_id() { return (unsigned)__builtin_amdgcn_s_getreg((3 << 11) | 20) & 0xFu; }
#define XB_SPIN(cond, bar) do { unsigned _sp = 0; while (cond) { __builtin_amdgcn_s_sleep(1); \
    if ((++_sp & 255u) == 0u) { if (xb_ld(&(bar)[XB_TMO])) break; if (_sp > XB_SPIN_CAP) { atomicAdd(&(bar)[XB_TMO], 1u); break; } } } } while (0)
struct XcdBarrier { unsigned* bar; unsigned x; volatile LAS unsigned* st; };
__device__ __forceinline__ XcdBarrier xcd_barrier_post(unsigned* bar, volatile LAS unsigned* st) {
    XcdBarrier b; b.bar = bar; b.x = xb_xcc_id(); b.st = st;
    if (threadIdx.x == 0) (void)xb_add(&bar[XB_XCNT(b.x)], 1u);
    return b;
}
__device__ __forceinline__ void xcd_barrier_complete(unsigned* bar, unsigned x, unsigned& nloc, unsigned& nx) {
    const unsigned G = gridDim.x * gridDim.y * gridDim.z;
    unsigned sum, cnt, mine, sp = 0u;
    for (;;) {
        sum = 0u; cnt = 0u; mine = 0u;
#pragma unroll
        for (unsigned j = 0; j < 16; ++j) { const unsigned c = xb_ld(&bar[XB_XCNT(j)]); sum += c; cnt += (c > 0u) ? 1u : 0u; mine = (j == x) ? c : mine; }
        if (sum == G) break;
        __builtin_amdgcn_s_sleep(1);
        if ((++sp & 255u) == 0u) { if (xb_ld(&bar[XB_TMO])) break; if (sp > XB_SPIN_CAP) { atomicAdd(&bar[XB_TMO], 1u); break; } }
    }
    nloc = mine > 0u ? mine : 1u; nx = cnt > 0u ? cnt : 1u;
}
__device__ __forceinline__ void xcd_barrier(const XcdBarrier& b) {
    asm volatile("s_waitcnt vmcnt(0)" ::: "memory");
    __syncthreads();
    if (threadIdx.x == 0) {
        unsigned* bar = b.bar;
        __builtin_amdgcn_s_waitcnt(0);
        unsigned nloc = b.st[0], nx = b.st[1];
        if (nloc == 0u) { xcd_barrier_complete(bar, b.x, nloc, nx); b.st[0] = nloc; b.st[1] = nx; }
        const unsigned old = xb_add(&bar[XB_XSUB(b.x)], 1u);
        const unsigned gen = old / nloc;
        if (old + 1u == (gen + 1u) * nloc) {
            __builtin_amdgcn_fence(__ATOMIC_RELEASE, "agent");
            asm volatile("s_waitcnt vmcnt(0)" ::: "memory");
            const unsigned og = xb_add(&bar[XB_TOP], 1u);
            const unsigned tg = og / nx;
            if (og + 1u == (tg + 1u) * nx) xb_add(&bar[XB_TOPGEN], 1u);
            else XB_SPIN(xb_ld(&bar[XB_TOPGEN]) == tg, bar);
            __builtin_amdgcn_fence(__ATOMIC_ACQUIRE, "agent");
            xb_add(&bar[XB_XGEN(b.x)], 1u);
            asm volatile("s_waitcnt vmcnt(0)" ::: "memory");
        } else {
            XB_SPIN(xb_ld(&bar[XB_XGEN(b.x)]) == gen, bar);
            __builtin_amdgcn_fence(__ATOMIC_ACQUIRE, "agent");
            asm volatile("s_waitcnt vmcnt(0)" ::: "memory");
        }
    }
    __syncthreads();
}

namespace pg8 {
constexpr int BM = 256, BK = 64, HALF = 128, HTB = HALF * BK * 2, STAGE_BYTES = 8 * HTB;
__host__ __device__ __forceinline__ int lds_byte(int r, int c) { const int st = (r >> 4) * 2 + (c >> 5), rr = r & 15, cc = c & 31, ob = rr * 64 + cc * 2; return st * 1024 + (ob ^ (((ob >> 9) & 1) << 5)); }
__host__ __device__ __forceinline__ void stage_rc(int b, int& R, int& C) { const int st = b / 1024, sb = b % 1024, swz = sb ^ (((sb >> 9) & 1) << 5); R = (st >> 1) * 16 + swz / 64; C = (st & 1) * 32 + (swz % 64) / 2; }
__host__ __device__ __forceinline__ int perm32(int rho) { const int n = rho >> 4, i = rho & 15; return 8 * (i >> 2) + 4 * n + (i & 3); }

struct GUnit { const char* a; const char* b; int pm, pn, z; };

__device__ __forceinline__ void dense_map(int L, int nM, int nN, int& pm, int& pn) {
    const int nwg = nM * nN;
    int wgid = L; { const int q = nwg / 8, r = nwg % 8, xcd = wgid % 8, off = wgid / 8; wgid = (xcd < r ? xcd * (q + 1) : r * (q + 1) + (xcd - r) * q) + off; }
    const int nig = 8 * nN, gid = wgid / nig, fm = gid * 8, gsz = (nM - fm) < 8 ? (nM - fm) : 8;
    pm = fm + ((wgid % nig) % gsz); pn = (wgid % nig) / gsz;
}

template <class Epi, class Sched, bool GATHER = false>
__device__ __forceinline__ void gemm_phase(LAS unsigned char* lds, const int lda, const int ldb, const int K, const Sched& S, const Epi& E, const int* gidx = nullptr) {
    int tid_ = threadIdx.x; asm volatile("" : "+v"(tid_));
    const int tid = tid_, wid = __builtin_amdgcn_readfirstlane(tid >> 6), lane = tid & 63, wr = wid >> 2, wc = wid & 3, fr = lane & 15, fq = lane >> 4;
    const int nt = K / BK;
    unsigned voffB[2]; int RA[2]; unsigned CA2[2];
#pragma unroll
    for (int i = 0; i < 2; ++i) { int R, C; stage_rc(tid * 16 + i * 8192, R, C); const int Rb = Epi::PERM ? ((R & ~31) + perm32(R & 31)) : R;
        RA[i] = R; CA2[i] = (unsigned)C * 2u; voffB[i] = (unsigned)(Rb * ldb + C) * 2u; }
    const size_t kstep = (size_t)(BK * 2);
    const size_t hstepB = (size_t)HALF * ldb * 2;
    const unsigned ldsw = (unsigned)wid * 1024u;
    const int aoff = lds_byte(wr * 64 + fr, fq * 8), boff = lds_byte(wc * 32 + fr, fq * 8);
#define PG8_AOFF(of, u) do { _Pragma("unroll") for (int hh_ = 0; hh_ < 2; ++hh_) _Pragma("unroll") for (int i_ = 0; i_ < 2; ++i_) { \
        if constexpr (GATHER) of[hh_][i_] = (unsigned)gidx[(u).pm * 256 + hh_ * 128 + RA[i_]] * (unsigned)(lda * 2) + CA2[i_]; \
        else of[hh_][i_] = (unsigned)((hh_ * HALF + RA[i_]) * lda) * 2u + CA2[i_]; } } while (0)
#define PG8_SA(b, h) (((b) * 2 + (h)) * HTB)
#define PG8_SB(b, h) ((4 + (b) * 2 + (h)) * HTB)
#define PG8_STAGE(bufoff, gbase, voff) do { _Pragma("unroll") for (int _i = 0; _i < 2; ++_i) \
        __builtin_amdgcn_global_load_lds((const unsigned*)((const char*)(gbase) + (voff)[_i]), (LAS unsigned*)(lds + (bufoff) + ldsw + _i * 8192), 16, 0, 0); } while (0)
#define PG8_LDA(dst, b, h) do { _Pragma("unroll") for (int m = 0; m < 4; ++m) _Pragma("unroll") for (int k = 0; k < 2; ++k) dst[m][k] = *(const LAS bf16x8*)(lds + PG8_SA(b, h) + aoff + m * 2048 + k * 1024); } while (0)
#define PG8_LDB(dst, b, h) do { _Pragma("unroll") for (int n = 0; n < 2; ++n) _Pragma("unroll") for (int k = 0; k < 2; ++k) dst[n][k] = *(const LAS bf16x8*)(lds + PG8_SB(b, h) + boff + n * 2048 + k * 1024); } while (0)
#define PG8_MMA(ai, bj, At, Bt) do { __builtin_amdgcn_s_setprio(1); _Pragma("unroll") for (int m = 0; m < 4; ++m) _Pragma("unroll") for (int n = 0; n < 2; ++n) _Pragma("unroll") for (int k = 0; k < 2; ++k) \
        acc[ai][bj][m][n] = __builtin_amdgcn_mfma_f32_16x16x32_bf16(Bt[n][k], At[m][k], acc[ai][bj][m][n], 0, 0, 0); __builtin_amdgcn_s_setprio(0); } while (0)
#define PG8_WAIT_V(n) asm volatile("s_waitcnt vmcnt(" #n ")" ::: "memory")
#define PG8_WAIT_L(n) asm volatile("s_waitcnt lgkmcnt(" #n ")" ::: "memory")
#define PG8_BAR __builtin_amdgcn_s_barrier()
#define PG8_SCHED __builtin_amdgcn_sched_barrier(0)
    GUnit cur, nxt; int ui = 0;
    if (!S.next(0, cur)) return;
    f32x4 acc[2][2][4][2];
#pragma unroll
    for (int a = 0; a < 2; ++a)
#pragma unroll
        for (int b = 0; b < 2; ++b)
#pragma unroll
            for (int m = 0; m < 4; ++m)
#pragma unroll
                for (int n = 0; n < 2; ++n) acc[a][b][m][n] = (f32x4){0.f, 0.f, 0.f, 0.f};
    bf16x8 At[4][2], B0[2][2], B1[2][2];
    unsigned ofc[2][2], ofn[2][2];
    PG8_AOFF(ofc, cur);
#pragma unroll
    for (int hh = 0; hh < 2; ++hh)
#pragma unroll
        for (int i = 0; i < 2; ++i) ofn[hh][i] = ofc[hh][i];
    const char* cA = cur.a; const char* cB = cur.b;
    PG8_STAGE(PG8_SB(0, 0), cB, voffB); PG8_STAGE(PG8_SB(0, 1), cB + hstepB, voffB); PG8_STAGE(PG8_SA(0, 0), cA, ofc[0]); PG8_STAGE(PG8_SA(0, 1), cA, ofc[1]);
    if (wr == 1) PG8_BAR;
    PG8_WAIT_V(2); PG8_BAR;
    PG8_STAGE(PG8_SB(1, 0), cB + kstep, voffB); PG8_STAGE(PG8_SA(1, 0), cA + kstep, ofc[0]); PG8_STAGE(PG8_SB(1, 1), cB + hstepB + kstep, voffB);
    PG8_WAIT_V(6); PG8_BAR;
    for (;;) {
        const bool has_next = S.next(ui + 1, nxt);
        const char* nA = has_next ? nxt.a : cA; const char* nB = has_next ? nxt.b : cB;
        for (int t = 0; t < nt; t += 2) {
            const bool last = (t == nt - 2);
            if constexpr (GATHER) { if (last && has_next) PG8_AOFF(ofn, nxt); }
            const char* a1 = cA + (size_t)(t + 1) * kstep;
            const char* a2 = last ? nA : cA + (size_t)(t + 2) * kstep; const char* b2 = last ? nB : cB + (size_t)(t + 2) * kstep;
            const char* a3 = a2 + kstep; const char* b3 = b2 + kstep;
            unsigned o2[2][2];
#pragma unroll
            for (int hh = 0; hh < 2; ++hh)
#pragma unroll
                for (int i = 0; i < 2; ++i) { if constexpr (GATHER) o2[hh][i] = last ? ofn[hh][i] : ofc[hh][i]; else o2[hh][i] = ofc[hh][i]; }
            PG8_LDB(B0, 0, 0); PG8_LDB(B1, 0, 1); PG8_SCHED; PG8_LDA(At, 0, 0); PG8_STAGE(PG8_SA(1, 1), a1, ofc[1]);
            PG8_WAIT_V(8); PG8_WAIT_L(0); PG8_BAR; PG8_MMA(0, 0, At, B0); PG8_MMA(0, 1, At, B1); PG8_BAR; PG8_SCHED;
            PG8_LDA(At, 0, 1); PG8_STAGE(PG8_SB(0, 0), b2, voffB); PG8_STAGE(PG8_SB(0, 1), b2 + hstepB, voffB); PG8_STAGE(PG8_SA(0, 0), a2, o2[0]);
            PG8_WAIT_V(8); PG8_WAIT_L(0); PG8_BAR; PG8_MMA(1, 0, At, B0); PG8_MMA(1, 1, At, B1); PG8_BAR; PG8_SCHED;
            PG8_LDB(B0, 1, 0); PG8_LDB(B1, 1, 1); PG8_SCHED; PG8_LDA(At, 1, 0); PG8_STAGE(PG8_SA(0, 1), a2, o2[1]);
            PG8_WAIT_V(8); PG8_WAIT_L(0); PG8_BAR; PG8_MMA(0, 0, At, B0); PG8_MMA(0, 1, At, B1); PG8_BAR; PG8_SCHED;
            PG8_LDA(At, 1, 1); PG8_STAGE(PG8_SB(1, 0), b3, voffB); PG8_STAGE(PG8_SB(1, 1), b3 + hstepB, voffB); PG8_STAGE(PG8_SA(1, 0), a3, o2[0]);
            PG8_WAIT_V(8); PG8_WAIT_L(0); PG8_BAR; PG8_MMA(1, 0, At, B0); PG8_MMA(1, 1, At, B1); PG8_BAR; PG8_SCHED;
        }
        if (wr == 0) PG8_BAR;
        E(acc, cur, wr, wc, fr, fq);
        if (!has_next) break;
#pragma unroll
        for (int a = 0; a < 2; ++a)
#pragma unroll
            for (int b = 0; b < 2; ++b)
#pragma unroll
                for (int m = 0; m < 4; ++m)
#pragma unroll
                    for (int n = 0; n < 2; ++n) acc[a][b][m][n] = (f32x4){0.f, 0.f, 0.f, 0.f};
        cur = nxt; cA = nA; cB = nB; ++ui;
        if constexpr (GATHER) {
#pragma unroll
            for (int hh = 0; hh < 2; ++hh)
#pragma unroll
                for (int i = 0; i < 2; ++i) ofc[hh][i] = ofn[hh][i];
        }
        if (wr == 1) PG8_BAR;
    }
    PG8_WAIT_V(0);
    PG8_BAR;
#undef PG8_AOFF
#undef PG8_SA
#undef PG8_SB
#undef PG8_STAGE
#undef PG8_LDA
#undef PG8_LDB
#undef PG8_MMA
#undef PG8_WAIT_V
#undef PG8_WAIT_L
#undef PG8_BAR
#undef PG8_SCHED
}
}
using pg8::GUnit;

struct SchedProj {
    const char* H; const char* WIN; const char* WPQ; int G, c;
    __device__ __forceinline__ bool next(int i, GUnit& u) const {
        const int L = i * G + c; if (L >= 480) return false;
        if (L < 416) { int pm, pn; pg8::dense_map(L, 32, 13, pm, pn); u.pm = pm; u.pn = pn; u.z = 0; u.a = H + (size_t)pm * 256 * 2048 * 2; u.b = WIN + (size_t)pn * 256 * 2048 * 2; }
        else { int pm, pn; pg8::dense_map(L - 416, 2, 32, pm, pn); u.pm = pm; u.pn = pn; u.z = 1; u.a = WPQ + (size_t)pm * 256 * 2048 * 2; u.b = H + (size_t)pn * 256 * 2048 * 2; }
        return true;
    }
};
struct SchedDft {
    const char* DFT; const char* XAT; int G, c;
    __device__ __forceinline__ bool next(int i, GUnit& u) const {
        const int L = i * G + c; if (L >= 256) return false;
        const int Lp = (L & 7) * 32 + (L >> 3);
        const int ks = Lp & 1, pn = (Lp >> 1) & 1, pm = (Lp >> 2) & 15, b = Lp >> 6;
        u.pm = b * 16 + pm; u.pn = pn; u.z = ks;
        u.a = DFT + ((size_t)pm * 256 * 2048 + ks * 1024) * 2; u.b = XAT + (((size_t)b * 512 + pn * 256) * 2048 + ks * 1024) * 2;
        return true;
    }
};
struct SchedDense {
    const char* A; const char* B; int nM, nN, K, G, c;
    __device__ __forceinline__ bool next(int i, GUnit& u) const {
        const int L = i * G + c; if (L >= nM * nN) return false;
        int pm, pn; pg8::dense_map(L, nM, nN, pm, pn); u.pm = pm; u.pn = pn; u.z = 0;
        u.a = A + (size_t)pm * 256 * K * 2; u.b = B + (size_t)pn * 256 * K * 2; return true;
    }
};
struct SchedMoeG {
    const char* A; const char* B; int K, G, c;
    __device__ __forceinline__ bool next(int i, GUnit& u) const {
        const int L = i * G + c; if (L >= 512) return false;
        const int Lp = (L & 7) * 64 + (L >> 3);
        const int e = Lp >> 5, r = Lp & 31, pm = r & 3, pn = r >> 2;
        u.pm = e * 4 + pm; u.pn = pn; u.z = e;
        u.a = A; u.b = B + ((size_t)e * 2048 + pn * 256) * K * 2; return true;
    }
};
struct SchedMoe {
    const char* A; const char* B; int K, G, c;
    __device__ __forceinline__ bool next(int i, GUnit& u) const {
        const int L = i * G + c; if (L >= 512) return false;
        const int Lp = (L & 7) * 64 + (L >> 3);
        const int e = Lp >> 5, r = Lp & 31, pm = r & 3, pn = r >> 2;
        u.pm = e * 4 + pm; u.pn = pn; u.z = e;
        u.a = A + ((size_t)e * 1024 + pm * 256) * K * 2; u.b = B + ((size_t)e * 2048 + pn * 256) * K * 2; return true;
    }
};

typedef f32x4 AccT[2][2][4][2];
struct EpiProj {
    static constexpr bool PERM = true;
    bf16_t* PROJ; bf16_t* PQT; const float* ropec; const float* ropes;
    __device__ __forceinline__ void operator()(const AccT& acc, const GUnit& u, int wr, int wc, int fr, int fq) const {
        if (u.z == 0) {
            const int pn = u.pn;
            const int row0 = u.pm * 256 + wr * 64 + fr;
#pragma unroll
            for (int ai = 0; ai < 2; ++ai)
#pragma unroll
                for (int m = 0; m < 4; ++m) {
                    const int row = row0 + ai * 128 + m * 16;
#pragma unroll
                    for (int bj = 0; bj < 2; ++bj) {
                        f32x4 v0 = acc[ai][bj][m][0], v1 = acc[ai][bj][m][1];
                        const int colt = pn * 256 + bj * 128;
                        if (pn < 4) {
#pragma unroll
                            for (int j = 0; j < 4; ++j) { v0[j] = gelu_tanh(v0[j]); v1[j] = gelu_tanh(v1[j]); }
                        } else {
                            const bool isq = (colt >= PC_QC && colt < PC_KC) || (colt >= PC_QD && colt < PC_KD);
                            const bool isk = (colt >= PC_KC && colt < PC_VC) || (colt >= PC_KD && colt < PC_VD);
                            if (isq || isk) {
                                if ((wc & 1) == 0) {
                                    f32x4 o0, o1;
#pragma unroll
                                    for (int j = 0; j < 4; ++j) { o0[j] = __shfl_xor(v0[j], 16); o1[j] = __shfl_xor(v1[j], 16); }
                                    if (fq < 2) {
                                        const f32x4 c0 = *(const f32x4*)(ropec + (size_t)row * 8), c1 = *(const f32x4*)(ropec + (size_t)row * 8 + 4);
                                        const f32x4 s0 = *(const f32x4*)(ropes + (size_t)row * 8), s1 = *(const f32x4*)(ropes + (size_t)row * 8 + 4);
                                        const float sg = fq == 0 ? -1.f : 1.f;
#pragma unroll
                                        for (int j = 0; j < 4; ++j) { v0[j] = v0[j] * c0[j] + sg * o0[j] * s0[j]; v1[j] = v1[j] * c1[j] + sg * o1[j] * s1[j]; }
                                    }
                                }
                                if (isq) { v0 = v0 * 0.125f; v1 = v1 * 0.125f; }
                            }
                        }
                        u32x4 w; w.x = pk2(v0[0], v0[1]); w.y = pk2(v0[2], v0[3]); w.z = pk2(v1[0], v1[1]); w.w = pk2(v1[2], v1[3]);
                        *(u32x4*)(PROJ + (size_t)row * NPROJ + colt + wc * 32 + 8 * fq) = w;
                    }
                }
        } else {
#pragma unroll
            for (int ai = 0; ai < 2; ++ai)
#pragma unroll
                for (int m = 0; m < 4; ++m) {
                    const int c = u.pm * 256 + ai * 128 + wr * 64 + m * 16 + fr;
#pragma unroll
                    for (int bj = 0; bj < 2; ++bj) {
                        const int t = u.pn * 256 + bj * 128 + wc * 32 + 8 * fq, b = t >> 11, s = t & 2047;
                        const f32x4 v0 = acc[ai][bj][m][0], v1 = acc[ai][bj][m][1];
                        u32x4 w; w.x = pk2(v0[0], v0[1]); w.y = pk2(v0[2], v0[3]); w.z = pk2(v1[0], v1[1]); w.w = pk2(v1[2], v1[3]);
                        *(u32x4*)(PQT + (((size_t)b * 512 + c) * 2048 + s)) = w;
                    }
                }
        }
    }
};
struct EpiBf16Plain {
    static constexpr bool PERM = true;
    bf16_t* O; int ldc; size_t zstride;
    __device__ __forceinline__ void operator()(const AccT& acc, const GUnit& u, int wr, int wc, int fr, int fq) const {
        bf16_t* base = O + (size_t)u.z * zstride;
#pragma unroll
        for (int ai = 0; ai < 2; ++ai)
#pragma unroll
            for (int m = 0; m < 4; ++m) {
                const int row = u.pm * 256 + ai * 128 + wr * 64 + m * 16 + fr;
#pragma unroll
                for (int bj = 0; bj < 2; ++bj) {
                    const f32x4 v0 = acc[ai][bj][m][0], v1 = acc[ai][bj][m][1];
                    u32x4 w; w.x = pk2(v0[0], v0[1]); w.y = pk2(v0[2], v0[3]); w.z = pk2(v1[0], v1[1]); w.w = pk2(v1[2], v1[3]);
                    *(u32x4*)(base + (size_t)row * ldc + u.pn * 256 + bj * 128 + wc * 32 + 8 * fq) = w;
                }
            }
    }
};
struct EpiWout {
    static constexpr bool PERM = true;
    const float* base32; const bf16_t* base16; bf16_t* X2; const float* gate;
    __device__ __forceinline__ void operator()(const AccT& acc, const GUnit& u, int wr, int wc, int fr, int fq) const {
        const int b = u.pm >> 3;
        const int col0 = u.pn * 256 + wc * 32 + 8 * fq;
        f32x4 g[2][2];
#pragma unroll
        for (int bj = 0; bj < 2; ++bj)
#pragma unroll
            for (int n = 0; n < 2; ++n) g[bj][n] = *(const f32x4*)(gate + (size_t)b * 12288 + col0 + bj * 128 + n * 4);
#pragma unroll
        for (int ai = 0; ai < 2; ++ai)
#pragma unroll
            for (int m = 0; m < 4; ++m) {
                const size_t ro = (size_t)(u.pm * 256 + ai * 128 + wr * 64 + m * 16 + fr) * DM + col0;
#pragma unroll
                for (int bj = 0; bj < 2; ++bj) {
                    f32x4 x0, x1;
                    if (base32) { x0 = *(const f32x4*)(base32 + ro + bj * 128); x1 = *(const f32x4*)(base32 + ro + bj * 128 + 4); }
                    else { const u32x4 w = *(const u32x4*)(base16 + ro + bj * 128); x0 = (f32x4){bflo(w.x), bfhi(w.x), bflo(w.y), bfhi(w.y)}; x1 = (f32x4){bflo(w.z), bfhi(w.z), bflo(w.w), bfhi(w.w)}; }
                    const f32x4 v0 = x0 + g[bj][0] * acc[ai][bj][m][0], v1 = x1 + g[bj][1] * acc[ai][bj][m][1];
                    u32x4 o; o.x = pk2(v0[0], v0[1]); o.y = pk2(v0[2], v0[3]); o.z = pk2(v1[0], v1[1]); o.w = pk2(v1[2], v1[3]);
                    *(u32x4*)(X2 + ro + bj * 128) = o;
                }
            }
    }
};
struct EpiGU {
    static constexpr bool PERM = true;
    bf16_t* ACT;
    __device__ __forceinline__ void operator()(const AccT& acc, const GUnit& u, int wr, int wc, int fr, int fq) const {
#pragma unroll
        for (int ai = 0; ai < 2; ++ai)
#pragma unroll
            for (int m = 0; m < 4; ++m) {
                const int row = u.pm * 256 + ai * 128 + wr * 64 + m * 16 + fr;
                f32x4 v0, v1;
#pragma unroll
                for (int j = 0; j < 4; ++j) { v0[j] = silu_f(acc[ai][0][m][0][j]) * acc[ai][1][m][0][j]; v1[j] = silu_f(acc[ai][0][m][1][j]) * acc[ai][1][m][1][j]; }
                u32x4 w; w.x = pk2(v0[0], v0[1]); w.y = pk2(v0[2], v0[3]); w.z = pk2(v1[0], v1[1]); w.w = pk2(v1[2], v1[3]);
                *(u32x4*)(ACT + (size_t)row * FF + u.pn * 128 + wc * 32 + 8 * fq) = w;
            }
    }
};
struct EpiDown {
    static constexpr bool PERM = true;
    bf16_t* EO; const float* gate;
    __device__ __forceinline__ void operator()(const AccT& acc, const GUnit& u, int wr, int wc, int fr, int fq) const {
#pragma unroll
        for (int ai = 0; ai < 2; ++ai)
#pragma unroll
            for (int m = 0; m < 4; ++m) {
                const int row = u.pm * 256 + ai * 128 + wr * 64 + m * 16 + fr;
                const float g = gate[row];
#pragma unroll
                for (int bj = 0; bj < 2; ++bj) {
                    const f32x4 v0 = acc[ai][bj][m][0] * g, v1 = acc[ai][bj][m][1] * g;
                    u32x4 w; w.x = pk2(v0[0], v0[1]); w.y = pk2(v0[2], v0[3]); w.z = pk2(v1[0], v1[1]); w.w = pk2(v1[2], v1[3]);
                    *(u32x4*)(EO + (size_t)row * DM + u.pn * 256 + bj * 128 + wc * 32 + 8 * fq) = w;
                }
            }
    }
};

__device__ __forceinline__ void ph_mod(const Params& p, LAS unsigned char* lds) {
    LAS float* sl = (LAS float*)lds;
    LAS float* red = (LAS float*)(lds + 32768);
    const int tid = opaque_tid();
    const float* c = p.in[1];
    float* mod = (float*)(p.ws + WS_MOD);
    for (int i = tid; i < 8192; i += 512) { const float v = c[i]; sl[i] = v / (1.f + expf(-v)); }
    __syncthreads();
    const int cl = tid & 31, ks = tid >> 5;
    for (int u = blockIdx.x; u < 192; u += gridDim.x) {
        const int l = u / 96, cc = u % 96;
        const float* W = p.in[3] + (size_t)l * 2048 * 12288 + cc * 128 + cl * 4;
        float acc[4][4];
#pragma unroll
        for (int b = 0; b < 4; ++b)
#pragma unroll
            for (int j = 0; j < 4; ++j) acc[b][j] = 0.f;
#pragma unroll 8
        for (int k = ks; k < 2048; k += 16) {
            const f32x4 w = __builtin_nontemporal_load((const f32x4*)(W + (size_t)k * 12288));
#pragma unroll
            for (int b = 0; b < 4; ++b) { const float s = sl[b * 2048 + k];
#pragma unroll
                for (int j = 0; j < 4; ++j) acc[b][j] += s * w[j]; }
        }
#pragma unroll
        for (int b = 0; b < 4; ++b)
#pragma unroll
            for (int j = 0; j < 4; ++j) red[((b * 4 + j) * 16 + ks) * 32 + cl] = acc[b][j];
        __syncthreads();
        { const int b = tid >> 7, col = tid & 127; float s = 0.f;
#pragma unroll
          for (int q = 0; q < 16; ++q) s += red[((b * 4 + (col & 3)) * 16 + q) * 32 + (col >> 2)];
          mod[(size_t)(l * 4 + b) * 12288 + cc * 128 + col] = s + p.in[4][(size_t)l * 12288 + cc * 128 + col]; }
        __syncthreads();
    }
}
__device__ __forceinline__ void ph_tables(const Params& p) {
    const int gt = blockIdx.x * 512 + opaque_tid(), ngt = gridDim.x * 512;
    float* rc = (float*)(p.ws + WS_ROPE); float* rs = rc + NT * 8;
    const int* pos = (const int*)p.in[2];
    for (int i = gt; i < NT * 8; i += ngt) {
        const int t = i >> 3, j = i & 7;
        float inv;
        switch (j) { case 0: inv = 1.0f; break; case 1: inv = 0.1939227432012558f; break; case 2: inv = 0.03760603070259094f; break; case 3: inv = 0.007292664609849453f; break;
                     case 4: inv = 0.0014142135623842478f; break; case 5: inv = 0.00027424818836152554f; break; case 6: inv = 5.318296098266728e-05f; break; default: inv = 1.0313386155758053e-05f; break; }
        const float ang = (float)pos[t] * inv;
        double r = (double)ang * 0.15915494309189535; r -= floor(r);
        const float a = (float)(2.0 * r);
        rc[i] = cospif(a); rs[i] = sinpif(a);
    }
    { bf16_t* sw = (bf16_t*)(p.ws + WS_SGUW);
      for (int i = gt; i < 2 * 8 * 128 * 128 / 4; i += ngt) { const f32x4 w = *(const f32x4*)(p.in[9] + (size_t)i * 4); u32x2 o; o.x = pk2(w[0], w[1]); o.y = pk2(w[2], w[3]); *(u32x2*)(sw + (size_t)i * 4) = o; } }
    { bf16_t* wrt = (bf16_t*)(p.ws + WS_WRT);
      for (int i = gt; i < 2 * 16 * 2048; i += ngt) { const int l = i >> 15, e = (i >> 11) & 15, k = i & 2047; wrt[i] = (bf16_t)(pk2(p.in[15][((size_t)l * 2048 + k) * 16 + e], 0.f) & 0xffffu); } }
    { bf16_t* abt = (bf16_t*)(p.ws + WS_ABT);
      for (int i = gt; i < 2 * 8 * 64 * 128; i += ngt) { const int k = i & 127, d = (i >> 7) & 63, lh = i >> 13, c = k & 63; const float* fw = p.in[7] + (size_t)lh * 4096;
          float sacc = 0.f;
          for (int cp = 0; cp < 64; ++cp) { const float a = (float)((c * cp) & 63) * (1.f / 32.f); sacc += ((k < 64) ? cospif(a) : sinpif(a)) * fw[cp * 64 + d]; }
          abt[i] = (bf16_t)(pk2(sacc * 0.125f, 0.f) & 0xffffu); } }
    bf16_t* dft = (bf16_t*)(p.ws + WS_DFT);
    for (int i = gt; i < 2048 * 512; i += ngt) {
        const int sp = i >> 9, k8 = (i & 511) * 8;
        float v[8];
#pragma unroll
        for (int e = 0; e < 8; ++e) { const int k = k8 + e, part = k >> 11, s = k & 2047, m = (s * sp) & 2047; const float a = (float)m * (1.f / 1024.f);
            v[e] = (part ? -sinpif(a) : cospif(a)) * 0.022097086912079608f; }
        u32x4 w; w.x = pk2(v[0], v[1]); w.y = pk2(v[2], v[3]); w.z = pk2(v[4], v[5]); w.w = pk2(v[6], v[7]);
        *(u32x4*)(dft + (size_t)sp * 4096 + k8) = w;
    }
}
struct TDesc { const float* src; bf16_t* dst; const float* ksc; int lds_, ldd; };
__device__ __forceinline__ bool tdecode(const Params& p, int it, TDesc& d) {
    if (it >= 2 * 6880) return false;
    const int l = it / 6880; int r = it % 6880;
    d.ksc = nullptr;
    if (r < 480) { const int kt = r / 30, nt = r % 30;
        d.src = p.in[6] + ((size_t)l * 2048 + kt * 128) * DIN + nt * 128; d.lds_ = DIN;
        d.dst = (nt < 4 ? (bf16_t*)(p.ws + WS_WPQ) + ((size_t)l * 512 + nt * 128) * 2048 : (bf16_t*)(p.ws + WS_WIN) + ((size_t)l * NPROJ + (nt - 4) * 128) * 2048) + kt * 128; d.ldd = 2048; return true; }
    r -= 480;
    if (r < 256) { const int kt = r / 16, nt = r % 16;
        d.src = p.in[13] + ((size_t)l * 2048 + kt * 128) * 2048 + nt * 128; d.lds_ = 2048; d.ksc = p.in[12] + (size_t)l * 2048 + kt * 128;
        d.dst = (bf16_t*)(p.ws + WS_WOUT) + ((size_t)l * 2048 + nt * 128) * 2048 + kt * 128; d.ldd = 2048; return true; }
    r -= 256;
    if (r < 4096) { const int isup = r / 2048, r2 = r % 2048, e = r2 / 128, kt = (r2 % 128) / 8, nt = r2 % 8;
        d.src = p.in[isup ? 17 : 16] + (((size_t)l * 16 + e) * 2048 + kt * 128) * 1024 + nt * 128; d.lds_ = 1024;
        d.dst = (bf16_t*)(p.ws + WS_WGU) + (((size_t)l * 16 + e) * 2048 + nt * 256 + isup * 128) * 2048 + kt * 128; d.ldd = 2048; return true; }
    r -= 4096;
    { const int e = r / 128, kt = (r % 128) / 16, nt = r % 16;
        d.src = p.in[18] + (((size_t)l * 16 + e) * 1024 + kt * 128) * 2048 + nt * 128; d.lds_ = 2048;
        d.dst = (bf16_t*)(p.ws + WS_WD) + (((size_t)l * 16 + e) * 2048 + nt * 128) * 1024 + kt * 128; d.ldd = 1024; return true; }
}
__device__ __forceinline__ void ph_weights(const Params& p, LAS unsigned char* lds, const int p0, const int p1, const int wi, const int wn) {
    const int tid = opaque_tid();
    LAS unsigned* l32 = (LAS unsigned*)lds;
    LAS bf16_t* l16 = (LAS bf16_t*)lds;
    TDesc dA0, dA1, dB0, dB1; f32x4 a0[8], a1[8], b0[8], b1[8];
#define PW_LOAD(pi, D0, D1, V0, V1, HAVE) do { HAVE = (pi) < p1; if (HAVE) { tdecode(p, 2 * (pi), D0); tdecode(p, 2 * (pi) + 1, D1); \
        _Pragma("unroll") for (int i = 0; i < 8; ++i) { const int f = tid + 512 * i, k = f >> 5, c4 = f & 31; \
            V0[i] = __builtin_nontemporal_load((const f32x4*)(D0.src + (size_t)k * D0.lds_ + c4 * 4)); V1[i] = __builtin_nontemporal_load((const f32x4*)(D1.src + (size_t)k * D1.lds_ + c4 * 4)); } } } while (0)
#define PW_TOLDS(D0, V0, V1) do { _Pragma("unroll") for (int i = 0; i < 8; ++i) { const int f = tid + 512 * i, k = f >> 5, c4 = f & 31; const float sc = D0.ksc ? D0.ksc[k] : 1.f; \
        const int sw = ((k >> 3) & 15) * 2; u32x2 w; w.x = pk2(V0[i][0] * sc, V0[i][1] * sc); w.y = pk2(V0[i][2] * sc, V0[i][3] * sc); \
        *(LAS u32x2*)(l32 + k * 64 + ((2 * c4) ^ sw)) = w; \
        u32x2 w2; w2.x = pk2(V1[i][0] * sc, V1[i][1] * sc); w2.y = pk2(V1[i][2] * sc, V1[i][3] * sc); \
        *(LAS u32x2*)(l32 + 8192 + k * 64 + ((2 * c4) ^ sw)) = w2; } } while (0)
#define PW_STORE(DS0, DS1) do { _Pragma("unroll") for (int i = 0; i < 4; ++i) { \
        const int n = (tid >> 4) + 32 * i, kc = tid & 15, cd = (n >> 1) ^ (2 * kc), hf = n & 1; \
        unsigned short e[8], g[8]; \
        _Pragma("unroll") for (int q = 0; q < 8; ++q) { e[q] = l16[((8 * kc + q) * 64 + cd) * 2 + hf]; g[q] = l16[16384 + ((8 * kc + q) * 64 + cd) * 2 + hf]; } \
        u32x4 w; w.x = e[0] | ((unsigned)e[1] << 16); w.y = e[2] | ((unsigned)e[3] << 16); w.z = e[4] | ((unsigned)e[5] << 16); w.w = e[6] | ((unsigned)e[7] << 16); \
        __builtin_nontemporal_store(w, (u32x4*)(DS0.dst + (size_t)n * DS0.ldd + 8 * kc)); \
        u32x4 w2; w2.x = g[0] | ((unsigned)g[1] << 16); w2.y = g[2] | ((unsigned)g[3] << 16); w2.z = g[4] | ((unsigned)g[5] << 16); w2.w = g[6] | ((unsigned)g[7] << 16); \
        __builtin_nontemporal_store(w2, (u32x4*)(DS1.dst + (size_t)n * DS1.ldd + 8 * kc)); } } while (0)
    int pi = p0 + wi; bool hA, hB;
    PW_LOAD(pi, dA0, dA1, a0, a1, hA);
    PW_LOAD(pi + wn, dB0, dB1, b0, b1, hB);
    while (hA) {
        { PW_TOLDS(dA0, a0, a1); __syncthreads(); const TDesc s0 = dA0, s1 = dA1; PW_LOAD(pi + 2 * wn, dA0, dA1, a0, a1, hA); PW_STORE(s0, s1); __syncthreads(); }
        if (!hB) break;
        { PW_TOLDS(dB0, b0, b1); __syncthreads(); const TDesc s0 = dB0, s1 = dB1; PW_LOAD(pi + 3 * wn, dB0, dB1, b0, b1, hB); PW_STORE(s0, s1); __syncthreads(); }
        pi += 2 * wn;
    }
#undef PW_LOAD
#undef PW_TOLDS
#undef PW_STORE
}

__device__ __forceinline__ void ph_norm1(const Params& p, int mode) {
    const int tid = opaque_tid(), lane = tid & 63, wv = tid >> 6;
    const float* mod = (const float*)(p.ws + WS_MOD);
    const int* slot_of = (const int*)(p.ws + WS_IDX + 131072);
    const bf16_t* EO = (const bf16_t*)(p.ws + WS_EO);
    for (int t = blockIdx.x * 8 + wv; t < NT; t += gridDim.x * 8) {
        const int b = t >> 11;
        f32x4 v[8];
        if (mode == 0) { const float* xr = p.in[0] + (size_t)t * DM;
#pragma unroll
            for (int j = 0; j < 8; ++j) v[j] = *(const f32x4*)(xr + 4 * lane + 256 * j);
        } else { const bf16_t* xr = (const bf16_t*)(p.ws + WS_X2) + (size_t)t * DM;
#pragma unroll
            for (int j = 0; j < 8; ++j) { const u32x2 w = *(const u32x2*)(xr + 4 * lane + 256 * j); v[j] = (f32x4){bflo(w.x), bfhi(w.x), bflo(w.y), bfhi(w.y)}; }
        }
        if (mode != 0) {
            f32x4 macc[8];
#pragma unroll
            for (int j = 0; j < 8; ++j) macc[j] = (f32x4){0.f, 0.f, 0.f, 0.f};
            const int myslot = slot_of[(size_t)(lane & 15) * NT + t];
            unsigned m = (unsigned)(__ballot(myslot >= 0) & 0xffffull);
            while (m) {
                const int e0 = __builtin_ctz(m); m &= m - 1u;
                const bool two = m != 0u; const int e1 = two ? __builtin_ctz(m) : e0; if (two) m &= m - 1u;
                const int s0 = __builtin_amdgcn_readlane(myslot, e0), s1 = __builtin_amdgcn_readlane(myslot, e1);
                const float w1 = two ? 1.f : 0.f;
                const bf16_t* r0 = EO + (size_t)s0 * DM; const bf16_t* r1 = EO + (size_t)s1 * DM;
                u32x2 a[8], c[8];
#pragma unroll
                for (int j = 0; j < 8; ++j) { a[j] = *(const u32x2*)(r0 + 4 * lane + 256 * j); c[j] = *(const u32x2*)(r1 + 4 * lane + 256 * j); }
#pragma unroll
                for (int j = 0; j < 8; ++j) {
                    macc[j][0] += bflo(a[j].x) + w1 * bflo(c[j].x); macc[j][1] += bfhi(a[j].x) + w1 * bfhi(c[j].x);
                    macc[j][2] += bflo(a[j].y) + w1 * bflo(c[j].y); macc[j][3] += bfhi(a[j].y) + w1 * bfhi(c[j].y); }
            }
            const float* gf = mod + ((size_t)(mode - 1) * 4 + b) * 12288 + 5 * 2048;
#pragma unroll
            for (int j = 0; j < 8; ++j) { const f32x4 g = *(const f32x4*)(gf + 4 * lane + 256 * j); v[j] = v[j] + g * macc[j]; }
            if (mode == 1) {
                bf16_t* xo = (bf16_t*)(p.ws + WS_X) + (size_t)t * DM;
#pragma unroll
                for (int j = 0; j < 8; ++j) { u32x2 w; w.x = pk2(v[j][0], v[j][1]); w.y = pk2(v[j][2], v[j][3]); *(u32x2*)(xo + 4 * lane + 256 * j) = w;
                    v[j] = (f32x4){bflo(w.x), bfhi(w.x), bflo(w.y), bfhi(w.y)}; }
            }
        }
        float ss = 0.f;
#pragma unroll
        for (int j = 0; j < 8; ++j) ss += v[j][0] * v[j][0] + v[j][1] * v[j][1] + v[j][2] * v[j][2] + v[j][3] * v[j][3];
        const float r = 1.0f / sqrtf(wave_sum(ss) * (1.f / DM) + EPS);
        if (mode == 2) {
            float* o = p.out + (size_t)t * DM;
#pragma unroll
            for (int j = 0; j < 8; ++j) { const f32x4 g = *(const f32x4*)(p.in[19] + 4 * lane + 256 * j); *(f32x4*)(o + 4 * lane + 256 * j) = v[j] * r * g; }
        } else {
            const int l = mode;
            const float* g1 = p.in[5] + (size_t)l * DM;
            const float* sh = mod + ((size_t)l * 4 + b) * 12288;
            const float* sc = sh + 2048;
            bf16_t* ho = (bf16_t*)(p.ws + WS_H) + (size_t)t * DM;
#pragma unroll
            for (int j = 0; j < 8; ++j) {
                const f32x4 g = *(const f32x4*)(g1 + 4 * lane + 256 * j), s1 = *(const f32x4*)(sc + 4 * lane + 256 * j), s0 = *(const f32x4*)(sh + 4 * lane + 256 * j);
                const f32x4 h = (v[j] * r * g) * (s1 + 1.f) + s0;
                u32x2 w; w.x = pk2(h[0], h[1]); w.y = pk2(h[2], h[3]);
                *(u32x2*)(ho + 4 * lane + 256 * j) = w;
            }
        }
    }
}


__device__ __forceinline__ void ph_norm2_router_mfma(const Params& p, int l, LAS unsigned char* lds) {
    const int tid = opaque_tid(), lane = tid & 63, wv = tid >> 6, r = lane & 31, h = lane >> 5;
    LAS float* part = (LAS float*)lds;
    LAS float* lgs = (LAS float*)(lds + 8 * 32 * 17 * 4);
    const float* mod = (const float*)(p.ws + WS_MOD);
    const float* g2 = p.in[14] + (size_t)l * DM;
    const bf16_t* WRT = (const bf16_t*)(p.ws + WS_WRT) + (size_t)l * 16 * 2048;
    bf16_t* Hb = (bf16_t*)(p.ws + WS_H);
    float* aff = (float*)(p.ws + WS_AFF);
    for (int blk = blockIdx.x; blk < NT / 32; blk += gridDim.x) {
        const int t0 = blk * 32, b = t0 >> 11;
        const float* sh = mod + ((size_t)l * 4 + b) * 12288 + 3 * 2048;
        const float* sc = sh + 2048;
#pragma unroll 1
        for (int half = 0; half < 2; ++half) {
            const int ta = t0 + 4 * wv + 2 * half;
            const bf16_t* xa = (const bf16_t*)(p.ws + WS_X2) + (size_t)ta * DM;
            f32x4 va[8], vb[8];
#pragma unroll
            for (int j = 0; j < 8; ++j) { const u32x2 wa = *(const u32x2*)(xa + 4 * lane + 256 * j), wb = *(const u32x2*)(xa + DM + 4 * lane + 256 * j);
                va[j] = (f32x4){bflo(wa.x), bfhi(wa.x), bflo(wa.y), bfhi(wa.y)}; vb[j] = (f32x4){bflo(wb.x), bfhi(wb.x), bflo(wb.y), bfhi(wb.y)}; }
            float sa = 0.f, sb = 0.f;
#pragma unroll
            for (int j = 0; j < 8; ++j) { sa += va[j][0] * va[j][0] + va[j][1] * va[j][1] + va[j][2] * va[j][2] + va[j][3] * va[j][3]; sb += vb[j][0] * vb[j][0] + vb[j][1] * vb[j][1] + vb[j][2] * vb[j][2] + vb[j][3] * vb[j][3]; }
#pragma unroll
            for (int o = 1; o < 64; o <<= 1) { sa += __shfl_xor(sa, o); sb += __shfl_xor(sb, o); }
            const float ra = 1.0f / sqrtf(sa * (1.f / DM) + EPS), rb = 1.0f / sqrtf(sb * (1.f / DM) + EPS);
            bf16_t* ho = Hb + (size_t)ta * DM;
#pragma unroll
            for (int j = 0; j < 8; ++j) {
                const f32x4 g = *(const f32x4*)(g2 + 4 * lane + 256 * j), s1 = *(const f32x4*)(sc + 4 * lane + 256 * j), s0 = *(const f32x4*)(sh + 4 * lane + 256 * j);
                const f32x4 gg = g * (s1 + 1.f);
                const f32x4 ha = (va[j] * ra) * gg + s0, hb = (vb[j] * rb) * gg + s0;
                u32x2 wa; wa.x = pk2(ha[0], ha[1]); wa.y = pk2(ha[2], ha[3]);
                u32x2 wb; wb.x = pk2(hb[0], hb[1]); wb.y = pk2(hb[2], hb[3]);
                *(u32x2*)(ho + 4 * lane + 256 * j) = wa; *(u32x2*)(ho + DM + 4 * lane + 256 * j) = wb;
            }
        }
        asm volatile("s_waitcnt vmcnt(0)" ::: "memory");
        __syncthreads();
        {
            f32x16 acc;
#pragma unroll
            for (int q = 0; q < 16; ++q) acc[q] = 0.f;
            const bf16_t* bp = Hb + (size_t)(t0 + r) * DM + 256 * wv + 8 * h;
            const bf16_t* ap = WRT + (size_t)(r & 15) * 2048 + 256 * wv + 8 * h;
            bf16x8 bfr[16], afr[16];
#pragma unroll
            for (int s = 0; s < 16; ++s) { bfr[s] = *(const bf16x8*)(bp + 16 * s); afr[s] = *(const bf16x8*)(ap + 16 * s); }
#pragma unroll
            for (int s = 0; s < 16; ++s) { const bf16x8 a = (r < 16) ? afr[s] : (bf16x8){0, 0, 0, 0, 0, 0, 0, 0}; acc = __builtin_amdgcn_mfma_f32_32x32x16_bf16(a, bfr[s], acc, 0, 0, 0); }
#pragma unroll
            for (int q = 0; q < 8; ++q) { const int e = (q & 3) + 8 * (q >> 2) + 4 * h; part[(wv * 32 + r) * 17 + e] = acc[q]; }
        }
        __syncthreads();
        const int e = tid >> 5, tk = tid & 31;
        { float s = 0.f;
#pragma unroll
          for (int w = 0; w < 8; ++w) s += part[(w * 32 + tk) * 17 + e];
          lgs[e * 32 + tk] = s; }
        __syncthreads();
        { float lg[16]; float mx = -1e30f;
#pragma unroll
          for (int q = 0; q < 16; ++q) { lg[q] = lgs[q * 32 + tk]; mx = fmaxf(mx, lg[q]); }
          float den = 0.f, mine = 0.f;
#pragma unroll
          for (int q = 0; q < 16; ++q) { const float ex = expf(lg[q] - mx); den += ex; mine = (q == e) ? ex : mine; }
          aff[((size_t)b * 16 + e) * 2048 + (t0 & 2047) + tk] = mine / den; }
        __syncthreads();
    }
}

__device__ __forceinline__ unsigned block_excl_scan(unsigned cnt, LAS unsigned* wsum, int tid) {
    const int lane = tid & 63, wv = tid >> 6;
    unsigned inc = cnt;
#pragma unroll
    for (int o = 1; o < 64; o <<= 1) { const unsigned t = __shfl_up(inc, o); if (lane >= o) inc += t; }
    if (lane == 63) wsum[wv] = inc;
    __syncthreads();
    unsigned base = 0;
#pragma unroll
    for (int w = 0; w < 8; ++w) base += (w < wv) ? wsum[w] : 0u;
    __syncthreads();
    return base + inc - cnt;
}
__device__ __forceinline__ void ph_topk(const Params& p, LAS unsigned char* lds) {
    const int tid = opaque_tid();
    LAS unsigned* hist = (LAS unsigned*)lds;
    LAS unsigned* misc = hist + 256;
    LAS unsigned* wsum = hist + 320;
    const float* aff = (const float*)(p.ws + WS_AFF);
    int* idx = (int*)(p.ws + WS_IDX); float* gate = (float*)(p.ws + WS_IDX + 65536); int* slot_of = (int*)(p.ws + WS_IDX + 131072);
    for (int u = blockIdx.x; u < 64; u += gridDim.x) {
        const int b = u >> 4, e = u & 15;
        const f32x4 a = *(const f32x4*)(aff + (size_t)u * 2048 + 4 * tid);
        unsigned k[4];
#pragma unroll
        for (int i = 0; i < 4; ++i) k[i] = __float_as_uint(a[i]);
        unsigned prefix = 0, krem = CAP;
#pragma unroll 1
        for (int pass = 0; pass < 4; ++pass) {
            const int shift = 24 - 8 * pass;
            if (tid < 256) hist[tid] = 0;
            __syncthreads();
#pragma unroll
            for (int i = 0; i < 4; ++i) if (pass == 0 || (k[i] >> (shift + 8)) == prefix) __hip_atomic_fetch_add(&hist[(k[i] >> shift) & 255u], 1u, __ATOMIC_RELAXED, __HIP_MEMORY_SCOPE_WORKGROUP);
            __syncthreads();
            { const unsigned cnt = (tid < 256) ? hist[255 - tid] : 0u;
              const unsigned Sn = block_excl_scan(cnt, wsum, tid), S = Sn + cnt;
              if (tid < 256 && S >= krem && Sn < krem) { misc[0] = (prefix << 8) | (unsigned)(255 - tid); misc[1] = krem - Sn; } }
            __syncthreads();
            prefix = misc[0]; krem = misc[1];
            __syncthreads();
        }
        unsigned neq = 0;
#pragma unroll
        for (int i = 0; i < 4; ++i) neq += (k[i] == prefix) ? 1u : 0u;
        unsigned eqbase = block_excl_scan(neq, wsum, tid);
        unsigned sel[4]; unsigned nsel = 0;
#pragma unroll
        for (int i = 0; i < 4; ++i) { const bool eq = k[i] == prefix; sel[i] = (k[i] > prefix || (eq && eqbase < krem)) ? 1u : 0u; eqbase += eq ? 1u : 0u; nsel += sel[i]; }
        unsigned sb = block_excl_scan(nsel, wsum, tid);
#pragma unroll
        for (int i = 0; i < 4; ++i) {
            const int s = 4 * tid + i, t = b * 2048 + s;
            if (sel[i]) { const int row = e * 1024 + b * 256 + (int)sb; idx[row] = t; gate[row] = a[i]; slot_of[(size_t)e * NT + t] = row; ++sb; }
            else slot_of[(size_t)e * NT + t] = -1;
        }
        __syncthreads();
    }
}

__device__ __forceinline__ bf16x8 pack8(float a0, float a1, float a2, float a3, float a4, float a5, float a6, float a7) {
    u32x4 p;
    asm volatile("v_cvt_pk_bf16_f32 %0, %4, %5\n\tv_cvt_pk_bf16_f32 %1, %6, %7\n\tv_cvt_pk_bf16_f32 %2, %8, %9\n\tv_cvt_pk_bf16_f32 %3, %10, %11\n\ts_nop 1"
                 : "=&v"(p[0]), "=&v"(p[1]), "=&v"(p[2]), "=&v"(p[3]) : "v"(a0), "v"(a1), "v"(a2), "v"(a3), "v"(a4), "v"(a5), "v"(a6), "v"(a7));
    return __builtin_bit_cast(bf16x8, p);
}
template <int CH>
__device__ __forceinline__ void attn_prefetch(const bf16_t* qp, const bf16_t* kb, const size_t kst, const int lk0, const int ls, const int r, bf16x8 (&qf)[4], bf16x8 (&kf0)[CH][4]) {
#pragma unroll
    for (int s = 0; s < 4; ++s) qf[s] = *(const bf16x8*)(qp + 16 * s);
#pragma unroll
    for (int i = 0; i < CH; ++i) {
        int lkr = lk0 + 32 * i + r; lkr = lkr < 0 ? 0 : (lkr >= ls ? ls - 1 : lkr);
        const bf16_t* kp = kb + (size_t)lkr * kst;
#pragma unroll
        for (int s = 0; s < 4; ++s) kf0[i][s] = *(const bf16x8*)(kp + 16 * s);
    }
}
template <int NTILES, int CH, bool SYNC = true, bool KLDS = false>
__device__ __forceinline__ void attn_wave(const bf16x8 (&qf)[4], const bf16x8 (&kf0)[CH][4], const bf16_t* kb, const size_t kst, const int lk0, const int ls, const LAS bf16_t* vt, const int vts,
                                          float m_run, float l_run, f32x16& O0, f32x16& O1, float& m_out, float& l_out, const int r, const int h, const LAS bf16_t* kl = nullptr, const int kls = 0) {
#pragma unroll
    for (int i = 0; i < 16; ++i) { O0[i] = 0.f; O1[i] = 0.f; }
#pragma unroll
    for (int c0 = 0; c0 < NTILES; c0 += CH) {
        constexpr int dummy = 0; (void)dummy;
        f32x16 S[CH];
#pragma unroll
        for (int ii = 0; ii < CH; ++ii) {
            const int i = c0 + ii;
            if (i < NTILES) {
                int lkr = lk0 + 32 * i + r; lkr = lkr < 0 ? 0 : (lkr >= ls ? ls - 1 : lkr);
                const bf16_t* kp = kb + (size_t)lkr * kst;
                f32x16 a;
#pragma unroll
                for (int q = 0; q < 16; ++q) a[q] = 0.f;
#pragma unroll
                for (int s = 0; s < 4; ++s) {
                    bf16x8 kf;
                    if constexpr (KLDS) kf = *(const LAS bf16x8*)(kl + i * 32 * kls + 16 * s);
                    else { if (c0 == 0) kf = kf0[ii][s]; else kf = *(const bf16x8*)(kp + 16 * s); }
                    a = __builtin_amdgcn_mfma_f32_32x32x16_bf16(kf, qf[s], a, 0, 0, 0);
                }
                S[ii] = a;
            }
        }
        float mx = m_run;
#pragma unroll
        for (int ii = 0; ii < CH; ++ii) {
            const int i = c0 + ii;
            if (i < NTILES) {
                const bool edge = (lk0 + 32 * i < 0) || (lk0 + 32 * i + 32 > ls);
                if (edge || i == 0 || i == NTILES - 1) {
#pragma unroll
                    for (int q = 0; q < 16; ++q) {
                        const int row = (q & 3) + 8 * (q >> 2) + 4 * h;
                        const int lk = lk0 + 32 * i + row;
                        bool valid = (lk >= 0) && (lk < ls);
                        if (i == 0) valid = valid && (row >= r);
                        if (i == NTILES - 1) valid = valid && (row <= r);
                        const float sv = valid ? S[ii][q] : -1e30f;
                        S[ii][q] = sv;
                        mx = fmaxf(mx, sv);
                    }
                } else {
#pragma unroll
                    for (int q = 0; q < 16; ++q) mx = fmaxf(mx, S[ii][q]);
                }
            }
        }
        mx = fmaxf(mx, __shfl_xor(mx, 32));
        const float corr = __builtin_amdgcn_exp2f((m_run - mx) * 1.442695041f);
        float psum = 0.f;
#pragma unroll
        for (int ii = 0; ii < CH; ++ii) {
            const int i = c0 + ii;
            if (i < NTILES) {
#pragma unroll
                for (int q = 0; q < 16; ++q) { const float pv = __builtin_amdgcn_exp2f((S[ii][q] - mx) * 1.442695041f); S[ii][q] = pv; psum += pv; }
            }
        }
        psum += __shfl_xor(psum, 32);
        l_run = l_run * corr + psum;
        m_run = mx;
        if (c0 > 0) {
#pragma unroll
            for (int q = 0; q < 16; ++q) { O0[q] *= corr; O1[q] *= corr; }
        } else { if (SYNC) __syncthreads(); }
#pragma unroll
        for (int ii = 0; ii < CH; ++ii) {
            const int i = c0 + ii;
            if (i < NTILES) {
#pragma unroll
                for (int sp = 0; sp < 2; ++sp) {
                    const bf16x8 pf = pack8(S[ii][8 * sp + 0], S[ii][8 * sp + 1], S[ii][8 * sp + 2], S[ii][8 * sp + 3], S[ii][8 * sp + 4], S[ii][8 * sp + 5], S[ii][8 * sp + 6], S[ii][8 * sp + 7]);
                    const LAS bf16_t* v0 = vt + 32 * i + 16 * sp;
                    { const u32x2 a0 = *(const LAS u32x2*)(v0), a1 = *(const LAS u32x2*)(v0 + 8);
                      const u32x4 vw = (u32x4){a0.x, a0.y, a1.x, a1.y};
                      O0 = __builtin_amdgcn_mfma_f32_32x32x16_bf16(__builtin_bit_cast(bf16x8, vw), pf, O0, 0, 0, 0); }
                    { const u32x2 a0 = *(const LAS u32x2*)(v0 + 32 * vts), a1 = *(const LAS u32x2*)(v0 + 32 * vts + 8);
                      const u32x4 vw = (u32x4){a0.x, a0.y, a1.x, a1.y};
                      O1 = __builtin_amdgcn_mfma_f32_32x32x16_bf16(__builtin_bit_cast(bf16x8, vw), pf, O1, 0, 0, 0); }
                }
            }
        }
    }
    m_out = m_run; l_out = l_run;
}
__device__ __forceinline__ void ph_dilated_mfma(const Params& p, LAS unsigned char* lds) {
    const int tid = opaque_tid(), lane = tid & 63, wv = tid >> 6, hw = wv >> 2, w4 = wv & 3, tl = tid & 255, r = lane & 31, h = lane >> 5;
    constexpr int VTS = 260;
    LAS bf16_t* Vt = (LAS bf16_t*)lds + hw * (64 * VTS);
    LAS unsigned* Vt32 = (LAS unsigned*)Vt;
    const bf16_t* PROJ = (const bf16_t*)(p.ws + WS_PROJ);
    int ufirst, ucount, ustep;
    if (gridDim.x == 256) { if (blockIdx.x < 128) { ufirst = blockIdx.x * 2; ucount = 2; } else { ufirst = 256 + (blockIdx.x - 128) * 4; ucount = 4; } ustep = 1; }
    else { ufirst = blockIdx.x; ustep = gridDim.x; ucount = (768 - (int)blockIdx.x + (int)gridDim.x - 1) / (int)gridDim.x; }
    constexpr int KSTR = 72;
    LAS bf16_t* Ks = (LAS bf16_t*)(lds + 2 * 64 * VTS * 2) + hw * (256 * KSTR);
    bf16x8 qf[4]; bf16x8 kdummy[5][4];
    for (int k = 0; k <= 2 * ucount; ++k) {
        const int kk = k - hw, ui = kk >> 1;
        if (kk >= 0 && ui < ucount) {
            const int u = ufirst + ui * ustep;
            const int cfg = u >> 8, r8 = u & 255, b = r8 >> 6, head = (r8 >> 3) & 7, blk = (r8 & 7) * 2 + hw;
            const int dsh = 2 * cfg, dil = 1 << dsh, ls = SEQ >> dsh, nblk = ls >> 7;
            const int res = blk / nblk, l0 = (blk % nblk) * 128;
            const bf16_t* base = PROJ + ((size_t)b * SEQ + res) * NPROJ;
            const size_t kst = (size_t)dil * NPROJ;
            const int lq = l0 + 32 * w4 + r;
            const int lk0 = l0 + 32 * w4 - 64;
            if (!(kk & 1)) {
                u32x4 va[4], vb[4], kc[8];
#pragma unroll
                for (int i = 0; i < 4; ++i) {
                    const int task = tl + 256 * i, kp = task & 127, dc = task >> 7;
                    int lkA = l0 - 64 + 2 * kp; lkA = lkA < 0 ? 0 : (lkA > ls - 2 ? ls - 2 : lkA);
                    va[i] = *(const u32x4*)(base + (size_t)lkA * kst + PC_VD + head * 64 + 8 * dc);
                    vb[i] = *(const u32x4*)(base + (size_t)(lkA + 1) * kst + PC_VD + head * 64 + 8 * dc);
                }
#pragma unroll
                for (int i = 0; i < 8; ++i) {
                    const int id = tl + 256 * i, j = id >> 3, c8 = id & 7;
                    int lk = l0 - 64 + j; lk = lk < 0 ? 0 : (lk >= ls ? ls - 1 : lk);
                    kc[i] = *(const u32x4*)(base + (size_t)lk * kst + PC_KD + head * 64 + 8 * c8);
                }
                { const bf16_t* qp = base + (size_t)lq * kst + PC_QD + head * 64 + 8 * h;
#pragma unroll
                  for (int s2 = 0; s2 < 4; ++s2) qf[s2] = *(const bf16x8*)(qp + 16 * s2); }
#pragma unroll
                for (int i = 0; i < 4; ++i) {
                    const int task = tl + 256 * i, kp = task & 127, dc = task >> 7;
                    LAS unsigned* o = Vt32 + (8 * dc) * (VTS / 2) + kp;
                    o[0 * (VTS / 2)] = (va[i].x & 0xffffu) | (vb[i].x << 16); o[1 * (VTS / 2)] = (va[i].x >> 16) | (vb[i].x & 0xffff0000u);
                    o[2 * (VTS / 2)] = (va[i].y & 0xffffu) | (vb[i].y << 16); o[3 * (VTS / 2)] = (va[i].y >> 16) | (vb[i].y & 0xffff0000u);
                    o[4 * (VTS / 2)] = (va[i].z & 0xffffu) | (vb[i].z << 16); o[5 * (VTS / 2)] = (va[i].z >> 16) | (vb[i].z & 0xffff0000u);
                    o[6 * (VTS / 2)] = (va[i].w & 0xffffu) | (vb[i].w << 16); o[7 * (VTS / 2)] = (va[i].w >> 16) | (vb[i].w & 0xffff0000u);
                }
#pragma unroll
                for (int i = 0; i < 8; ++i) { const int id = tl + 256 * i, j = id >> 3, c8 = id & 7; *(LAS u32x4*)(Ks + j * KSTR + 8 * c8) = kc[i]; }
            } else {
                const LAS bf16_t* vt = Vt + r * VTS + 32 * w4 + 4 * h;
                const LAS bf16_t* kl = Ks + (32 * w4 + r) * KSTR + 8 * h;
                f32x16 O0, O1; float m, l;
                attn_wave<5, 5, false, true>(qf, kdummy, nullptr, kst, lk0, ls, vt, VTS, -1e30f, 0.f, O0, O1, m, l, r, h, kl, KSTR);
                const float inv = 1.f / l;
                const size_t tq = (size_t)b * SEQ + (size_t)lq * dil + res;
                bf16_t* o = (bf16_t*)(p.ws + WS_YD) + ((size_t)cfg * NT + tq) * 512 + head * 64 + 4 * h;
#pragma unroll
                for (int g = 0; g < 4; ++g) {
                    u32x2 w0; w0.x = pk2(O0[4 * g] * inv, O0[4 * g + 1] * inv); w0.y = pk2(O0[4 * g + 2] * inv, O0[4 * g + 3] * inv);
                    u32x2 w1; w1.x = pk2(O1[4 * g] * inv, O1[4 * g + 1] * inv); w1.y = pk2(O1[4 * g + 2] * inv, O1[4 * g + 3] * inv);
                    *(u32x2*)(o + 8 * g) = w0; *(u32x2*)(o + 32 + 8 * g) = w1;
                }
                if (h == 0) ((float*)(p.ws + WS_LSE))[((size_t)cfg * NT + tq) * 8 + head] = m + __logf(l);
            }
        }
        __syncthreads();
    }
}

__device__ __forceinline__ void ph_swa_mfma(const Params& p, int l, LAS unsigned char* lds) {
    const int tid = opaque_tid(), lane = tid & 63, wv = tid >> 6, g = wv >> 1, ph = wv & 1, r = lane & 31, h = lane >> 5;
    constexpr int VTS = 324;
    LAS bf16_t* Vt = (LAS bf16_t*)lds;
    LAS unsigned* Vt32 = (LAS unsigned*)lds;
    const bf16_t* PROJ = (const bf16_t*)(p.ws + WS_PROJ);
    for (int u = blockIdx.x; u < 256; u += gridDim.x) {
        const int b = u >> 6, kvh = (u >> 5) & 1, q0 = (u & 31) * 64;
        const bf16_t* base = PROJ + (size_t)b * SEQ * NPROJ;
        u32x4 va[3], vb[3];
#pragma unroll
        for (int i = 0; i < 3; ++i) {
            const int task = tid + 512 * i;
            if (task < 1280) {
                const int kp = task % 160, dc = task / 160;
                int kA = q0 - 128 + 2 * kp; kA = kA < 0 ? 0 : (kA > SEQ - 2 ? SEQ - 2 : kA);
                va[i] = *(const u32x4*)(base + (size_t)kA * NPROJ + PC_VC + kvh * 64 + 8 * dc);
                vb[i] = *(const u32x4*)(base + (size_t)(kA + 1) * NPROJ + PC_VC + kvh * 64 + 8 * dc);
            }
        }
        const int head = kvh * 4 + g;
        const int qpos = q0 + 32 * ph + r;
        const int lk0 = q0 + 32 * ph - 128;
        const bf16_t* kb = base + PC_KC + kvh * 64 + 8 * h;
        bf16x8 qf[4], kf0[5][4];
        attn_prefetch<5>(base + (size_t)qpos * NPROJ + PC_QC + head * 64 + 8 * h, kb, (size_t)NPROJ, lk0, SEQ, r, qf, kf0);
#pragma unroll
        for (int i = 0; i < 3; ++i) {
            const int task = tid + 512 * i;
            if (task < 1280) {
                const int kp = task % 160, dc = task / 160;
                LAS unsigned* o = Vt32 + (8 * dc) * (VTS / 2) + kp;
                o[0 * (VTS / 2)] = (va[i].x & 0xffffu) | (vb[i].x << 16); o[1 * (VTS / 2)] = (va[i].x >> 16) | (vb[i].x & 0xffff0000u);
                o[2 * (VTS / 2)] = (va[i].y & 0xffffu) | (vb[i].y << 16); o[3 * (VTS / 2)] = (va[i].y >> 16) | (vb[i].y & 0xffff0000u);
                o[4 * (VTS / 2)] = (va[i].z & 0xffffu) | (vb[i].z << 16); o[5 * (VTS / 2)] = (va[i].z >> 16) | (vb[i].z & 0xffff0000u);
                o[6 * (VTS / 2)] = (va[i].w & 0xffffu) | (vb[i].w << 16); o[7 * (VTS / 2)] = (va[i].w >> 16) | (vb[i].w & 0xffff0000u);
            }
        }
        {
            const LAS bf16_t* vt = Vt + r * VTS + 32 * ph + 4 * h;
            f32x16 O0, O1; float m, lsum;
            attn_wave<9, 5>(qf, kf0, kb, (size_t)NPROJ, lk0, SEQ, vt, VTS, p.in[11][l * 8 + head], 1.f, O0, O1, m, lsum, r, h);
            const float inv = 1.f / lsum;
            bf16_t* o = (bf16_t*)(p.ws + WS_YC) + ((size_t)b * SEQ + qpos) * 512 + head * 64 + 4 * h;
#pragma unroll
            for (int gg = 0; gg < 4; ++gg) {
                u32x2 w0; w0.x = pk2(O0[4 * gg] * inv, O0[4 * gg + 1] * inv); w0.y = pk2(O0[4 * gg + 2] * inv, O0[4 * gg + 3] * inv);
                u32x2 w1; w1.x = pk2(O1[4 * gg] * inv, O1[4 * gg + 1] * inv); w1.y = pk2(O1[4 * gg + 2] * inv, O1[4 * gg + 3] * inv);
                *(u32x2*)(o + 8 * gg) = w0; *(u32x2*)(o + 32 + 8 * gg) = w1;
            }
        }
        __syncthreads();
    }
}

__device__ __forceinline__ void ph_gmlp_mfma(const Params& p, int l, LAS unsigned char* lds) {
    const int tid = opaque_tid(), lane = tid & 63, wv = tid >> 6, hh = wv >> 1, ph = wv & 1, r = lane & 31, h = lane >> 5;
    constexpr int VTS = 136;
    LAS bf16_t* Vt = (LAS bf16_t*)lds;
    LAS unsigned* Vt32 = (LAS unsigned*)lds;
    LAS float* rv = (LAS float*)(lds + 256 * VTS * 2);
    const bf16_t* PROJ = (const bf16_t*)(p.ws + WS_PROJ); bf16_t* YB = (bf16_t*)(p.ws + WS_YB);
    const bf16_t* SW = (const bf16_t*)(p.ws + WS_SGUW) + (size_t)l * 8 * 128 * 128;
    const float* sn = p.in[8] + (size_t)l * 512;
    for (int u = blockIdx.x; u < 128; u += gridDim.x) {
        const int hg = u & 1, t0 = (u >> 1) * 128;
        { u32x4 w[16]; float ss[16];
#pragma unroll
          for (int q = 0; q < 16; ++q) w[q] = *(const u32x4*)(PROJ + (size_t)(t0 + wv * 16 + q) * NPROJ + PC_V + 8 * lane);
#pragma unroll
          for (int q = 0; q < 16; ++q) ss[q] = bflo(w[q].x) * bflo(w[q].x) + bfhi(w[q].x) * bfhi(w[q].x) + bflo(w[q].y) * bflo(w[q].y) + bfhi(w[q].y) * bfhi(w[q].y) + bflo(w[q].z) * bflo(w[q].z) + bfhi(w[q].z) * bfhi(w[q].z) + bflo(w[q].w) * bflo(w[q].w) + bfhi(w[q].w) * bfhi(w[q].w);
#pragma unroll
          for (int o = 1; o < 64; o <<= 1)
#pragma unroll
              for (int q = 0; q < 16; ++q) ss[q] += __shfl_xor(ss[q], o);
          float mine = 0.f;
#pragma unroll
          for (int q = 0; q < 16; ++q) mine = (lane == q) ? ss[q] : mine;
          if (lane < 16) rv[wv * 16 + lane] = 1.0f / sqrtf(mine * (1.f / 512.f) + EPS); }
        __syncthreads();
#pragma unroll
        for (int i = 0; i < 4; ++i) {
            const int task = tid + 512 * i, kp = task & 63, dc = task >> 6;
            const bf16_t* src = PROJ + (size_t)(t0 + 2 * kp) * NPROJ + PC_V + hg * 256 + 8 * dc;
            const u32x4 va = *(const u32x4*)src, vb = *(const u32x4*)(src + NPROJ);
            const float ra = rv[2 * kp], rb = rv[2 * kp + 1];
            const f32x4 g0 = *(const f32x4*)(sn + hg * 256 + 8 * dc), g1 = *(const f32x4*)(sn + hg * 256 + 8 * dc + 4);
            LAS unsigned* o = Vt32 + (8 * dc) * (VTS / 2) + kp;
            o[0 * (VTS / 2)] = pk2(bflo(va.x) * ra * g0[0], bflo(vb.x) * rb * g0[0]); o[1 * (VTS / 2)] = pk2(bfhi(va.x) * ra * g0[1], bfhi(vb.x) * rb * g0[1]);
            o[2 * (VTS / 2)] = pk2(bflo(va.y) * ra * g0[2], bflo(vb.y) * rb * g0[2]); o[3 * (VTS / 2)] = pk2(bfhi(va.y) * ra * g0[3], bfhi(vb.y) * rb * g0[3]);
            o[4 * (VTS / 2)] = pk2(bflo(va.z) * ra * g1[0], bflo(vb.z) * rb * g1[0]); o[5 * (VTS / 2)] = pk2(bfhi(va.z) * ra * g1[1], bfhi(vb.z) * rb * g1[1]);
            o[6 * (VTS / 2)] = pk2(bflo(va.w) * ra * g1[2], bflo(vb.w) * rb * g1[2]); o[7 * (VTS / 2)] = pk2(bfhi(va.w) * ra * g1[3], bfhi(vb.w) * rb * g1[3]);
        }
        __syncthreads();
        {
            const int habs = hg * 4 + hh;
            f32x16 acc[2][2];
#pragma unroll
            for (int ct = 0; ct < 2; ++ct)
#pragma unroll
                for (int pt = 0; pt < 2; ++pt)
#pragma unroll
                    for (int q = 0; q < 16; ++q) acc[ct][pt][q] = 0.f;
            const bf16_t* wp = SW + ((size_t)habs * 128 + 64 * ph + r) * 128 + 8 * h;
            const LAS bf16_t* ap = Vt + (hh * 64 + r) * VTS + 8 * h;
#pragma unroll
            for (int s = 0; s < 8; ++s) {
                bf16x8 bfr[2], afr[2];
#pragma unroll
                for (int pt = 0; pt < 2; ++pt) bfr[pt] = *(const bf16x8*)(wp + (size_t)pt * 32 * 128 + 16 * s);
#pragma unroll
                for (int ct = 0; ct < 2; ++ct) afr[ct] = *(const LAS bf16x8*)(ap + ct * 32 * VTS + 16 * s);
#pragma unroll
                for (int ct = 0; ct < 2; ++ct)
#pragma unroll
                    for (int pt = 0; pt < 2; ++pt) acc[ct][pt] = __builtin_amdgcn_mfma_f32_32x32x16_bf16(afr[ct], bfr[pt], acc[ct][pt], 0, 0, 0);
            }
#pragma unroll
            for (int pt = 0; pt < 2; ++pt) {
                const int pp = 64 * ph + 32 * pt + r;
                const float bias = p.in[10][((size_t)l * 8 + habs) * 128 + pp];
                const bf16_t* us = PROJ + (size_t)(t0 + pp) * NPROJ + PC_U + habs * 64 + 4 * h;
                bf16_t* o = YB + (size_t)(t0 + pp) * 512 + habs * 64 + 4 * h;
#pragma unroll
                for (int ct = 0; ct < 2; ++ct)
#pragma unroll
                    for (int gg = 0; gg < 4; ++gg) {
                        const u32x2 uw = *(const u32x2*)(us + 32 * ct + 8 * gg);
                        u32x2 w; w.x = pk2(bflo(uw.x) * (acc[ct][pt][4 * gg] + bias), bfhi(uw.x) * (acc[ct][pt][4 * gg + 1] + bias));
                        w.y = pk2(bflo(uw.y) * (acc[ct][pt][4 * gg + 2] + bias), bfhi(uw.y) * (acc[ct][pt][4 * gg + 3] + bias));
                        *(u32x2*)(o + 32 * ct + 8 * gg) = w;
                    }
            }
        }
        __syncthreads();
    }
}

__device__ __forceinline__ void ph_merge(const Params& p, int l, LAS unsigned char* lds) {
    const int tid = opaque_tid(), lane = tid & 63, wv = tid >> 6, r = lane & 31, h2 = lane >> 5;
    LAS float* ssA = (LAS float*)lds;
    const bf16_t* UV = (const bf16_t*)(p.ws + WS_YA); const bf16_t* YB = (const bf16_t*)(p.ws + WS_YB); const bf16_t* YC = (const bf16_t*)(p.ws + WS_YC); const bf16_t* YD = (const bf16_t*)(p.ws + WS_YD);
    const float* LSE = (const float*)(p.ws + WS_LSE); bf16_t* YN = (bf16_t*)(p.ws + WS_YN);
    const bf16_t* ABT = (const bf16_t*)(p.ws + WS_ABT) + ((size_t)l * 8 + wv) * 64 * 128;
    for (int blk = blockIdx.x; blk < NT / 32; blk += gridDim.x) {
        const int t0 = blk * 32, b = t0 >> 11, s0 = t0 & 2047;
        f32x16 O0, O1;
        {
#pragma unroll
            for (int q = 0; q < 16; ++q) { O0[q] = 0.f; O1[q] = 0.f; }
            const size_t row = ((size_t)b * 4096 + 2 * (s0 + r)) * 512 + wv * 64 + 8 * h2;
            u32x4 u0[8], u1[8];
#pragma unroll
            for (int s = 0; s < 8; ++s) { const size_t o = row + (s >> 2) * 512 + 16 * (s & 3); u0[s] = *(const u32x4*)(UV + o); u1[s] = *(const u32x4*)(UV + (size_t)4 * 4096 * 512 + o); }
            bf16x8 af0[8], af1[8];
#pragma unroll
            for (int s = 0; s < 8; ++s) { af0[s] = *(const bf16x8*)(ABT + (size_t)r * 128 + 16 * s + 8 * h2); af1[s] = *(const bf16x8*)(ABT + (size_t)(32 + r) * 128 + 16 * s + 8 * h2); }
#pragma unroll
            for (int s = 0; s < 8; ++s) {
                const bf16x8 bfr = pack8(bflo(u0[s].x) + bflo(u1[s].x), bfhi(u0[s].x) + bfhi(u1[s].x), bflo(u0[s].y) + bflo(u1[s].y), bfhi(u0[s].y) + bfhi(u1[s].y),
                                         bflo(u0[s].z) + bflo(u1[s].z), bfhi(u0[s].z) + bfhi(u1[s].z), bflo(u0[s].w) + bflo(u1[s].w), bfhi(u0[s].w) + bfhi(u1[s].w));
                O0 = __builtin_amdgcn_mfma_f32_32x32x16_bf16(af0[s], bfr, O0, 0, 0, 0);
                O1 = __builtin_amdgcn_mfma_f32_32x32x16_bf16(af1[s], bfr, O1, 0, 0, 0);
            }
            float ss = 0.f;
#pragma unroll
            for (int q = 0; q < 16; ++q) ss += O0[q] * O0[q] + O1[q] * O1[q];
            ss += __shfl_xor(ss, 32);
            if (h2 == 0) ssA[wv * 32 + r] = ss;
        }
#pragma unroll 1
        for (int i = 0; i < 4; ++i) {
            const int t = t0 + 4 * wv + i;
            float y[3][8];
            { const u32x4 w = *(const u32x4*)(YB + (size_t)t * 512 + 8 * lane);
                y[0][0] = bflo(w.x); y[0][1] = bfhi(w.x); y[0][2] = bflo(w.y); y[0][3] = bfhi(w.y); y[0][4] = bflo(w.z); y[0][5] = bfhi(w.z); y[0][6] = bflo(w.w); y[0][7] = bfhi(w.w); }
            { const u32x4 w = *(const u32x4*)(YC + (size_t)t * 512 + 8 * lane);
                y[1][0] = bflo(w.x); y[1][1] = bfhi(w.x); y[1][2] = bflo(w.y); y[1][3] = bfhi(w.y); y[1][4] = bflo(w.z); y[1][5] = bfhi(w.z); y[1][6] = bflo(w.w); y[1][7] = bfhi(w.w); }
            { const int head = lane >> 3;
              const float l0 = LSE[(size_t)t * 8 + head], l1 = LSE[((size_t)NT + t) * 8 + head], l2 = LSE[((size_t)2 * NT + t) * 8 + head];
              const float mx = fmaxf(l0, fmaxf(l1, l2)); float w0 = __expf(l0 - mx), w1 = __expf(l1 - mx), w2 = __expf(l2 - mx); const float iv = 1.f / (w0 + w1 + w2); w0 *= iv; w1 *= iv; w2 *= iv;
              const u32x4 a = *(const u32x4*)(YD + (size_t)t * 512 + 8 * lane), bq = *(const u32x4*)(YD + ((size_t)NT + t) * 512 + 8 * lane), c = *(const u32x4*)(YD + ((size_t)2 * NT + t) * 512 + 8 * lane);
              y[2][0] = w0 * bflo(a.x) + w1 * bflo(bq.x) + w2 * bflo(c.x); y[2][1] = w0 * bfhi(a.x) + w1 * bfhi(bq.x) + w2 * bfhi(c.x);
              y[2][2] = w0 * bflo(a.y) + w1 * bflo(bq.y) + w2 * bflo(c.y); y[2][3] = w0 * bfhi(a.y) + w1 * bfhi(bq.y) + w2 * bfhi(c.y);
              y[2][4] = w0 * bflo(a.z) + w1 * bflo(bq.z) + w2 * bflo(c.z); y[2][5] = w0 * bfhi(a.z) + w1 * bfhi(bq.z) + w2 * bfhi(c.z);
              y[2][6] = w0 * bflo(a.w) + w1 * bflo(bq.w) + w2 * bflo(c.w); y[2][7] = w0 * bfhi(a.w) + w1 * bfhi(bq.w) + w2 * bfhi(c.w); }
#pragma unroll
            for (int g = 0; g < 3; ++g) {
                float ss = 0.f;
#pragma unroll
                for (int q = 0; q < 8; ++q) ss += y[g][q] * y[g][q];
                const float rr = 1.0f / sqrtf(wave_sum(ss) * (1.f / 512.f) + EPS);
                u32x4 w; w.x = pk2(y[g][0] * rr, y[g][1] * rr); w.y = pk2(y[g][2] * rr, y[g][3] * rr); w.z = pk2(y[g][4] * rr, y[g][5] * rr); w.w = pk2(y[g][6] * rr, y[g][7] * rr);
                *(u32x4*)(YN + (size_t)t * DM + (g + 1) * 512 + 8 * lane) = w;
            }
        }
        __syncthreads();
        {
            float tot = 0.f;
#pragma unroll
            for (int w = 0; w < 8; ++w) tot += ssA[w * 32 + r];
            const float rr = 1.0f / sqrtf(tot * (1.f / 512.f) + EPS);
            bf16_t* o = YN + (size_t)(t0 + r) * DM + wv * 64 + 4 * h2;
#pragma unroll
            for (int g = 0; g < 4; ++g) {
                u32x2 w0; w0.x = pk2(O0[4 * g] * rr, O0[4 * g + 1] * rr); w0.y = pk2(O0[4 * g + 2] * rr, O0[4 * g + 3] * rr);
                u32x2 w1; w1.x = pk2(O1[4 * g] * rr, O1[4 * g + 1] * rr); w1.y = pk2(O1[4 * g + 2] * rr, O1[4 * g + 3] * rr);
                *(u32x2*)(o + 8 * g) = w0; *(u32x2*)(o + 32 + 8 * g) = w1;
            }
        }
        __syncthreads();
    }
}

#ifndef PHASE_MASK
#define PHASE_MASK 0xFFFFFFu
#endif
#define EN(k) (((PHASE_MASK) >> (k)) & 1u)
#ifndef REP_MASK
#define REP_MASK 0u
#endif
#define REP(k) _Pragma("unroll") for (int rep_ = 0; rep_ < 1 + (int)(((REP_MASK) >> (k)) & 1u); ++rep_)
constexpr int MIX_GW = 128, MIX_A = 4400;
constexpr int NPHASE = 22;
__global__ void __launch_bounds__(512, 2) mk_fwd(Params p) {
    extern __shared__ __attribute__((aligned(16))) unsigned char lds_raw[];
    LAS unsigned char* lds = (LAS unsigned char*)lds_raw;
    const int tid = threadIdx.x, G = gridDim.x, bx = blockIdx.x;
    volatile LAS unsigned* misc = (volatile LAS unsigned*)(lds + MISC_OFF);
    if (tid < 16) misc[tid] = 0u;
    __syncthreads();
    const int lo = p.ph_lo, hi = p.ph_hi;
    XcdBarrier bar; bar.bar = (unsigned*)(p.ws + WS_CTL); bar.x = 0; bar.st = misc + 8;
    if (hi - lo > 1) bar = xcd_barrier_post((unsigned*)(p.ws + WS_CTL), misc + 8);
#define IN(k) (lo <= (k) && (k) < hi)
#define SEAM(k) do { if (IN(k) && IN((k) + 1)) xcd_barrier(bar); } while (0)
    if (IN(0)) { if (EN(0)) REP(0) ph_mod(p, lds); if (EN(1)) REP(1) ph_tables(p); if (EN(2)) REP(2) ph_weights(p, lds, 0, G == 256 ? 240 : 6880, bx, G); }
    SEAM(0);
    for (int l = 0; l < 2; ++l) {
        const int pb = 1 + 10 * l;
        const char* H = (const char*)(p.ws + WS_H);
        if (EN(3) && IN(pb + 0)) REP(3) { ph_norm1(p, l); }
        SEAM(pb + 0);
        if (EN(4) && IN(pb + 1)) REP(4) {
            SchedProj S{H, (const char*)(p.ws + WS_WIN) + (size_t)l * NPROJ * 2048 * 2, (const char*)(p.ws + WS_WPQ) + (size_t)l * 512 * 2048 * 2, G, bx};
            EpiProj E{(bf16_t*)(p.ws + WS_PROJ), (bf16_t*)(p.ws + WS_PQT), (const float*)(p.ws + WS_ROPE), (const float*)(p.ws + WS_ROPE) + NT * 8};
            if (l == 0 && G == 256 && EN(2)) {
                if (bx < MIX_GW) { SchedProj S2{S.H, S.WIN, S.WPQ, MIX_GW, bx}; pg8::gemm_phase<EpiProj, SchedProj>(lds, 2048, 2048, 2048, S2, E); }
                else ph_weights(p, lds, 240, 240 + MIX_A, bx - MIX_GW, G - MIX_GW);
                __syncthreads();
                ph_weights(p, lds, 240 + MIX_A, 6880, bx, G);
            } else
            pg8::gemm_phase<EpiProj, SchedProj>(lds, 2048, 2048, 2048, S, E);
        }
        SEAM(pb + 1);
        if (IN(pb + 2)) {
            if (EN(5)) REP(5) { SchedDft S{(const char*)(p.ws + WS_DFT), (const char*)(p.ws + WS_PQT), G, bx};
              EpiBf16Plain E{(bf16_t*)(p.ws + WS_YA), 512, (size_t)4 * 4096 * 512};
              pg8::gemm_phase<EpiBf16Plain, SchedDft>(lds, 2048, 2048, 1024, S, E); }
            __syncthreads();
            if (EN(6)) REP(6) ph_gmlp_mfma(p, l, lds);
            if (EN(7)) REP(7) ph_swa_mfma(p, l, lds);
            if (EN(8)) REP(8) ph_dilated_mfma(p, lds);
        }
        SEAM(pb + 2);
        if (EN(9) && IN(pb + 3)) REP(9) { ph_merge(p, l, lds); }
        SEAM(pb + 3);
        if (EN(10) && IN(pb + 4)) REP(10) {
            SchedDense S{(const char*)(p.ws + WS_YN), (const char*)(p.ws + WS_WOUT) + (size_t)l * 2048 * 2048 * 2, 32, 8, 2048, G, bx};
            EpiWout E{l == 0 ? p.in[0] : nullptr, (const bf16_t*)(p.ws + WS_X), (bf16_t*)(p.ws + WS_X2), (const float*)(p.ws + WS_MOD) + (size_t)l * 4 * 12288 + 2 * 2048};
            pg8::gemm_phase<EpiWout, SchedDense>(lds, 2048, 2048, 2048, S, E);
        }
        SEAM(pb + 4);
        if (EN(11) && IN(pb + 5)) REP(11) { ph_norm2_router_mfma(p, l, lds); }
        SEAM(pb + 5);
        if (EN(12) && IN(pb + 6)) REP(12) { ph_topk(p, lds); }
        SEAM(pb + 6);
        if (EN(14) && IN(pb + 8)) REP(14) {
            SchedMoeG S{H, (const char*)(p.ws + WS_WGU) + (size_t)l * 16 * 2048 * 2048 * 2, 2048, G, bx};
            EpiGU E{(bf16_t*)(p.ws + WS_ACT)};
            pg8::gemm_phase<EpiGU, SchedMoeG, true>(lds, 2048, 2048, 2048, S, E, (const int*)(p.ws + WS_IDX));
        }
        SEAM(pb + 8);
        if (EN(15) && IN(pb + 9)) REP(15) {
            SchedMoe S{(const char*)(p.ws + WS_ACT), (const char*)(p.ws + WS_WD) + (size_t)l * 16 * 2048 * 1024 * 2, 1024, G, bx};
            EpiDown E{(bf16_t*)(p.ws + WS_EO), (const float*)(p.ws + WS_IDX + 65536)};
            pg8::gemm_phase<EpiDown, SchedMoe>(lds, 1024, 1024, 1024, S, E);
        }
        SEAM(pb + 9);
    }
    if (EN(16) && IN(21)) REP(16) { ph_norm1(p, 2); }
#undef IN
#undef SEAM
}

extern "C" void kernel_launch(void* const* d_in, const int* in_sizes, int n_in, void* d_out, int out_size, void* d_ws, size_t ws_size, hipStream_t stream) {
    static int grid = 0;
    if (grid == 0) {
        if (n_in != 20 || out_size != NT * DM || ws_size < WS_END) { fprintf(stderr, "kernel_launch: unexpected shapes (n_in %d out %d ws %zu)\n", n_in, out_size, ws_size); grid = -1; return; }
        int dev = 0, cus = 0, per_cu = 0;
        if (hipGetDevice(&dev) != hipSuccess || hipDeviceGetAttribute(&cus, hipDeviceAttributeMultiprocessorCount, dev) != hipSuccess) { grid = -1; return; }
        if (hipFuncSetAttribute((const void*)mk_fwd, hipFuncAttributeMaxDynamicSharedMemorySize, LDS_BYTES) != hipSuccess) { fprintf(stderr, "kernel_launch: hipFuncSetAttribute failed\n"); grid = -1; return; }
        if (hipOccupancyMaxActiveBlocksPerMultiprocessor(&per_cu, (const void*)mk_fwd, 512, LDS_BYTES) != hipSuccess || per_cu < 1) { fprintf(stderr, "kernel_launch: occupancy query says %d\n", per_cu); }
        (void)hipGetLastError();
        grid = cus;
    }
    if (grid < 0) return;
    (void)hipMemsetAsync((char*)d_ws + WS_CTL, 0, 64 * 1024, stream);
    Params p{};
    for (int i = 0; i < 20; ++i) p.in[i] = (const float*)d_in[i];
    p.out = (float*)d_out; p.ws = (unsigned char*)d_ws;
#if defined(MK_MULTI)
    for (int ph = 0; ph < NPHASE; ++ph) { p.ph_lo = ph; p.ph_hi = ph + 1; hipLaunchKernelGGL(mk_fwd, dim3(grid), dim3(512), LDS_BYTES, stream, p); }
#else
    p.ph_lo = 0; p.ph_hi = NPHASE; hipLaunchKernelGGL(mk_fwd, dim3(grid), dim3(512), LDS_BYTES, stream, p);
#endif
}
```

```cpp
#include <hip/hip_runtime.h>
#include <cstdio>
#include <cstdint>

#define LAS __attribute__((address_space(3)))
typedef unsigned short bf16_t;
typedef short bf16x8 __attribute__((ext_vector_type(8)));
typedef float f32x4 __attribute__((ext_vector_type(4)));
typedef float f32x2 __attribute__((ext_vector_type(2)));
typedef unsigned u32x4 __attribute__((ext_vector_type(4)));
typedef unsigned u32x2 __attribute__((ext_vector_type(2)));
typedef float f32x16 __attribute__((ext_vector_type(16)));

constexpr int NB = 4, SEQ = 2048, NT = NB * SEQ, DM = 2048, DIN = 3840, NPROJ = 3328, NE = 16, FF = 1024, CAP = 256;
constexpr float EPS = 1e-6f;
constexpr int PC_U = 0, PC_V = 512, PC_QC = 1024, PC_KC = 1536, PC_VC = 1664, PC_QD = 1792, PC_KD = 2304, PC_VD = 2816;

constexpr size_t MiB = (size_t)1 << 20;
constexpr size_t WS_CTL = 0;
constexpr size_t WS_MOD = 1 * MiB;
constexpr size_t WS_ROPE = WS_MOD + 512 * 1024;
constexpr size_t WS_DFT = 2 * MiB;
constexpr size_t WS_WIN = 18 * MiB;
constexpr size_t WS_WPQ = 44 * MiB;
constexpr size_t WS_WOUT = 52 * MiB;
constexpr size_t WS_WGU = 68 * MiB;
constexpr size_t WS_WD = 324 * MiB;
constexpr size_t WS_X = 452 * MiB;
constexpr size_t WS_X2 = 516 * MiB;
constexpr size_t WS_H = 580 * MiB;
constexpr size_t WS_PROJ = 612 * MiB;
constexpr size_t WS_PQT = 664 * MiB;
constexpr size_t WS_YA = 680 * MiB;
constexpr size_t WS_YB = 712 * MiB;
constexpr size_t WS_YC = 720 * MiB;
constexpr size_t WS_YD = 728 * MiB;
constexpr size_t WS_LSE = 752 * MiB;
constexpr size_t WS_YN = 753 * MiB;
constexpr size_t WS_AFF = 785 * MiB;
constexpr size_t WS_IDX = 786 * MiB;
constexpr size_t WS_XE = 787 * MiB;
constexpr size_t WS_ACT = 851 * MiB;
constexpr size_t WS_EO = 883 * MiB;
constexpr size_t WS_SGUW = 947 * MiB;
constexpr size_t WS_WRT = WS_SGUW + 512 * 1024;
constexpr size_t WS_ABT = WS_WRT + 128 * 1024;
constexpr size_t WS_END = 948 * MiB;

constexpr int LDS_BYTES = 163840;
constexpr int MISC_OFF = LDS_BYTES - 256;

struct Params { const float* in[20]; float* out; unsigned char* ws; int ph_lo, ph_hi; };

__device__ __forceinline__ unsigned pk2(float lo, float hi) { unsigned r; asm("v_cvt_pk_bf16_f32 %0, %1, %2" : "=v"(r) : "v"(lo), "v"(hi)); return r; }
__device__ __forceinline__ float bflo(unsigned u) { return __uint_as_float(u << 16); }
__device__ __forceinline__ float bfhi(unsigned u) { return __uint_as_float(u & 0xffff0000u); }
__device__ __forceinline__ float wave_sum(float v) {
#pragma unroll
    for (int o = 1; o < 64; o <<= 1) v += __shfl_xor(v, o);
    return v;
}
__device__ __forceinline__ float gelu_tanh(float x) { const float u = 0.7978845608f * (x + 0.044715f * x * x * x); return x * __builtin_amdgcn_rcpf(1.f + __builtin_amdgcn_exp2f(-2.885390082f * u)); }
__device__ __forceinline__ float silu_f(float x) { return x * __builtin_amdgcn_rcpf(1.f + __builtin_amdgcn_exp2f(-1.442695041f * x)); }

__device__ __forceinline__ int opaque_tid() { int t = threadIdx.x; asm volatile("" : "+v"(t)); return t; }
#define XB_TMO      128
#define XB_XCNT(j)  (256  + 64 * (j))
#define XB_XSUB(j)  (1280 + 64 * (j))
#define XB_XGEN(j)  (2304 + 64 * (j))
#define XB_TOP      3328
#define XB_TOPGEN   3392
#define XCD_BAR_WORDS 3456
#define XB_SPIN_CAP (1u << 18)
__device__ __forceinline__ unsigned xb_ld(unsigned* p)              { return __hip_atomic_load(p, __ATOMIC_RELAXED, __HIP_MEMORY_SCOPE_AGENT); }
__device__ __forceinline__ unsigned xb_add(unsigned* p, unsigned v) { return __hip_atomic_fetch_add(p, v, __ATOMIC_RELAXED, __HIP_MEMORY_SCOPE_AGENT); }
__device__ __forceinline__ unsigned xb_xcc_id() { return (unsigned)__builtin_amdgcn_s_getreg((3 << 11) | 20) & 0xFu; }
#define XB_SPIN(cond, bar) do { unsigned _sp = 0; while (cond) { __builtin_amdgcn_s_sleep(1); \
    if ((++_sp & 255u) == 0u) { if (xb_ld(&(bar)[XB_TMO])) break; if (_sp > XB_SPIN_CAP) { atomicAdd(&(bar)[XB_TMO], 1u); break; } } } } while (0)
struct XcdBarrier { unsigned* bar; unsigned x; volatile LAS unsigned* st; };
__device__ __forceinline__ XcdBarrier xcd_barrier_post(unsigned* bar, volatile LAS unsigned* st) {
    XcdBarrier b; b.bar = bar; b.x = xb_xcc_id(); b.st = st;
    if (threadIdx.x == 0) (void)xb_add(&bar[XB_XCNT(b.x)], 1u);
    return b;
}
__device__ __forceinline__ void xcd_barrier_complete(unsigned* bar, unsigned x, unsigned& nloc, unsigned& nx) {
    const unsigned G = gridDim.x * gridDim.y * gridDim.z;
    unsigned sum, cnt, mine, sp = 0u;
    for (;;) {
        sum = 0u; cnt = 0u; mine = 0u;
#pragma unroll
        for (unsigned j = 0; j < 16; ++j) { const unsigned c = xb_ld(&bar[XB_XCNT(j)]); sum += c; cnt += (c > 0u) ? 1u : 0u; mine = (j == x) ? c : mine; }
        if (sum == G) break;
        __builtin_amdgcn_s_sleep(1);
        if ((++sp & 255u) == 0u) { if (xb_ld(&bar[XB_TMO])) break; if (sp > XB_SPIN_CAP) { atomicAdd(&bar[XB_TMO], 1u); break; } }
    }
    nloc = mine > 0u ? mine : 1u; nx = cnt > 0u ? cnt : 1u;
}
__device__ __forceinline__ void xcd_barrier(const XcdBarrier& b) {
    asm volatile("s_waitcnt vmcnt(0)" ::: "memory");
    __syncthreads();
    if (threadIdx.x == 0) {
        unsigned* bar = b.bar;
        __builtin_amdgcn_s_waitcnt(0);
        unsigned nloc = b.st[0], nx = b.st[1];
        if (nloc == 0u) { xcd_barrier_complete(bar, b.x, nloc, nx); b.st[0] = nloc; b.st[1] = nx; }
        const unsigned old = xb_add(&bar[XB_XSUB(b.x)], 1u);
        const unsigned gen = old / nloc;
        if (old + 1u == (gen + 1u) * nloc) {
            __builtin_amdgcn_fence(__ATOMIC_RELEASE, "agent");
            asm volatile("s_waitcnt vmcnt(0)" ::: "memory");
            const unsigned og = xb_add(&bar[XB_TOP], 1u);
            const unsigned tg = og / nx;
            if (og + 1u == (tg + 1u) * nx) xb_add(&bar[XB_TOPGEN], 1u);
            else XB_SPIN(xb_ld(&bar[XB_TOPGEN]) == tg, bar);
            __builtin_amdgcn_fence(__ATOMIC_ACQUIRE, "agent");
            xb_add(&bar[XB_XGEN(b.x)], 1u);
            asm volatile("s_waitcnt vmcnt(0)" ::: "memory");
        } else {
            XB_SPIN(xb_ld(&bar[XB_XGEN(b.x)]) == gen, bar);
            __builtin_amdgcn_fence(__ATOMIC_ACQUIRE, "agent");
            asm volatile("s_waitcnt vmcnt(0)" ::: "memory");
        }
    }
    __syncthreads();
}

namespace pg8 {
constexpr int BM = 256, BK = 64, HALF = 128, HTB = HALF * BK * 2, STAGE_BYTES = 8 * HTB;
__host__ __device__ __forceinline__ int lds_byte(int r, int c) { const int st = (r >> 4) * 2 + (c >> 5), rr = r & 15, cc = c & 31, ob = rr * 64 + cc * 2; return st * 1024 + (ob ^ (((ob >> 9) & 1) << 5)); }
__host__ __device__ __forceinline__ void stage_rc(int b, int& R, int& C) { const int st = b / 1024, sb = b % 1024, swz = sb ^ (((sb >> 9) & 1) << 5); R = (st >> 1) * 16 + swz / 64; C = (st & 1) * 32 + (swz % 64) / 2; }
__host__ __device__ __forceinline__ int perm32(int rho) { const int n = rho >> 4, i = rho & 15; return 8 * (i >> 2) + 4 * n + (i & 3); }

struct GUnit { const char* a; const char* b; int pm, pn, z; };

__device__ __forceinline__ void dense_map(int L, int nM, int nN, int& pm, int& pn) {
    const int nwg = nM * nN;
    int wgid = L; { const int q = nwg / 8, r = nwg % 8, xcd = wgid % 8, off = wgid / 8; wgid = (xcd < r ? xcd * (q + 1) : r * (q + 1) + (xcd - r) * q) + off; }
    const int nig = 8 * nN, gid = wgid / nig, fm = gid * 8, gsz = (nM - fm) < 8 ? (nM - fm) : 8;
    pm = fm + ((wgid % nig) % gsz); pn = (wgid % nig) / gsz;
}

template <class Epi, class Sched, bool GATHER = false>
__device__ __forceinline__ void gemm_phase(LAS unsigned char* lds, const int lda, const int ldb, const int K, const Sched& S, const Epi& E, const int* gidx = nullptr) {
    int tid_ = threadIdx.x; asm volatile("" : "+v"(tid_));
    const int tid = tid_, wid = __builtin_amdgcn_readfirstlane(tid >> 6), lane = tid & 63, wr = wid >> 2, wc = wid & 3, fr = lane & 15, fq = lane >> 4;
    const int nt = K / BK;
    unsigned voffB[2]; int RA[2]; unsigned CA2[2];
#pragma unroll
    for (int i = 0; i < 2; ++i) { int R, C; stage_rc(tid * 16 + i * 8192, R, C); const int Rb = Epi::PERM ? ((R & ~31) + perm32(R & 31)) : R;
        RA[i] = R; CA2[i] = (unsigned)C * 2u; voffB[i] = (unsigned)(Rb * ldb + C) * 2u; }
    const size_t kstep = (size_t)(BK * 2);
    const size_t hstepB = (size_t)HALF * ldb * 2;
    const unsigned ldsw = (unsigned)wid * 1024u;
    const int aoff = lds_byte(wr * 64 + fr, fq * 8), boff = lds_byte(wc * 32 + fr, fq * 8);
#define PG8_AOFF(of, u) do { _Pragma("unroll") for (int hh_ = 0; hh_ < 2; ++hh_) _Pragma("unroll") for (int i_ = 0; i_ < 2; ++i_) { \
        if constexpr (GATHER) of[hh_][i_] = (unsigned)gidx[(u).pm * 256 + hh_ * 128 + RA[i_]] * (unsigned)(lda * 2) + CA2[i_]; \
        else of[hh_][i_] = (unsigned)((hh_ * HALF + RA[i_]) * lda) * 2u + CA2[i_]; } } while (0)
#define PG8_SA(b, h) (((b) * 2 + (h)) * HTB)
#define PG8_SB(b, h) ((4 + (b) * 2 + (h)) * HTB)
#define PG8_STAGE(bufoff, gbase, voff) do { _Pragma("unroll") for (int _i = 0; _i < 2; ++_i) \
        __builtin_amdgcn_global_load_lds((const unsigned*)((const char*)(gbase) + (voff)[_i]), (LAS unsigned*)(lds + (bufoff) + ldsw + _i * 8192), 16, 0, 0); } while (0)
#define PG8_LDA(dst, b, h) do { _Pragma("unroll") for (int m = 0; m < 4; ++m) _Pragma("unroll") for (int k = 0; k < 2; ++k) dst[m][k] = *(const LAS bf16x8*)(lds + PG8_SA(b, h) + aoff + m * 2048 + k * 1024); } while (0)
#define PG8_LDB(dst, b, h) do { _Pragma("unroll") for (int n = 0; n < 2; ++n) _Pragma("unroll") for (int k = 0; k < 2; ++k) dst[n][k] = *(const LAS bf16x8*)(lds + PG8_SB(b, h) + boff + n * 2048 + k * 1024); } while (0)
#define PG8_MMA(ai, bj, At, Bt) do { __builtin_amdgcn_s_setprio(1); _Pragma("unroll") for (int m = 0; m < 4; ++m) _Pragma("unroll") for (int n = 0; n < 2; ++n) _Pragma("unroll") for (int k = 0; k < 2; ++k) \
        acc[ai][bj][m][n] = __builtin_amdgcn_mfma_f32_16x16x32_bf16(Bt[n][k], At[m][k], acc[ai][bj][m][n], 0, 0, 0); __builtin_amdgcn_s_setprio(0); } while (0)
#define PG8_WAIT_V(n) asm volatile("s_waitcnt vmcnt(" #n ")" ::: "memory")
#define PG8_WAIT_L(n) asm volatile("s_waitcnt lgkmcnt(" #n ")" ::: "memory")
#define PG8_BAR __builtin_amdgcn_s_barrier()
#define PG8_SCHED __builtin_amdgcn_sched_barrier(0)
    GUnit cur, nxt; int ui = 0;
    if (!S.next(0, cur)) return;
    f32x4 acc[2][2][4][2];
#pragma unroll
    for (int a = 0; a < 2; ++a)
#pragma unroll
        for (int b = 0; b < 2; ++b)
#pragma unroll
            for (int m = 0; m < 4; ++m)
#pragma unroll
                for (int n = 0; n < 2; ++n) acc[a][b][m][n] = (f32x4){0.f, 0.f, 0.f, 0.f};
    bf16x8 At[4][2], B0[2][2], B1[2][2];
    unsigned ofc[2][2], ofn[2][2];
    PG8_AOFF(ofc, cur);
#pragma unroll
    for (int hh = 0; hh < 2; ++hh)
#pragma unroll
        for (int i = 0; i < 2; ++i) ofn[hh][i] = ofc[hh][i];
    const char* cA = cur.a; const char* cB = cur.b;
    PG8_STAGE(PG8_SB(0, 0), cB, voffB); PG8_STAGE(PG8_SB(0, 1), cB + hstepB, voffB); PG8_STAGE(PG8_SA(0, 0), cA, ofc[0]); PG8_STAGE(PG8_SA(0, 1), cA, ofc[1]);
    if (wr == 1) PG8_BAR;
    PG8_WAIT_V(2); PG8_BAR;
    PG8_STAGE(PG8_SB(1, 0), cB + kstep, voffB); PG8_STAGE(PG8_SA(1, 0), cA + kstep, ofc[0]); PG8_STAGE(PG8_SB(1, 1), cB + hstepB + kstep, voffB);
    PG8_WAIT_V(6); PG8_BAR;
    for (;;) {
        const bool has_next = S.next(ui + 1, nxt);
        const char* nA = has_next ? nxt.a : cA; const char* nB = has_next ? nxt.b : cB;
        for (int t = 0; t < nt; t += 2) {
            const bool last = (t == nt - 2);
            if constexpr (GATHER) { if (last && has_next) PG8_AOFF(ofn, nxt); }
            const char* a1 = cA + (size_t)(t + 1) * kstep;
            const char* a2 = last ? nA : cA + (size_t)(t + 2) * kstep; const char* b2 = last ? nB : cB + (size_t)(t + 2) * kstep;
            const char* a3 = a2 + kstep; const char* b3 = b2 + kstep;
            unsigned o2[2][2];
#pragma unroll
            for (int hh = 0; hh < 2; ++hh)
#pragma unroll
                for (int i = 0; i < 2; ++i) { if constexpr (GATHER) o2[hh][i] = last ? ofn[hh][i] : ofc[hh][i]; else o2[hh][i] = ofc[hh][i]; }
            PG8_LDB(B0, 0, 0); PG8_LDB(B1, 0, 1); PG8_SCHED; PG8_LDA(At, 0, 0); PG8_STAGE(PG8_SA(1, 1), a1, ofc[1]);
            PG8_WAIT_V(8); PG8_WAIT_L(0); PG8_BAR; PG8_MMA(0, 0, At, B0); PG8_MMA(0, 1, At, B1); PG8_BAR; PG8_SCHED;
            PG8_LDA(At, 0, 1); PG8_STAGE(PG8_SB(0, 0), b2, voffB); PG8_STAGE(PG8_SB(0, 1), b2 + hstepB, voffB); PG8_STAGE(PG8_SA(0, 0), a2, o2[0]);
            PG8_WAIT_V(8); PG8_WAIT_L(0); PG8_BAR; PG8_MMA(1, 0, At, B0); PG8_MMA(1, 1, At, B1); PG8_BAR; PG8_SCHED;
            PG8_LDB(B0, 1, 0); PG8_LDB(B1, 1, 1); PG8_SCHED; PG8_LDA(At, 1, 0); PG8_STAGE(PG8_SA(0, 1), a2, o2[1]);
            PG8_WAIT_V(8); PG8_WAIT_L(0); PG8_BAR; PG8_MMA(0, 0, At, B0); PG8_MMA(0, 1, At, B1); PG8_BAR; PG8_SCHED;
            PG8_LDA(At, 1, 1); PG8_STAGE(PG8_SB(1, 0), b3, voffB); PG8_STAGE(PG8_SB(1, 1), b3 + hstepB, voffB); PG8_STAGE(PG8_SA(1, 0), a3, o2[0]);
            PG8_WAIT_V(8); PG8_WAIT_L(0); PG8_BAR; PG8_MMA(1, 0, At, B0); PG8_MMA(1, 1, At, B1); PG8_BAR; PG8_SCHED;
        }
        if (wr == 0) PG8_BAR;
        E(acc, cur, wr, wc, fr, fq);
        if (!has_next) break;
#pragma unroll
        for (int a = 0; a < 2; ++a)
#pragma unroll
            for (int b = 0; b < 2; ++b)
#pragma unroll
                for (int m = 0; m < 4; ++m)
#pragma unroll
                    for (int n = 0; n < 2; ++n) acc[a][b][m][n] = (f32x4){0.f, 0.f, 0.f, 0.f};
        cur = nxt; cA = nA; cB = nB; ++ui;
        if constexpr (GATHER) {
#pragma unroll
            for (int hh = 0; hh < 2; ++hh)
#pragma unroll
                for (int i = 0; i < 2; ++i) ofc[hh][i] = ofn[hh][i];
        }
        if (wr == 1) PG8_BAR;
    }
    PG8_WAIT_V(0);
    PG8_BAR;
#undef PG8_AOFF
#undef PG8_SA
#undef PG8_SB
#undef PG8_STAGE
#undef PG8_LDA
#undef PG8_LDB
#undef PG8_MMA
#undef PG8_WAIT_V
#undef PG8_WAIT_L
#undef PG8_BAR
#undef PG8_SCHED
}
}
using pg8::GUnit;

struct SchedProj {
    const char* H; const char* WIN; const char* WPQ; int G, c;
    __device__ __forceinline__ bool next(int i, GUnit& u) const {
        const int L = i * G + c; if (L >= 480) return false;
        if (L < 416) { int pm, pn; pg8::dense_map(L, 32, 13, pm, pn); u.pm = pm; u.pn = pn; u.z = 0; u.a = H + (size_t)pm * 256 * 2048 * 2; u.b = WIN + (size_t)pn * 256 * 2048 * 2; }
        else { int pm, pn; pg8::dense_map(L - 416, 2, 32, pm, pn); u.pm = pm; u.pn = pn; u.z = 1; u.a = WPQ + (size_t)pm * 256 * 2048 * 2; u.b = H + (size_t)pn * 256 * 2048 * 2; }
        return true;
    }
};
struct SchedDft {
    const char* DFT; const char* XAT; int G, c;
    __device__ __forceinline__ bool next(int i, GUnit& u) const {
        const int L = i * G + c; if (L >= 256) return false;
        const int Lp = (L & 7) * 32 + (L >> 3);
        const int ks = Lp & 1, pn = (Lp >> 1) & 1, pm = (Lp >> 2) & 15, b = Lp >> 6;
        u.pm = b * 16 + pm; u.pn = pn; u.z = ks;
        u.a = DFT + ((size_t)pm * 256 * 2048 + ks * 1024) * 2; u.b = XAT + (((size_t)b * 512 + pn * 256) * 2048 + ks * 1024) * 2;
        return true;
    }
};
struct SchedDense {
    const char* A; const char* B; int nM, nN, K, G, c;
    __device__ __forceinline__ bool next(int i, GUnit& u) const {
        const int L = i * G + c; if (L >= nM * nN) return false;
        int pm, pn; pg8::dense_map(L, nM, nN, pm, pn); u.pm = pm; u.pn = pn; u.z = 0;
        u.a = A + (size_t)pm * 256 * K * 2; u.b = B + (size_t)pn * 256 * K * 2; return true;
    }
};
struct SchedMoeG {
    const char* A; const char* B; int K, G, c;
    __device__ __forceinline__ bool next(int i, GUnit& u) const {
        const int L = i * G + c; if (L >= 512) return false;
        const int Lp = (L & 7) * 64 + (L >> 3);
        const int e = Lp >> 5, r = Lp & 31, pm = r & 3, pn = r >> 2;
        u.pm = e * 4 + pm; u.pn = pn; u.z = e;
        u.a = A; u.b = B + ((size_t)e * 2048 + pn * 256) * K * 2; return true;
    }
};
struct SchedMoe {
    const char* A; const char* B; int K, G, c;
    __device__ __forceinline__ bool next(int i, GUnit& u) const {
        const int L = i * G + c; if (L >= 512) return false;
        const int Lp = (L & 7) * 64 + (L >> 3);
        const int e = Lp >> 5, r = Lp & 31, pm = r & 3, pn = r >> 2;
        u.pm = e * 4 + pm; u.pn = pn; u.z = e;
        u.a = A + ((size_t)e * 1024 + pm * 256) * K * 2; u.b = B + ((size_t)e * 2048 + pn * 256) * K * 2; return true;
    }
};

typedef f32x4 AccT[2][2][4][2];
struct EpiProj {
    static constexpr bool PERM = true;
    bf16_t* PROJ; bf16_t* PQT; const float* ropec; const float* ropes;
    __device__ __forceinline__ void operator()(const AccT& acc, const GUnit& u, int wr, int wc, int fr, int fq) const {
        if (u.z == 0) {
            const int pn = u.pn;
            const int row0 = u.pm * 256 + wr * 64 + fr;
#pragma unroll
            for (int ai = 0; ai < 2; ++ai)
#pragma unroll
                for (int m = 0; m < 4; ++m) {
                    const int row = row0 + ai * 128 + m * 16;
#pragma unroll
                    for (int bj = 0; bj < 2; ++bj) {
                        f32x4 v0 = acc[ai][bj][m][0], v1 = acc[ai][bj][m][1];
                        const int colt = pn * 256 + bj * 128;
                        if (pn < 4) {
#pragma unroll
                            for (int j = 0; j < 4; ++j) { v0[j] = gelu_tanh(v0[j]); v1[j] = gelu_tanh(v1[j]); }
                        } else {
                            const bool isq = (colt >= PC_QC && colt < PC_KC) || (colt >= PC_QD && colt < PC_KD);
                            const bool isk = (colt >= PC_KC && colt < PC_VC) || (colt >= PC_KD && colt < PC_VD);
                            if (isq || isk) {
                                if ((wc & 1) == 0) {
                                    f32x4 o0, o1;
#pragma unroll
                                    for (int j = 0; j < 4; ++j) { o0[j] = __shfl_xor(v0[j], 16); o1[j] = __shfl_xor(v1[j], 16); }
                                    if (fq < 2) {
                                        const f32x4 c0 = *(const f32x4*)(ropec + (size_t)row * 8), c1 = *(const f32x4*)(ropec + (size_t)row * 8 + 4);
                                        const f32x4 s0 = *(const f32x4*)(ropes + (size_t)row * 8), s1 = *(const f32x4*)(ropes + (size_t)row * 8 + 4);
                                        const float sg = fq == 0 ? -1.f : 1.f;
#pragma unroll
                                        for (int j = 0; j < 4; ++j) { v0[j] = v0[j] * c0[j] + sg * o0[j] * s0[j]; v1[j] = v1[j] * c1[j] + sg * o1[j] * s1[j]; }
                                    }
                                }
                                if (isq) { v0 = v0 * 0.125f; v1 = v1 * 0.125f; }
                            }
                        }
                        u32x4 w; w.x = pk2(v0[0], v0[1]); w.y = pk2(v0[2], v0[3]); w.z = pk2(v1[0], v1[1]); w.w = pk2(v1[2], v1[3]);
                        *(u32x4*)(PROJ + (size_t)row * NPROJ + colt + wc * 32 + 8 * fq) = w;
                    }
                }
        } else {
#pragma unroll
            for (int ai = 0; ai < 2; ++ai)
#pragma unroll
                for (int m = 0; m < 4; ++m) {
                    const int c = u.pm * 256 + ai * 128 + wr * 64 + m * 16 + fr;
#pragma unroll
                    for (int bj = 0; bj < 2; ++bj) {
                        const int t = u.pn * 256 + bj * 128 + wc * 32 + 8 * fq, b = t >> 11, s = t & 2047;
                        const f32x4 v0 = acc[ai][bj][m][0], v1 = acc[ai][bj][m][1];
                        u32x4 w; w.x = pk2(v0[0], v0[1]); w.y = pk2(v0[2], v0[3]); w.z = pk2(v1[0], v1[1]); w.w = pk2(v1[2], v1[3]);
                        *(u32x4*)(PQT + (((size_t)b * 512 + c) * 2048 + s)) = w;
                    }
                }
        }
    }
};
struct EpiBf16Plain {
    static constexpr bool PERM = true;
    bf16_t* O; int ldc; size_t zstride;
    __device__ __forceinline__ void operator()(const AccT& acc, const GUnit& u, int wr, int wc, int fr, int fq) const {
        bf16_t* base = O + (size_t)u.z * zstride;
#pragma unroll
        for (int ai = 0; ai < 2; ++ai)
#pragma unroll
            for (int m = 0; m < 4; ++m) {
                const int row = u.pm * 256 + ai * 128 + wr * 64 + m * 16 + fr;
#pragma unroll
                for (int bj = 0; bj < 2; ++bj) {
                    const f32x4 v0 = acc[ai][bj][m][0], v1 = acc[ai][bj][m][1];
                    u32x4 w; w.x = pk2(v0[0], v0[1]); w.y = pk2(v0[2], v0[3]); w.z = pk2(v1[0], v1[1]); w.w = pk2(v1[2], v1[3]);
                    *(u32x4*)(base + (size_t)row * ldc + u.pn * 256 + bj * 128 + wc * 32 + 8 * fq) = w;
                }
            }
    }
};
struct EpiWout {
    static constexpr bool PERM = true;
    const float* base32; const bf16_t* base16; bf16_t* X2; const float* gate;
    __device__ __forceinline__ void operator()(const AccT& acc, const GUnit& u, int wr, int wc, int fr, int fq) const {
        const int b = u.pm >> 3;
        const int col0 = u.pn * 256 + wc * 32 + 8 * fq;
        f32x4 g[2][2];
#pragma unroll
        for (int bj = 0; bj < 2; ++bj)
#pragma unroll
            for (int n = 0; n < 2; ++n) g[bj][n] = *(const f32x4*)(gate + (size_t)b * 12288 + col0 + bj * 128 + n * 4);
#pragma unroll
        for (int ai = 0; ai < 2; ++ai)
#pragma unroll
            for (int m = 0; m < 4; ++m) {
                const size_t ro = (size_t)(u.pm * 256 + ai * 128 + wr * 64 + m * 16 + fr) * DM + col0;
#pragma unroll
                for (int bj = 0; bj < 2; ++bj) {
                    f32x4 x0, x1;
                    if (base32) { x0 = *(const f32x4*)(base32 + ro + bj * 128); x1 = *(const f32x4*)(base32 + ro + bj * 128 + 4); }
                    else { const u32x4 w = *(const u32x4*)(base16 + ro + bj * 128); x0 = (f32x4){bflo(w.x), bfhi(w.x), bflo(w.y), bfhi(w.y)}; x1 = (f32x4){bflo(w.z), bfhi(w.z), bflo(w.w), bfhi(w.w)}; }
                    const f32x4 v0 = x0 + g[bj][0] * acc[ai][bj][m][0], v1 = x1 + g[bj][1] * acc[ai][bj][m][1];
                    u32x4 o; o.x = pk2(v0[0], v0[1]); o.y = pk2(v0[2], v0[3]); o.z = pk2(v1[0], v1[1]); o.w = pk2(v1[2], v1[3]);
                    *(u32x4*)(X2 + ro + bj * 128) = o;
                }
            }
    }
};
struct EpiGU {
    static constexpr bool PERM = true;
    bf16_t* ACT;
    __device__ __forceinline__ void operator()(const AccT& acc, const GUnit& u, int wr, int wc, int fr, int fq) const {
#pragma unroll
        for (int ai = 0; ai < 2; ++ai)
#pragma unroll
            for (int m = 0; m < 4; ++m) {
                const int row = u.pm * 256 + ai * 128 + wr * 64 + m * 16 + fr;
                f32x4 v0, v1;
#pragma unroll
                for (int j = 0; j < 4; ++j) { v0[j] = silu_f(acc[ai][0][m][0][j]) * acc[ai][1][m][0][j]; v1[j] = silu_f(acc[ai][0][m][1][j]) * acc[ai][1][m][1][j]; }
                u32x4 w; w.x = pk2(v0[0], v0[1]); w.y = pk2(v0[2], v0[3]); w.z = pk2(v1[0], v1[1]); w.w = pk2(v1[2], v1[3]);
                *(u32x4*)(ACT + (size_t)row * FF + u.pn * 128 + wc * 32 + 8 * fq) = w;
            }
    }
};
struct EpiDown {
    static constexpr bool PERM = true;
    bf16_t* EO; const float* gate;
    __device__ __forceinline__ void operator()(const AccT& acc, const GUnit& u, int wr, int wc, int fr, int fq) const {
#pragma unroll
        for (int ai = 0; ai < 2; ++ai)
#pragma unroll
            for (int m = 0; m < 4; ++m) {
                const int row = u.pm * 256 + ai * 128 + wr * 64 + m * 16 + fr;
                const float g = gate[row];
#pragma unroll
                for (int bj = 0; bj < 2; ++bj) {
                    const f32x4 v0 = acc[ai][bj][m][0] * g, v1 = acc[ai][bj][m][1] * g;
                    u32x4 w; w.x = pk2(v0[0], v0[1]); w.y = pk2(v0[2], v0[3]); w.z = pk2(v1[0], v1[1]); w.w = pk2(v1[2], v1[3]);
                    *(u32x4*)(EO + (size_t)row * DM + u.pn * 256 + bj * 128 + wc * 32 + 8 * fq) = w;
                }
            }
    }
};

__device__ __forceinline__ void ph_mod(const Params& p, LAS unsigned char* lds) {
    LAS float* sl = (LAS float*)lds;
    LAS float* red = (LAS float*)(lds + 32768);
    const int tid = opaque_tid();
    const float* c = p.in[1];
    float* mod = (float*)(p.ws + WS_MOD);
    for (int i = tid; i < 8192; i += 512) { const float v = c[i]; sl[i] = v / (1.f + expf(-v)); }
    __syncthreads();
    const int cl = tid & 31, ks = tid >> 5;
    for (int u = blockIdx.x; u < 192; u += gridDim.x) {
        const int l = u / 96, cc = u % 96;
        const float* W = p.in[3] + (size_t)l * 2048 * 12288 + cc * 128 + cl * 4;
        float acc[4][4];
#pragma unroll
        for (int b = 0; b < 4; ++b)
#pragma unroll
            for (int j = 0; j < 4; ++j) acc[b][j] = 0.f;
#pragma unroll 8
        for (int k = ks; k < 2048; k += 16) {
            const f32x4 w = __builtin_nontemporal_load((const f32x4*)(W + (size_t)k * 12288));
#pragma unroll
            for (int b = 0; b < 4; ++b) { const float s = sl[b * 2048 + k];
#pragma unroll
                for (int j = 0; j < 4; ++j) acc[b][j] += s * w[j]; }
        }
#pragma unroll
        for (int b = 0; b < 4; ++b)
#pragma unroll
            for (int j = 0; j < 4; ++j) red[((b * 4 + j) * 16 + ks) * 32 + cl] = acc[b][j];
        __syncthreads();
        { const int b = tid >> 7, col = tid & 127; float s = 0.f;
#pragma unroll
          for (int q = 0; q < 16; ++q) s += red[((b * 4 + (col & 3)) * 16 + q) * 32 + (col >> 2)];
          mod[(size_t)(l * 4 + b) * 12288 + cc * 128 + col] = s + p.in[4][(size_t)l * 12288 + cc * 128 + col]; }
        __syncthreads();
    }
}
__device__ __forceinline__ void ph_tables(const Params& p) {
    const int gt = blockIdx.x * 512 + opaque_tid(), ngt = gridDim.x * 512;
    float* rc = (float*)(p.ws + WS_ROPE); float* rs = rc + NT * 8;
    const int* pos = (const int*)p.in[2];
    for (int i = gt; i < NT * 8; i += ngt) {
        const int t = i >> 3, j = i & 7;
        float inv;
        switch (j) { case 0: inv = 1.0f; break; case 1: inv = 0.1939227432012558f; break; case 2: inv = 0.03760603070259094f; break; case 3: inv = 0.007292664609849453f; break;
                     case 4: inv = 0.0014142135623842478f; break; case 5: inv = 0.00027424818836152554f; break; case 6: inv = 5.318296098266728e-05f; break; default: inv = 1.0313386155758053e-05f; break; }
        const float ang = (float)pos[t] * inv;
        double r = (double)ang * 0.15915494309189535; r -= floor(r);
        const float a = (float)(2.0 * r);
        rc[i] = cospif(a); rs[i] = sinpif(a);
    }
    { bf16_t* sw = (bf16_t*)(p.ws + WS_SGUW);
      for (int i = gt; i < 2 * 8 * 128 * 128 / 4; i += ngt) { const f32x4 w = *(const f32x4*)(p.in[9] + (size_t)i * 4); u32x2 o; o.x = pk2(w[0], w[1]); o.y = pk2(w[2], w[3]); *(u32x2*)(sw + (size_t)i * 4) = o; } }
    { bf16_t* wrt = (bf16_t*)(p.ws + WS_WRT);
      for (int i = gt; i < 2 * 16 * 2048; i += ngt) { const int l = i >> 15, e = (i >> 11) & 15, k = i & 2047; wrt[i] = (bf16_t)(pk2(p.in[15][((size_t)l * 2048 + k) * 16 + e], 0.f) & 0xffffu); } }
    { bf16_t* abt = (bf16_t*)(p.ws + WS_ABT);
      for (int i = gt; i < 2 * 8 * 64 * 128; i += ngt) { const int k = i & 127, d = (i >> 7) & 63, lh = i >> 13, c = k & 63; const float* fw = p.in[7] + (size_t)lh * 4096;
          float sacc = 0.f;
          for (int cp = 0; cp < 64; ++cp) { const float a = (float)((c * cp) & 63) * (1.f / 32.f); sacc += ((k < 64) ? cospif(a) : sinpif(a)) * fw[cp * 64 + d]; }
          abt[i] = (bf16_t)(pk2(sacc * 0.125f, 0.f) & 0xffffu); } }
    bf16_t* dft = (bf16_t*)(p.ws + WS_DFT);
    for (int i = gt; i < 2048 * 512; i += ngt) {
        const int sp = i >> 9, k8 = (i & 511) * 8;
        float v[8];
#pragma unroll
        for (int e = 0; e < 8; ++e) { const int k = k8 + e, part = k >> 11, s = k & 2047, m = (s * sp) & 2047; const float a = (float)m * (1.f / 1024.f);
            v[e] = (part ? -sinpif(a) : cospif(a)) * 0.022097086912079608f; }
        u32x4 w; w.x = pk2(v[0], v[1]); w.y = pk2(v[2], v[3]); w.z = pk2(v[4], v[5]); w.w = pk2(v[6], v[7]);
        *(u32x4*)(dft + (size_t)sp * 4096 + k8) = w;
    }
}
struct TDesc { const float* src; bf16_t* dst; const float* ksc; int lds_, ldd; };
__device__ __forceinline__ bool tdecode(const Params& p, int it, TDesc& d) {
    if (it >= 2 * 6880) return false;
    const int l = it / 6880; int r = it % 6880;
    d.ksc = nullptr;
    if (r < 480) { const int kt = r / 30, nt = r % 30;
        d.src = p.in[6] + ((size_t)l * 2048 + kt * 128) * DIN + nt * 128; d.lds_ = DIN;
        d.dst = (nt < 4 ? (bf16_t*)(p.ws + WS_WPQ) + ((size_t)l * 512 + nt * 128) * 2048 : (bf16_t*)(p.ws + WS_WIN) + ((size_t)l * NPROJ + (nt - 4) * 128) * 2048) + kt * 128; d.ldd = 2048; return true; }
    r -= 480;
    if (r < 256) { const int kt = r / 16, nt = r % 16;
        d.src = p.in[13] + ((size_t)l * 2048 + kt * 128) * 2048 + nt * 128; d.lds_ = 2048; d.ksc = p.in[12] + (size_t)l * 2048 + kt * 128;
        d.dst = (bf16_t*)(p.ws + WS_WOUT) + ((size_t)l * 2048 + nt * 128) * 2048 + kt * 128; d.ldd = 2048; return true; }
    r -= 256;
    if (r < 4096) { const int isup = r / 2048, r2 = r % 2048, e = r2 / 128, kt = (r2 % 128) / 8, nt = r2 % 8;
        d.src = p.in[isup ? 17 : 16] + (((size_t)l * 16 + e) * 2048 + kt * 128) * 1024 + nt * 128; d.lds_ = 1024;
        d.dst = (bf16_t*)(p.ws + WS_WGU) + (((size_t)l * 16 + e) * 2048 + nt * 256 + isup * 128) * 2048 + kt * 128; d.ldd = 2048; return true; }
    r -= 4096;
    { const int e = r / 128, kt = (r % 128) / 16, nt = r % 16;
        d.src = p.in[18] + (((size_t)l * 16 + e) * 1024 + kt * 128) * 2048 + nt * 128; d.lds_ = 2048;
        d.dst = (bf16_t*)(p.ws + WS_WD) + (((size_t)l * 16 + e) * 2048 + nt * 128) * 1024 + kt * 128; d.ldd = 1024; return true; }
}
__device__ __forceinline__ void ph_weights(const Params& p, LAS unsigned char* lds, const int p0, const int p1, const int wi, const int wn) {
    const int tid = opaque_tid();
    LAS unsigned* l32 = (LAS unsigned*)lds;
    LAS bf16_t* l16 = (LAS bf16_t*)lds;
    TDesc dA0, dA1, dB0, dB1; f32x4 a0[8], a1[8], b0[8], b1[8];
#define PW_LOAD(pi, D0, D1, V0, V1, HAVE) do { HAVE = (pi) < p1; if (HAVE) { tdecode(p, 2 * (pi), D0); tdecode(p, 2 * (pi) + 1, D1); \
        _Pragma("unroll") for (int i = 0; i < 8; ++i) { const int f = tid + 512 * i, k = f >> 5, c4 = f & 31; \
            V0[i] = __builtin_nontemporal_load((const f32x4*)(D0.src + (size_t)k * D0.lds_ + c4 * 4)); V1[i] = __builtin_nontemporal_load((const f32x4*)(D1.src + (size_t)k * D1.lds_ + c4 * 4)); } } } while (0)
#define PW_TOLDS(D0, V0, V1) do { _Pragma("unroll") for (int i = 0; i < 8; ++i) { const int f = tid + 512 * i, k = f >> 5, c4 = f & 31; const float sc = D0.ksc ? D0.ksc[k] : 1.f; \
        const int sw = ((k >> 3) & 15) * 2; u32x2 w; w.x = pk2(V0[i][0] * sc, V0[i][1] * sc); w.y = pk2(V0[i][2] * sc, V0[i][3] * sc); \
        *(LAS u32x2*)(l32 + k * 64 + ((2 * c4) ^ sw)) = w; \
        u32x2 w2; w2.x = pk2(V1[i][0] * sc, V1[i][1] * sc); w2.y = pk2(V1[i][2] * sc, V1[i][3] * sc); \
        *(LAS u32x2*)(l32 + 8192 + k * 64 + ((2 * c4) ^ sw)) = w2; } } while (0)
#define PW_STORE(DS0, DS1) do { _Pragma("unroll") for (int i = 0; i < 4; ++i) { \
        const int n = (tid >> 4) + 32 * i, kc = tid & 15, cd = (n >> 1) ^ (2 * kc), hf = n & 1; \
        unsigned short e[8], g[8]; \
        _Pragma("unroll") for (int q = 0; q < 8; ++q) { e[q] = l16[((8 * kc + q) * 64 + cd) * 2 + hf]; g[q] = l16[16384 + ((8 * kc + q) * 64 + cd) * 2 + hf]; } \
        u32x4 w; w.x = e[0] | ((unsigned)e[1] << 16); w.y = e[2] | ((unsigned)e[3] << 16); w.z = e[4] | ((unsigned)e[5] << 16); w.w = e[6] | ((unsigned)e[7] << 16); \
        __builtin_nontemporal_store(w, (u32x4*)(DS0.dst + (size_t)n * DS0.ldd + 8 * kc)); \
        u32x4 w2; w2.x = g[0] | ((unsigned)g[1] << 16); w2.y = g[2] | ((unsigned)g[3] << 16); w2.z = g[4] | ((unsigned)g[5] << 16); w2.w = g[6] | ((unsigned)g[7] << 16); \
        __builtin_nontemporal_store(w2, (u32x4*)(DS1.dst + (size_t)n * DS1.ldd + 8 * kc)); } } while (0)
    int pi = p0 + wi; bool hA, hB;
    PW_LOAD(pi, dA0, dA1, a0, a1, hA);
    PW_LOAD(pi + wn, dB0, dB1, b0, b1, hB);
    while (hA) {
        { PW_TOLDS(dA0, a0, a1); __syncthreads(); const TDesc s0 = dA0, s1 = dA1; PW_LOAD(pi + 2 * wn, dA0, dA1, a0, a1, hA); PW_STORE(s0, s1); __syncthreads(); }
        if (!hB) break;
        { PW_TOLDS(dB0, b0, b1); __syncthreads(); const TDesc s0 = dB0, s1 = dB1; PW_LOAD(pi + 3 * wn, dB0, dB1, b0, b1, hB); PW_STORE(s0, s1); __syncthreads(); }
        pi += 2 * wn;
    }
#undef PW_LOAD
#undef PW_TOLDS
#undef PW_STORE
}

__device__ __forceinline__ void ph_norm1(const Params& p, int mode) {
    const int tid = opaque_tid(), lane = tid & 63, wv = tid >> 6;
    const float* mod = (const float*)(p.ws + WS_MOD);
    const int* slot_of = (const int*)(p.ws + WS_IDX + 131072);
    const bf16_t* EO = (const bf16_t*)(p.ws + WS_EO);
    for (int t = blockIdx.x * 8 + wv; t < NT; t += gridDim.x * 8) {
        const int b = t >> 11;
        f32x4 v[8];
        if (mode == 0) { const float* xr = p.in[0] + (size_t)t * DM;
#pragma unroll
            for (int j = 0; j < 8; ++j) v[j] = *(const f32x4*)(xr + 4 * lane + 256 * j);
        } else { const bf16_t* xr = (const bf16_t*)(p.ws + WS_X2) + (size_t)t * DM;
#pragma unroll
            for (int j = 0; j < 8; ++j) { const u32x2 w = *(const u32x2*)(xr + 4 * lane + 256 * j); v[j] = (f32x4){bflo(w.x), bfhi(w.x), bflo(w.y), bfhi(w.y)}; }
        }
        if (mode != 0) {
            f32x4 macc[8];
#pragma unroll
            for (int j = 0; j < 8; ++j) macc[j] = (f32x4){0.f, 0.f, 0.f, 0.f};
            const int myslot = slot_of[(size_t)(lane & 15) * NT + t];
            unsigned m = (unsigned)(__ballot(myslot >= 0) & 0xffffull);
            while (m) {
                const int e0 = __builtin_ctz(m); m &= m - 1u;
                const bool two = m != 0u; const int e1 = two ? __builtin_ctz(m) : e0; if (two) m &= m - 1u;
                const int s0 = __builtin_amdgcn_readlane(myslot, e0), s1 = __builtin_amdgcn_readlane(myslot, e1);
                const float w1 = two ? 1.f : 0.f;
                const bf16_t* r0 = EO + (size_t)s0 * DM; const bf16_t* r1 = EO + (size_t)s1 * DM;
                u32x2 a[8], c[8];
#pragma unroll
                for (int j = 0; j < 8; ++j) { a[j] = *(const u32x2*)(r0 + 4 * lane + 256 * j); c[j] = *(const u32x2*)(r1 + 4 * lane + 256 * j); }
#pragma unroll
                for (int j = 0; j < 8; ++j) {
                    macc[j][0] += bflo(a[j].x) + w1 * bflo(c[j].x); macc[j][1] += bfhi(a[j].x) + w1 * bfhi(c[j].x);
                    macc[j][2] += bflo(a[j].y) + w1 * bflo(c[j].y); macc[j][3] += bfhi(a[j].y) + w1 * bfhi(c[j].y); }
            }
            const float* gf = mod + ((size_t)(mode - 1) * 4 + b) * 12288 + 5 * 2048;
#pragma unroll
            for (int j = 0; j < 8; ++j) { const f32x4 g = *(const f32x4*)(gf + 4 * lane + 256 * j); v[j] = v[j] + g * macc[j]; }
            if (mode == 1) {
                bf16_t* xo = (bf16_t*)(p.ws + WS_X) + (size_t)t * DM;
#pragma unroll
                for (int j = 0; j < 8; ++j) { u32x2 w; w.x = pk2(v[j][0], v[j][1]); w.y = pk2(v[j][2], v[j][3]); *(u32x2*)(xo + 4 * lane + 256 * j) = w;
                    v[j] = (f32x4){bflo(w.x), bfhi(w.x), bflo(w.y), bfhi(w.y)}; }
            }
        }
        float ss = 0.f;
#pragma unroll
        for (int j = 0; j < 8; ++j) ss += v[j][0] * v[j][0] + v[j][1] * v[j][1] + v[j][2] * v[j][2] + v[j][3] * v[j][3];
        const float r = 1.0f / sqrtf(wave_sum(ss) * (1.f / DM) + EPS);
        if (mode == 2) {
            float* o = p.out + (size_t)t * DM;
#pragma unroll
            for (int j = 0; j < 8; ++j) { const f32x4 g = *(const f32x4*)(p.in[19] + 4 * lane + 256 * j); *(f32x4*)(o + 4 * lane + 256 * j) = v[j] * r * g; }
        } else {
            const int l = mode;
            const float* g1 = p.in[5] + (size_t)l * DM;
            const float* sh = mod + ((size_t)l * 4 + b) * 12288;
            const float* sc = sh + 2048;
            bf16_t* ho = (bf16_t*)(p.ws + WS_H) + (size_t)t * DM;
#pragma unroll
            for (int j = 0; j < 8; ++j) {
                const f32x4 g = *(const f32x4*)(g1 + 4 * lane + 256 * j), s1 = *(const f32x4*)(sc + 4 * lane + 256 * j), s0 = *(const f32x4*)(sh + 4 * lane + 256 * j);
                const f32x4 h = (v[j] * r * g) * (s1 + 1.f) + s0;
                u32x2 w; w.x = pk2(h[0], h[1]); w.y = pk2(h[2], h[3]);
                *(u32x2*)(ho + 4 * lane + 256 * j) = w;
            }
        }
    }
}


__device__ __forceinline__ void ph_norm2_router_mfma(const Params& p, int l, LAS unsigned char* lds) {
    const int tid = opaque_tid(), lane = tid & 63, wv = tid >> 6, r = lane & 31, h = lane >> 5;
    LAS float* part = (LAS float*)lds;
    LAS float* lgs = (LAS float*)(lds + 8 * 32 * 17 * 4);
    const float* mod = (const float*)(p.ws + WS_MOD);
    const float* g2 = p.in[14] + (size_t)l * DM;
    const bf16_t* WRT = (const bf16_t*)(p.ws + WS_WRT) + (size_t)l * 16 * 2048;
    bf16_t* Hb = (bf16_t*)(p.ws + WS_H);
    float* aff = (float*)(p.ws + WS_AFF);
    for (int blk = blockIdx.x; blk < NT / 32; blk += gridDim.x) {
        const int t0 = blk * 32, b = t0 >> 11;
        const float* sh = mod + ((size_t)l * 4 + b) * 12288 + 3 * 2048;
        const float* sc = sh + 2048;
#pragma unroll 1
        for (int half = 0; half < 2; ++half) {
            const int ta = t0 + 4 * wv + 2 * half;
            const bf16_t* xa = (const bf16_t*)(p.ws + WS_X2) + (size_t)ta * DM;
            f32x4 va[8], vb[8];
#pragma unroll
            for (int j = 0; j < 8; ++j) { const u32x2 wa = *(const u32x2*)(xa + 4 * lane + 256 * j), wb = *(const u32x2*)(xa + DM + 4 * lane + 256 * j);
                va[j] = (f32x4){bflo(wa.x), bfhi(wa.x), bflo(wa.y), bfhi(wa.y)}; vb[j] = (f32x4){bflo(wb.x), bfhi(wb.x), bflo(wb.y), bfhi(wb.y)}; }
            float sa = 0.f, sb = 0.f;
#pragma unroll
            for (int j = 0; j < 8; ++j) { sa += va[j][0] * va[j][0] + va[j][1] * va[j][1] + va[j][2] * va[j][2] + va[j][3] * va[j][3]; sb += vb[j][0] * vb[j][0] + vb[j][1] * vb[j][1] + vb[j][2] * vb[j][2] + vb[j][3] * vb[j][3]; }
#pragma unroll
            for (int o = 1; o < 64; o <<= 1) { sa += __shfl_xor(sa, o); sb += __shfl_xor(sb, o); }
            const float ra = 1.0f / sqrtf(sa * (1.f / DM) + EPS), rb = 1.0f / sqrtf(sb * (1.f / DM) + EPS);
            bf16_t* ho = Hb + (size_t)ta * DM;
#pragma unroll
            for (int j = 0; j < 8; ++j) {
                const f32x4 g = *(const f32x4*)(g2 + 4 * lane + 256 * j), s1 = *(const f32x4*)(sc + 4 * lane + 256 * j), s0 = *(const f32x4*)(sh + 4 * lane + 256 * j);
                const f32x4 gg = g * (s1 + 1.f);
                const f32x4 ha = (va[j] * ra) * gg + s0, hb = (vb[j] * rb) * gg + s0;
                u32x2 wa; wa.x = pk2(ha[0], ha[1]); wa.y = pk2(ha[2], ha[3]);
                u32x2 wb; wb.x = pk2(hb[0], hb[1]); wb.y = pk2(hb[2], hb[3]);
                *(u32x2*)(ho + 4 * lane + 256 * j) = wa; *(u32x2*)(ho + DM + 4 * lane + 256 * j) = wb;
            }
        }
        asm volatile("s_waitcnt vmcnt(0)" ::: "memory");
        __syncthreads();
        {
            f32x16 acc;
#pragma unroll
            for (int q = 0; q < 16; ++q) acc[q] = 0.f;
            const bf16_t* bp = Hb + (size_t)(t0 + r) * DM + 256 * wv + 8 * h;
            const bf16_t* ap = WRT + (size_t)(r & 15) * 2048 + 256 * wv + 8 * h;
            bf16x8 bfr[16], afr[16];
#pragma unroll
            for (int s = 0; s < 16; ++s) { bfr[s] = *(const bf16x8*)(bp + 16 * s); afr[s] = *(const bf16x8*)(ap + 16 * s); }
#pragma unroll
            for (int s = 0; s < 16; ++s) { const bf16x8 a = (r < 16) ? afr[s] : (bf16x8){0, 0, 0, 0, 0, 0, 0, 0}; acc = __builtin_amdgcn_mfma_f32_32x32x16_bf16(a, bfr[s], acc, 0, 0, 0); }
#pragma unroll
            for (int q = 0; q < 8; ++q) { const int e = (q & 3) + 8 * (q >> 2) + 4 * h; part[(wv * 32 + r) * 17 + e] = acc[q]; }
        }
        __syncthreads();
        const int e = tid >> 5, tk = tid & 31;
        { float s = 0.f;
#pragma unroll
          for (int w = 0; w < 8; ++w) s += part[(w * 32 + tk) * 17 + e];
          lgs[e * 32 + tk] = s; }
        __syncthreads();
        { float lg[16]; float mx = -1e30f;
#pragma unroll
          for (int q = 0; q < 16; ++q) { lg[q] = lgs[q * 32 + tk]; mx = fmaxf(mx, lg[q]); }
          float den = 0.f, mine = 0.f;
#pragma unroll
          for (int q = 0; q < 16; ++q) { const float ex = expf(lg[q] - mx); den += ex; mine = (q == e) ? ex : mine; }
          aff[((size_t)b * 16 + e) * 2048 + (t0 & 2047) + tk] = mine / den; }
        __syncthreads();
    }
}

__device__ __forceinline__ unsigned block_excl_scan(unsigned cnt, LAS unsigned* wsum, int tid) {
    const int lane = tid & 63, wv = tid >> 6;
    unsigned inc = cnt;
#pragma unroll
    for (int o = 1; o < 64; o <<= 1) { const unsigned t = __shfl_up(inc, o); if (lane >= o) inc += t; }
    if (lane == 63) wsum[wv] = inc;
    __syncthreads();
    unsigned base = 0;
#pragma unroll
    for (int w = 0; w < 8; ++w) base += (w < wv) ? wsum[w] : 0u;
    __syncthreads();
    return base + inc - cnt;
}
__device__ __forceinline__ void ph_topk(const Params& p, LAS unsigned char* lds) {
    const int tid = opaque_tid();
    LAS unsigned* hist = (LAS unsigned*)lds;
    LAS unsigned* misc = hist + 256;
    LAS unsigned* wsum = hist + 320;
    const float* aff = (const float*)(p.ws + WS_AFF);
    int* idx = (int*)(p.ws + WS_IDX); float* gate = (float*)(p.ws + WS_IDX + 65536); int* slot_of = (int*)(p.ws + WS_IDX + 131072);
    for (int u = blockIdx.x; u < 64; u += gridDim.x) {
        const int b = u >> 4, e = u & 15;
        const f32x4 a = *(const f32x4*)(aff + (size_t)u * 2048 + 4 * tid);
        unsigned k[4];
#pragma unroll
        for (int i = 0; i < 4; ++i) k[i] = __float_as_uint(a[i]);
        unsigned prefix = 0, krem = CAP;
#pragma unroll 1
        for (int pass = 0; pass < 4; ++pass) {
            const int shift = 24 - 8 * pass;
            if (tid < 256) hist[tid] = 0;
            __syncthreads();
#pragma unroll
            for (int i = 0; i < 4; ++i) if (pass == 0 || (k[i] >> (shift + 8)) == prefix) __hip_atomic_fetch_add(&hist[(k[i] >> shift) & 255u], 1u, __ATOMIC_RELAXED, __HIP_MEMORY_SCOPE_WORKGROUP);
            __syncthreads();
            { const unsigned cnt = (tid < 256) ? hist[255 - tid] : 0u;
              const unsigned Sn = block_excl_scan(cnt, wsum, tid), S = Sn + cnt;
              if (tid < 256 && S >= krem && Sn < krem) { misc[0] = (prefix << 8) | (unsigned)(255 - tid); misc[1] = krem - Sn; } }
            __syncthreads();
            prefix = misc[0]; krem = misc[1];
            __syncthreads();
        }
        unsigned neq = 0;
#pragma unroll
        for (int i = 0; i < 4; ++i) neq += (k[i] == prefix) ? 1u : 0u;
        unsigned eqbase = block_excl_scan(neq, wsum, tid);
        unsigned sel[4]; unsigned nsel = 0;
#pragma unroll
        for (int i = 0; i < 4; ++i) { const bool eq = k[i] == prefix; sel[i] = (k[i] > prefix || (eq && eqbase < krem)) ? 1u : 0u; eqbase += eq ? 1u : 0u; nsel += sel[i]; }
        unsigned sb = block_excl_scan(nsel, wsum, tid);
#pragma unroll
        for (int i = 0; i < 4; ++i) {
            const int s = 4 * tid + i, t = b * 2048 + s;
            if (sel[i]) { const int row = e * 1024 + b * 256 + (int)sb; idx[row] = t; gate[row] = a[i]; slot_of[(size_t)e * NT + t] = row; ++sb; }
            else slot_of[(size_t)e * NT + t] = -1;
        }
        __syncthreads();
    }
}

__device__ __forceinline__ bf16x8 pack8(float a0, float a1, float a2, float a3, float a4, float a5, float a6, float a7) {
    u32x4 p;
    asm volatile("v_cvt_pk_bf16_f32 %0, %4, %5\n\tv_cvt_pk_bf16_f32 %1, %6, %7\n\tv_cvt_pk_bf16_f32 %2, %8, %9\n\tv_cvt_pk_bf16_f32 %3, %10, %11\n\ts_nop 1"
                 : "=&v"(p[0]), "=&v"(p[1]), "=&v"(p[2]), "=&v"(p[3]) : "v"(a0), "v"(a1), "v"(a2), "v"(a3), "v"(a4), "v"(a5), "v"(a6), "v"(a7));
    return __builtin_bit_cast(bf16x8, p);
}
template <int CH>
__device__ __forceinline__ void attn_prefetch(const bf16_t* qp, const bf16_t* kb, const size_t kst, const int lk0, const int ls, const int r, bf16x8 (&qf)[4], bf16x8 (&kf0)[CH][4]) {
#pragma unroll
    for (int s = 0; s < 4; ++s) qf[s] = *(const bf16x8*)(qp + 16 * s);
#pragma unroll
    for (int i = 0; i < CH; ++i) {
        int lkr = lk0 + 32 * i + r; lkr = lkr < 0 ? 0 : (lkr >= ls ? ls - 1 : lkr);
        const bf16_t* kp = kb + (size_t)lkr * kst;
#pragma unroll
        for (int s = 0; s < 4; ++s) kf0[i][s] = *(const bf16x8*)(kp + 16 * s);
    }
}
template <int NTILES, int CH, bool SYNC = true, bool KLDS = false>
__device__ __forceinline__ void attn_wave(const bf16x8 (&qf)[4], const bf16x8 (&kf0)[CH][4], const bf16_t* kb, const size_t kst, const int lk0, const int ls, const LAS bf16_t* vt, const int vts,
                                          float m_run, float l_run, f32x16& O0, f32x16& O1, float& m_out, float& l_out, const int r, const int h, const LAS bf16_t* kl = nullptr, const int kls = 0) {
#pragma unroll
    for (int i = 0; i < 16; ++i) { O0[i] = 0.f; O1[i] = 0.f; }
#pragma unroll
    for (int c0 = 0; c0 < NTILES; c0 += CH) {
        constexpr int dummy = 0; (void)dummy;
        f32x16 S[CH];
#pragma unroll
        for (int ii = 0; ii < CH; ++ii) {
            const int i = c0 + ii;
            if (i < NTILES) {
                int lkr = lk0 + 32 * i + r; lkr = lkr < 0 ? 0 : (lkr >= ls ? ls - 1 : lkr);
                const bf16_t* kp = kb + (size_t)lkr * kst;
                f32x16 a;
#pragma unroll
                for (int q = 0; q < 16; ++q) a[q] = 0.f;
#pragma unroll
                for (int s = 0; s < 4; ++s) {
                    bf16x8 kf;
                    if constexpr (KLDS) kf = *(const LAS bf16x8*)(kl + i * 32 * kls + 16 * s);
                    else { if (c0 == 0) kf = kf0[ii][s]; else kf = *(const bf16x8*)(kp + 16 * s); }
                    a = __builtin_amdgcn_mfma_f32_32x32x16_bf16(kf, qf[s], a, 0, 0, 0);
                }
                S[ii] = a;
            }
        }
        float mx = m_run;
#pragma unroll
        for (int ii = 0; ii < CH; ++ii) {
            const int i = c0 + ii;
            if (i < NTILES) {
                const bool edge = (lk0 + 32 * i < 0) || (lk0 + 32 * i + 32 > ls);
                if (edge || i == 0 || i == NTILES - 1) {
#pragma unroll
                    for (int q = 0; q < 16; ++q) {
                        const int row = (q & 3) + 8 * (q >> 2) + 4 * h;
                        const int lk = lk0 + 32 * i + row;
                        bool valid = (lk >= 0) && (lk < ls);
                        if (i == 0) valid = valid && (row >= r);
                        if (i == NTILES - 1) valid = valid && (row <= r);
                        const float sv = valid ? S[ii][q] : -1e30f;
                        S[ii][q] = sv;
                        mx = fmaxf(mx, sv);
                    }
                } else {
#pragma unroll
                    for (int q = 0; q < 16; ++q) mx = fmaxf(mx, S[ii][q]);
                }
            }
        }
        mx = fmaxf(mx, __shfl_xor(mx, 32));
        const float corr = __builtin_amdgcn_exp2f((m_run - mx) * 1.442695041f);
        float psum = 0.f;
#pragma unroll
        for (int ii = 0; ii < CH; ++ii) {
            const int i = c0 + ii;
            if (i < NTILES) {
#pragma unroll
                for (int q = 0; q < 16; ++q) { const float pv = __builtin_amdgcn_exp2f((S[ii][q] - mx) * 1.442695041f); S[ii][q] = pv; psum += pv; }
            }
        }
        psum += __shfl_xor(psum, 32);
        l_run = l_run * corr + psum;
        m_run = mx;
        if (c0 > 0) {
#pragma unroll
            for (int q = 0; q < 16; ++q) { O0[q] *= corr; O1[q] *= corr; }
        } else { if (SYNC) __syncthreads(); }
#pragma unroll
        for (int ii = 0; ii < CH; ++ii) {
            const int i = c0 + ii;
            if (i < NTILES) {
#pragma unroll
                for (int sp = 0; sp < 2; ++sp) {
                    const bf16x8 pf = pack8(S[ii][8 * sp + 0], S[ii][8 * sp + 1], S[ii][8 * sp + 2], S[ii][8 * sp + 3], S[ii][8 * sp + 4], S[ii][8 * sp + 5], S[ii][8 * sp + 6], S[ii][8 * sp + 7]);
                    const LAS bf16_t* v0 = vt + 32 * i + 16 * sp;
                    { const u32x2 a0 = *(const LAS u32x2*)(v0), a1 = *(const LAS u32x2*)(v0 + 8);
                      const u32x4 vw = (u32x4){a0.x, a0.y, a1.x, a1.y};
                      O0 = __builtin_amdgcn_mfma_f32_32x32x16_bf16(__builtin_bit_cast(bf16x8, vw), pf, O0, 0, 0, 0); }
                    { const u32x2 a0 = *(const LAS u32x2*)(v0 + 32 * vts), a1 = *(const LAS u32x2*)(v0 + 32 * vts + 8);
                      const u32x4 vw = (u32x4){a0.x, a0.y, a1.x, a1.y};
                      O1 = __builtin_amdgcn_mfma_f32_32x32x16_bf16(__builtin_bit_cast(bf16x8, vw), pf, O1, 0, 0, 0); }
                }
            }
        }
    }
    m_out = m_run; l_out = l_run;
}
__device__ __forceinline__ void ph_dilated_mfma(const Params& p, const int l, LAS unsigned char* lds) {
    const int tid = opaque_tid(), lane = tid & 63, wv = tid >> 6, hw = wv >> 2, w4 = wv & 3, tl = tid & 255, r = lane & 31, h = lane >> 5;
    constexpr int VTS = 260, VTSS = 292, KSTR = 72, ARENA = 78848, KOFF = 37376;
    LAS bf16_t* Vt = (LAS bf16_t*)(lds + hw * ARENA);
    LAS unsigned* Vt32 = (LAS unsigned*)Vt;
    LAS bf16_t* Ks = (LAS bf16_t*)(lds + hw * ARENA + KOFF);
    const bf16_t* PROJ = (const bf16_t*)(p.ws + WS_PROJ);
    int ufirst, ucount, ustep;
    if (gridDim.x == 256) { if (blockIdx.x < 128) { ufirst = blockIdx.x * 2; ucount = 2; } else { ufirst = 256 + (blockIdx.x - 128) * 4; ucount = 4; } ustep = 1; }
    else { ufirst = blockIdx.x; ustep = gridDim.x; ucount = (768 - (int)blockIdx.x + (int)gridDim.x - 1) / (int)gridDim.x; }
    const int nsw = (256 - (int)blockIdx.x + (int)gridDim.x - 1) / (int)gridDim.x;
    const int nitems = nsw + ucount;
    bf16x8 qf[4]; bf16x8 kdummy[5][4];
    for (int k = 0; k <= 2 * nitems; ++k) {
        const int kk = k - hw, it = kk >> 1;
        if (kk >= 0 && it < nitems) {
            if (it < nsw) {
                const int u = blockIdx.x + it * gridDim.x;
                const int b = u >> 6, kvh = (u >> 5) & 1, q0 = (u & 31) * 64 + 32 * hw;
                const bf16_t* base = PROJ + (size_t)b * SEQ * NPROJ;
                const int head = kvh * 4 + w4, qpos = q0 + r, lk0 = q0 - 128;
                if (!(kk & 1)) {
                    u32x4 va[5], vb[5], kc[9];
#pragma unroll
                    for (int i = 0; i < 5; ++i) {
                        const int task = tl + 256 * i;
                        if (task < 1152) { const int kp = task % 144, dc = task / 144;
                            int kA = lk0 + 2 * kp; kA = kA < 0 ? 0 : (kA > SEQ - 2 ? SEQ - 2 : kA);
                            va[i] = *(const u32x4*)(base + (size_t)kA * NPROJ + PC_VC + kvh * 64 + 8 * dc);
                            vb[i] = *(const u32x4*)(base + (size_t)(kA + 1) * NPROJ + PC_VC + kvh * 64 + 8 * dc); }
                    }
#pragma unroll
                    for (int i = 0; i < 9; ++i) { const int id = tl + 256 * i, j = id >> 3, c8 = id & 7;
                        int kp2 = lk0 + j; kp2 = kp2 < 0 ? 0 : (kp2 >= SEQ ? SEQ - 1 : kp2);
                        kc[i] = *(const u32x4*)(base + (size_t)kp2 * NPROJ + PC_KC + kvh * 64 + 8 * c8); }
                    { const bf16_t* qp = base + (size_t)qpos * NPROJ + PC_QC + head * 64 + 8 * h;
#pragma unroll
                      for (int s2 = 0; s2 < 4; ++s2) qf[s2] = *(const bf16x8*)(qp + 16 * s2); }
#pragma unroll
                    for (int i = 0; i < 5; ++i) {
                        const int task = tl + 256 * i;
                        if (task < 1152) { const int kp = task % 144, dc = task / 144;
                            LAS unsigned* o = Vt32 + (8 * dc) * (VTSS / 2) + kp;
                            o[0 * (VTSS / 2)] = (va[i].x & 0xffffu) | (vb[i].x << 16); o[1 * (VTSS / 2)] = (va[i].x >> 16) | (vb[i].x & 0xffff0000u);
                            o[2 * (VTSS / 2)] = (va[i].y & 0xffffu) | (vb[i].y << 16); o[3 * (VTSS / 2)] = (va[i].y >> 16) | (vb[i].y & 0xffff0000u);
                            o[4 * (VTSS / 2)] = (va[i].z & 0xffffu) | (vb[i].z << 16); o[5 * (VTSS / 2)] = (va[i].z >> 16) | (vb[i].z & 0xffff0000u);
                            o[6 * (VTSS / 2)] = (va[i].w & 0xffffu) | (vb[i].w << 16); o[7 * (VTSS / 2)] = (va[i].w >> 16) | (vb[i].w & 0xffff0000u); }
                    }
#pragma unroll
                    for (int i = 0; i < 9; ++i) { const int id = tl + 256 * i, j = id >> 3, c8 = id & 7; *(LAS u32x4*)(Ks + j * KSTR + 8 * c8) = kc[i]; }
                } else {
                    const LAS bf16_t* vt = Vt + r * VTSS + 4 * h;
                    const LAS bf16_t* kl = Ks + r * KSTR + 8 * h;
                    f32x16 O0, O1; float m, lsum;
                    attn_wave<9, 5, false, true>(qf, kdummy, nullptr, (size_t)NPROJ, lk0, SEQ, vt, VTSS, p.in[11][l * 8 + head], 1.f, O0, O1, m, lsum, r, h, kl, KSTR);
                    const float inv = 1.f / lsum;
                    bf16_t* o = (bf16_t*)(p.ws + WS_YC) + ((size_t)b * SEQ + qpos) * 512 + head * 64 + 4 * h;
#pragma unroll
                    for (int gg = 0; gg < 4; ++gg) {
                        u32x2 w0; w0.x = pk2(O0[4 * gg] * inv, O0[4 * gg + 1] * inv); w0.y = pk2(O0[4 * gg + 2] * inv, O0[4 * gg + 3] * inv);
                        u32x2 w1; w1.x = pk2(O1[4 * gg] * inv, O1[4 * gg + 1] * inv); w1.y = pk2(O1[4 * gg + 2] * inv, O1[4 * gg + 3] * inv);
                        *(u32x2*)(o + 8 * gg) = w0; *(u32x2*)(o + 32 + 8 * gg) = w1;
                    }
                }
            } else {
                const int u = ufirst + (it - nsw) * ustep;
                const int cfg = u >> 8, r8 = u & 255, b = r8 >> 6, head = (r8 >> 3) & 7, blk = (r8 & 7) * 2 + hw;
                const int dsh = 2 * cfg, dil = 1 << dsh, ls = SEQ >> dsh, nblk = ls >> 7;
                const int res = blk / nblk, l0 = (blk % nblk) * 128;
                const bf16_t* base = PROJ + ((size_t)b * SEQ + res) * NPROJ;
                const size_t kst = (size_t)dil * NPROJ;
                const int lq = l0 + 32 * w4 + r;
                const int lk0 = l0 + 32 * w4 - 64;
                if (!(kk & 1)) {
                    u32x4 va[4], vb[4], kc[8];
#pragma unroll
                    for (int i = 0; i < 4; ++i) {
                        const int task = tl + 256 * i, kp = task & 127, dc = task >> 7;
                        int lkA = l0 - 64 + 2 * kp; lkA = lkA < 0 ? 0 : (lkA > ls - 2 ? ls - 2 : lkA);
                        va[i] = *(const u32x4*)(base + (size_t)lkA * kst + PC_VD + head * 64 + 8 * dc);
                        vb[i] = *(const u32x4*)(base + (size_t)(lkA + 1) * kst + PC_VD + head * 64 + 8 * dc);
                    }
#pragma unroll
                    for (int i = 0; i < 8; ++i) {
                        const int id = tl + 256 * i, j = id >> 3, c8 = id & 7;
                        int lk = l0 - 64 + j; lk = lk < 0 ? 0 : (lk >= ls ? ls - 1 : lk);
                        kc[i] = *(const u32x4*)(base + (size_t)lk * kst + PC_KD + head * 64 + 8 * c8);
                    }
                    { const bf16_t* qp = base + (size_t)lq * kst + PC_QD + head * 64 + 8 * h;
#pragma unroll
                      for (int s2 = 0; s2 < 4; ++s2) qf[s2] = *(const bf16x8*)(qp + 16 * s2); }
#pragma unroll
                    for (int i = 0; i < 4; ++i) {
                        const int task = tl + 256 * i, kp = task & 127, dc = task >> 7;
                        LAS unsigned* o = Vt32 + (8 * dc) * (VTS / 2) + kp;
                        o[0 * (VTS / 2)] = (va[i].x & 0xffffu) | (vb[i].x << 16); o[1 * (VTS / 2)] = (va[i].x >> 16) | (vb[i].x & 0xffff0000u);
                        o[2 * (VTS / 2)] = (va[i].y & 0xffffu) | (vb[i].y << 16); o[3 * (VTS / 2)] = (va[i].y >> 16) | (vb[i].y & 0xffff0000u);
                        o[4 * (VTS / 2)] = (va[i].z & 0xffffu) | (vb[i].z << 16); o[5 * (VTS / 2)] = (va[i].z >> 16) | (vb[i].z & 0xffff0000u);
                        o[6 * (VTS / 2)] = (va[i].w & 0xffffu) | (vb[i].w << 16); o[7 * (VTS / 2)] = (va[i].w >> 16) | (vb[i].w & 0xffff0000u);
                    }
#pragma unroll
                    for (int i = 0; i < 8; ++i) { const int id = tl + 256 * i, j = id >> 3, c8 = id & 7; *(LAS u32x4*)(Ks + j * KSTR + 8 * c8) = kc[i]; }
                } else {
                    const LAS bf16_t* vt = Vt + r * VTS + 32 * w4 + 4 * h;
                    const LAS bf16_t* kl = Ks + (32 * w4 + r) * KSTR + 8 * h;
                    f32x16 O0, O1; float m, lsm;
                    attn_wave<5, 5, false, true>(qf, kdummy, nullptr, kst, lk0, ls, vt, VTS, -1e30f, 0.f, O0, O1, m, lsm, r, h, kl, KSTR);
                    const float inv = 1.f / lsm;
                    const size_t tq = (size_t)b * SEQ + (size_t)lq * dil + res;
                    bf16_t* o = (bf16_t*)(p.ws + WS_YD) + ((size_t)cfg * NT + tq) * 512 + head * 64 + 4 * h;
#pragma unroll
                    for (int g = 0; g < 4; ++g) {
                        u32x2 w0; w0.x = pk2(O0[4 * g] * inv, O0[4 * g + 1] * inv); w0.y = pk2(O0[4 * g + 2] * inv, O0[4 * g + 3] * inv);
                        u32x2 w1; w1.x = pk2(O1[4 * g] * inv, O1[4 * g + 1] * inv); w1.y = pk2(O1[4 * g + 2] * inv, O1[4 * g + 3] * inv);
                        *(u32x2*)(o + 8 * g) = w0; *(u32x2*)(o + 32 + 8 * g) = w1;
                    }
                    if (h == 0) ((float*)(p.ws + WS_LSE))[((size_t)cfg * NT + tq) * 8 + head] = m + __logf(lsm);
                }
            }
        }
        __syncthreads();
    }
}

__device__ __forceinline__ void ph_swa_mfma(const Params& p, int l, LAS unsigned char* lds) {
    const int tid = opaque_tid(), lane = tid & 63, wv = tid >> 6, g = wv >> 1, ph = wv & 1, r = lane & 31, h = lane >> 5;
    constexpr int VTS = 324;
    LAS bf16_t* Vt = (LAS bf16_t*)lds;
    LAS unsigned* Vt32 = (LAS unsigned*)lds;
    const bf16_t* PROJ = (const bf16_t*)(p.ws + WS_PROJ);
    for (int u = blockIdx.x; u < 256; u += gridDim.x) {
        const int b = u >> 6, kvh = (u >> 5) & 1, q0 = (u & 31) * 64;
        const bf16_t* base = PROJ + (size_t)b * SEQ * NPROJ;
        u32x4 va[3], vb[3];
#pragma unroll
        for (int i = 0; i < 3; ++i) {
            const int task = tid + 512 * i;
            if (task < 1280) {
                const int kp = task % 160, dc = task / 160;
                int kA = q0 - 128 + 2 * kp; kA = kA < 0 ? 0 : (kA > SEQ - 2 ? SEQ - 2 : kA);
                va[i] = *(const u32x4*)(base + (size_t)kA * NPROJ + PC_VC + kvh * 64 + 8 * dc);
                vb[i] = *(const u32x4*)(base + (size_t)(kA + 1) * NPROJ + PC_VC + kvh * 64 + 8 * dc);
            }
        }
        const int head = kvh * 4 + g;
        const int qpos = q0 + 32 * ph + r;
        const int lk0 = q0 + 32 * ph - 128;
        const bf16_t* kb = base + PC_KC + kvh * 64 + 8 * h;
        bf16x8 qf[4], kf0[5][4];
        attn_prefetch<5>(base + (size_t)qpos * NPROJ + PC_QC + head * 64 + 8 * h, kb, (size_t)NPROJ, lk0, SEQ, r, qf, kf0);
#pragma unroll
        for (int i = 0; i < 3; ++i) {
            const int task = tid + 512 * i;
            if (task < 1280) {
                const int kp = task % 160, dc = task / 160;
                LAS unsigned* o = Vt32 + (8 * dc) * (VTS / 2) + kp;
                o[0 * (VTS / 2)] = (va[i].x & 0xffffu) | (vb[i].x << 16); o[1 * (VTS / 2)] = (va[i].x >> 16) | (vb[i].x & 0xffff0000u);
                o[2 * (VTS / 2)] = (va[i].y & 0xffffu) | (vb[i].y << 16); o[3 * (VTS / 2)] = (va[i].y >> 16) | (vb[i].y & 0xffff0000u);
                o[4 * (VTS / 2)] = (va[i].z & 0xffffu) | (vb[i].z << 16); o[5 * (VTS / 2)] = (va[i].z >> 16) | (vb[i].z & 0xffff0000u);
                o[6 * (VTS / 2)] = (va[i].w & 0xffffu) | (vb[i].w << 16); o[7 * (VTS / 2)] = (va[i].w >> 16) | (vb[i].w & 0xffff0000u);
            }
        }
        {
            const LAS bf16_t* vt = Vt + r * VTS + 32 * ph + 4 * h;
            f32x16 O0, O1; float m, lsum;
            attn_wave<9, 5>(qf, kf0, kb, (size_t)NPROJ, lk0, SEQ, vt, VTS, p.in[11][l * 8 + head], 1.f, O0, O1, m, lsum, r, h);
            const float inv = 1.f / lsum;
            bf16_t* o = (bf16_t*)(p.ws + WS_YC) + ((size_t)b * SEQ + qpos) * 512 + head * 64 + 4 * h;
#pragma unroll
            for (int gg = 0; gg < 4; ++gg) {
                u32x2 w0; w0.x = pk2(O0[4 * gg] * inv, O0[4 * gg + 1] * inv); w0.y = pk2(O0[4 * gg + 2] * inv, O0[4 * gg + 3] * inv);
                u32x2 w1; w1.x = pk2(O1[4 * gg] * inv, O1[4 * gg + 1] * inv); w1.y = pk2(O1[4 * gg + 2] * inv, O1[4 * gg + 3] * inv);
                *(u32x2*)(o + 8 * gg) = w0; *(u32x2*)(o + 32 + 8 * gg) = w1;
            }
        }
        __syncthreads();
    }
}

__device__ __forceinline__ void ph_gmlp_mfma(const Params& p, int l, LAS unsigned char* lds) {
    const int tid = opaque_tid(), lane = tid & 63, wv = tid >> 6, hh = wv >> 1, ph = wv & 1, r = lane & 31, h = lane >> 5;
    constexpr int VTS = 136;
    LAS bf16_t* Vt = (LAS bf16_t*)lds;
    LAS unsigned* Vt32 = (LAS unsigned*)lds;
    LAS float* rv = (LAS float*)(lds + 256 * VTS * 2);
    const bf16_t* PROJ = (const bf16_t*)(p.ws + WS_PROJ); bf16_t* YB = (bf16_t*)(p.ws + WS_YB);
    const bf16_t* SW = (const bf16_t*)(p.ws + WS_SGUW) + (size_t)l * 8 * 128 * 128;
    const float* sn = p.in[8] + (size_t)l * 512;
    for (int u = blockIdx.x; u < 128; u += gridDim.x) {
        const int hg = u & 1, t0 = (u >> 1) * 128;
        { u32x4 w[16]; float ss[16];
#pragma unroll
          for (int q = 0; q < 16; ++q) w[q] = *(const u32x4*)(PROJ + (size_t)(t0 + wv * 16 + q) * NPROJ + PC_V + 8 * lane);
#pragma unroll
          for (int q = 0; q < 16; ++q) ss[q] = bflo(w[q].x) * bflo(w[q].x) + bfhi(w[q].x) * bfhi(w[q].x) + bflo(w[q].y) * bflo(w[q].y) + bfhi(w[q].y) * bfhi(w[q].y) + bflo(w[q].z) * bflo(w[q].z) + bfhi(w[q].z) * bfhi(w[q].z) + bflo(w[q].w) * bflo(w[q].w) + bfhi(w[q].w) * bfhi(w[q].w);
#pragma unroll
          for (int o = 1; o < 64; o <<= 1)
#pragma unroll
              for (int q = 0; q < 16; ++q) ss[q] += __shfl_xor(ss[q], o);
          float mine = 0.f;
#pragma unroll
          for (int q = 0; q < 16; ++q) mine = (lane == q) ? ss[q] : mine;
          if (lane < 16) rv[wv * 16 + lane] = 1.0f / sqrtf(mine * (1.f / 512.f) + EPS); }
        __syncthreads();
#pragma unroll
        for (int i = 0; i < 4; ++i) {
            const int task = tid + 512 * i, kp = task & 63, dc = task >> 6;
            const bf16_t* src = PROJ + (size_t)(t0 + 2 * kp) * NPROJ + PC_V + hg * 256 + 8 * dc;
            const u32x4 va = *(const u32x4*)src, vb = *(const u32x4*)(src + NPROJ);
            const float ra = rv[2 * kp], rb = rv[2 * kp + 1];
            const f32x4 g0 = *(const f32x4*)(sn + hg * 256 + 8 * dc), g1 = *(const f32x4*)(sn + hg * 256 + 8 * dc + 4);
            LAS unsigned* o = Vt32 + (8 * dc) * (VTS / 2) + kp;
            o[0 * (VTS / 2)] = pk2(bflo(va.x) * ra * g0[0], bflo(vb.x) * rb * g0[0]); o[1 * (VTS / 2)] = pk2(bfhi(va.x) * ra * g0[1], bfhi(vb.x) * rb * g0[1]);
            o[2 * (VTS / 2)] = pk2(bflo(va.y) * ra * g0[2], bflo(vb.y) * rb * g0[2]); o[3 * (VTS / 2)] = pk2(bfhi(va.y) * ra * g0[3], bfhi(vb.y) * rb * g0[3]);
            o[4 * (VTS / 2)] = pk2(bflo(va.z) * ra * g1[0], bflo(vb.z) * rb * g1[0]); o[5 * (VTS / 2)] = pk2(bfhi(va.z) * ra * g1[1], bfhi(vb.z) * rb * g1[1]);
            o[6 * (VTS / 2)] = pk2(bflo(va.w) * ra * g1[2], bflo(vb.w) * rb * g1[2]); o[7 * (VTS / 2)] = pk2(bfhi(va.w) * ra * g1[3], bfhi(vb.w) * rb * g1[3]);
        }
        __syncthreads();
        {
            const int habs = hg * 4 + hh;
            f32x16 acc[2][2];
#pragma unroll
            for (int ct = 0; ct < 2; ++ct)
#pragma unroll
                for (int pt = 0; pt < 2; ++pt)
#pragma unroll
                    for (int q = 0; q < 16; ++q) acc[ct][pt][q] = 0.f;
            const bf16_t* wp = SW + ((size_t)habs * 128 + 64 * ph + r) * 128 + 8 * h;
            const LAS bf16_t* ap = Vt + (hh * 64 + r) * VTS + 8 * h;
#pragma unroll
            for (int s = 0; s < 8; ++s) {
                bf16x8 bfr[2], afr[2];
#pragma unroll
                for (int pt = 0; pt < 2; ++pt) bfr[pt] = *(const bf16x8*)(wp + (size_t)pt * 32 * 128 + 16 * s);
#pragma unroll
                for (int ct = 0; ct < 2; ++ct) afr[ct] = *(const LAS bf16x8*)(ap + ct * 32 * VTS + 16 * s);
#pragma unroll
                for (int ct = 0; ct < 2; ++ct)
#pragma unroll
                    for (int pt = 0; pt < 2; ++pt) acc[ct][pt] = __builtin_amdgcn_mfma_f32_32x32x16_bf16(afr[ct], bfr[pt], acc[ct][pt], 0, 0, 0);
            }
#pragma unroll
            for (int pt = 0; pt < 2; ++pt) {
                const int pp = 64 * ph + 32 * pt + r;
                const float bias = p.in[10][((size_t)l * 8 + habs) * 128 + pp];
                const bf16_t* us = PROJ + (size_t)(t0 + pp) * NPROJ + PC_U + habs * 64 + 4 * h;
                bf16_t* o = YB + (size_t)(t0 + pp) * 512 + habs * 64 + 4 * h;
#pragma unroll
                for (int ct = 0; ct < 2; ++ct)
#pragma unroll
                    for (int gg = 0; gg < 4; ++gg) {
                        const u32x2 uw = *(const u32x2*)(us + 32 * ct + 8 * gg);
                        u32x2 w; w.x = pk2(bflo(uw.x) * (acc[ct][pt][4 * gg] + bias), bfhi(uw.x) * (acc[ct][pt][4 * gg + 1] + bias));
                        w.y = pk2(bflo(uw.y) * (acc[ct][pt][4 * gg + 2] + bias), bfhi(uw.y) * (acc[ct][pt][4 * gg + 3] + bias));
                        *(u32x2*)(o + 32 * ct + 8 * gg) = w;
                    }
            }
        }
        __syncthreads();
    }
}

__device__ __forceinline__ void ph_merge(const Params& p, int l, LAS unsigned char* lds) {
    const int tid = opaque_tid(), lane = tid & 63, wv = tid >> 6, r = lane & 31, h2 = lane >> 5;
    LAS float* ssA = (LAS float*)lds;
    const bf16_t* UV = (const bf16_t*)(p.ws + WS_YA); const bf16_t* YB = (const bf16_t*)(p.ws + WS_YB); const bf16_t* YC = (const bf16_t*)(p.ws + WS_YC); const bf16_t* YD = (const bf16_t*)(p.ws + WS_YD);
    const float* LSE = (const float*)(p.ws + WS_LSE); bf16_t* YN = (bf16_t*)(p.ws + WS_YN);
    const bf16_t* ABT = (const bf16_t*)(p.ws + WS_ABT) + ((size_t)l * 8 + wv) * 64 * 128;
    for (int blk = blockIdx.x; blk < NT / 32; blk += gridDim.x) {
        const int t0 = blk * 32, b = t0 >> 11, s0 = t0 & 2047;
        f32x16 O0, O1;
        {
#pragma unroll
            for (int q = 0; q < 16; ++q) { O0[q] = 0.f; O1[q] = 0.f; }
            const size_t row = ((size_t)b * 4096 + 2 * (s0 + r)) * 512 + wv * 64 + 8 * h2;
            u32x4 u0[8], u1[8];
#pragma unroll
            for (int s = 0; s < 8; ++s) { const size_t o = row + (s >> 2) * 512 + 16 * (s & 3); u0[s] = *(const u32x4*)(UV + o); u1[s] = *(const u32x4*)(UV + (size_t)4 * 4096 * 512 + o); }
            bf16x8 af0[8], af1[8];
#pragma unroll
            for (int s = 0; s < 8; ++s) { af0[s] = *(const bf16x8*)(ABT + (size_t)r * 128 + 16 * s + 8 * h2); af1[s] = *(const bf16x8*)(ABT + (size_t)(32 + r) * 128 + 16 * s + 8 * h2); }
#pragma unroll
            for (int s = 0; s < 8; ++s) {
                const bf16x8 bfr = pack8(bflo(u0[s].x) + bflo(u1[s].x), bfhi(u0[s].x) + bfhi(u1[s].x), bflo(u0[s].y) + bflo(u1[s].y), bfhi(u0[s].y) + bfhi(u1[s].y),
                                         bflo(u0[s].z) + bflo(u1[s].z), bfhi(u0[s].z) + bfhi(u1[s].z), bflo(u0[s].w) + bflo(u1[s].w), bfhi(u0[s].w) + bfhi(u1[s].w));
                O0 = __builtin_amdgcn_mfma_f32_32x32x16_bf16(af0[s], bfr, O0, 0, 0, 0);
                O1 = __builtin_amdgcn_mfma_f32_32x32x16_bf16(af1[s], bfr, O1, 0, 0, 0);
            }
            float ss = 0.f;
#pragma unroll
            for (int q = 0; q < 16; ++q) ss += O0[q] * O0[q] + O1[q] * O1[q];
            ss += __shfl_xor(ss, 32);
            if (h2 == 0) ssA[wv * 32 + r] = ss;
        }
#pragma unroll 1
        for (int i = 0; i < 4; ++i) {
            const int t = t0 + 4 * wv + i;
            float y[3][8];
            { const u32x4 w = *(const u32x4*)(YB + (size_t)t * 512 + 8 * lane);
                y[0][0] = bflo(w.x); y[0][1] = bfhi(w.x); y[0][2] = bflo(w.y); y[0][3] = bfhi(w.y); y[0][4] = bflo(w.z); y[0][5] = bfhi(w.z); y[0][6] = bflo(w.w); y[0][7] = bfhi(w.w); }
            { const u32x4 w = *(const u32x4*)(YC + (size_t)t * 512 + 8 * lane);
                y[1][0] = bflo(w.x); y[1][1] = bfhi(w.x); y[1][2] = bflo(w.y); y[1][3] = bfhi(w.y); y[1][4] = bflo(w.z); y[1][5] = bfhi(w.z); y[1][6] = bflo(w.w); y[1][7] = bfhi(w.w); }
            { const int head = lane >> 3;
              const float l0 = LSE[(size_t)t * 8 + head], l1 = LSE[((size_t)NT + t) * 8 + head], l2 = LSE[((size_t)2 * NT + t) * 8 + head];
              const float mx = fmaxf(l0, fmaxf(l1, l2)); float w0 = __expf(l0 - mx), w1 = __expf(l1 - mx), w2 = __expf(l2 - mx); const float iv = 1.f / (w0 + w1 + w2); w0 *= iv; w1 *= iv; w2 *= iv;
              const u32x4 a = *(const u32x4*)(YD + (size_t)t * 512 + 8 * lane), bq = *(const u32x4*)(YD + ((size_t)NT + t) * 512 + 8 * lane), c = *(const u32x4*)(YD + ((size_t)2 * NT + t) * 512 + 8 * lane);
              y[2][0] = w0 * bflo(a.x) + w1 * bflo(bq.x) + w2 * bflo(c.x); y[2][1] = w0 * bfhi(a.x) + w1 * bfhi(bq.x) + w2 * bfhi(c.x);
              y[2][2] = w0 * bflo(a.y) + w1 * bflo(bq.y) + w2 * bflo(c.y); y[2][3] = w0 * bfhi(a.y) + w1 * bfhi(bq.y) + w2 * bfhi(c.y);
              y[2][4] = w0 * bflo(a.z) + w1 * bflo(bq.z) + w2 * bflo(c.z); y[2][5] = w0 * bfhi(a.z) + w1 * bfhi(bq.z) + w2 * bfhi(c.z);
              y[2][6] = w0 * bflo(a.w) + w1 * bflo(bq.w) + w2 * bflo(c.w); y[2][7] = w0 * bfhi(a.w) + w1 * bfhi(bq.w) + w2 * bfhi(c.w); }
#pragma unroll
            for (int g = 0; g < 3; ++g) {
                float ss = 0.f;
#pragma unroll
                for (int q = 0; q < 8; ++q) ss += y[g][q] * y[g][q];
                const float rr = 1.0f / sqrtf(wave_sum(ss) * (1.f / 512.f) + EPS);
                u32x4 w; w.x = pk2(y[g][0] * rr, y[g][1] * rr); w.y = pk2(y[g][2] * rr, y[g][3] * rr); w.z = pk2(y[g][4] * rr, y[g][5] * rr); w.w = pk2(y[g][6] * rr, y[g][7] * rr);
                *(u32x4*)(YN + (size_t)t * DM + (g + 1) * 512 + 8 * lane) = w;
            }
        }
        __syncthreads();
        {
            float tot = 0.f;
#pragma unroll
            for (int w = 0; w < 8; ++w) tot += ssA[w * 32 + r];
            const float rr = 1.0f / sqrtf(tot * (1.f / 512.f) + EPS);
            bf16_t* o = YN + (size_t)(t0 + r) * DM + wv * 64 + 4 * h2;
#pragma unroll
            for (int g = 0; g < 4; ++g) {
                u32x2 w0; w0.x = pk2(O0[4 * g] * rr, O0[4 * g + 1] * rr); w0.y = pk2(O0[4 * g + 2] * rr, O0[4 * g + 3] * rr);
                u32x2 w1; w1.x = pk2(O1[4 * g] * rr, O1[4 * g + 1] * rr); w1.y = pk2(O1[4 * g + 2] * rr, O1[4 * g + 3] * rr);
                *(u32x2*)(o + 8 * g) = w0; *(u32x2*)(o + 32 + 8 * g) = w1;
            }
        }
        __syncthreads();
    }
}

#ifndef PHASE_MASK
#define PHASE_MASK 0xFFFFFFu
#endif
#define EN(k) (((PHASE_MASK) >> (k)) & 1u)
#ifndef REP_MASK
#define REP_MASK 0u
#endif
#define REP(k) _Pragma("unroll") for (int rep_ = 0; rep_ < 1 + (int)(((REP_MASK) >> (k)) & 1u); ++rep_)
constexpr int MIX_GW = 128, MIX_A = 4400;
constexpr int NPHASE = 22;
__global__ void __launch_bounds__(512, 2) mk_fwd(Params p) {
    extern __shared__ __attribute__((aligned(16))) unsigned char lds_raw[];
    LAS unsigned char* lds = (LAS unsigned char*)lds_raw;
    const int tid = threadIdx.x, G = gridDim.x, bx = blockIdx.x;
    volatile LAS unsigned* misc = (volatile LAS unsigned*)(lds + MISC_OFF);
    if (tid < 16) misc[tid] = 0u;
    __syncthreads();
    const int lo = p.ph_lo, hi = p.ph_hi;
    XcdBarrier bar; bar.bar = (unsigned*)(p.ws + WS_CTL); bar.x = 0; bar.st = misc + 8;
    if (hi - lo > 1) bar = xcd_barrier_post((unsigned*)(p.ws + WS_CTL), misc + 8);
#define IN(k) (lo <= (k) && (k) < hi)
#define SEAM(k) do { if (IN(k) && IN((k) + 1)) xcd_barrier(bar); } while (0)
    if (IN(0)) { if (EN(0)) REP(0) ph_mod(p, lds); if (EN(1)) REP(1) ph_tables(p); if (EN(2)) REP(2) ph_weights(p, lds, 0, G == 256 ? 240 : 6880, bx, G); }
    SEAM(0);
    for (int l = 0; l < 2; ++l) {
        const int pb = 1 + 10 * l;
        const char* H = (const char*)(p.ws + WS_H);
        if (EN(3) && IN(pb + 0)) REP(3) { ph_norm1(p, l); }
        SEAM(pb + 0);
        if (EN(4) && IN(pb + 1)) REP(4) {
            SchedProj S{H, (const char*)(p.ws + WS_WIN) + (size_t)l * NPROJ * 2048 * 2, (const char*)(p.ws + WS_WPQ) + (size_t)l * 512 * 2048 * 2, G, bx};
            EpiProj E{(bf16_t*)(p.ws + WS_PROJ), (bf16_t*)(p.ws + WS_PQT), (const float*)(p.ws + WS_ROPE), (const float*)(p.ws + WS_ROPE) + NT * 8};
            if (l == 0 && G == 256 && EN(2)) {
                if (bx < MIX_GW) { SchedProj S2{S.H, S.WIN, S.WPQ, MIX_GW, bx}; pg8::gemm_phase<EpiProj, SchedProj>(lds, 2048, 2048, 2048, S2, E); }
                else ph_weights(p, lds, 240, 240 + MIX_A, bx - MIX_GW, G - MIX_GW);
                __syncthreads();
                ph_weights(p, lds, 240 + MIX_A, 6880, bx, G);
            } else
            pg8::gemm_phase<EpiProj, SchedProj>(lds, 2048, 2048, 2048, S, E);
        }
        SEAM(pb + 1);
        if (IN(pb + 2)) {
            if (EN(5)) REP(5) { SchedDft S{(const char*)(p.ws + WS_DFT), (const char*)(p.ws + WS_PQT), G, bx};
              EpiBf16Plain E{(bf16_t*)(p.ws + WS_YA), 512, (size_t)4 * 4096 * 512};
              pg8::gemm_phase<EpiBf16Plain, SchedDft>(lds, 2048, 2048, 1024, S, E); }
            __syncthreads();
            if (EN(6)) REP(6) ph_gmlp_mfma(p, l, lds);
            if (EN(8)) REP(8) ph_dilated_mfma(p, l, lds);
        }
        SEAM(pb + 2);
        if (EN(9) && IN(pb + 3)) REP(9) { ph_merge(p, l, lds); }
        SEAM(pb + 3);
        if (EN(10) && IN(pb + 4)) REP(10) {
            SchedDense S{(const char*)(p.ws + WS_YN), (const char*)(p.ws + WS_WOUT) + (size_t)l * 2048 * 2048 * 2, 32, 8, 2048, G, bx};
            EpiWout E{l == 0 ? p.in[0] : nullptr, (const bf16_t*)(p.ws + WS_X), (bf16_t*)(p.ws + WS_X2), (const float*)(p.ws + WS_MOD) + (size_t)l * 4 * 12288 + 2 * 2048};
            pg8::gemm_phase<EpiWout, SchedDense>(lds, 2048, 2048, 2048, S, E);
        }
        SEAM(pb + 4);
        if (EN(11) && IN(pb + 5)) REP(11) { ph_norm2_router_mfma(p, l, lds); }
        SEAM(pb + 5);
        if (EN(12) && IN(pb + 6)) REP(12) { ph_topk(p, lds); }
        SEAM(pb + 6);
        if (EN(14) && IN(pb + 8)) REP(14) {
            SchedMoeG S{H, (const char*)(p.ws + WS_WGU) + (size_t)l * 16 * 2048 * 2048 * 2, 2048, G, bx};
            EpiGU E{(bf16_t*)(p.ws + WS_ACT)};
            pg8::gemm_phase<EpiGU, SchedMoeG, true>(lds, 2048, 2048, 2048, S, E, (const int*)(p.ws + WS_IDX));
        }
        SEAM(pb + 8);
        if (EN(15) && IN(pb + 9)) REP(15) {
            SchedMoe S{(const char*)(p.ws + WS_ACT), (const char*)(p.ws + WS_WD) + (size_t)l * 16 * 2048 * 1024 * 2, 1024, G, bx};
            EpiDown E{(bf16_t*)(p.ws + WS_EO), (const float*)(p.ws + WS_IDX + 65536)};
            pg8::gemm_phase<EpiDown, SchedMoe>(lds, 1024, 1024, 1024, S, E);
        }
        SEAM(pb + 9);
    }
    if (EN(16) && IN(21)) REP(16) { ph_norm1(p, 2); }
#undef IN
#undef SEAM
}

extern "C" void kernel_launch(void* const* d_in, const int* in_sizes, int n_in, void* d_out, int out_size, void* d_ws, size_t ws_size, hipStream_t stream) {
    static int grid = 0;
    if (grid == 0) {
        if (n_in != 20 || out_size != NT * DM || ws_size < WS_END) { fprintf(stderr, "kernel_launch: unexpected shapes (n_in %d out %d ws %zu)\n", n_in, out_size, ws_size); grid = -1; return; }
        int dev = 0, cus = 0, per_cu = 0;
        if (hipGetDevice(&dev) != hipSuccess || hipDeviceGetAttribute(&cus, hipDeviceAttributeMultiprocessorCount, dev) != hipSuccess) { grid = -1; return; }
        if (hipFuncSetAttribute((const void*)mk_fwd, hipFuncAttributeMaxDynamicSharedMemorySize, LDS_BYTES) != hipSuccess) { fprintf(stderr, "kernel_launch: hipFuncSetAttribute failed\n"); grid = -1; return; }
        if (hipOccupancyMaxActiveBlocksPerMultiprocessor(&per_cu, (const void*)mk_fwd, 512, LDS_BYTES) != hipSuccess || per_cu < 1) { fprintf(stderr, "kernel_launch: occupancy query says %d\n", per_cu); }
        (void)hipGetLastError();
        grid = cus;
    }
    if (grid < 0) return;
    (void)hipMemsetAsync((char*)d_ws + WS_CTL, 0, 64 * 1024, stream);
    Params p{};
    for (int i = 0; i < 20; ++i) p.in[i] = (const float*)d_in[i];
    p.out = (float*)d_out; p.ws = (unsigned char*)d_ws;
#if defined(MK_MULTI)
    for (int ph = 0; ph < NPHASE; ++ph) { p.ph_lo = ph; p.ph_hi = ph + 1; hipLaunchKernelGGL(mk_fwd, dim3(grid), dim3(512), LDS_BYTES, stream, p); }
#else
    p.ph_lo = 0; p.ph_hi = NPHASE; hipLaunchKernelGGL(mk_fwd, dim3(grid), dim3(512), LDS_BYTES, stream, p);
#endif
}
```

```cpp
#include <hip/hip_runtime.h>
#include <cstdio>
#include <cstdint>

#define LAS __attribute__((address_space(3)))
typedef unsigned short bf16_t;
typedef short bf16x8 __attribute__((ext_vector_type(8)));
typedef float f32x4 __attribute__((ext_vector_type(4)));
typedef float f32x2 __attribute__((ext_vector_type(2)));
typedef unsigned u32x4 __attribute__((ext_vector_type(4)));
typedef unsigned u32x2 __attribute__((ext_vector_type(2)));
typedef float f32x16 __attribute__((ext_vector_type(16)));

constexpr int NB = 4, SEQ = 2048, NT = NB * SEQ, DM = 2048, DIN = 3840, NPROJ = 3328, NE = 16, FF = 1024, CAP = 256;
constexpr float EPS = 1e-6f;
constexpr int PC_U = 0, PC_V = 512, PC_QC = 1024, PC_KC = 1536, PC_VC = 1664, PC_QD = 1792, PC_KD = 2304, PC_VD = 2816;

constexpr size_t MiB = (size_t)1 << 20;
constexpr size_t WS_CTL = 0;
constexpr size_t WS_MOD = 1 * MiB;
constexpr size_t WS_ROPE = WS_MOD + 512 * 1024;
constexpr size_t WS_DFT = 2 * MiB;
constexpr size_t WS_WIN = 18 * MiB;
constexpr size_t WS_WPQ = 44 * MiB;
constexpr size_t WS_WOUT = 52 * MiB;
constexpr size_t WS_WGU = 68 * MiB;
constexpr size_t WS_WD = 324 * MiB;
constexpr size_t WS_X = 452 * MiB;
constexpr size_t WS_X2 = 516 * MiB;
constexpr size_t WS_H = 580 * MiB;
constexpr size_t WS_PROJ = 612 * MiB;
constexpr size_t WS_PQT = 664 * MiB;
constexpr size_t WS_YA = 680 * MiB;
constexpr size_t WS_YB = 712 * MiB;
constexpr size_t WS_YC = 720 * MiB;
constexpr size_t WS_YD = 728 * MiB;
constexpr size_t WS_LSE = 752 * MiB;
constexpr size_t WS_YN = 753 * MiB;
constexpr size_t WS_AFF = 785 * MiB;
constexpr size_t WS_IDX = 786 * MiB;
constexpr size_t WS_XE = 787 * MiB;
constexpr size_t WS_ACT = 851 * MiB;
constexpr size_t WS_EO = 883 * MiB;
constexpr size_t WS_SGUW = 947 * MiB;
constexpr size_t WS_WRT = WS_SGUW + 512 * 1024;
constexpr size_t WS_ABT = WS_WRT + 128 * 1024;
constexpr size_t WS_VSS = WS_ABT + 256 * 1024;
constexpr size_t WS_END = 948 * MiB;

constexpr int LDS_BYTES = 163840;
constexpr int MISC_OFF = LDS_BYTES - 256;

struct Params { const float* in[20]; float* out; unsigned char* ws; int ph_lo, ph_hi; };

__device__ __forceinline__ unsigned pk2(float lo, float hi) { unsigned r; asm("v_cvt_pk_bf16_f32 %0, %1, %2" : "=v"(r) : "v"(lo), "v"(hi)); return r; }
__device__ __forceinline__ float bflo(unsigned u) { return __uint_as_float(u << 16); }
__device__ __forceinline__ float bfhi(unsigned u) { return __uint_as_float(u & 0xffff0000u); }
__device__ __forceinline__ float wave_sum(float v) {
#pragma unroll
    for (int o = 1; o < 64; o <<= 1) v += __shfl_xor(v, o);
    return v;
}
__device__ __forceinline__ float gelu_tanh(float x) { const float u = 0.7978845608f * (x + 0.044715f * x * x * x); return x * __builtin_amdgcn_rcpf(1.f + __builtin_amdgcn_exp2f(-2.885390082f * u)); }
__device__ __forceinline__ float silu_f(float x) { return x * __builtin_amdgcn_rcpf(1.f + __builtin_amdgcn_exp2f(-1.442695041f * x)); }

__device__ __forceinline__ int opaque_tid() { int t = threadIdx.x; asm volatile("" : "+v"(t)); return t; }
#define XB_TMO      128
#define XB_XCNT(j)  (256  + 64 * (j))
#define XB_XSUB(j)  (1280 + 64 * (j))
#define XB_XGEN(j)  (2304 + 64 * (j))
#define XB_TOP      3328
#define XB_TOPGEN   3392
#define XCD_BAR_WORDS 3456
#define XB_SPIN_CAP (1u << 18)
__device__ __forceinline__ unsigned xb_ld(unsigned* p)              { return __hip_atomic_load(p, __ATOMIC_RELAXED, __HIP_MEMORY_SCOPE_AGENT); }
__device__ __forceinline__ unsigned xb_add(unsigned* p, unsigned v) { return __hip_atomic_fetch_add(p, v, __ATOMIC_RELAXED, __HIP_MEMORY_SCOPE_AGENT); }
__device__ __forceinline__ unsigned xb_xcc_id() { return (unsigned)__builtin_amdgcn_s_getreg((3 << 11) | 20) & 0xFu; }
#define XB_SPIN(cond, bar) do { unsigned _sp = 0; while (cond) { __builtin_amdgcn_s_sleep(1); \
    if ((++_sp & 255u) == 0u) { if (xb_ld(&(bar)[XB_TMO])) break; if (_sp > XB_SPIN_CAP) { atomicAdd(&(bar)[XB_TMO], 1u); break; } } } } while (0)
struct XcdBarrier { unsigned* bar; unsigned x; volatile LAS unsigned* st; };
__device__ __forceinline__ XcdBarrier xcd_barrier_post(unsigned* bar, volatile LAS unsigned* st) {
    XcdBarrier b; b.bar = bar; b.x = xb_xcc_id(); b.st = st;
    if (threadIdx.x == 0) (void)xb_add(&bar[XB_XCNT(b.x)], 1u);
    return b;
}
__device__ __forceinline__ void xcd_barrier_complete(unsigned* bar, unsigned x, unsigned& nloc, unsigned& nx) {
    const unsigned G = gridDim.x * gridDim.y * gridDim.z;
    unsigned sum, cnt, mine, sp = 0u;
    for (;;) {
        sum = 0u; cnt = 0u; mine = 0u;
#pragma unroll
        for (unsigned j = 0; j < 16; ++j) { const unsigned c = xb_ld(&bar[XB_XCNT(j)]); sum += c; cnt += (c > 0u) ? 1u : 0u; mine = (j == x) ? c : mine; }
        if (sum == G) break;
        __builtin_amdgcn_s_sleep(1);
        if ((++sp & 255u) == 0u) { if (xb_ld(&bar[XB_TMO])) break; if (sp > XB_SPIN_CAP) { atomicAdd(&bar[XB_TMO], 1u); break; } }
    }
    nloc = mine > 0u ? mine : 1u; nx = cnt > 0u ? cnt : 1u;
}
__device__ __forceinline__ void xcd_barrier(const XcdBarrier& b) {
    asm volatile("s_waitcnt vmcnt(0)" ::: "memory");
    __syncthreads();
    if (threadIdx.x == 0) {
        unsigned* bar = b.bar;
        __builtin_amdgcn_s_waitcnt(0);
        unsigned nloc = b.st[0], nx = b.st[1];
        if (nloc == 0u) { xcd_barrier_complete(bar, b.x, nloc, nx); b.st[0] = nloc; b.st[1] = nx; }
        const unsigned old = xb_add(&bar[XB_XSUB(b.x)], 1u);
        const unsigned gen = old / nloc;
        if (old + 1u == (gen + 1u) * nloc) {
            __builtin_amdgcn_fence(__ATOMIC_RELEASE, "agent");
            asm volatile("s_waitcnt vmcnt(0)" ::: "memory");
            const unsigned og = xb_add(&bar[XB_TOP], 1u);
            const unsigned tg = og / nx;
            if (og + 1u == (tg + 1u) * nx) xb_add(&bar[XB_TOPGEN], 1u);
            else XB_SPIN(xb_ld(&bar[XB_TOPGEN]) == tg, bar);
            __builtin_amdgcn_fence(__ATOMIC_ACQUIRE, "agent");
            xb_add(&bar[XB_XGEN(b.x)], 1u);
            asm volatile("s_waitcnt vmcnt(0)" ::: "memory");
        } else {
            XB_SPIN(xb_ld(&bar[XB_XGEN(b.x)]) == gen, bar);
            __builtin_amdgcn_fence(__ATOMIC_ACQUIRE, "agent");
            asm volatile("s_waitcnt vmcnt(0)" ::: "memory");
        }
    }
    __syncthreads();
}

namespace pg8 {
constexpr int BM = 256, BK = 64, HALF = 128, HTB = HALF * BK * 2, STAGE_BYTES = 8 * HTB;
__host__ __device__ __forceinline__ int lds_byte(int r, int c) { const int st = (r >> 4) * 2 + (c >> 5), rr = r & 15, cc = c & 31, ob = rr * 64 + cc * 2; return st * 1024 + (ob ^ (((ob >> 9) & 1) << 5)); }
__host__ __device__ __forceinline__ void stage_rc(int b, int& R, int& C) { const int st = b / 1024, sb = b % 1024, swz = sb ^ (((sb >> 9) & 1) << 5); R = (st >> 1) * 16 + swz / 64; C = (st & 1) * 32 + (swz % 64) / 2; }
__host__ __device__ __forceinline__ int perm32(int rho) { const int n = rho >> 4, i = rho & 15; return 8 * (i >> 2) + 4 * n + (i & 3); }

struct GUnit { const char* a; const char* b; int pm, pn, z; };

__device__ __forceinline__ void dense_map(int L, int nM, int nN, int& pm, int& pn) {
    const int nwg = nM * nN;
    int wgid = L; { const int q = nwg / 8, r = nwg % 8, xcd = wgid % 8, off = wgid / 8; wgid = (xcd < r ? xcd * (q + 1) : r * (q + 1) + (xcd - r) * q) + off; }
    const int nig = 8 * nN, gid = wgid / nig, fm = gid * 8, gsz = (nM - fm) < 8 ? (nM - fm) : 8;
    pm = fm + ((wgid % nig) % gsz); pn = (wgid % nig) / gsz;
}

template <class Epi, class Sched, bool GATHER = false>
__device__ __forceinline__ void gemm_phase(LAS unsigned char* lds, const int lda, const int ldb, const int K, const Sched& S, const Epi& E, const int* gidx = nullptr) {
    int tid_ = threadIdx.x; asm volatile("" : "+v"(tid_));
    const int tid = tid_, wid = __builtin_amdgcn_readfirstlane(tid >> 6), lane = tid & 63, wr = wid >> 2, wc = wid & 3, fr = lane & 15, fq = lane >> 4;
    const int nt = K / BK;
    unsigned voffB[2]; int RA[2]; unsigned CA2[2];
#pragma unroll
    for (int i = 0; i < 2; ++i) { int R, C; stage_rc(tid * 16 + i * 8192, R, C); const int Rb = Epi::PERM ? ((R & ~31) + perm32(R & 31)) : R;
        RA[i] = R; CA2[i] = (unsigned)C * 2u; voffB[i] = (unsigned)(Rb * ldb + C) * 2u; }
    const size_t kstep = (size_t)(BK * 2);
    const size_t hstepB = (size_t)HALF * ldb * 2;
    const unsigned ldsw = (unsigned)wid * 1024u;
    const int aoff = lds_byte(wr * 64 + fr, fq * 8), boff = lds_byte(wc * 32 + fr, fq * 8);
#define PG8_AOFF(of, u) do { _Pragma("unroll") for (int hh_ = 0; hh_ < 2; ++hh_) _Pragma("unroll") for (int i_ = 0; i_ < 2; ++i_) { \
        if constexpr (GATHER) of[hh_][i_] = (unsigned)gidx[(u).pm * 256 + hh_ * 128 + RA[i_]] * (unsigned)(lda * 2) + CA2[i_]; \
        else of[hh_][i_] = (unsigned)((hh_ * HALF + RA[i_]) * lda) * 2u + CA2[i_]; } } while (0)
#define PG8_SA(b, h) (((b) * 2 + (h)) * HTB)
#define PG8_SB(b, h) ((4 + (b) * 2 + (h)) * HTB)
#define PG8_STAGE(bufoff, gbase, voff) do { _Pragma("unroll") for (int _i = 0; _i < 2; ++_i) \
        __builtin_amdgcn_global_load_lds((const unsigned*)((const char*)(gbase) + (voff)[_i]), (LAS unsigned*)(lds + (bufoff) + ldsw + _i * 8192), 16, 0, 0); } while (0)
#define PG8_LDA(dst, b, h) do { _Pragma("unroll") for (int m = 0; m < 4; ++m) _Pragma("unroll") for (int k = 0; k < 2; ++k) dst[m][k] = *(const LAS bf16x8*)(lds + PG8_SA(b, h) + aoff + m * 2048 + k * 1024); } while (0)
#define PG8_LDB(dst, b, h) do { _Pragma("unroll") for (int n = 0; n < 2; ++n) _Pragma("unroll") for (int k = 0; k < 2; ++k) dst[n][k] = *(const LAS bf16x8*)(lds + PG8_SB(b, h) + boff + n * 2048 + k * 1024); } while (0)
#define PG8_MMA(ai, bj, At, Bt) do { __builtin_amdgcn_s_setprio(1); _Pragma("unroll") for (int m = 0; m < 4; ++m) _Pragma("unroll") for (int n = 0; n < 2; ++n) _Pragma("unroll") for (int k = 0; k < 2; ++k) \
        acc[ai][bj][m][n] = __builtin_amdgcn_mfma_f32_16x16x32_bf16(Bt[n][k], At[m][k], acc[ai][bj][m][n], 0, 0, 0); __builtin_amdgcn_s_setprio(0); } while (0)
#define PG8_WAIT_V(n) asm volatile("s_waitcnt vmcnt(" #n ")" ::: "memory")
#define PG8_WAIT_L(n) asm volatile("s_waitcnt lgkmcnt(" #n ")" ::: "memory")
#define PG8_BAR __builtin_amdgcn_s_barrier()
#define PG8_SCHED __builtin_amdgcn_sched_barrier(0)
    GUnit cur, nxt; int ui = 0;
    if (!S.next(0, cur)) return;
    f32x4 acc[2][2][4][2];
#pragma unroll
    for (int a = 0; a < 2; ++a)
#pragma unroll
        for (int b = 0; b < 2; ++b)
#pragma unroll
            for (int m = 0; m < 4; ++m)
#pragma unroll
                for (int n = 0; n < 2; ++n) acc[a][b][m][n] = (f32x4){0.f, 0.f, 0.f, 0.f};
    bf16x8 At[4][2], B0[2][2], B1[2][2];
    unsigned ofc[2][2], ofn[2][2];
    PG8_AOFF(ofc, cur);
#pragma unroll
    for (int hh = 0; hh < 2; ++hh)
#pragma unroll
        for (int i = 0; i < 2; ++i) ofn[hh][i] = ofc[hh][i];
    const char* cA = cur.a; const char* cB = cur.b;
    PG8_STAGE(PG8_SB(0, 0), cB, voffB); PG8_STAGE(PG8_SB(0, 1), cB + hstepB, voffB); PG8_STAGE(PG8_SA(0, 0), cA, ofc[0]); PG8_STAGE(PG8_SA(0, 1), cA, ofc[1]);
    if (wr == 1) PG8_BAR;
    PG8_WAIT_V(2); PG8_BAR;
    PG8_STAGE(PG8_SB(1, 0), cB + kstep, voffB); PG8_STAGE(PG8_SA(1, 0), cA + kstep, ofc[0]); PG8_STAGE(PG8_SB(1, 1), cB + hstepB + kstep, voffB);
    PG8_WAIT_V(6); PG8_BAR;
    for (;;) {
        const bool has_next = S.next(ui + 1, nxt);
        const char* nA = has_next ? nxt.a : cA; const char* nB = has_next ? nxt.b : cB;
        for (int t = 0; t < nt; t += 2) {
            const bool last = (t == nt - 2);
            if constexpr (GATHER) { if (last && has_next) PG8_AOFF(ofn, nxt); }
            const char* a1 = cA + (size_t)(t + 1) * kstep;
            const char* a2 = last ? nA : cA + (size_t)(t + 2) * kstep; const char* b2 = last ? nB : cB + (size_t)(t + 2) * kstep;
            const char* a3 = a2 + kstep; const char* b3 = b2 + kstep;
            unsigned o2[2][2];
#pragma unroll
            for (int hh = 0; hh < 2; ++hh)
#pragma unroll
                for (int i = 0; i < 2; ++i) { if constexpr (GATHER) o2[hh][i] = last ? ofn[hh][i] : ofc[hh][i]; else o2[hh][i] = ofc[hh][i]; }
            PG8_LDB(B0, 0, 0); PG8_LDB(B1, 0, 1); PG8_SCHED; PG8_LDA(At, 0, 0); PG8_STAGE(PG8_SA(1, 1), a1, ofc[1]);
            PG8_WAIT_V(8); PG8_WAIT_L(0); PG8_BAR; PG8_MMA(0, 0, At, B0); PG8_MMA(0, 1, At, B1); PG8_BAR; PG8_SCHED;
            PG8_LDA(At, 0, 1); PG8_STAGE(PG8_SB(0, 0), b2, voffB); PG8_STAGE(PG8_SB(0, 1), b2 + hstepB, voffB); PG8_STAGE(PG8_SA(0, 0), a2, o2[0]);
            PG8_WAIT_V(8); PG8_WAIT_L(0); PG8_BAR; PG8_MMA(1, 0, At, B0); PG8_MMA(1, 1, At, B1); PG8_BAR; PG8_SCHED;
            PG8_LDB(B0, 1, 0); PG8_LDB(B1, 1, 1); PG8_SCHED; PG8_LDA(At, 1, 0); PG8_STAGE(PG8_SA(0, 1), a2, o2[1]);
            PG8_WAIT_V(8); PG8_WAIT_L(0); PG8_BAR; PG8_MMA(0, 0, At, B0); PG8_MMA(0, 1, At, B1); PG8_BAR; PG8_SCHED;
            PG8_LDA(At, 1, 1); PG8_STAGE(PG8_SB(1, 0), b3, voffB); PG8_STAGE(PG8_SB(1, 1), b3 + hstepB, voffB); PG8_STAGE(PG8_SA(1, 0), a3, o2[0]);
            PG8_WAIT_V(8); PG8_WAIT_L(0); PG8_BAR; PG8_MMA(1, 0, At, B0); PG8_MMA(1, 1, At, B1); PG8_BAR; PG8_SCHED;
        }
        if (wr == 0) PG8_BAR;
        E(acc, cur, wr, wc, fr, fq);
        if (!has_next) break;
#pragma unroll
        for (int a = 0; a < 2; ++a)
#pragma unroll
            for (int b = 0; b < 2; ++b)
#pragma unroll
                for (int m = 0; m < 4; ++m)
#pragma unroll
                    for (int n = 0; n < 2; ++n) acc[a][b][m][n] = (f32x4){0.f, 0.f, 0.f, 0.f};
        cur = nxt; cA = nA; cB = nB; ++ui;
        if constexpr (GATHER) {
#pragma unroll
            for (int hh = 0; hh < 2; ++hh)
#pragma unroll
                for (int i = 0; i < 2; ++i) ofc[hh][i] = ofn[hh][i];
        }
        if (wr == 1) PG8_BAR;
    }
    PG8_WAIT_V(0);
    PG8_BAR;
#undef PG8_AOFF
#undef PG8_SA
#undef PG8_SB
#undef PG8_STAGE
#undef PG8_LDA
#undef PG8_LDB
#undef PG8_MMA
#undef PG8_WAIT_V
#undef PG8_WAIT_L
#undef PG8_BAR
#undef PG8_SCHED
}
}
using pg8::GUnit;

struct SchedProj {
    const char* H; const char* WIN; const char* WPQ; int G, c;
    __device__ __forceinline__ bool next(int i, GUnit& u) const {
        const int L = i * G + c; if (L >= 480) return false;
        if (L < 416) { int pm, pn; pg8::dense_map(L, 32, 13, pm, pn); u.pm = pm; u.pn = pn; u.z = 0; u.a = H + (size_t)pm * 256 * 2048 * 2; u.b = WIN + (size_t)pn * 256 * 2048 * 2; }
        else { int pm, pn; pg8::dense_map(L - 416, 2, 32, pm, pn); u.pm = pm; u.pn = pn + 64; u.z = 0; u.a = WPQ + (size_t)pm * 256 * 2048 * 2; u.b = H + (size_t)pn * 256 * 2048 * 2; }
        return true;
    }
};
struct SchedDft {
    const char* DFT; const char* XAT; int G, c;
    __device__ __forceinline__ bool next(int i, GUnit& u) const {
        const int L = i * G + c; if (L >= 256) return false;
        const int Lp = (L & 7) * 32 + (L >> 3);
        const int ks = Lp & 1, pn = (Lp >> 1) & 1, pm = (Lp >> 2) & 15, b = Lp >> 6;
        u.pm = b * 16 + pm; u.pn = pn; u.z = ks;
        u.a = DFT + ((size_t)pm * 256 * 2048 + ks * 1024) * 2; u.b = XAT + (((size_t)b * 512 + pn * 256) * 2048 + ks * 1024) * 2;
        return true;
    }
};
struct SchedDense {
    const char* A; const char* B; int nM, nN, K, G, c;
    __device__ __forceinline__ bool next(int i, GUnit& u) const {
        const int L = i * G + c; if (L >= nM * nN) return false;
        int pm, pn; pg8::dense_map(L, nM, nN, pm, pn); u.pm = pm; u.pn = pn; u.z = 0;
        u.a = A + (size_t)pm * 256 * K * 2; u.b = B + (size_t)pn * 256 * K * 2; return true;
    }
};
struct SchedMoeG {
    const char* A; const char* B; int K, G, c;
    __device__ __forceinline__ bool next(int i, GUnit& u) const {
        const int L = i * G + c; if (L >= 512) return false;
        const int Lp = (L & 7) * 64 + (L >> 3);
        const int e = Lp >> 5, r = Lp & 31, pm = r & 3, pn = r >> 2;
        u.pm = e * 4 + pm; u.pn = pn; u.z = e;
        u.a = A; u.b = B + ((size_t)e * 2048 + pn * 256) * K * 2; return true;
    }
};
struct SchedMoe {
    const char* A; const char* B; int K, G, c;
    __device__ __forceinline__ bool next(int i, GUnit& u) const {
        const int L = i * G + c; if (L >= 512) return false;
        const int Lp = (L & 7) * 64 + (L >> 3);
        const int e = Lp >> 5, r = Lp & 31, pm = r & 3, pn = r >> 2;
        u.pm = e * 4 + pm; u.pn = pn; u.z = e;
        u.a = A + ((size_t)e * 1024 + pm * 256) * K * 2; u.b = B + ((size_t)e * 2048 + pn * 256) * K * 2; return true;
    }
};

typedef f32x4 AccT[2][2][4][2];
struct EpiProj {
    static constexpr bool PERM = true;
    bf16_t* PROJ; bf16_t* PQT; const float* ropec; const float* ropes;
    __device__ __forceinline__ void operator()(const AccT& acc, const GUnit& u, int wr, int wc, int fr, int fq) const {
        if (u.pn < 64) {
            const int pn = u.pn;
            const int row0 = u.pm * 256 + wr * 64 + fr;
#pragma unroll
            for (int ai = 0; ai < 2; ++ai)
#pragma unroll
                for (int m = 0; m < 4; ++m) {
                    const int row = row0 + ai * 128 + m * 16;
                    float vsq = 0.f;
#pragma unroll
                    for (int bj = 0; bj < 2; ++bj) {
                        f32x4 v0 = acc[ai][bj][m][0], v1 = acc[ai][bj][m][1];
                        const int colt = pn * 256 + bj * 128;
                        if (pn < 4) {
#pragma unroll
                            for (int j = 0; j < 4; ++j) { v0[j] = gelu_tanh(v0[j]); v1[j] = gelu_tanh(v1[j]); vsq += v0[j] * v0[j] + v1[j] * v1[j]; }
                        } else {
                            const bool isq = (colt >= PC_QC && colt < PC_KC) || (colt >= PC_QD && colt < PC_KD);
                            const bool isk = (colt >= PC_KC && colt < PC_VC) || (colt >= PC_KD && colt < PC_VD);
                            if (isq || isk) {
                                if ((wc & 1) == 0) {
                                    f32x4 o0, o1;
#pragma unroll
                                    for (int j = 0; j < 4; ++j) { o0[j] = __shfl_xor(v0[j], 16); o1[j] = __shfl_xor(v1[j], 16); }
                                    if (fq < 2) {
                                        const f32x4 c0 = *(const f32x4*)(ropec + (size_t)row * 8), c1 = *(const f32x4*)(ropec + (size_t)row * 8 + 4);
                                        const f32x4 s0 = *(const f32x4*)(ropes + (size_t)row * 8), s1 = *(const f32x4*)(ropes + (size_t)row * 8 + 4);
                                        const float sg = fq == 0 ? -1.f : 1.f;
#pragma unroll
                                        for (int j = 0; j < 4; ++j) { v0[j] = v0[j] * c0[j] + sg * o0[j] * s0[j]; v1[j] = v1[j] * c1[j] + sg * o1[j] * s1[j]; }
                                    }
                                }
                                if (isq) { v0 = v0 * 0.125f; v1 = v1 * 0.125f; }
                            }
                        }
                        u32x4 w; w.x = pk2(v0[0], v0[1]); w.y = pk2(v0[2], v0[3]); w.z = pk2(v1[0], v1[1]); w.w = pk2(v1[2], v1[3]);
                        *(u32x4*)(PROJ + (size_t)row * NPROJ + colt + wc * 32 + 8 * fq) = w;
                    }
                    if (pn == 2 || pn == 3) {
                        vsq += __shfl_xor(vsq, 16); vsq += __shfl_xor(vsq, 32);
                        if (fq == 0) ((float*)((char*)PROJ + (WS_VSS - WS_PROJ)))[(size_t)row * 8 + (pn - 2) * 4 + wc] = vsq;
                    }
                }
        } else {
#pragma unroll
            for (int ai = 0; ai < 2; ++ai)
#pragma unroll
                for (int m = 0; m < 4; ++m) {
                    const int c = u.pm * 256 + ai * 128 + wr * 64 + m * 16 + fr;
#pragma unroll
                    for (int bj = 0; bj < 2; ++bj) {
                        const int t = (u.pn - 64) * 256 + bj * 128 + wc * 32 + 8 * fq, b = t >> 11, s = t & 2047;
                        const f32x4 v0 = acc[ai][bj][m][0], v1 = acc[ai][bj][m][1];
                        u32x4 w; w.x = pk2(v0[0], v0[1]); w.y = pk2(v0[2], v0[3]); w.z = pk2(v1[0], v1[1]); w.w = pk2(v1[2], v1[3]);
                        *(u32x4*)(PQT + (((size_t)b * 512 + c) * 2048 + s)) = w;
                    }
                }
        }
    }
};
struct EpiBf16Plain {
    static constexpr bool PERM = true;
    bf16_t* O; int ldc; size_t zstride;
    __device__ __forceinline__ void operator()(const AccT& acc, const GUnit& u, int wr, int wc, int fr, int fq) const {
        bf16_t* base = O + (size_t)u.z * zstride;
#pragma unroll
        for (int ai = 0; ai < 2; ++ai)
#pragma unroll
            for (int m = 0; m < 4; ++m) {
                const int row = u.pm * 256 + ai * 128 + wr * 64 + m * 16 + fr;
#pragma unroll
                for (int bj = 0; bj < 2; ++bj) {
                    const f32x4 v0 = acc[ai][bj][m][0], v1 = acc[ai][bj][m][1];
                    u32x4 w; w.x = pk2(v0[0], v0[1]); w.y = pk2(v0[2], v0[3]); w.z = pk2(v1[0], v1[1]); w.w = pk2(v1[2], v1[3]);
                    *(u32x4*)(base + (size_t)row * ldc + u.pn * 256 + bj * 128 + wc * 32 + 8 * fq) = w;
                }
            }
    }
};
struct EpiWout {
    static constexpr bool PERM = true;
    const float* base32; const bf16_t* base16; bf16_t* X2; const float* gate;
    __device__ __forceinline__ void operator()(const AccT& acc, const GUnit& u, int wr, int wc, int fr, int fq) const {
        const int b = u.pm >> 3;
        const int col0 = u.pn * 256 + wc * 32 + 8 * fq;
        f32x4 g[2][2];
#pragma unroll
        for (int bj = 0; bj < 2; ++bj)
#pragma unroll
            for (int n = 0; n < 2; ++n) g[bj][n] = *(const f32x4*)(gate + (size_t)b * 12288 + col0 + bj * 128 + n * 4);
#pragma unroll
        for (int ai = 0; ai < 2; ++ai)
#pragma unroll
            for (int m = 0; m < 4; ++m) {
                const size_t ro = (size_t)(u.pm * 256 + ai * 128 + wr * 64 + m * 16 + fr) * DM + col0;
#pragma unroll
                for (int bj = 0; bj < 2; ++bj) {
                    f32x4 x0, x1;
                    if (base32) { x0 = *(const f32x4*)(base32 + ro + bj * 128); x1 = *(const f32x4*)(base32 + ro + bj * 128 + 4); }
                    else { const u32x4 w = *(const u32x4*)(base16 + ro + bj * 128); x0 = (f32x4){bflo(w.x), bfhi(w.x), bflo(w.y), bfhi(w.y)}; x1 = (f32x4){bflo(w.z), bfhi(w.z), bflo(w.w), bfhi(w.w)}; }
                    const f32x4 v0 = x0 + g[bj][0] * acc[ai][bj][m][0], v1 = x1 + g[bj][1] * acc[ai][bj][m][1];
                    u32x4 o; o.x = pk2(v0[0], v0[1]); o.y = pk2(v0[2], v0[3]); o.z = pk2(v1[0], v1[1]); o.w = pk2(v1[2], v1[3]);
                    *(u32x4*)(X2 + ro + bj * 128) = o;
                }
            }
    }
};
struct EpiGU {
    static constexpr bool PERM = true;
    bf16_t* ACT;
    __device__ __forceinline__ void operator()(const AccT& acc, const GUnit& u, int wr, int wc, int fr, int fq) const {
#pragma unroll
        for (int ai = 0; ai < 2; ++ai)
#pragma unroll
            for (int m = 0; m < 4; ++m) {
                const int row = u.pm * 256 + ai * 128 + wr * 64 + m * 16 + fr;
                f32x4 v0, v1;
#pragma unroll
                for (int j = 0; j < 4; ++j) { v0[j] = silu_f(acc[ai][0][m][0][j]) * acc[ai][1][m][0][j]; v1[j] = silu_f(acc[ai][0][m][1][j]) * acc[ai][1][m][1][j]; }
                u32x4 w; w.x = pk2(v0[0], v0[1]); w.y = pk2(v0[2], v0[3]); w.z = pk2(v1[0], v1[1]); w.w = pk2(v1[2], v1[3]);
                *(u32x4*)(ACT + (size_t)row * FF + u.pn * 128 + wc * 32 + 8 * fq) = w;
            }
    }
};
struct EpiDown {
    static constexpr bool PERM = true;
    bf16_t* EO; const float* gate;
    __device__ __forceinline__ void operator()(const AccT& acc, const GUnit& u, int wr, int wc, int fr, int fq) const {
#pragma unroll
        for (int ai = 0; ai < 2; ++ai)
#pragma unroll
            for (int m = 0; m < 4; ++m) {
                const int row = u.pm * 256 + ai * 128 + wr * 64 + m * 16 + fr;
                const float g = gate[row];
#pragma unroll
                for (int bj = 0; bj < 2; ++bj) {
                    const f32x4 v0 = acc[ai][bj][m][0] * g, v1 = acc[ai][bj][m][1] * g;
                    u32x4 w; w.x = pk2(v0[0], v0[1]); w.y = pk2(v0[2], v0[3]); w.z = pk2(v1[0], v1[1]); w.w = pk2(v1[2], v1[3]);
                    *(u32x4*)(EO + (size_t)row * DM + u.pn * 256 + bj * 128 + wc * 32 + 8 * fq) = w;
                }
            }
    }
};

__device__ __forceinline__ void ph_mod(const Params& p, LAS unsigned char* lds) {
    LAS float* sl = (LAS float*)lds;
    LAS float* red = (LAS float*)(lds + 32768);
    const int tid = opaque_tid();
    const float* c = p.in[1];
    float* mod = (float*)(p.ws + WS_MOD);
    for (int i = tid; i < 8192; i += 512) { const float v = c[i]; sl[i] = v / (1.f + expf(-v)); }
    __syncthreads();
    const int cl = tid & 31, ks = tid >> 5;
    for (int u = blockIdx.x; u < 192; u += gridDim.x) {
        const int l = u / 96, cc = u % 96;
        const float* W = p.in[3] + (size_t)l * 2048 * 12288 + cc * 128 + cl * 4;
        float acc[4][4];
#pragma unroll
        for (int b = 0; b < 4; ++b)
#pragma unroll
            for (int j = 0; j < 4; ++j) acc[b][j] = 0.f;
#pragma unroll 8
        for (int k = ks; k < 2048; k += 16) {
            const f32x4 w = __builtin_nontemporal_load((const f32x4*)(W + (size_t)k * 12288));
#pragma unroll
            for (int b = 0; b < 4; ++b) { const float s = sl[b * 2048 + k];
#pragma unroll
                for (int j = 0; j < 4; ++j) acc[b][j] += s * w[j]; }
        }
#pragma unroll
        for (int b = 0; b < 4; ++b)
#pragma unroll
            for (int j = 0; j < 4; ++j) red[((b * 4 + j) * 16 + ks) * 32 + cl] = acc[b][j];
        __syncthreads();
        { const int b = tid >> 7, col = tid & 127; float s = 0.f;
#pragma unroll
          for (int q = 0; q < 16; ++q) s += red[((b * 4 + (col & 3)) * 16 + q) * 32 + (col >> 2)];
          mod[(size_t)(l * 4 + b) * 12288 + cc * 128 + col] = s + p.in[4][(size_t)l * 12288 + cc * 128 + col]; }
        __syncthreads();
    }
}
__device__ __forceinline__ void ph_tables(const Params& p) {
    const int gt = blockIdx.x * 512 + opaque_tid(), ngt = gridDim.x * 512;
    float* rc = (float*)(p.ws + WS_ROPE); float* rs = rc + NT * 8;
    const int* pos = (const int*)p.in[2];
    for (int i = gt; i < NT * 8; i += ngt) {
        const int t = i >> 3, j = i & 7;
        float inv;
        switch (j) { case 0: inv = 1.0f; break; case 1: inv = 0.1939227432012558f; break; case 2: inv = 0.03760603070259094f; break; case 3: inv = 0.007292664609849453f; break;
                     case 4: inv = 0.0014142135623842478f; break; case 5: inv = 0.00027424818836152554f; break; case 6: inv = 5.318296098266728e-05f; break; default: inv = 1.0313386155758053e-05f; break; }
        const float ang = (float)pos[t] * inv;
        double r = (double)ang * 0.15915494309189535; r -= floor(r);
        const float a = (float)(2.0 * r);
        rc[i] = cospif(a); rs[i] = sinpif(a);
    }
    { bf16_t* sw = (bf16_t*)(p.ws + WS_SGUW);
      for (int i = gt; i < 2 * 8 * 128 * 128 / 4; i += ngt) { const f32x4 w = *(const f32x4*)(p.in[9] + (size_t)i * 4); u32x2 o; o.x = pk2(w[0], w[1]); o.y = pk2(w[2], w[3]); *(u32x2*)(sw + (size_t)i * 4) = o; } }
    { bf16_t* wrt = (bf16_t*)(p.ws + WS_WRT);
      for (int i = gt; i < 2 * 16 * 2048; i += ngt) { const int l = i >> 15, e = (i >> 11) & 15, k = i & 2047; wrt[i] = (bf16_t)(pk2(p.in[15][((size_t)l * 2048 + k) * 16 + e], 0.f) & 0xffffu); } }
    { bf16_t* abt = (bf16_t*)(p.ws + WS_ABT);
      for (int i = gt; i < 2 * 8 * 64 * 128; i += ngt) { const int k = i & 127, d = (i >> 7) & 63, lh = i >> 13, c = k & 63; const float* fw = p.in[7] + (size_t)lh * 4096;
          float sacc = 0.f;
          for (int cp = 0; cp < 64; ++cp) { const float a = (float)((c * cp) & 63) * (1.f / 32.f); sacc += ((k < 64) ? cospif(a) : sinpif(a)) * fw[cp * 64 + d]; }
          abt[i] = (bf16_t)(pk2(sacc * 0.125f, 0.f) & 0xffffu); } }
    bf16_t* dft = (bf16_t*)(p.ws + WS_DFT);
    for (int i = gt; i < 2048 * 512; i += ngt) {
        const int sp = i >> 9, k8 = (i & 511) * 8;
        float v[8];
#pragma unroll
        for (int e = 0; e < 8; ++e) { const int k = k8 + e, part = k >> 11, s = k & 2047, m = (s * sp) & 2047; const float a = (float)m * (1.f / 1024.f);
            v[e] = (part ? -sinpif(a) : cospif(a)) * 0.022097086912079608f; }
        u32x4 w; w.x = pk2(v[0], v[1]); w.y = pk2(v[2], v[3]); w.z = pk2(v[4], v[5]); w.w = pk2(v[6], v[7]);
        *(u32x4*)(dft + (size_t)sp * 4096 + k8) = w;
    }
}
struct TDesc { const float* src; bf16_t* dst; const float* ksc; int lds_, ldd; };
__device__ __forceinline__ bool tdecode(const Params& p, int it, TDesc& d) {
    if (it >= 2 * 6880) return false;
    const int l = it / 6880; int r = it % 6880;
    d.ksc = nullptr;
    if (r < 480) { const int kt = r / 30, nt = r % 30;
        d.src = p.in[6] + ((size_t)l * 2048 + kt * 128) * DIN + nt * 128; d.lds_ = DIN;
        d.dst = (nt < 4 ? (bf16_t*)(p.ws + WS_WPQ) + ((size_t)l * 512 + nt * 128) * 2048 : (bf16_t*)(p.ws + WS_WIN) + ((size_t)l * NPROJ + (nt - 4) * 128) * 2048) + kt * 128; d.ldd = 2048; return true; }
    r -= 480;
    if (r < 256) { const int kt = r / 16, nt = r % 16;
        d.src = p.in[13] + ((size_t)l * 2048 + kt * 128) * 2048 + nt * 128; d.lds_ = 2048; d.ksc = p.in[12] + (size_t)l * 2048 + kt * 128;
        d.dst = (bf16_t*)(p.ws + WS_WOUT) + ((size_t)l * 2048 + nt * 128) * 2048 + kt * 128; d.ldd = 2048; return true; }
    r -= 256;
    if (r < 4096) { const int isup = r / 2048, r2 = r % 2048, e = r2 / 128, kt = (r2 % 128) / 8, nt = r2 % 8;
        d.src = p.in[isup ? 17 : 16] + (((size_t)l * 16 + e) * 2048 + kt * 128) * 1024 + nt * 128; d.lds_ = 1024;
        d.dst = (bf16_t*)(p.ws + WS_WGU) + (((size_t)l * 16 + e) * 2048 + nt * 256 + isup * 128) * 2048 + kt * 128; d.ldd = 2048; return true; }
    r -= 4096;
    { const int e = r / 128, kt = (r % 128) / 16, nt = r % 16;
        d.src = p.in[18] + (((size_t)l * 16 + e) * 1024 + kt * 128) * 2048 + nt * 128; d.lds_ = 2048;
        d.dst = (bf16_t*)(p.ws + WS_WD) + (((size_t)l * 16 + e) * 2048 + nt * 128) * 1024 + kt * 128; d.ldd = 1024; return true; }
}
__device__ __forceinline__ void ph_weights(const Params& p, LAS unsigned char* lds, const int p0, const int p1, const int wi, const int wn) {
    const int tid = opaque_tid();
    LAS unsigned* l32 = (LAS unsigned*)lds;
    LAS bf16_t* l16 = (LAS bf16_t*)lds;
    TDesc dA0, dA1, dB0, dB1; f32x4 a0[8], a1[8], b0[8], b1[8];
#define PW_LOAD(pi, D0, D1, V0, V1, HAVE) do { HAVE = (pi) < p1; if (HAVE) { tdecode(p, 2 * (pi), D0); tdecode(p, 2 * (pi) + 1, D1); \
        _Pragma("unroll") for (int i = 0; i < 8; ++i) { const int f = tid + 512 * i, k = f >> 5, c4 = f & 31; \
            V0[i] = __builtin_nontemporal_load((const f32x4*)(D0.src + (size_t)k * D0.lds_ + c4 * 4)); V1[i] = __builtin_nontemporal_load((const f32x4*)(D1.src + (size_t)k * D1.lds_ + c4 * 4)); } } } while (0)
#define PW_TOLDS(D0, V0, V1) do { _Pragma("unroll") for (int i = 0; i < 8; ++i) { const int f = tid + 512 * i, k = f >> 5, c4 = f & 31; const float sc = D0.ksc ? D0.ksc[k] : 1.f; \
        const int sw = ((k >> 3) & 15) * 2; u32x2 w; w.x = pk2(V0[i][0] * sc, V0[i][1] * sc); w.y = pk2(V0[i][2] * sc, V0[i][3] * sc); \
        *(LAS u32x2*)(l32 + k * 64 + ((2 * c4) ^ sw)) = w; \
        u32x2 w2; w2.x = pk2(V1[i][0] * sc, V1[i][1] * sc); w2.y = pk2(V1[i][2] * sc, V1[i][3] * sc); \
        *(LAS u32x2*)(l32 + 8192 + k * 64 + ((2 * c4) ^ sw)) = w2; } } while (0)
#define PW_STORE(DS0, DS1) do { _Pragma("unroll") for (int i = 0; i < 4; ++i) { \
        const int n = (tid >> 4) + 32 * i, kc = tid & 15, cd = (n >> 1) ^ (2 * kc), hf = n & 1; \
        unsigned short e[8], g[8]; \
        _Pragma("unroll") for (int q = 0; q < 8; ++q) { e[q] = l16[((8 * kc + q) * 64 + cd) * 2 + hf]; g[q] = l16[16384 + ((8 * kc + q) * 64 + cd) * 2 + hf]; } \
        u32x4 w; w.x = e[0] | ((unsigned)e[1] << 16); w.y = e[2] | ((unsigned)e[3] << 16); w.z = e[4] | ((unsigned)e[5] << 16); w.w = e[6] | ((unsigned)e[7] << 16); \
        __builtin_nontemporal_store(w, (u32x4*)(DS0.dst + (size_t)n * DS0.ldd + 8 * kc)); \
        u32x4 w2; w2.x = g[0] | ((unsigned)g[1] << 16); w2.y = g[2] | ((unsigned)g[3] << 16); w2.z = g[4] | ((unsigned)g[5] << 16); w2.w = g[6] | ((unsigned)g[7] << 16); \
        __builtin_nontemporal_store(w2, (u32x4*)(DS1.dst + (size_t)n * DS1.ldd + 8 * kc)); } } while (0)
    int pi = p0 + wi; bool hA, hB;
    PW_LOAD(pi, dA0, dA1, a0, a1, hA);
    PW_LOAD(pi + wn, dB0, dB1, b0, b1, hB);
    while (hA) {
        { PW_TOLDS(dA0, a0, a1); __syncthreads(); const TDesc s0 = dA0, s1 = dA1; PW_LOAD(pi + 2 * wn, dA0, dA1, a0, a1, hA); PW_STORE(s0, s1); __syncthreads(); }
        if (!hB) break;
        { PW_TOLDS(dB0, b0, b1); __syncthreads(); const TDesc s0 = dB0, s1 = dB1; PW_LOAD(pi + 3 * wn, dB0, dB1, b0, b1, hB); PW_STORE(s0, s1); __syncthreads(); }
        pi += 2 * wn;
    }
#undef PW_LOAD
#undef PW_TOLDS
#undef PW_STORE
}

__device__ __forceinline__ void ph_norm1(const Params& p, int mode) {
    const int tid = opaque_tid(), lane = tid & 63, wv = tid >> 6;
    const float* mod = (const float*)(p.ws + WS_MOD);
    const int* slot_of = (const int*)(p.ws + WS_IDX + 131072);
    const bf16_t* EO = (const bf16_t*)(p.ws + WS_EO);
    for (int t = blockIdx.x * 8 + wv; t < NT; t += gridDim.x * 8) {
        const int b = t >> 11;
        f32x4 v[8];
        if (mode == 0) { const float* xr = p.in[0] + (size_t)t * DM;
#pragma unroll
            for (int j = 0; j < 8; ++j) v[j] = *(const f32x4*)(xr + 4 * lane + 256 * j);
        } else { const bf16_t* xr = (const bf16_t*)(p.ws + WS_X2) + (size_t)t * DM;
#pragma unroll
            for (int j = 0; j < 8; ++j) { const u32x2 w = *(const u32x2*)(xr + 4 * lane + 256 * j); v[j] = (f32x4){bflo(w.x), bfhi(w.x), bflo(w.y), bfhi(w.y)}; }
        }
        if (mode != 0) {
            f32x4 macc[8];
#pragma unroll
            for (int j = 0; j < 8; ++j) macc[j] = (f32x4){0.f, 0.f, 0.f, 0.f};
            const int myslot = slot_of[(size_t)(lane & 15) * NT + t];
            unsigned m = (unsigned)(__ballot(myslot >= 0) & 0xffffull);
            while (m) {
                const int e0 = __builtin_ctz(m); m &= m - 1u;
                const bool two = m != 0u; const int e1 = two ? __builtin_ctz(m) : e0; if (two) m &= m - 1u;
                const int s0 = __builtin_amdgcn_readlane(myslot, e0), s1 = __builtin_amdgcn_readlane(myslot, e1);
                const float w1 = two ? 1.f : 0.f;
                const bf16_t* r0 = EO + (size_t)s0 * DM; const bf16_t* r1 = EO + (size_t)s1 * DM;
                u32x2 a[8], c[8];
#pragma unroll
                for (int j = 0; j < 8; ++j) { a[j] = *(const u32x2*)(r0 + 4 * lane + 256 * j); c[j] = *(const u32x2*)(r1 + 4 * lane + 256 * j); }
#pragma unroll
                for (int j = 0; j < 8; ++j) {
                    macc[j][0] += bflo(a[j].x) + w1 * bflo(c[j].x); macc[j][1] += bfhi(a[j].x) + w1 * bfhi(c[j].x);
                    macc[j][2] += bflo(a[j].y) + w1 * bflo(c[j].y); macc[j][3] += bfhi(a[j].y) + w1 * bfhi(c[j].y); }
            }
            const float* gf = mod + ((size_t)(mode - 1) * 4 + b) * 12288 + 5 * 2048;
#pragma unroll
            for (int j = 0; j < 8; ++j) { const f32x4 g = *(const f32x4*)(gf + 4 * lane + 256 * j); v[j] = v[j] + g * macc[j]; }
            if (mode == 1) {
                bf16_t* xo = (bf16_t*)(p.ws + WS_X) + (size_t)t * DM;
#pragma unroll
                for (int j = 0; j < 8; ++j) { u32x2 w; w.x = pk2(v[j][0], v[j][1]); w.y = pk2(v[j][2], v[j][3]); *(u32x2*)(xo + 4 * lane + 256 * j) = w;
                    v[j] = (f32x4){bflo(w.x), bfhi(w.x), bflo(w.y), bfhi(w.y)}; }
            }
        }
        float ss = 0.f;
#pragma unroll
        for (int j = 0; j < 8; ++j) ss += v[j][0] * v[j][0] + v[j][1] * v[j][1] + v[j][2] * v[j][2] + v[j][3] * v[j][3];
        const float r = 1.0f / sqrtf(wave_sum(ss) * (1.f / DM) + EPS);
        if (mode == 2) {
            float* o = p.out + (size_t)t * DM;
#pragma unroll
            for (int j = 0; j < 8; ++j) { const f32x4 g = *(const f32x4*)(p.in[19] + 4 * lane + 256 * j); *(f32x4*)(o + 4 * lane + 256 * j) = v[j] * r * g; }
        } else {
            const int l = mode;
            const float* g1 = p.in[5] + (size_t)l * DM;
            const float* sh = mod + ((size_t)l * 4 + b) * 12288;
            const float* sc = sh + 2048;
            bf16_t* ho = (bf16_t*)(p.ws + WS_H) + (size_t)t * DM;
#pragma unroll
            for (int j = 0; j < 8; ++j) {
                const f32x4 g = *(const f32x4*)(g1 + 4 * lane + 256 * j), s1 = *(const f32x4*)(sc + 4 * lane + 256 * j), s0 = *(const f32x4*)(sh + 4 * lane + 256 * j);
                const f32x4 h = (v[j] * r * g) * (s1 + 1.f) + s0;
                u32x2 w; w.x = pk2(h[0], h[1]); w.y = pk2(h[2], h[3]);
                *(u32x2*)(ho + 4 * lane + 256 * j) = w;
            }
        }
    }
}


__device__ __forceinline__ void ph_norm2_router_mfma(const Params& p, int l, LAS unsigned char* lds) {
    const int tid = opaque_tid(), lane = tid & 63, wv = tid >> 6, r = lane & 31, h = lane >> 5;
    LAS float* part = (LAS float*)lds;
    LAS float* lgs = (LAS float*)(lds + 8 * 32 * 17 * 4);
    const float* mod = (const float*)(p.ws + WS_MOD);
    const float* g2 = p.in[14] + (size_t)l * DM;
    const bf16_t* WRT = (const bf16_t*)(p.ws + WS_WRT) + (size_t)l * 16 * 2048;
    bf16_t* Hb = (bf16_t*)(p.ws + WS_H);
    float* aff = (float*)(p.ws + WS_AFF);
    for (int blk = blockIdx.x; blk < NT / 32; blk += gridDim.x) {
        const int t0 = blk * 32, b = t0 >> 11;
        const float* sh = mod + ((size_t)l * 4 + b) * 12288 + 3 * 2048;
        const float* sc = sh + 2048;
#pragma unroll 1
        for (int half = 0; half < 2; ++half) {
            const int ta = t0 + 4 * wv + 2 * half;
            const bf16_t* xa = (const bf16_t*)(p.ws + WS_X2) + (size_t)ta * DM;
            f32x4 va[8], vb[8];
#pragma unroll
            for (int j = 0; j < 8; ++j) { const u32x2 wa = *(const u32x2*)(xa + 4 * lane + 256 * j), wb = *(const u32x2*)(xa + DM + 4 * lane + 256 * j);
                va[j] = (f32x4){bflo(wa.x), bfhi(wa.x), bflo(wa.y), bfhi(wa.y)}; vb[j] = (f32x4){bflo(wb.x), bfhi(wb.x), bflo(wb.y), bfhi(wb.y)}; }
            float sa = 0.f, sb = 0.f;
#pragma unroll
            for (int j = 0; j < 8; ++j) { sa += va[j][0] * va[j][0] + va[j][1] * va[j][1] + va[j][2] * va[j][2] + va[j][3] * va[j][3]; sb += vb[j][0] * vb[j][0] + vb[j][1] * vb[j][1] + vb[j][2] * vb[j][2] + vb[j][3] * vb[j][3]; }
#pragma unroll
            for (int o = 1; o < 64; o <<= 1) { sa += __shfl_xor(sa, o); sb += __shfl_xor(sb, o); }
            const float ra = 1.0f / sqrtf(sa * (1.f / DM) + EPS), rb = 1.0f / sqrtf(sb * (1.f / DM) + EPS);
            bf16_t* ho = Hb + (size_t)ta * DM;
#pragma unroll
            for (int j = 0; j < 8; ++j) {
                const f32x4 g = *(const f32x4*)(g2 + 4 * lane + 256 * j), s1 = *(const f32x4*)(sc + 4 * lane + 256 * j), s0 = *(const f32x4*)(sh + 4 * lane + 256 * j);
                const f32x4 gg = g * (s1 + 1.f);
                const f32x4 ha = (va[j] * ra) * gg + s0, hb = (vb[j] * rb) * gg + s0;
                u32x2 wa; wa.x = pk2(ha[0], ha[1]); wa.y = pk2(ha[2], ha[3]);
                u32x2 wb; wb.x = pk2(hb[0], hb[1]); wb.y = pk2(hb[2], hb[3]);
                *(u32x2*)(ho + 4 * lane + 256 * j) = wa; *(u32x2*)(ho + DM + 4 * lane + 256 * j) = wb;
            }
        }
        asm volatile("s_waitcnt vmcnt(0)" ::: "memory");
        __syncthreads();
        {
            f32x16 acc;
#pragma unroll
            for (int q = 0; q < 16; ++q) acc[q] = 0.f;
            const bf16_t* bp = Hb + (size_t)(t0 + r) * DM + 256 * wv + 8 * h;
            const bf16_t* ap = WRT + (size_t)(r & 15) * 2048 + 256 * wv + 8 * h;
            bf16x8 bfr[16], afr[16];
#pragma unroll
            for (int s = 0; s < 16; ++s) { bfr[s] = *(const bf16x8*)(bp + 16 * s); afr[s] = *(const bf16x8*)(ap + 16 * s); }
#pragma unroll
            for (int s = 0; s < 16; ++s) { const bf16x8 a = (r < 16) ? afr[s] : (bf16x8){0, 0, 0, 0, 0, 0, 0, 0}; acc = __builtin_amdgcn_mfma_f32_32x32x16_bf16(a, bfr[s], acc, 0, 0, 0); }
#pragma unroll
            for (int q = 0; q < 8; ++q) { const int e = (q & 3) + 8 * (q >> 2) + 4 * h; part[(wv * 32 + r) * 17 + e] = acc[q]; }
        }
        __syncthreads();
        const int e = tid >> 5, tk = tid & 31;
        { float s = 0.f;
#pragma unroll
          for (int w = 0; w < 8; ++w) s += part[(w * 32 + tk) * 17 + e];
          lgs[e * 32 + tk] = s; }
        __syncthreads();
        { float lg[16]; float mx = -1e30f;
#pragma unroll
          for (int q = 0; q < 16; ++q) { lg[q] = lgs[q * 32 + tk]; mx = fmaxf(mx, lg[q]); }
          float den = 0.f, mine = 0.f;
#pragma unroll
          for (int q = 0; q < 16; ++q) { const float ex = expf(lg[q] - mx); den += ex; mine = (q == e) ? ex : mine; }
          aff[((size_t)b * 16 + e) * 2048 + (t0 & 2047) + tk] = mine / den; }
        __syncthreads();
    }
}

__device__ __forceinline__ unsigned block_excl_scan(unsigned cnt, LAS unsigned* wsum, int tid) {
    const int lane = tid & 63, wv = tid >> 6;
    unsigned inc = cnt;
#pragma unroll
    for (int o = 1; o < 64; o <<= 1) { const unsigned t = __shfl_up(inc, o); if (lane >= o) inc += t; }
    if (lane == 63) wsum[wv] = inc;
    __syncthreads();
    unsigned base = 0;
#pragma unroll
    for (int w = 0; w < 8; ++w) base += (w < wv) ? wsum[w] : 0u;
    __syncthreads();
    return base + inc - cnt;
}
__device__ __forceinline__ void ph_topk(const Params& p, LAS unsigned char* lds) {
    const int tid = opaque_tid();
    LAS unsigned* hist = (LAS unsigned*)lds;
    LAS unsigned* misc = hist + 256;
    LAS unsigned* wsum = hist + 320;
    const float* aff = (const float*)(p.ws + WS_AFF);
    int* idx = (int*)(p.ws + WS_IDX); float* gate = (float*)(p.ws + WS_IDX + 65536); int* slot_of = (int*)(p.ws + WS_IDX + 131072);
    for (int u = blockIdx.x; u < 64; u += gridDim.x) {
        const int b = u >> 4, e = u & 15;
        const f32x4 a = *(const f32x4*)(aff + (size_t)u * 2048 + 4 * tid);
        unsigned k[4];
#pragma unroll
        for (int i = 0; i < 4; ++i) k[i] = __float_as_uint(a[i]);
        unsigned prefix = 0, krem = CAP;
#pragma unroll 1
        for (int pass = 0; pass < 4; ++pass) {
            const int shift = 24 - 8 * pass;
            if (tid < 256) hist[tid] = 0;
            __syncthreads();
#pragma unroll
            for (int i = 0; i < 4; ++i) if (pass == 0 || (k[i] >> (shift + 8)) == prefix) __hip_atomic_fetch_add(&hist[(k[i] >> shift) & 255u], 1u, __ATOMIC_RELAXED, __HIP_MEMORY_SCOPE_WORKGROUP);
            __syncthreads();
            { const unsigned cnt = (tid < 256) ? hist[255 - tid] : 0u;
              const unsigned Sn = block_excl_scan(cnt, wsum, tid), S = Sn + cnt;
              if (tid < 256 && S >= krem && Sn < krem) { misc[0] = (prefix << 8) | (unsigned)(255 - tid); misc[1] = krem - Sn; } }
            __syncthreads();
            prefix = misc[0]; krem = misc[1];
            __syncthreads();
        }
        unsigned neq = 0;
#pragma unroll
        for (int i = 0; i < 4; ++i) neq += (k[i] == prefix) ? 1u : 0u;
        unsigned eqbase = block_excl_scan(neq, wsum, tid);
        unsigned sel[4]; unsigned nsel = 0;
#pragma unroll
        for (int i = 0; i < 4; ++i) { const bool eq = k[i] == prefix; sel[i] = (k[i] > prefix || (eq && eqbase < krem)) ? 1u : 0u; eqbase += eq ? 1u : 0u; nsel += sel[i]; }
        unsigned sb = block_excl_scan(nsel, wsum, tid);
#pragma unroll
        for (int i = 0; i < 4; ++i) {
            const int s = 4 * tid + i, t = b * 2048 + s;
            if (sel[i]) { const int row = e * 1024 + b * 256 + (int)sb; idx[row] = t; gate[row] = a[i]; slot_of[(size_t)e * NT + t] = row; ++sb; }
            else slot_of[(size_t)e * NT + t] = -1;
        }
        __syncthreads();
    }
}

__device__ __forceinline__ bf16x8 pack8(float a0, float a1, float a2, float a3, float a4, float a5, float a6, float a7) {
    u32x4 p;
    asm volatile("v_cvt_pk_bf16_f32 %0, %4, %5\n\tv_cvt_pk_bf16_f32 %1, %6, %7\n\tv_cvt_pk_bf16_f32 %2, %8, %9\n\tv_cvt_pk_bf16_f32 %3, %10, %11\n\ts_nop 1"
                 : "=&v"(p[0]), "=&v"(p[1]), "=&v"(p[2]), "=&v"(p[3]) : "v"(a0), "v"(a1), "v"(a2), "v"(a3), "v"(a4), "v"(a5), "v"(a6), "v"(a7));
    return __builtin_bit_cast(bf16x8, p);
}
template <int CH>
__device__ __forceinline__ void attn_prefetch(const bf16_t* qp, const bf16_t* kb, const size_t kst, const int lk0, const int ls, const int r, bf16x8 (&qf)[4], bf16x8 (&kf0)[CH][4]) {
#pragma unroll
    for (int s = 0; s < 4; ++s) qf[s] = *(const bf16x8*)(qp + 16 * s);
#pragma unroll
    for (int i = 0; i < CH; ++i) {
        int lkr = lk0 + 32 * i + r; lkr = lkr < 0 ? 0 : (lkr >= ls ? ls - 1 : lkr);
        const bf16_t* kp = kb + (size_t)lkr * kst;
#pragma unroll
        for (int s = 0; s < 4; ++s) kf0[i][s] = *(const bf16x8*)(kp + 16 * s);
    }
}
template <int NTILES, int CH, bool SYNC = true, bool KLDS = false>
__device__ __forceinline__ void attn_wave(const bf16x8 (&qf)[4], const bf16x8 (&kf0)[CH][4], const bf16_t* kb, const size_t kst, const int lk0, const int ls, const LAS bf16_t* vt, const int vts,
                                          float m_run, float l_run, f32x16& O0, f32x16& O1, float& m_out, float& l_out, const int r, const int h, const LAS bf16_t* kl = nullptr, const int kls = 0) {
#pragma unroll
    for (int i = 0; i < 16; ++i) { O0[i] = 0.f; O1[i] = 0.f; }
#pragma unroll
    for (int c0 = 0; c0 < NTILES; c0 += CH) {
        constexpr int dummy = 0; (void)dummy;
        f32x16 S[CH];
#pragma unroll
        for (int ii = 0; ii < CH; ++ii) {
            const int i = c0 + ii;
            if (i < NTILES) {
                int lkr = lk0 + 32 * i + r; lkr = lkr < 0 ? 0 : (lkr >= ls ? ls - 1 : lkr);
                const bf16_t* kp = kb + (size_t)lkr * kst;
                f32x16 a;
#pragma unroll
                for (int q = 0; q < 16; ++q) a[q] = 0.f;
#pragma unroll
                for (int s = 0; s < 4; ++s) {
                    bf16x8 kf;
                    if constexpr (KLDS) kf = *(const LAS bf16x8*)(kl + i * 32 * kls + 16 * s);
                    else { if (c0 == 0) kf = kf0[ii][s]; else kf = *(const bf16x8*)(kp + 16 * s); }
                    a = __builtin_amdgcn_mfma_f32_32x32x16_bf16(kf, qf[s], a, 0, 0, 0);
                }
                S[ii] = a;
            }
        }
        float mx = m_run;
#pragma unroll
        for (int ii = 0; ii < CH; ++ii) {
            const int i = c0 + ii;
            if (i < NTILES) {
                const bool edge = (lk0 + 32 * i < 0) || (lk0 + 32 * i + 32 > ls);
                if (edge || i == 0 || i == NTILES - 1) {
#pragma unroll
                    for (int q = 0; q < 16; ++q) {
                        const int row = (q & 3) + 8 * (q >> 2) + 4 * h;
                        const int lk = lk0 + 32 * i + row;
                        bool valid = (lk >= 0) && (lk < ls);
                        if (i == 0) valid = valid && (row >= r);
                        if (i == NTILES - 1) valid = valid && (row <= r);
                        const float sv = valid ? S[ii][q] : -1e30f;
                        S[ii][q] = sv;
                        mx = fmaxf(mx, sv);
                    }
                } else {
#pragma unroll
                    for (int q = 0; q < 16; ++q) mx = fmaxf(mx, S[ii][q]);
                }
            }
        }
        mx = fmaxf(mx, __shfl_xor(mx, 32));
        const float corr = __builtin_amdgcn_exp2f((m_run - mx) * 1.442695041f);
        float psum = 0.f;
#pragma unroll
        for (int ii = 0; ii < CH; ++ii) {
            const int i = c0 + ii;
            if (i < NTILES) {
#pragma unroll
                for (int q = 0; q < 16; ++q) { const float pv = __builtin_amdgcn_exp2f((S[ii][q] - mx) * 1.442695041f); S[ii][q] = pv; psum += pv; }
            }
        }
        psum += __shfl_xor(psum, 32);
        l_run = l_run * corr + psum;
        m_run = mx;
        if (c0 > 0) {
#pragma unroll
            for (int q = 0; q < 16; ++q) { O0[q] *= corr; O1[q] *= corr; }
        } else { if (SYNC) __syncthreads(); }
#pragma unroll
        for (int ii = 0; ii < CH; ++ii) {
            const int i = c0 + ii;
            if (i < NTILES) {
#pragma unroll
                for (int sp = 0; sp < 2; ++sp) {
                    const bf16x8 pf = pack8(S[ii][8 * sp + 0], S[ii][8 * sp + 1], S[ii][8 * sp + 2], S[ii][8 * sp + 3], S[ii][8 * sp + 4], S[ii][8 * sp + 5], S[ii][8 * sp + 6], S[ii][8 * sp + 7]);
                    const LAS bf16_t* v0 = vt + 32 * i + 16 * sp;
                    { const u32x2 a0 = *(const LAS u32x2*)(v0), a1 = *(const LAS u32x2*)(v0 + 8);
                      const u32x4 vw = (u32x4){a0.x, a0.y, a1.x, a1.y};
                      O0 = __builtin_amdgcn_mfma_f32_32x32x16_bf16(__builtin_bit_cast(bf16x8, vw), pf, O0, 0, 0, 0); }
                    { const u32x2 a0 = *(const LAS u32x2*)(v0 + 32 * vts), a1 = *(const LAS u32x2*)(v0 + 32 * vts + 8);
                      const u32x4 vw = (u32x4){a0.x, a0.y, a1.x, a1.y};
                      O1 = __builtin_amdgcn_mfma_f32_32x32x16_bf16(__builtin_bit_cast(bf16x8, vw), pf, O1, 0, 0, 0); }
                }
            }
        }
    }
    m_out = m_run; l_out = l_run;
}
__device__ __forceinline__ void ph_dilated_mfma(const Params& p, const int l, LAS unsigned char* lds) {
    constexpr int VTS = 260, VTSS = 292, KSTR = 72, ARENA = 78848, KOFF = 37376;
    const int hw = (opaque_tid() >> 8) & 1;
    const bf16_t* PROJ = (const bf16_t*)(p.ws + WS_PROJ);
    int ufirst, ucount, ustep;
    if (gridDim.x == 256) { if (blockIdx.x < 128) { ufirst = blockIdx.x * 2; ucount = 2; } else { ufirst = 256 + (blockIdx.x - 128) * 4; ucount = 4; } ustep = 1; }
    else { ufirst = blockIdx.x; ustep = gridDim.x; ucount = (768 - (int)blockIdx.x + (int)gridDim.x - 1) / (int)gridDim.x; }
    const int nsw = (256 - (int)blockIdx.x + (int)gridDim.x - 1) / (int)gridDim.x;
    const int ngm = (int)blockIdx.x < 128 ? (128 - (int)blockIdx.x + (int)gridDim.x - 1) / (int)gridDim.x : 0;
    const int nitems = ngm + nsw + ucount;
    constexpr int VTSG = 136;
    const bf16_t* SW = (const bf16_t*)(p.ws + WS_SGUW) + (size_t)l * 8 * 128 * 128;
    bf16x8 qf[4]; bf16x8 kdummy[5][4];
    for (int k = 0; k <= 2 * nitems; ++k) {
        const int tid = opaque_tid(), lane = tid & 63, w4 = (tid >> 6) & 3, tl = tid & 255, r = lane & 31, h = lane >> 5;
        LAS bf16_t* Vt = (LAS bf16_t*)(lds + hw * ARENA);
        LAS unsigned* Vt32 = (LAS unsigned*)Vt;
        LAS bf16_t* Ks = (LAS bf16_t*)(lds + hw * ARENA + KOFF);
        const int kk = k - hw, it0 = kk >> 1;
        if (kk >= 0 && it0 < nitems) {
            if (it0 < ngm) {
                const int u = blockIdx.x + it0 * gridDim.x;
                const int hg = u & 1, t0 = (u >> 1) * 128, hh2 = w4 >> 1, ph = w4 & 1, habs = hg * 4 + 2 * hw + hh2;
                if (!(kk & 1)) {
                    const int kp = tl & 63, ta = t0 + 2 * kp;
                    const float* vs = (const float*)(p.ws + WS_VSS) + (size_t)ta * 8;
                    const f32x4 sa0 = *(const f32x4*)vs, sa1 = *(const f32x4*)(vs + 4), sb0 = *(const f32x4*)(vs + 8), sb1 = *(const f32x4*)(vs + 12);
                    u32x4 va[4], vb[4]; f32x4 g0[4], g1[4];
                    const float* sn = p.in[8] + (size_t)l * 512 + hg * 256 + hw * 128;
#pragma unroll
                    for (int i = 0; i < 4; ++i) { const int dc = (tl >> 6) + 4 * i;
                        const bf16_t* src = PROJ + (size_t)ta * NPROJ + PC_V + hg * 256 + hw * 128 + 8 * dc;
                        va[i] = *(const u32x4*)src; vb[i] = *(const u32x4*)(src + NPROJ);
                        g0[i] = *(const f32x4*)(sn + 8 * dc); g1[i] = *(const f32x4*)(sn + 8 * dc + 4); }
                    const float ra = 1.0f / sqrtf((((sa0[0] + sa0[1]) + (sa0[2] + sa0[3])) + ((sa1[0] + sa1[1]) + (sa1[2] + sa1[3]))) * (1.f / 512.f) + EPS);
                    const float rb = 1.0f / sqrtf((((sb0[0] + sb0[1]) + (sb0[2] + sb0[3])) + ((sb1[0] + sb1[1]) + (sb1[2] + sb1[3]))) * (1.f / 512.f) + EPS);
#pragma unroll
                    for (int i = 0; i < 4; ++i) { const int dc = (tl >> 6) + 4 * i;
                        LAS unsigned* o = Vt32 + (8 * dc) * (VTSG / 2) + kp;
                        o[0 * (VTSG / 2)] = pk2(bflo(va[i].x) * ra * g0[i][0], bflo(vb[i].x) * rb * g0[i][0]); o[1 * (VTSG / 2)] = pk2(bfhi(va[i].x) * ra * g0[i][1], bfhi(vb[i].x) * rb * g0[i][1]);
                        o[2 * (VTSG / 2)] = pk2(bflo(va[i].y) * ra * g0[i][2], bflo(vb[i].y) * rb * g0[i][2]); o[3 * (VTSG / 2)] = pk2(bfhi(va[i].y) * ra * g0[i][3], bfhi(vb[i].y) * rb * g0[i][3]);
                        o[4 * (VTSG / 2)] = pk2(bflo(va[i].z) * ra * g1[i][0], bflo(vb[i].z) * rb * g1[i][0]); o[5 * (VTSG / 2)] = pk2(bfhi(va[i].z) * ra * g1[i][1], bfhi(vb[i].z) * rb * g1[i][1]);
                        o[6 * (VTSG / 2)] = pk2(bflo(va[i].w) * ra * g1[i][2], bflo(vb[i].w) * rb * g1[i][2]); o[7 * (VTSG / 2)] = pk2(bfhi(va[i].w) * ra * g1[i][3], bfhi(vb[i].w) * rb * g1[i][3]); }
                } else {
                    f32x16 acc[2][2];
#pragma unroll
                    for (int ct = 0; ct < 2; ++ct)
#pragma unroll
                        for (int pt = 0; pt < 2; ++pt)
#pragma unroll
                            for (int q = 0; q < 16; ++q) acc[ct][pt][q] = 0.f;
                    const LAS bf16_t* ap = Vt + (hh2 * 64 + r) * VTSG + 8 * h;
                    const bf16_t* wp = SW + ((size_t)habs * 128 + 64 * ph + r) * 128 + 8 * h;
#pragma unroll
                    for (int s2 = 0; s2 < 8; ++s2) {
                        bf16x8 afr[2], bfr[2];
#pragma unroll
                        for (int pt = 0; pt < 2; ++pt) bfr[pt] = *(const bf16x8*)(wp + (size_t)pt * 32 * 128 + 16 * s2);
#pragma unroll
                        for (int ct = 0; ct < 2; ++ct) afr[ct] = *(const LAS bf16x8*)(ap + ct * 32 * VTSG + 16 * s2);
#pragma unroll
                        for (int ct = 0; ct < 2; ++ct)
#pragma unroll
                            for (int pt = 0; pt < 2; ++pt) acc[ct][pt] = __builtin_amdgcn_mfma_f32_32x32x16_bf16(afr[ct], bfr[pt], acc[ct][pt], 0, 0, 0);
                    }
                    bf16_t* YB = (bf16_t*)(p.ws + WS_YB);
#pragma unroll
                    for (int pt = 0; pt < 2; ++pt) {
                        const int pp = 64 * ph + 32 * pt + r;
                        const float bias = p.in[10][((size_t)l * 8 + habs) * 128 + pp];
                        const bf16_t* us = PROJ + (size_t)(t0 + pp) * NPROJ + PC_U + habs * 64 + 4 * h;
                        bf16_t* o = YB + (size_t)(t0 + pp) * 512 + habs * 64 + 4 * h;
#pragma unroll
                        for (int ct = 0; ct < 2; ++ct)
#pragma unroll
                            for (int gg = 0; gg < 4; ++gg) {
                                const u32x2 uw = *(const u32x2*)(us + 32 * ct + 8 * gg);
                                u32x2 w; w.x = pk2(bflo(uw.x) * (acc[ct][pt][4 * gg] + bias), bfhi(uw.x) * (acc[ct][pt][4 * gg + 1] + bias));
                                w.y = pk2(bflo(uw.y) * (acc[ct][pt][4 * gg + 2] + bias), bfhi(uw.y) * (acc[ct][pt][4 * gg + 3] + bias));
                                *(u32x2*)(o + 32 * ct + 8 * gg) = w;
                            }
                    }
                }
            } else if (it0 < ngm + nsw) {
                const int it = it0 - ngm;
                const int u = blockIdx.x + it * gridDim.x;
                const int b = u >> 6, kvh = (u >> 5) & 1, q0 = (u & 31) * 64 + 32 * hw;
                const bf16_t* base = PROJ + (size_t)b * SEQ * NPROJ;
                const int head = kvh * 4 + w4, qpos = q0 + r, lk0 = q0 - 128;
                if (!(kk & 1)) {
                    u32x4 va[5], vb[5], kc[9];
#pragma unroll
                    for (int i = 0; i < 5; ++i) {
                        const int task = tl + 256 * i;
                        if (task < 1152) { const int kp = task % 144, dc = task / 144;
                            int kA = lk0 + 2 * kp; kA = kA < 0 ? 0 : (kA > SEQ - 2 ? SEQ - 2 : kA);
                            va[i] = *(const u32x4*)(base + (size_t)kA * NPROJ + PC_VC + kvh * 64 + 8 * dc);
                            vb[i] = *(const u32x4*)(base + (size_t)(kA + 1) * NPROJ + PC_VC + kvh * 64 + 8 * dc); }
                    }
#pragma unroll
                    for (int i = 0; i < 9; ++i) { const int id = tl + 256 * i, j = id >> 3, c8 = id & 7;
                        int kp2 = lk0 + j; kp2 = kp2 < 0 ? 0 : (kp2 >= SEQ ? SEQ - 1 : kp2);
                        kc[i] = *(const u32x4*)(base + (size_t)kp2 * NPROJ + PC_KC + kvh * 64 + 8 * c8); }
                    { const bf16_t* qp = base + (size_t)qpos * NPROJ + PC_QC + head * 64 + 8 * h;
#pragma unroll
                      for (int s2 = 0; s2 < 4; ++s2) qf[s2] = *(const bf16x8*)(qp + 16 * s2); }
#pragma unroll
                    for (int i = 0; i < 5; ++i) {
                        const int task = tl + 256 * i;
                        if (task < 1152) { const int kp = task % 144, dc = task / 144;
                            LAS unsigned* o = Vt32 + (8 * dc) * (VTSS / 2) + kp;
                            o[0 * (VTSS / 2)] = (va[i].x & 0xffffu) | (vb[i].x << 16); o[1 * (VTSS / 2)] = (va[i].x >> 16) | (vb[i].x & 0xffff0000u);
                            o[2 * (VTSS / 2)] = (va[i].y & 0xffffu) | (vb[i].y << 16); o[3 * (VTSS / 2)] = (va[i].y >> 16) | (vb[i].y & 0xffff0000u);
                            o[4 * (VTSS / 2)] = (va[i].z & 0xffffu) | (vb[i].z << 16); o[5 * (VTSS / 2)] = (va[i].z >> 16) | (vb[i].z & 0xffff0000u);
                            o[6 * (VTSS / 2)] = (va[i].w & 0xffffu) | (vb[i].w << 16); o[7 * (VTSS / 2)] = (va[i].w >> 16) | (vb[i].w & 0xffff0000u); }
                    }
#pragma unroll
                    for (int i = 0; i < 9; ++i) { const int id = tl + 256 * i, j = id >> 3, c8 = id & 7; *(LAS u32x4*)(Ks + j * KSTR + 8 * c8) = kc[i]; }
                } else {
                    const LAS bf16_t* vt = Vt + r * VTSS + 4 * h;
                    const LAS bf16_t* kl = Ks + r * KSTR + 8 * h;
                    f32x16 O0, O1; float m, lsum;
                    attn_wave<9, 5, false, true>(qf, kdummy, nullptr, (size_t)NPROJ, lk0, SEQ, vt, VTSS, p.in[11][l * 8 + head], 1.f, O0, O1, m, lsum, r, h, kl, KSTR);
                    const float inv = 1.f / lsum;
                    bf16_t* o = (bf16_t*)(p.ws + WS_YC) + ((size_t)b * SEQ + qpos) * 512 + head * 64 + 4 * h;
#pragma unroll
                    for (int gg = 0; gg < 4; ++gg) {
                        u32x2 w0; w0.x = pk2(O0[4 * gg] * inv, O0[4 * gg + 1] * inv); w0.y = pk2(O0[4 * gg + 2] * inv, O0[4 * gg + 3] * inv);
                        u32x2 w1; w1.x = pk2(O1[4 * gg] * inv, O1[4 * gg + 1] * inv); w1.y = pk2(O1[4 * gg + 2] * inv, O1[4 * gg + 3] * inv);
                        *(u32x2*)(o + 8 * gg) = w0; *(u32x2*)(o + 32 + 8 * gg) = w1;
                    }
                }
            } else {
                const int u = ufirst + (it0 - ngm - nsw) * ustep;
                const int cfg = u >> 8, r8 = u & 255, b = r8 >> 6, head = (r8 >> 3) & 7, blk = (r8 & 7) * 2 + hw;
                const int dsh = 2 * cfg, dil = 1 << dsh, ls = SEQ >> dsh, nblk = ls >> 7;
                const int res = blk / nblk, l0 = (blk % nblk) * 128;
                const bf16_t* base = PROJ + ((size_t)b * SEQ + res) * NPROJ;
                const size_t kst = (size_t)dil * NPROJ;
                const int lq = l0 + 32 * w4 + r;
                const int lk0 = l0 + 32 * w4 - 64;
                if (!(kk & 1)) {
                    u32x4 va[4], vb[4], kc[8];
#pragma unroll
                    for (int i = 0; i < 4; ++i) {
                        const int task = tl + 256 * i, kp = task & 127, dc = task >> 7;
                        int lkA = l0 - 64 + 2 * kp; lkA = lkA < 0 ? 0 : (lkA > ls - 2 ? ls - 2 : lkA);
                        va[i] = *(const u32x4*)(base + (size_t)lkA * kst + PC_VD + head * 64 + 8 * dc);
                        vb[i] = *(const u32x4*)(base + (size_t)(lkA + 1) * kst + PC_VD + head * 64 + 8 * dc);
                    }
#pragma unroll
                    for (int i = 0; i < 8; ++i) {
                        const int id = tl + 256 * i, j = id >> 3, c8 = id & 7;
                        int lk = l0 - 64 + j; lk = lk < 0 ? 0 : (lk >= ls ? ls - 1 : lk);
                        kc[i] = *(const u32x4*)(base + (size_t)lk * kst + PC_KD + head * 64 + 8 * c8);
                    }
                    { const bf16_t* qp = base + (size_t)lq * kst + PC_QD + head * 64 + 8 * h;
#pragma unroll
                      for (int s2 = 0; s2 < 4; ++s2) qf[s2] = *(const bf16x8*)(qp + 16 * s2); }
#pragma unroll
                    for (int i = 0; i < 4; ++i) {
                        const int task = tl + 256 * i, kp = task & 127, dc = task >> 7;
                        LAS unsigned* o = Vt32 + (8 * dc) * (VTS / 2) + kp;
                        o[0 * (VTS / 2)] = (va[i].x & 0xffffu) | (vb[i].x << 16); o[1 * (VTS / 2)] = (va[i].x >> 16) | (vb[i].x & 0xffff0000u);
                        o[2 * (VTS / 2)] = (va[i].y & 0xffffu) | (vb[i].y << 16); o[3 * (VTS / 2)] = (va[i].y >> 16) | (vb[i].y & 0xffff0000u);
                        o[4 * (VTS / 2)] = (va[i].z & 0xffffu) | (vb[i].z << 16); o[5 * (VTS / 2)] = (va[i].z >> 16) | (vb[i].z & 0xffff0000u);
                        o[6 * (VTS / 2)] = (va[i].w & 0xffffu) | (vb[i].w << 16); o[7 * (VTS / 2)] = (va[i].w >> 16) | (vb[i].w & 0xffff0000u);
                    }
#pragma unroll
                    for (int i = 0; i < 8; ++i) { const int id = tl + 256 * i, j = id >> 3, c8 = id & 7; *(LAS u32x4*)(Ks + j * KSTR + 8 * c8) = kc[i]; }
                } else {
                    const LAS bf16_t* vt = Vt + r * VTS + 32 * w4 + 4 * h;
                    const LAS bf16_t* kl = Ks + (32 * w4 + r) * KSTR + 8 * h;
                    f32x16 O0, O1; float m, lsm;
                    attn_wave<5, 5, false, true>(qf, kdummy, nullptr, kst, lk0, ls, vt, VTS, -1e30f, 0.f, O0, O1, m, lsm, r, h, kl, KSTR);
                    const float inv = 1.f / lsm;
                    const size_t tq = (size_t)b * SEQ + (size_t)lq * dil + res;
                    bf16_t* o = (bf16_t*)(p.ws + WS_YD) + ((size_t)cfg * NT + tq) * 512 + head * 64 + 4 * h;
#pragma unroll
                    for (int g = 0; g < 4; ++g) {
                        u32x2 w0; w0.x = pk2(O0[4 * g] * inv, O0[4 * g + 1] * inv); w0.y = pk2(O0[4 * g + 2] * inv, O0[4 * g + 3] * inv);
                        u32x2 w1; w1.x = pk2(O1[4 * g] * inv, O1[4 * g + 1] * inv); w1.y = pk2(O1[4 * g + 2] * inv, O1[4 * g + 3] * inv);
                        *(u32x2*)(o + 8 * g) = w0; *(u32x2*)(o + 32 + 8 * g) = w1;
                    }
                    if (h == 0) ((float*)(p.ws + WS_LSE))[((size_t)cfg * NT + tq) * 8 + head] = m + __logf(lsm);
                }
            }
        }
        __syncthreads();
    }
}

__device__ __forceinline__ void ph_swa_mfma(const Params& p, int l, LAS unsigned char* lds) {
    const int tid = opaque_tid(), lane = tid & 63, wv = tid >> 6, g = wv >> 1, ph = wv & 1, r = lane & 31, h = lane >> 5;
    constexpr int VTS = 324;
    LAS bf16_t* Vt = (LAS bf16_t*)lds;
    LAS unsigned* Vt32 = (LAS unsigned*)lds;
    const bf16_t* PROJ = (const bf16_t*)(p.ws + WS_PROJ);
    for (int u = blockIdx.x; u < 256; u += gridDim.x) {
        const int b = u >> 6, kvh = (u >> 5) & 1, q0 = (u & 31) * 64;
        const bf16_t* base = PROJ + (size_t)b * SEQ * NPROJ;
        u32x4 va[3], vb[3];
#pragma unroll
        for (int i = 0; i < 3; ++i) {
            const int task = tid + 512 * i;
            if (task < 1280) {
                const int kp = task % 160, dc = task / 160;
                int kA = q0 - 128 + 2 * kp; kA = kA < 0 ? 0 : (kA > SEQ - 2 ? SEQ - 2 : kA);
                va[i] = *(const u32x4*)(base + (size_t)kA * NPROJ + PC_VC + kvh * 64 + 8 * dc);
                vb[i] = *(const u32x4*)(base + (size_t)(kA + 1) * NPROJ + PC_VC + kvh * 64 + 8 * dc);
            }
        }
        const int head = kvh * 4 + g;
        const int qpos = q0 + 32 * ph + r;
        const int lk0 = q0 + 32 * ph - 128;
        const bf16_t* kb = base + PC_KC + kvh * 64 + 8 * h;
        bf16x8 qf[4], kf0[5][4];
        attn_prefetch<5>(base + (size_t)qpos * NPROJ + PC_QC + head * 64 + 8 * h, kb, (size_t)NPROJ, lk0, SEQ, r, qf, kf0);
#pragma unroll
        for (int i = 0; i < 3; ++i) {
            const int task = tid + 512 * i;
            if (task < 1280) {
                const int kp = task % 160, dc = task / 160;
                LAS unsigned* o = Vt32 + (8 * dc) * (VTS / 2) + kp;
                o[0 * (VTS / 2)] = (va[i].x & 0xffffu) | (vb[i].x << 16); o[1 * (VTS / 2)] = (va[i].x >> 16) | (vb[i].x & 0xffff0000u);
                o[2 * (VTS / 2)] = (va[i].y & 0xffffu) | (vb[i].y << 16); o[3 * (VTS / 2)] = (va[i].y >> 16) | (vb[i].y & 0xffff0000u);
                o[4 * (VTS / 2)] = (va[i].z & 0xffffu) | (vb[i].z << 16); o[5 * (VTS / 2)] = (va[i].z >> 16) | (vb[i].z & 0xffff0000u);
                o[6 * (VTS / 2)] = (va[i].w & 0xffffu) | (vb[i].w << 16); o[7 * (VTS / 2)] = (va[i].w >> 16) | (vb[i].w & 0xffff0000u);
            }
        }
        {
            const LAS bf16_t* vt = Vt + r * VTS + 32 * ph + 4 * h;
            f32x16 O0, O1; float m, lsum;
            attn_wave<9, 5>(qf, kf0, kb, (size_t)NPROJ, lk0, SEQ, vt, VTS, p.in[11][l * 8 + head], 1.f, O0, O1, m, lsum, r, h);
            const float inv = 1.f / lsum;
            bf16_t* o = (bf16_t*)(p.ws + WS_YC) + ((size_t)b * SEQ + qpos) * 512 + head * 64 + 4 * h;
#pragma unroll
            for (int gg = 0; gg < 4; ++gg) {
                u32x2 w0; w0.x = pk2(O0[4 * gg] * inv, O0[4 * gg + 1] * inv); w0.y = pk2(O0[4 * gg + 2] * inv, O0[4 * gg + 3] * inv);
                u32x2 w1; w1.x = pk2(O1[4 * gg] * inv, O1[4 * gg + 1] * inv); w1.y = pk2(O1[4 * gg + 2] * inv, O1[4 * gg + 3] * inv);
                *(u32x2*)(o + 8 * gg) = w0; *(u32x2*)(o + 32 + 8 * gg) = w1;
            }
        }
        __syncthreads();
    }
}

__device__ __forceinline__ void ph_gmlp_mfma(const Params& p, int l, LAS unsigned char* lds) {
    const int tid = opaque_tid(), lane = tid & 63, wv = tid >> 6, hh = wv >> 1, ph = wv & 1, r = lane & 31, h = lane >> 5;
    constexpr int VTS = 136;
    LAS bf16_t* Vt = (LAS bf16_t*)lds;
    LAS unsigned* Vt32 = (LAS unsigned*)lds;
    LAS float* rv = (LAS float*)(lds + 256 * VTS * 2);
    const bf16_t* PROJ = (const bf16_t*)(p.ws + WS_PROJ); bf16_t* YB = (bf16_t*)(p.ws + WS_YB);
    const bf16_t* SW = (const bf16_t*)(p.ws + WS_SGUW) + (size_t)l * 8 * 128 * 128;
    const float* sn = p.in[8] + (size_t)l * 512;
    for (int u = blockIdx.x; u < 128; u += gridDim.x) {
        const int hg = u & 1, t0 = (u >> 1) * 128;
        { u32x4 w[16]; float ss[16];
#pragma unroll
          for (int q = 0; q < 16; ++q) w[q] = *(const u32x4*)(PROJ + (size_t)(t0 + wv * 16 + q) * NPROJ + PC_V + 8 * lane);
#pragma unroll
          for (int q = 0; q < 16; ++q) ss[q] = bflo(w[q].x) * bflo(w[q].x) + bfhi(w[q].x) * bfhi(w[q].x) + bflo(w[q].y) * bflo(w[q].y) + bfhi(w[q].y) * bfhi(w[q].y) + bflo(w[q].z) * bflo(w[q].z) + bfhi(w[q].z) * bfhi(w[q].z) + bflo(w[q].w) * bflo(w[q].w) + bfhi(w[q].w) * bfhi(w[q].w);
#pragma unroll
          for (int o = 1; o < 64; o <<= 1)
#pragma unroll
              for (int q = 0; q < 16; ++q) ss[q] += __shfl_xor(ss[q], o);
          float mine = 0.f;
#pragma unroll
          for (int q = 0; q < 16; ++q) mine = (lane == q) ? ss[q] : mine;
          if (lane < 16) rv[wv * 16 + lane] = 1.0f / sqrtf(mine * (1.f / 512.f) + EPS); }
        __syncthreads();
#pragma unroll
        for (int i = 0; i < 4; ++i) {
            const int task = tid + 512 * i, kp = task & 63, dc = task >> 6;
            const bf16_t* src = PROJ + (size_t)(t0 + 2 * kp) * NPROJ + PC_V + hg * 256 + 8 * dc;
            const u32x4 va = *(const u32x4*)src, vb = *(const u32x4*)(src + NPROJ);
            const float ra = rv[2 * kp], rb = rv[2 * kp + 1];
            const f32x4 g0 = *(const f32x4*)(sn + hg * 256 + 8 * dc), g1 = *(const f32x4*)(sn + hg * 256 + 8 * dc + 4);
            LAS unsigned* o = Vt32 + (8 * dc) * (VTS / 2) + kp;
            o[0 * (VTS / 2)] = pk2(bflo(va.x) * ra * g0[0], bflo(vb.x) * rb * g0[0]); o[1 * (VTS / 2)] = pk2(bfhi(va.x) * ra * g0[1], bfhi(vb.x) * rb * g0[1]);
            o[2 * (VTS / 2)] = pk2(bflo(va.y) * ra * g0[2], bflo(vb.y) * rb * g0[2]); o[3 * (VTS / 2)] = pk2(bfhi(va.y) * ra * g0[3], bfhi(vb.y) * rb * g0[3]);
            o[4 * (VTS / 2)] = pk2(bflo(va.z) * ra * g1[0], bflo(vb.z) * rb * g1[0]); o[5 * (VTS / 2)] = pk2(bfhi(va.z) * ra * g1[1], bfhi(vb.z) * rb * g1[1]);
            o[6 * (VTS / 2)] = pk2(bflo(va.w) * ra * g1[2], bflo(vb.w) * rb * g1[2]); o[7 * (VTS / 2)] = pk2(bfhi(va.w) * ra * g1[3], bfhi(vb.w) * rb * g1[3]);
        }
        __syncthreads();
        {
            const int habs = hg * 4 + hh;
            f32x16 acc[2][2];
#pragma unroll
            for (int ct = 0; ct < 2; ++ct)
#pragma unroll
                for (int pt = 0; pt < 2; ++pt)
#pragma unroll
                    for (int q = 0; q < 16; ++q) acc[ct][pt][q] = 0.f;
            const bf16_t* wp = SW + ((size_t)habs * 128 + 64 * ph + r) * 128 + 8 * h;
            const LAS bf16_t* ap = Vt + (hh * 64 + r) * VTS + 8 * h;
#pragma unroll
            for (int s = 0; s < 8; ++s) {
                bf16x8 bfr[2], afr[2];
#pragma unroll
                for (int pt = 0; pt < 2; ++pt) bfr[pt] = *(const bf16x8*)(wp + (size_t)pt * 32 * 128 + 16 * s);
#pragma unroll
                for (int ct = 0; ct < 2; ++ct) afr[ct] = *(const LAS bf16x8*)(ap + ct * 32 * VTS + 16 * s);
#pragma unroll
                for (int ct = 0; ct < 2; ++ct)
#pragma unroll
                    for (int pt = 0; pt < 2; ++pt) acc[ct][pt] = __builtin_amdgcn_mfma_f32_32x32x16_bf16(afr[ct], bfr[pt], acc[ct][pt], 0, 0, 0);
            }
#pragma unroll
            for (int pt = 0; pt < 2; ++pt) {
                const int pp = 64 * ph + 32 * pt + r;
                const float bias = p.in[10][((size_t)l * 8 + habs) * 128 + pp];
                const bf16_t* us = PROJ + (size_t)(t0 + pp) * NPROJ + PC_U + habs * 64 + 4 * h;
                bf16_t* o = YB + (size_t)(t0 + pp) * 512 + habs * 64 + 4 * h;
#pragma unroll
                for (int ct = 0; ct < 2; ++ct)
#pragma unroll
                    for (int gg = 0; gg < 4; ++gg) {
                        const u32x2 uw = *(const u32x2*)(us + 32 * ct + 8 * gg);
                        u32x2 w; w.x = pk2(bflo(uw.x) * (acc[ct][pt][4 * gg] + bias), bfhi(uw.x) * (acc[ct][pt][4 * gg + 1] + bias));
                        w.y = pk2(bflo(uw.y) * (acc[ct][pt][4 * gg + 2] + bias), bfhi(uw.y) * (acc[ct][pt][4 * gg + 3] + bias));
                        *(u32x2*)(o + 32 * ct + 8 * gg) = w;
                    }
            }
        }
        __syncthreads();
    }
}

__device__ __forceinline__ void ph_merge(const Params& p, int l, LAS unsigned char* lds) {
    const int tid = opaque_tid(), lane = tid & 63, wv = tid >> 6, r = lane & 31, h2 = lane >> 5;
    LAS float* ssA = (LAS float*)lds;
    const bf16_t* UV = (const bf16_t*)(p.ws + WS_YA); const bf16_t* YB = (const bf16_t*)(p.ws + WS_YB); const bf16_t* YC = (const bf16_t*)(p.ws + WS_YC); const bf16_t* YD = (const bf16_t*)(p.ws + WS_YD);
    const float* LSE = (const float*)(p.ws + WS_LSE); bf16_t* YN = (bf16_t*)(p.ws + WS_YN);
    const bf16_t* ABT = (const bf16_t*)(p.ws + WS_ABT) + ((size_t)l * 8 + wv) * 64 * 128;
    for (int blk = blockIdx.x; blk < NT / 32; blk += gridDim.x) {
        const int t0 = blk * 32, b = t0 >> 11, s0 = t0 & 2047;
        f32x16 O0, O1;
        {
#pragma unroll
            for (int q = 0; q < 16; ++q) { O0[q] = 0.f; O1[q] = 0.f; }
            const size_t row = ((size_t)b * 4096 + 2 * (s0 + r)) * 512 + wv * 64 + 8 * h2;
            u32x4 u0[8], u1[8];
#pragma unroll
            for (int s = 0; s < 8; ++s) { const size_t o = row + (s >> 2) * 512 + 16 * (s & 3); u0[s] = *(const u32x4*)(UV + o); u1[s] = *(const u32x4*)(UV + (size_t)4 * 4096 * 512 + o); }
            bf16x8 af0[8], af1[8];
#pragma unroll
            for (int s = 0; s < 8; ++s) { af0[s] = *(const bf16x8*)(ABT + (size_t)r * 128 + 16 * s + 8 * h2); af1[s] = *(const bf16x8*)(ABT + (size_t)(32 + r) * 128 + 16 * s + 8 * h2); }
#pragma unroll
            for (int s = 0; s < 8; ++s) {
                const bf16x8 bfr = pack8(bflo(u0[s].x) + bflo(u1[s].x), bfhi(u0[s].x) + bfhi(u1[s].x), bflo(u0[s].y) + bflo(u1[s].y), bfhi(u0[s].y) + bfhi(u1[s].y),
                                         bflo(u0[s].z) + bflo(u1[s].z), bfhi(u0[s].z) + bfhi(u1[s].z), bflo(u0[s].w) + bflo(u1[s].w), bfhi(u0[s].w) + bfhi(u1[s].w));
                O0 = __builtin_amdgcn_mfma_f32_32x32x16_bf16(af0[s], bfr, O0, 0, 0, 0);
                O1 = __builtin_amdgcn_mfma_f32_32x32x16_bf16(af1[s], bfr, O1, 0, 0, 0);
            }
            float ss = 0.f;
#pragma unroll
            for (int q = 0; q < 16; ++q) ss += O0[q] * O0[q] + O1[q] * O1[q];
            ss += __shfl_xor(ss, 32);
            if (h2 == 0) ssA[wv * 32 + r] = ss;
        }
#pragma unroll 1
        for (int i = 0; i < 4; ++i) {
            const int t = t0 + 4 * wv + i;
            float y[3][8];
            { const u32x4 w = *(const u32x4*)(YB + (size_t)t * 512 + 8 * lane);
                y[0][0] = bflo(w.x); y[0][1] = bfhi(w.x); y[0][2] = bflo(w.y); y[0][3] = bfhi(w.y); y[0][4] = bflo(w.z); y[0][5] = bfhi(w.z); y[0][6] = bflo(w.w); y[0][7] = bfhi(w.w); }
            { const u32x4 w = *(const u32x4*)(YC + (size_t)t * 512 + 8 * lane);
                y[1][0] = bflo(w.x); y[1][1] = bfhi(w.x); y[1][2] = bflo(w.y); y[1][3] = bfhi(w.y); y[1][4] = bflo(w.z); y[1][5] = bfhi(w.z); y[1][6] = bflo(w.w); y[1][7] = bfhi(w.w); }
            { const int head = lane >> 3;
              const float l0 = LSE[(size_t)t * 8 + head], l1 = LSE[((size_t)NT + t) * 8 + head], l2 = LSE[((size_t)2 * NT + t) * 8 + head];
              const float mx = fmaxf(l0, fmaxf(l1, l2)); float w0 = __expf(l0 - mx), w1 = __expf(l1 - mx), w2 = __expf(l2 - mx); const float iv = 1.f / (w0 + w1 + w2); w0 *= iv; w1 *= iv; w2 *= iv;
              const u32x4 a = *(const u32x4*)(YD + (size_t)t * 512 + 8 * lane), bq = *(const u32x4*)(YD + ((size_t)NT + t) * 512 + 8 * lane), c = *(const u32x4*)(YD + ((size_t)2 * NT + t) * 512 + 8 * lane);
              y[2][0] = w0 * bflo(a.x) + w1 * bflo(bq.x) + w2 * bflo(c.x); y[2][1] = w0 * bfhi(a.x) + w1 * bfhi(bq.x) + w2 * bfhi(c.x);
              y[2][2] = w0 * bflo(a.y) + w1 * bflo(bq.y) + w2 * bflo(c.y); y[2][3] = w0 * bfhi(a.y) + w1 * bfhi(bq.y) + w2 * bfhi(c.y);
              y[2][4] = w0 * bflo(a.z) + w1 * bflo(bq.z) + w2 * bflo(c.z); y[2][5] = w0 * bfhi(a.z) + w1 * bfhi(bq.z) + w2 * bfhi(c.z);
              y[2][6] = w0 * bflo(a.w) + w1 * bflo(bq.w) + w2 * bflo(c.w); y[2][7] = w0 * bfhi(a.w) + w1 * bfhi(bq.w) + w2 * bfhi(c.w); }
#pragma unroll
            for (int g = 0; g < 3; ++g) {
                float ss = 0.f;
#pragma unroll
                for (int q = 0; q < 8; ++q) ss += y[g][q] * y[g][q];
                const float rr = 1.0f / sqrtf(wave_sum(ss) * (1.f / 512.f) + EPS);
                u32x4 w; w.x = pk2(y[g][0] * rr, y[g][1] * rr); w.y = pk2(y[g][2] * rr, y[g][3] * rr); w.z = pk2(y[g][4] * rr, y[g][5] * rr); w.w = pk2(y[g][6] * rr, y[g][7] * rr);
                *(u32x4*)(YN + (size_t)t * DM + (g + 1) * 512 + 8 * lane) = w;
            }
        }
        __syncthreads();
        {
            float tot = 0.f;
#pragma unroll
            for (int w = 0; w < 8; ++w) tot += ssA[w * 32 + r];
            const float rr = 1.0f / sqrtf(tot * (1.f / 512.f) + EPS);
            bf16_t* o = YN + (size_t)(t0 + r) * DM + wv * 64 + 4 * h2;
#pragma unroll
            for (int g = 0; g < 4; ++g) {
                u32x2 w0; w0.x = pk2(O0[4 * g] * rr, O0[4 * g + 1] * rr); w0.y = pk2(O0[4 * g + 2] * rr, O0[4 * g + 3] * rr);
                u32x2 w1; w1.x = pk2(O1[4 * g] * rr, O1[4 * g + 1] * rr); w1.y = pk2(O1[4 * g + 2] * rr, O1[4 * g + 3] * rr);
                *(u32x2*)(o + 8 * g) = w0; *(u32x2*)(o + 32 + 8 * g) = w1;
            }
        }
        __syncthreads();
    }
}

#ifndef PHASE_MASK
#define PHASE_MASK 0xFFFFFFu
#endif
#define EN(k) (((PHASE_MASK) >> (k)) & 1u)
#ifndef REP_MASK
#define REP_MASK 0u
#endif
#define REP(k) _Pragma("unroll") for (int rep_ = 0; rep_ < 1 + (int)(((REP_MASK) >> (k)) & 1u); ++rep_)
constexpr int MIX_GW = 128, MIX_A = 4400;
constexpr int NPHASE = 22;
__global__ void __launch_bounds__(512, 2) mk_fwd(Params p) {
    extern __shared__ __attribute__((aligned(16))) unsigned char lds_raw[];
    LAS unsigned char* lds = (LAS unsigned char*)lds_raw;
    const int tid = threadIdx.x, G = gridDim.x, bx = blockIdx.x;
    volatile LAS unsigned* misc = (volatile LAS unsigned*)(lds + MISC_OFF);
    if (tid < 16) misc[tid] = 0u;
    __syncthreads();
    const int lo = p.ph_lo, hi = p.ph_hi;
    XcdBarrier bar; bar.bar = (unsigned*)(p.ws + WS_CTL); bar.x = 0; bar.st = misc + 8;
    if (hi - lo > 1) bar = xcd_barrier_post((unsigned*)(p.ws + WS_CTL), misc + 8);
#define IN(k) (lo <= (k) && (k) < hi)
#define SEAM(k) do { if (IN(k) && IN((k) + 1)) xcd_barrier(bar); } while (0)
    if (IN(0)) { if (EN(0)) REP(0) ph_mod(p, lds); if (EN(1)) REP(1) ph_tables(p); if (EN(2)) REP(2) ph_weights(p, lds, 0, G == 256 ? 240 : 6880, bx, G); }
    SEAM(0);
    for (int l = 0; l < 2; ++l) {
        const int pb = 1 + 10 * l;
        const char* H = (const char*)(p.ws + WS_H);
        if (EN(3) && IN(pb + 0)) REP(3) { ph_norm1(p, l); }
        SEAM(pb + 0);
        if (EN(4) && IN(pb + 1)) REP(4) {
            SchedProj S{H, (const char*)(p.ws + WS_WIN) + (size_t)l * NPROJ * 2048 * 2, (const char*)(p.ws + WS_WPQ) + (size_t)l * 512 * 2048 * 2, G, bx};
            EpiProj E{(bf16_t*)(p.ws + WS_PROJ), (bf16_t*)(p.ws + WS_PQT), (const float*)(p.ws + WS_ROPE), (const float*)(p.ws + WS_ROPE) + NT * 8};
            if (l == 0 && G == 256 && EN(2)) {
                if (bx < MIX_GW) { SchedProj S2{S.H, S.WIN, S.WPQ, MIX_GW, bx}; pg8::gemm_phase<EpiProj, SchedProj>(lds, 2048, 2048, 2048, S2, E); }
                else ph_weights(p, lds, 240, 240 + MIX_A, bx - MIX_GW, G - MIX_GW);
                __syncthreads();
                ph_weights(p, lds, 240 + MIX_A, 6880, bx, G);
            } else
            pg8::gemm_phase<EpiProj, SchedProj>(lds, 2048, 2048, 2048, S, E);
        }
        SEAM(pb + 1);
        if (IN(pb + 2)) {
            if (EN(5)) REP(5) { SchedDft S{(const char*)(p.ws + WS_DFT), (const char*)(p.ws + WS_PQT), G, bx};
              EpiBf16Plain E{(bf16_t*)(p.ws + WS_YA), 512, (size_t)4 * 4096 * 512};
              pg8::gemm_phase<EpiBf16Plain, SchedDft>(lds, 2048, 2048, 1024, S, E); }
            __syncthreads();
            if (EN(8)) REP(8) ph_dilated_mfma(p, l, lds);
        }
        SEAM(pb + 2);
        if (EN(9) && IN(pb + 3)) REP(9) { ph_merge(p, l, lds); }
        SEAM(pb + 3);
        if (EN(10) && IN(pb + 4)) REP(10) {
            SchedDense S{(const char*)(p.ws + WS_YN), (const char*)(p.ws + WS_WOUT) + (size_t)l * 2048 * 2048 * 2, 32, 8, 2048, G, bx};
            EpiWout E{l == 0 ? p.in[0] : nullptr, (const bf16_t*)(p.ws + WS_X), (bf16_t*)(p.ws + WS_X2), (const float*)(p.ws + WS_MOD) + (size_t)l * 4 * 12288 + 2 * 2048};
            pg8::gemm_phase<EpiWout, SchedDense>(lds, 2048, 2048, 2048, S, E);
        }
        SEAM(pb + 4);
        if (EN(11) && IN(pb + 5)) REP(11) { ph_norm2_router_mfma(p, l, lds); }
        SEAM(pb + 5);
        if (EN(12) && IN(pb + 6)) REP(12) { ph_topk(p, lds); }
        SEAM(pb + 6);
        if (EN(14) && IN(pb + 8)) REP(14) {
            SchedMoeG S{H, (const char*)(p.ws + WS_WGU) + (size_t)l * 16 * 2048 * 2048 * 2, 2048, G, bx};
            EpiGU E{(bf16_t*)(p.ws + WS_ACT)};
            pg8::gemm_phase<EpiGU, SchedMoeG, true>(lds, 2048, 2048, 2048, S, E, (const int*)(p.ws + WS_IDX));
        }
        SEAM(pb + 8);
        if (EN(15) && IN(pb + 9)) REP(15) {
            SchedMoe S{(const char*)(p.ws + WS_ACT), (const char*)(p.ws + WS_WD) + (size_t)l * 16 * 2048 * 1024 * 2, 1024, G, bx};
            EpiDown E{(bf16_t*)(p.ws + WS_EO), (const float*)(p.ws + WS_IDX + 65536)};
            pg8::gemm_phase<EpiDown, SchedMoe>(lds, 1024, 1024, 1024, S, E);
        }
        SEAM(pb + 9);
    }
    if (EN(16) && IN(21)) REP(16) { ph_norm1(p, 2); }
#undef IN
#undef SEAM
}

extern "C" void kernel_launch(void* const* d_in, const int* in_sizes, int n_in, void* d_out, int out_size, void* d_ws, size_t ws_size, hipStream_t stream) {
    static int grid = 0;
    if (grid == 0) {
        if (n_in != 20 || out_size != NT * DM || ws_size < WS_END) { fprintf(stderr, "kernel_launch: unexpected shapes (n_in %d out %d ws %zu)\n", n_in, out_size, ws_size); grid = -1; return; }
        int dev = 0, cus = 0, per_cu = 0;
        if (hipGetDevice(&dev) != hipSuccess || hipDeviceGetAttribute(&cus, hipDeviceAttributeMultiprocessorCount, dev) != hipSuccess) { grid = -1; return; }
        if (hipFuncSetAttribute((const void*)mk_fwd, hipFuncAttributeMaxDynamicSharedMemorySize, LDS_BYTES) != hipSuccess) { fprintf(stderr, "kernel_launch: hipFuncSetAttribute failed\n"); grid = -1; return; }
        if (hipOccupancyMaxActiveBlocksPerMultiprocessor(&per_cu, (const void*)mk_fwd, 512, LDS_BYTES) != hipSuccess || per_cu < 1) { fprintf(stderr, "kernel_launch: occupancy query says %d\n", per_cu); }
        (void)hipGetLastError();
        grid = cus;
    }
    if (grid < 0) return;
    (void)hipMemsetAsync((char*)d_ws + WS_CTL, 0, 64 * 1024, stream);
    Params p{};
    for (int i = 0; i < 20; ++i) p.in[i] = (const float*)d_in[i];
    p.out = (float*)d_out; p.ws = (unsigned char*)d_ws;
#if defined(MK_MULTI)
    for (int ph = 0; ph < NPHASE; ++ph) { p.ph_lo = ph; p.ph_hi = ph + 1; hipLaunchKernelGGL(mk_fwd, dim3(grid), dim3(512), LDS_BYTES, stream, p); }
#else
    p.ph_lo = 0; p.ph_hi = NPHASE; hipLaunchKernelGGL(mk_fwd, dim3(grid), dim3(512), LDS_BYTES, stream, p);
#endif
}
```

```cpp
#include <hip/hip_runtime.h>
#include <cstdio>
#include <cstdint>

#define LAS __attribute__((address_space(3)))
typedef unsigned short bf16_t;
typedef short bf16x8 __attribute__((ext_vector_type(8)));
typedef float f32x4 __attribute__((ext_vector_type(4)));
typedef float f32x2 __attribute__((ext_vector_type(2)));
typedef unsigned u32x4 __attribute__((ext_vector_type(4)));
typedef unsigned u32x2 __attribute__((ext_vector_type(2)));
typedef float f32x16 __attribute__((ext_vector_type(16)));

constexpr int NB = 4, SEQ = 2048, NT = NB * SEQ, DM = 2048, DIN = 3840, NPROJ = 3328, NE = 16, FF = 1024, CAP = 256;
constexpr float EPS = 1e-6f;
constexpr int PC_U = 0, PC_V = 512, PC_QC = 1024, PC_KC = 1536, PC_VC = 1664, PC_QD = 1792, PC_KD = 2304, PC_VD = 2816;

constexpr size_t MiB = (size_t)1 << 20;
constexpr size_t WS_CTL = 0;
constexpr size_t WS_MOD = 1 * MiB;
constexpr size_t WS_ROPE = WS_MOD + 512 * 1024;
constexpr size_t WS_DFT = 2 * MiB;
constexpr size_t WS_WIN = 18 * MiB;
constexpr size_t WS_WPQ = 44 * MiB;
constexpr size_t WS_WOUT = 52 * MiB;
constexpr size_t WS_WGU = 68 * MiB;
constexpr size_t WS_WD = 324 * MiB;
constexpr size_t WS_X = 452 * MiB;
constexpr size_t WS_X2 = 516 * MiB;
constexpr size_t WS_H = 580 * MiB;
constexpr size_t WS_PROJ = 612 * MiB;
constexpr size_t WS_PQT = 664 * MiB;
constexpr size_t WS_YA = 680 * MiB;
constexpr size_t WS_YB = 712 * MiB;
constexpr size_t WS_YC = 720 * MiB;
constexpr size_t WS_YD = 728 * MiB;
constexpr size_t WS_LSE = 752 * MiB;
constexpr size_t WS_YN = 753 * MiB;
constexpr size_t WS_AFF = 785 * MiB;
constexpr size_t WS_IDX = 786 * MiB;
constexpr size_t WS_XE = 787 * MiB;
constexpr size_t WS_ACT = 851 * MiB;
constexpr size_t WS_EO = 883 * MiB;
constexpr size_t WS_SGUW = 947 * MiB;
constexpr size_t WS_WRT = WS_SGUW + 512 * 1024;
constexpr size_t WS_ABT = WS_WRT + 128 * 1024;
constexpr size_t WS_VSS = WS_ABT + 256 * 1024;
constexpr size_t WS_END = 948 * MiB;

constexpr int LDS_BYTES = 163840;
constexpr int MISC_OFF = LDS_BYTES - 256;

struct Params { const float* in[20]; float* out; unsigned char* ws; int ph_lo, ph_hi; };

__device__ __forceinline__ unsigned pk2(float lo, float hi) { unsigned r; asm("v_cvt_pk_bf16_f32 %0, %1, %2" : "=v"(r) : "v"(lo), "v"(hi)); return r; }
__device__ __forceinline__ float bflo(unsigned u) { return __uint_as_float(u << 16); }
__device__ __forceinline__ float bfhi(unsigned u) { return __uint_as_float(u & 0xffff0000u); }
__device__ __forceinline__ float wave_sum(float v) {
#pragma unroll
    for (int o = 1; o < 64; o <<= 1) v += __shfl_xor(v, o);
    return v;
}
__device__ __forceinline__ float gelu_tanh(float x) { const float u = 0.7978845608f * (x + 0.044715f * x * x * x); return x * __builtin_amdgcn_rcpf(1.f + __builtin_amdgcn_exp2f(-2.885390082f * u)); }
__device__ __forceinline__ float silu_f(float x) { return x * __builtin_amdgcn_rcpf(1.f + __builtin_amdgcn_exp2f(-1.442695041f * x)); }

__device__ __forceinline__ int opaque_tid() { int t = threadIdx.x; asm volatile("" : "+v"(t)); return t; }
#define XB_TMO      128
#define XB_XCNT(j)  (256  + 64 * (j))
#define XB_XSUB(j)  (1280 + 64 * (j))
#define XB_XGEN(j)  (2304 + 64 * (j))
#define XB_TOP      3328
#define XB_TOPGEN   3392
#define XCD_BAR_WORDS 3456
#define XB_SPIN_CAP (1u << 18)
__device__ __forceinline__ unsigned xb_ld(unsigned* p)              { return __hip_atomic_load(p, __ATOMIC_RELAXED, __HIP_MEMORY_SCOPE_AGENT); }
__device__ __forceinline__ unsigned xb_add(unsigned* p, unsigned v) { return __hip_atomic_fetch_add(p, v, __ATOMIC_RELAXED, __HIP_MEMORY_SCOPE_AGENT); }
__device__ __forceinline__ unsigned xb_xcc_id() { return (unsigned)__builtin_amdgcn_s_getreg((3 << 11) | 20) & 0xFu; }
#define XB_SPIN(cond, bar) do { unsigned _sp = 0; while (cond) { __builtin_amdgcn_s_sleep(1); \
    if ((++_sp & 255u) == 0u) { if (xb_ld(&(bar)[XB_TMO])) break; if (_sp > XB_SPIN_CAP) { atomicAdd(&(bar)[XB_TMO], 1u); break; } } } } while (0)
struct XcdBarrier { unsigned* bar; unsigned x; volatile LAS unsigned* st; };
__device__ __forceinline__ XcdBarrier xcd_barrier_post(unsigned* bar, volatile LAS unsigned* st) {
    XcdBarrier b; b.bar = bar; b.x = xb_xcc_id(); b.st = st;
    if (threadIdx.x == 0) (void)xb_add(&bar[XB_XCNT(b.x)], 1u);
    return b;
}
__device__ __forceinline__ void xcd_barrier_complete(unsigned* bar, unsigned x, unsigned& nloc, unsigned& nx) {
    const unsigned G = gridDim.x * gridDim.y * gridDim.z;
    unsigned sum, cnt, mine, sp = 0u;
    for (;;) {
        sum = 0u; cnt = 0u; mine = 0u;
#pragma unroll
        for (unsigned j = 0; j < 16; ++j) { const unsigned c = xb_ld(&bar[XB_XCNT(j)]); sum += c; cnt += (c > 0u) ? 1u : 0u; mine = (j == x) ? c : mine; }
        if (sum == G) break;
        __builtin_amdgcn_s_sleep(1);
        if ((++sp & 255u) == 0u) { if (xb_ld(&bar[XB_TMO])) break; if (sp > XB_SPIN_CAP) { atomicAdd(&bar[XB_TMO], 1u); break; } }
    }
    nloc = mine > 0u ? mine : 1u; nx = cnt > 0u ? cnt : 1u;
}
__device__ __forceinline__ void xcd_barrier(const XcdBarrier& b) {
    asm volatile("s_waitcnt vmcnt(0)" ::: "memory");
    __syncthreads();
    if (threadIdx.x == 0) {
        unsigned* bar = b.bar;
        __builtin_amdgcn_s_waitcnt(0);
        unsigned nloc = b.st[0], nx = b.st[1];
        if (nloc == 0u) { xcd_barrier_complete(bar, b.x, nloc, nx); b.st[0] = nloc; b.st[1] = nx; }
        const unsigned old = xb_add(&bar[XB_XSUB(b.x)], 1u);
        const unsigned gen = old / nloc;
        if (old + 1u == (gen + 1u) * nloc) {
            __builtin_amdgcn_fence(__ATOMIC_RELEASE, "agent");
            asm volatile("s_waitcnt vmcnt(0)" ::: "memory");
            const unsigned og = xb_add(&bar[XB_TOP], 1u);
            const unsigned tg = og / nx;
            if (og + 1u == (tg + 1u) * nx) xb_add(&bar[XB_TOPGEN], 1u);
            else XB_SPIN(xb_ld(&bar[XB_TOPGEN]) == tg, bar);
            __builtin_amdgcn_fence(__ATOMIC_ACQUIRE, "agent");
            xb_add(&bar[XB_XGEN(b.x)], 1u);
            asm volatile("s_waitcnt vmcnt(0)" ::: "memory");
        } else {
            XB_SPIN(xb_ld(&bar[XB_XGEN(b.x)]) == gen, bar);
            __builtin_amdgcn_fence(__ATOMIC_ACQUIRE, "agent");
            asm volatile("s_waitcnt vmcnt(0)" ::: "memory");
        }
    }
    __syncthreads();
}

namespace pg8 {
constexpr int BM = 256, BK = 64, HALF = 128, HTB = HALF * BK * 2, STAGE_BYTES = 8 * HTB;
__host__ __device__ __forceinline__ int lds_byte(int r, int c) { const int st = (r >> 4) * 2 + (c >> 5), rr = r & 15, cc = c & 31, ob = rr * 64 + cc * 2; return st * 1024 + (ob ^ (((ob >> 9) & 1) << 5)); }
__host__ __device__ __forceinline__ void stage_rc(int b, int& R, int& C) { const int st = b / 1024, sb = b % 1024, swz = sb ^ (((sb >> 9) & 1) << 5); R = (st >> 1) * 16 + swz / 64; C = (st & 1) * 32 + (swz % 64) / 2; }
__host__ __device__ __forceinline__ int perm32(int rho) { const int n = rho >> 4, i = rho & 15; return 8 * (i >> 2) + 4 * n + (i & 3); }

struct GUnit { const char* a; const char* b; int pm, pn, z; };

__device__ __forceinline__ void dense_map(int L, int nM, int nN, int& pm, int& pn) {
    const int nwg = nM * nN;
    int wgid = L; { const int q = nwg / 8, r = nwg % 8, xcd = wgid % 8, off = wgid / 8; wgid = (xcd < r ? xcd * (q + 1) : r * (q + 1) + (xcd - r) * q) + off; }
    const int nig = 8 * nN, gid = wgid / nig, fm = gid * 8, gsz = (nM - fm) < 8 ? (nM - fm) : 8;
    pm = fm + ((wgid % nig) % gsz); pn = (wgid % nig) / gsz;
}

template <class Epi, class Sched, bool GATHER = false>
__device__ __forceinline__ void gemm_phase(LAS unsigned char* lds, const int lda, const int ldb, const int K, const Sched& S, const Epi& E, const int* gidx = nullptr) {
    int tid_ = threadIdx.x; asm volatile("" : "+v"(tid_));
    const int tid = tid_, wid = __builtin_amdgcn_readfirstlane(tid >> 6), lane = tid & 63, wr = wid >> 2, wc = wid & 3, fr = lane & 15, fq = lane >> 4;
    const int nt = K / BK;
    unsigned voffB[2]; int RA[2]; unsigned CA2[2];
#pragma unroll
    for (int i = 0; i < 2; ++i) { int R, C; stage_rc(tid * 16 + i * 8192, R, C); const int Rb = Epi::PERM ? ((R & ~31) + perm32(R & 31)) : R;
        RA[i] = R; CA2[i] = (unsigned)C * 2u; voffB[i] = (unsigned)(Rb * ldb + C) * 2u; }
    const size_t kstep = (size_t)(BK * 2);
    const size_t hstepB = (size_t)HALF * ldb * 2;
    const unsigned ldsw = (unsigned)wid * 1024u;
    const int aoff = lds_byte(wr * 64 + fr, fq * 8), boff = lds_byte(wc * 32 + fr, fq * 8);
#define PG8_AOFF(of, u) do { _Pragma("unroll") for (int hh_ = 0; hh_ < 2; ++hh_) _Pragma("unroll") for (int i_ = 0; i_ < 2; ++i_) { \
        if constexpr (GATHER) of[hh_][i_] = (unsigned)gidx[(u).pm * 256 + hh_ * 128 + RA[i_]] * (unsigned)(lda * 2) + CA2[i_]; \
        else of[hh_][i_] = (unsigned)((hh_ * HALF + RA[i_]) * lda) * 2u + CA2[i_]; } } while (0)
#define PG8_SA(b, h) (((b) * 2 + (h)) * HTB)
#define PG8_SB(b, h) ((4 + (b) * 2 + (h)) * HTB)
#define PG8_STAGE(bufoff, gbase, voff) do { _Pragma("unroll") for (int _i = 0; _i < 2; ++_i) \
        __builtin_amdgcn_global_load_lds((const unsigned*)((const char*)(gbase) + (voff)[_i]), (LAS unsigned*)(lds + (bufoff) + ldsw + _i * 8192), 16, 0, 0); } while (0)
#define PG8_LDA(dst, b, h) do { _Pragma("unroll") for (int m = 0; m < 4; ++m) _Pragma("unroll") for (int k = 0; k < 2; ++k) dst[m][k] = *(const LAS bf16x8*)(lds + PG8_SA(b, h) + aoff + m * 2048 + k * 1024); } while (0)
#define PG8_LDB(dst, b, h) do { _Pragma("unroll") for (int n = 0; n < 2; ++n) _Pragma("unroll") for (int k = 0; k < 2; ++k) dst[n][k] = *(const LAS bf16x8*)(lds + PG8_SB(b, h) + boff + n * 2048 + k * 1024); } while (0)
#define PG8_MMA(ai, bj, At, Bt) do { __builtin_amdgcn_s_setprio(1); _Pragma("unroll") for (int m = 0; m < 4; ++m) _Pragma("unroll") for (int n = 0; n < 2; ++n) _Pragma("unroll") for (int k = 0; k < 2; ++k) \
        acc[ai][bj][m][n] = __builtin_amdgcn_mfma_f32_16x16x32_bf16(Bt[n][k], At[m][k], acc[ai][bj][m][n], 0, 0, 0); __builtin_amdgcn_s_setprio(0); } while (0)
#define PG8_WAIT_V(n) asm volatile("s_waitcnt vmcnt(" #n ")" ::: "memory")
#define PG8_WAIT_L(n) asm volatile("s_waitcnt lgkmcnt(" #n ")" ::: "memory")
#define PG8_BAR __builtin_amdgcn_s_barrier()
#define PG8_SCHED __builtin_amdgcn_sched_barrier(0)
    GUnit cur, nxt; int ui = 0;
    if (!S.next(0, cur)) return;
    f32x4 acc[2][2][4][2];
#pragma unroll
    for (int a = 0; a < 2; ++a)
#pragma unroll
        for (int b = 0; b < 2; ++b)
#pragma unroll
            for (int m = 0; m < 4; ++m)
#pragma unroll
                for (int n = 0; n < 2; ++n) acc[a][b][m][n] = (f32x4){0.f, 0.f, 0.f, 0.f};
    bf16x8 At[4][2], B0[2][2], B1[2][2];
    unsigned ofc[2][2], ofn[2][2];
    PG8_AOFF(ofc, cur);
#pragma unroll
    for (int hh = 0; hh < 2; ++hh)
#pragma unroll
        for (int i = 0; i < 2; ++i) ofn[hh][i] = ofc[hh][i];
    const char* cA = cur.a; const char* cB = cur.b;
    PG8_STAGE(PG8_SB(0, 0), cB, voffB); PG8_STAGE(PG8_SB(0, 1), cB + hstepB, voffB); PG8_STAGE(PG8_SA(0, 0), cA, ofc[0]); PG8_STAGE(PG8_SA(0, 1), cA, ofc[1]);
    if (wr == 1) PG8_BAR;
    PG8_WAIT_V(2); PG8_BAR;
    PG8_STAGE(PG8_SB(1, 0), cB + kstep, voffB); PG8_STAGE(PG8_SA(1, 0), cA + kstep, ofc[0]); PG8_STAGE(PG8_SB(1, 1), cB + hstepB + kstep, voffB);
    PG8_WAIT_V(6); PG8_BAR;
    for (;;) {
        const bool has_next = S.next(ui + 1, nxt);
        const char* nA = has_next ? nxt.a : cA; const char* nB = has_next ? nxt.b : cB;
        for (int t = 0; t < nt; t += 2) {
            const bool last = (t == nt - 2);
            if constexpr (GATHER) { if (last && has_next) PG8_AOFF(ofn, nxt); }
            const char* a1 = cA + (size_t)(t + 1) * kstep;
            const char* a2 = last ? nA : cA + (size_t)(t + 2) * kstep; const char* b2 = last ? nB : cB + (size_t)(t + 2) * kstep;
            const char* a3 = a2 + kstep; const char* b3 = b2 + kstep;
            unsigned o2[2][2];
#pragma unroll
            for (int hh = 0; hh < 2; ++hh)
#pragma unroll
                for (int i = 0; i < 2; ++i) { if constexpr (GATHER) o2[hh][i] = last ? ofn[hh][i] : ofc[hh][i]; else o2[hh][i] = ofc[hh][i]; }
            PG8_LDB(B0, 0, 0); PG8_LDB(B1, 0, 1); PG8_SCHED; PG8_LDA(At, 0, 0); PG8_STAGE(PG8_SA(1, 1), a1, ofc[1]);
            PG8_WAIT_V(8); PG8_WAIT_L(0); PG8_BAR; PG8_MMA(0, 0, At, B0); PG8_MMA(0, 1, At, B1); PG8_BAR; PG8_SCHED;
            PG8_LDA(At, 0, 1); PG8_STAGE(PG8_SB(0, 0), b2, voffB); PG8_STAGE(PG8_SB(0, 1), b2 + hstepB, voffB); PG8_STAGE(PG8_SA(0, 0), a2, o2[0]);
            PG8_WAIT_V(8); PG8_WAIT_L(0); PG8_BAR; PG8_MMA(1, 0, At, B0); PG8_MMA(1, 1, At, B1); PG8_BAR; PG8_SCHED;
            PG8_LDB(B0, 1, 0); PG8_LDB(B1, 1, 1); PG8_SCHED; PG8_LDA(At, 1, 0); PG8_STAGE(PG8_SA(0, 1), a2, o2[1]);
            PG8_WAIT_V(8); PG8_WAIT_L(0); PG8_BAR; PG8_MMA(0, 0, At, B0); PG8_MMA(0, 1, At, B1); PG8_BAR; PG8_SCHED;
            PG8_LDA(At, 1, 1); PG8_STAGE(PG8_SB(1, 0), b3, voffB); PG8_STAGE(PG8_SB(1, 1), b3 + hstepB, voffB); PG8_STAGE(PG8_SA(1, 0), a3, o2[0]);
            PG8_WAIT_V(8); PG8_WAIT_L(0); PG8_BAR; PG8_MMA(1, 0, At, B0); PG8_MMA(1, 1, At, B1); PG8_BAR; PG8_SCHED;
        }
        if (wr == 0) PG8_BAR;
        E(acc, cur, wr, wc, fr, fq);
        if (!has_next) break;
#pragma unroll
        for (int a = 0; a < 2; ++a)
#pragma unroll
            for (int b = 0; b < 2; ++b)
#pragma unroll
                for (int m = 0; m < 4; ++m)
#pragma unroll
                    for (int n = 0; n < 2; ++n) acc[a][b][m][n] = (f32x4){0.f, 0.f, 0.f, 0.f};
        cur = nxt; cA = nA; cB = nB; ++ui;
        if constexpr (GATHER) {
#pragma unroll
            for (int hh = 0; hh < 2; ++hh)
#pragma unroll
                for (int i = 0; i < 2; ++i) ofc[hh][i] = ofn[hh][i];
        }
        if (wr == 1) PG8_BAR;
    }
    PG8_WAIT_V(0);
    PG8_BAR;
#undef PG8_AOFF
#undef PG8_SA
#undef PG8_SB
#undef PG8_STAGE
#undef PG8_LDA
#undef PG8_LDB
#undef PG8_MMA
#undef PG8_WAIT_V
#undef PG8_WAIT_L
#undef PG8_BAR
#undef PG8_SCHED
}
}
using pg8::GUnit;

struct SchedProj {
    const char* H; const char* WIN; const char* WPQ; int G, c;
    __device__ __forceinline__ bool next(int i, GUnit& u) const {
        const int L = i * G + c; if (L >= 480) return false;
        if (L < 416) { int pm, pn; pg8::dense_map(L, 32, 13, pm, pn); u.pm = pm; u.pn = pn; u.z = 0; u.a = H + (size_t)pm * 256 * 2048 * 2; u.b = WIN + (size_t)pn * 256 * 2048 * 2; }
        else { int pm, pn; pg8::dense_map(L - 416, 2, 32, pm, pn); u.pm = pm; u.pn = pn + 64; u.z = 0; u.a = WPQ + (size_t)pm * 256 * 2048 * 2; u.b = H + (size_t)pn * 256 * 2048 * 2; }
        return true;
    }
};
struct SchedDft {
    const char* DFT; const char* XAT; int G, c;
    __device__ __forceinline__ bool next(int i, GUnit& u) const {
        const int L = i * G + c; if (L >= 256) return false;
        const int Lp = (L & 7) * 32 + (L >> 3);
        const int ks = Lp & 1, pn = (Lp >> 1) & 1, pm = (Lp >> 2) & 15, b = Lp >> 6;
        u.pm = b * 16 + pm; u.pn = pn; u.z = ks;
        u.a = DFT + ((size_t)pm * 256 * 2048 + ks * 1024) * 2; u.b = XAT + (((size_t)b * 512 + pn * 256) * 2048 + ks * 1024) * 2;
        return true;
    }
};
struct SchedDense {
    const char* A; const char* B; int nM, nN, K, G, c;
    __device__ __forceinline__ bool next(int i, GUnit& u) const {
        const int L = i * G + c; if (L >= nM * nN) return false;
        int pm, pn; pg8::dense_map(L, nM, nN, pm, pn); u.pm = pm; u.pn = pn; u.z = 0;
        u.a = A + (size_t)pm * 256 * K * 2; u.b = B + (size_t)pn * 256 * K * 2; return true;
    }
};
struct SchedMoeG {
    const char* A; const char* B; int K, G, c;
    __device__ __forceinline__ bool next(int i, GUnit& u) const {
        const int L = i * G + c; if (L >= 512) return false;
        const int Lp = (L & 7) * 64 + (L >> 3);
        const int e = Lp >> 5, r = Lp & 31, pm = r & 3, pn = r >> 2;
        u.pm = e * 4 + pm; u.pn = pn; u.z = e;
        u.a = A; u.b = B + ((size_t)e * 2048 + pn * 256) * K * 2; return true;
    }
};
struct SchedMoe {
    const char* A; const char* B; int K, G, c;
    __device__ __forceinline__ bool next(int i, GUnit& u) const {
        const int L = i * G + c; if (L >= 512) return false;
        const int Lp = (L & 7) * 64 + (L >> 3);
        const int e = Lp >> 5, r = Lp & 31, pm = r & 3, pn = r >> 2;
        u.pm = e * 4 + pm; u.pn = pn; u.z = e;
        u.a = A + ((size_t)e * 1024 + pm * 256) * K * 2; u.b = B + ((size_t)e * 2048 + pn * 256) * K * 2; return true;
    }
};

typedef f32x4 AccT[2][2][4][2];
struct EpiProj {
    static constexpr bool PERM = true;
    bf16_t* PROJ; bf16_t* PQT; const float* ropec; const float* ropes;
    __device__ __forceinline__ void operator()(const AccT& acc, const GUnit& u, int wr, int wc, int fr, int fq) const {
        if (u.pn < 64) {
            const int pn = u.pn;
            const int row0 = u.pm * 256 + wr * 64 + fr;
#pragma unroll
            for (int ai = 0; ai < 2; ++ai)
#pragma unroll
                for (int m = 0; m < 4; ++m) {
                    const int row = row0 + ai * 128 + m * 16;
                    float vsq = 0.f;
#pragma unroll
                    for (int bj = 0; bj < 2; ++bj) {
                        f32x4 v0 = acc[ai][bj][m][0], v1 = acc[ai][bj][m][1];
                        const int colt = pn * 256 + bj * 128;
                        if (pn < 4) {
#pragma unroll
                            for (int j = 0; j < 4; ++j) { v0[j] = gelu_tanh(v0[j]); v1[j] = gelu_tanh(v1[j]); vsq += v0[j] * v0[j] + v1[j] * v1[j]; }
                        } else {
                            const bool isq = (colt >= PC_QC && colt < PC_KC) || (colt >= PC_QD && colt < PC_KD);
                            const bool isk = (colt >= PC_KC && colt < PC_VC) || (colt >= PC_KD && colt < PC_VD);
                            if (isq || isk) {
                                if ((wc & 1) == 0) {
                                    f32x4 o0, o1;
#pragma unroll
                                    for (int j = 0; j < 4; ++j) { o0[j] = __shfl_xor(v0[j], 16); o1[j] = __shfl_xor(v1[j], 16); }
                                    if (fq < 2) {
                                        const f32x4 c0 = *(const f32x4*)(ropec + (size_t)row * 8), c1 = *(const f32x4*)(ropec + (size_t)row * 8 + 4);
                                        const f32x4 s0 = *(const f32x4*)(ropes + (size_t)row * 8), s1 = *(const f32x4*)(ropes + (size_t)row * 8 + 4);
                                        const float sg = fq == 0 ? -1.f : 1.f;
#pragma unroll
                                        for (int j = 0; j < 4; ++j) { v0[j] = v0[j] * c0[j] + sg * o0[j] * s0[j]; v1[j] = v1[j] * c1[j] + sg * o1[j] * s1[j]; }
                                    }
                                }
                                if (isq) { v0 = v0 * 0.125f; v1 = v1 * 0.125f; }
                            }
                        }
                        u32x4 w; w.x = pk2(v0[0], v0[1]); w.y = pk2(v0[2], v0[3]); w.z = pk2(v1[0], v1[1]); w.w = pk2(v1[2], v1[3]);
                        *(u32x4*)(PROJ + (size_t)row * NPROJ + colt + wc * 32 + 8 * fq) = w;
                    }
                    if (pn == 2 || pn == 3) {
                        vsq += __shfl_xor(vsq, 16); vsq += __shfl_xor(vsq, 32);
                        if (fq == 0) ((float*)((char*)PROJ + (WS_VSS - WS_PROJ)))[(size_t)row * 8 + (pn - 2) * 4 + wc] = vsq;
                    }
                }
        } else {
#pragma unroll
            for (int ai = 0; ai < 2; ++ai)
#pragma unroll
                for (int m = 0; m < 4; ++m) {
                    const int c = u.pm * 256 + ai * 128 + wr * 64 + m * 16 + fr;
#pragma unroll
                    for (int bj = 0; bj < 2; ++bj) {
                        const int t = (u.pn - 64) * 256 + bj * 128 + wc * 32 + 8 * fq, b = t >> 11, s = t & 2047;
                        const f32x4 v0 = acc[ai][bj][m][0], v1 = acc[ai][bj][m][1];
                        u32x4 w; w.x = pk2(v0[0], v0[1]); w.y = pk2(v0[2], v0[3]); w.z = pk2(v1[0], v1[1]); w.w = pk2(v1[2], v1[3]);
                        *(u32x4*)(PQT + (((size_t)b * 512 + c) * 2048 + s)) = w;
                    }
                }
        }
    }
};
struct EpiBf16Plain {
    static constexpr bool PERM = true;
    bf16_t* O; int ldc; size_t zstride;
    __device__ __forceinline__ void operator()(const AccT& acc, const GUnit& u, int wr, int wc, int fr, int fq) const {
        bf16_t* base = O + (size_t)u.z * zstride;
#pragma unroll
        for (int ai = 0; ai < 2; ++ai)
#pragma unroll
            for (int m = 0; m < 4; ++m) {
                const int row = u.pm * 256 + ai * 128 + wr * 64 + m * 16 + fr;
#pragma unroll
                for (int bj = 0; bj < 2; ++bj) {
                    const f32x4 v0 = acc[ai][bj][m][0], v1 = acc[ai][bj][m][1];
                    u32x4 w; w.x = pk2(v0[0], v0[1]); w.y = pk2(v0[2], v0[3]); w.z = pk2(v1[0], v1[1]); w.w = pk2(v1[2], v1[3]);
                    *(u32x4*)(base + (size_t)row * ldc + u.pn * 256 + bj * 128 + wc * 32 + 8 * fq) = w;
                }
            }
    }
};
struct EpiWout {
    static constexpr bool PERM = true;
    const float* base32; const bf16_t* base16; bf16_t* X2; const float* gate;
    __device__ __forceinline__ void operator()(const AccT& acc, const GUnit& u, int wr, int wc, int fr, int fq) const {
        const int b = u.pm >> 3;
        const int col0 = u.pn * 256 + wc * 32 + 8 * fq;
        f32x4 g[2][2];
#pragma unroll
        for (int bj = 0; bj < 2; ++bj)
#pragma unroll
            for (int n = 0; n < 2; ++n) g[bj][n] = *(const f32x4*)(gate + (size_t)b * 12288 + col0 + bj * 128 + n * 4);
#pragma unroll
        for (int ai = 0; ai < 2; ++ai)
#pragma unroll
            for (int m = 0; m < 4; ++m) {
                const size_t ro = (size_t)(u.pm * 256 + ai * 128 + wr * 64 + m * 16 + fr) * DM + col0;
#pragma unroll
                for (int bj = 0; bj < 2; ++bj) {
                    f32x4 x0, x1;
                    if (base32) { x0 = *(const f32x4*)(base32 + ro + bj * 128); x1 = *(const f32x4*)(base32 + ro + bj * 128 + 4); }
                    else { const u32x4 w = *(const u32x4*)(base16 + ro + bj * 128); x0 = (f32x4){bflo(w.x), bfhi(w.x), bflo(w.y), bfhi(w.y)}; x1 = (f32x4){bflo(w.z), bfhi(w.z), bflo(w.w), bfhi(w.w)}; }
                    const f32x4 v0 = x0 + g[bj][0] * acc[ai][bj][m][0], v1 = x1 + g[bj][1] * acc[ai][bj][m][1];
                    u32x4 o; o.x = pk2(v0[0], v0[1]); o.y = pk2(v0[2], v0[3]); o.z = pk2(v1[0], v1[1]); o.w = pk2(v1[2], v1[3]);
                    *(u32x4*)(X2 + ro + bj * 128) = o;
                }
            }
    }
};
struct EpiGU {
    static constexpr bool PERM = true;
    bf16_t* ACT;
    __device__ __forceinline__ void operator()(const AccT& acc, const GUnit& u, int wr, int wc, int fr, int fq) const {
#pragma unroll
        for (int ai = 0; ai < 2; ++ai)
#pragma unroll
            for (int m = 0; m < 4; ++m) {
                const int row = u.pm * 256 + ai * 128 + wr * 64 + m * 16 + fr;
                f32x4 v0, v1;
#pragma unroll
                for (int j = 0; j < 4; ++j) { v0[j] = silu_f(acc[ai][0][m][0][j]) * acc[ai][1][m][0][j]; v1[j] = silu_f(acc[ai][0][m][1][j]) * acc[ai][1][m][1][j]; }
                u32x4 w; w.x = pk2(v0[0], v0[1]); w.y = pk2(v0[2], v0[3]); w.z = pk2(v1[0], v1[1]); w.w = pk2(v1[2], v1[3]);
                *(u32x4*)(ACT + (size_t)row * FF + u.pn * 128 + wc * 32 + 8 * fq) = w;
            }
    }
};
struct EpiDown {
    static constexpr bool PERM = true;
    bf16_t* EO; const float* gate;
    __device__ __forceinline__ void operator()(const AccT& acc, const GUnit& u, int wr, int wc, int fr, int fq) const {
#pragma unroll
        for (int ai = 0; ai < 2; ++ai)
#pragma unroll
            for (int m = 0; m < 4; ++m) {
                const int row = u.pm * 256 + ai * 128 + wr * 64 + m * 16 + fr;
                const float g = gate[row];
#pragma unroll
                for (int bj = 0; bj < 2; ++bj) {
                    const f32x4 v0 = acc[ai][bj][m][0] * g, v1 = acc[ai][bj][m][1] * g;
                    u32x4 w; w.x = pk2(v0[0], v0[1]); w.y = pk2(v0[2], v0[3]); w.z = pk2(v1[0], v1[1]); w.w = pk2(v1[2], v1[3]);
                    *(u32x4*)(EO + (size_t)row * DM + u.pn * 256 + bj * 128 + wc * 32 + 8 * fq) = w;
                }
            }
    }
};

__device__ __forceinline__ void ph_mod(const Params& p, LAS unsigned char* lds) {
    LAS float* sl = (LAS float*)lds;
    LAS float* red = (LAS float*)(lds + 32768);
    const int tid = opaque_tid();
    const float* c = p.in[1];
    float* mod = (float*)(p.ws + WS_MOD);
    for (int i = tid; i < 8192; i += 512) { const float v = c[i]; sl[i] = v / (1.f + expf(-v)); }
    __syncthreads();
    const int cl = tid & 31, ks = tid >> 5;
    for (int u = blockIdx.x; u < 192; u += gridDim.x) {
        const int l = u / 96, cc = u % 96;
        const float* W = p.in[3] + (size_t)l * 2048 * 12288 + cc * 128 + cl * 4;
        float acc[4][4];
#pragma unroll
        for (int b = 0; b < 4; ++b)
#pragma unroll
            for (int j = 0; j < 4; ++j) acc[b][j] = 0.f;
#pragma unroll 8
        for (int k = ks; k < 2048; k += 16) {
            const f32x4 w = __builtin_nontemporal_load((const f32x4*)(W + (size_t)k * 12288));
#pragma unroll
            for (int b = 0; b < 4; ++b) { const float s = sl[b * 2048 + k];
#pragma unroll
                for (int j = 0; j < 4; ++j) acc[b][j] += s * w[j]; }
        }
#pragma unroll
        for (int b = 0; b < 4; ++b)
#pragma unroll
            for (int j = 0; j < 4; ++j) red[((b * 4 + j) * 16 + ks) * 32 + cl] = acc[b][j];
        __syncthreads();
        { const int b = tid >> 7, col = tid & 127; float s = 0.f;
#pragma unroll
          for (int q = 0; q < 16; ++q) s += red[((b * 4 + (col & 3)) * 16 + q) * 32 + (col >> 2)];
          mod[(size_t)(l * 4 + b) * 12288 + cc * 128 + col] = s + p.in[4][(size_t)l * 12288 + cc * 128 + col]; }
        __syncthreads();
    }
}
__device__ __forceinline__ void ph_tables(const Params& p, LAS unsigned char* lds) {
    const int tid = opaque_tid();
    const int gt = blockIdx.x * 512 + tid, ngt = gridDim.x * 512;
    LAS float* ct = (LAS float*)lds;
    LAS float* c64 = ct + 2048;
    for (int m = tid; m < 2048; m += 512) ct[m] = cospif((float)m * (1.f / 1024.f));
    if (tid < 64) { c64[tid] = cospif((float)tid * (1.f / 32.f)); c64[64 + tid] = sinpif((float)tid * (1.f / 32.f)); }
    __syncthreads();
    float* rc = (float*)(p.ws + WS_ROPE); float* rs = rc + NT * 8;
    const int* pos = (const int*)p.in[2];
    for (int i = gt; i < NT * 8; i += ngt) {
        const int t = i >> 3, j = i & 7;
        float inv;
        switch (j) { case 0: inv = 1.0f; break; case 1: inv = 0.1939227432012558f; break; case 2: inv = 0.03760603070259094f; break; case 3: inv = 0.007292664609849453f; break;
                     case 4: inv = 0.0014142135623842478f; break; case 5: inv = 0.00027424818836152554f; break; case 6: inv = 5.318296098266728e-05f; break; default: inv = 1.0313386155758053e-05f; break; }
        const float ang = (float)pos[t] * inv;
        double r = (double)ang * 0.15915494309189535; r -= floor(r);
        const float a = (float)(2.0 * r);
        rc[i] = cospif(a); rs[i] = sinpif(a);
    }
    { bf16_t* sw = (bf16_t*)(p.ws + WS_SGUW);
      for (int i = gt; i < 2 * 8 * 128 * 128 / 4; i += ngt) { const f32x4 w = *(const f32x4*)(p.in[9] + (size_t)i * 4); u32x2 o; o.x = pk2(w[0], w[1]); o.y = pk2(w[2], w[3]); *(u32x2*)(sw + (size_t)i * 4) = o; } }
    { bf16_t* wrt = (bf16_t*)(p.ws + WS_WRT);
      for (int i = gt; i < 2 * 16 * 2048; i += ngt) { const int l = i >> 15, e = (i >> 11) & 15, k = i & 2047; wrt[i] = (bf16_t)(pk2(p.in[15][((size_t)l * 2048 + k) * 16 + e], 0.f) & 0xffffu); } }
    { bf16_t* abt = (bf16_t*)(p.ws + WS_ABT);
      for (int i = gt; i < 2 * 8 * 64 * 128; i += ngt) { const int k = i & 127, d = (i >> 7) & 63, lh = i >> 13, c = k & 63; const float* fw = p.in[7] + (size_t)lh * 4096;
          float sacc = 0.f;
          for (int cp = 0; cp < 64; ++cp) sacc += c64[(k < 64 ? 0 : 64) + ((c * cp) & 63)] * fw[cp * 64 + d];
          abt[i] = (bf16_t)(pk2(sacc * 0.125f, 0.f) & 0xffffu); } }
    bf16_t* dft = (bf16_t*)(p.ws + WS_DFT);
    for (int i = gt; i < 2048 * 512; i += ngt) {
        const int sp = i >> 9, k8 = (i & 511) * 8;
        float v[8];
#pragma unroll
        for (int e = 0; e < 8; ++e) { const int k = k8 + e, part = k >> 11, s = k & 2047, m = (s * sp + part * 512) & 2047;
            v[e] = ct[m] * 0.022097086912079608f; }
        u32x4 w; w.x = pk2(v[0], v[1]); w.y = pk2(v[2], v[3]); w.z = pk2(v[4], v[5]); w.w = pk2(v[6], v[7]);
        *(u32x4*)(dft + (size_t)sp * 4096 + k8) = w;
    }
    __syncthreads();
}
struct TDesc { const float* src; bf16_t* dst; const float* ksc; int lds_, ldd; };
__device__ __forceinline__ bool tdecode(const Params& p, int it, TDesc& d) {
    if (it >= 2 * 6880) return false;
    const int l = it / 6880; int r = it % 6880;
    d.ksc = nullptr;
    if (r < 480) { const int kt = r / 30, nt = r % 30;
        d.src = p.in[6] + ((size_t)l * 2048 + kt * 128) * DIN + nt * 128; d.lds_ = DIN;
        d.dst = (nt < 4 ? (bf16_t*)(p.ws + WS_WPQ) + ((size_t)l * 512 + nt * 128) * 2048 : (bf16_t*)(p.ws + WS_WIN) + ((size_t)l * NPROJ + (nt - 4) * 128) * 2048) + kt * 128; d.ldd = 2048; return true; }
    r -= 480;
    if (r < 256) { const int kt = r / 16, nt = r % 16;
        d.src = p.in[13] + ((size_t)l * 2048 + kt * 128) * 2048 + nt * 128; d.lds_ = 2048; d.ksc = p.in[12] + (size_t)l * 2048 + kt * 128;
        d.dst = (bf16_t*)(p.ws + WS_WOUT) + ((size_t)l * 2048 + nt * 128) * 2048 + kt * 128; d.ldd = 2048; return true; }
    r -= 256;
    if (r < 4096) { const int isup = r / 2048, r2 = r % 2048, e = r2 / 128, kt = (r2 % 128) / 8, nt = r2 % 8;
        d.src = p.in[isup ? 17 : 16] + (((size_t)l * 16 + e) * 2048 + kt * 128) * 1024 + nt * 128; d.lds_ = 1024;
        d.dst = (bf16_t*)(p.ws + WS_WGU) + (((size_t)l * 16 + e) * 2048 + nt * 256 + isup * 128) * 2048 + kt * 128; d.ldd = 2048; return true; }
    r -= 4096;
    { const int e = r / 128, kt = (r % 128) / 16, nt = r % 16;
        d.src = p.in[18] + (((size_t)l * 16 + e) * 1024 + kt * 128) * 2048 + nt * 128; d.lds_ = 2048;
        d.dst = (bf16_t*)(p.ws + WS_WD) + (((size_t)l * 16 + e) * 2048 + nt * 128) * 1024 + kt * 128; d.ldd = 1024; return true; }
}
__device__ __forceinline__ void ph_weights(const Params& p, LAS unsigned char* lds, const int p0, const int p1, const int wi, const int wn) {
    const int tid = opaque_tid();
    LAS unsigned* l32 = (LAS unsigned*)lds;
    LAS bf16_t* l16 = (LAS bf16_t*)lds;
    TDesc dA0, dA1, dB0, dB1; f32x4 a0[8], a1[8], b0[8], b1[8];
#define PW_LOAD(pi, D0, D1, V0, V1, HAVE) do { HAVE = (pi) < p1; if (HAVE) { tdecode(p, 2 * (pi), D0); tdecode(p, 2 * (pi) + 1, D1); \
        _Pragma("unroll") for (int i = 0; i < 8; ++i) { const int f = tid + 512 * i, k = f >> 5, c4 = f & 31; \
            V0[i] = __builtin_nontemporal_load((const f32x4*)(D0.src + (size_t)k * D0.lds_ + c4 * 4)); V1[i] = __builtin_nontemporal_load((const f32x4*)(D1.src + (size_t)k * D1.lds_ + c4 * 4)); } } } while (0)
#define PW_TOLDS(D0, V0, V1) do { _Pragma("unroll") for (int i = 0; i < 8; ++i) { const int f = tid + 512 * i, k = f >> 5, c4 = f & 31; const float sc = D0.ksc ? D0.ksc[k] : 1.f; \
        const int sw = ((k >> 3) & 15) * 2; u32x2 w; w.x = pk2(V0[i][0] * sc, V0[i][1] * sc); w.y = pk2(V0[i][2] * sc, V0[i][3] * sc); \
        *(LAS u32x2*)(l32 + k * 64 + ((2 * c4) ^ sw)) = w; \
        u32x2 w2; w2.x = pk2(V1[i][0] * sc, V1[i][1] * sc); w2.y = pk2(V1[i][2] * sc, V1[i][3] * sc); \
        *(LAS u32x2*)(l32 + 8192 + k * 64 + ((2 * c4) ^ sw)) = w2; } } while (0)
#define PW_STORE(DS0, DS1) do { _Pragma("unroll") for (int i = 0; i < 4; ++i) { \
        const int n = (tid >> 4) + 32 * i, kc = tid & 15, cd = (n >> 1) ^ (2 * kc), hf = n & 1; \
        unsigned short e[8], g[8]; \
        _Pragma("unroll") for (int q = 0; q < 8; ++q) { e[q] = l16[((8 * kc + q) * 64 + cd) * 2 + hf]; g[q] = l16[16384 + ((8 * kc + q) * 64 + cd) * 2 + hf]; } \
        u32x4 w; w.x = e[0] | ((unsigned)e[1] << 16); w.y = e[2] | ((unsigned)e[3] << 16); w.z = e[4] | ((unsigned)e[5] << 16); w.w = e[6] | ((unsigned)e[7] << 16); \
        __builtin_nontemporal_store(w, (u32x4*)(DS0.dst + (size_t)n * DS0.ldd + 8 * kc)); \
        u32x4 w2; w2.x = g[0] | ((unsigned)g[1] << 16); w2.y = g[2] | ((unsigned)g[3] << 16); w2.z = g[4] | ((unsigned)g[5] << 16); w2.w = g[6] | ((unsigned)g[7] << 16); \
        __builtin_nontemporal_store(w2, (u32x4*)(DS1.dst + (size_t)n * DS1.ldd + 8 * kc)); } } while (0)
    int pi = p0 + wi; bool hA, hB;
    PW_LOAD(pi, dA0, dA1, a0, a1, hA);
    PW_LOAD(pi + wn, dB0, dB1, b0, b1, hB);
    while (hA) {
        { PW_TOLDS(dA0, a0, a1); __syncthreads(); const TDesc s0 = dA0, s1 = dA1; PW_LOAD(pi + 2 * wn, dA0, dA1, a0, a1, hA); PW_STORE(s0, s1); __syncthreads(); }
        if (!hB) break;
        { PW_TOLDS(dB0, b0, b1); __syncthreads(); const TDesc s0 = dB0, s1 = dB1; PW_LOAD(pi + 3 * wn, dB0, dB1, b0, b1, hB); PW_STORE(s0, s1); __syncthreads(); }
        pi += 2 * wn;
    }
#undef PW_LOAD
#undef PW_TOLDS
#undef PW_STORE
}

__device__ __forceinline__ void ph_norm1(const Params& p, int mode) {
    const int tid = opaque_tid(), lane = tid & 63, wv = tid >> 6;
    const float* mod = (const float*)(p.ws + WS_MOD);
    const int* slot_of = (const int*)(p.ws + WS_IDX + 131072);
    const bf16_t* EO = (const bf16_t*)(p.ws + WS_EO);
    for (int t = blockIdx.x * 8 + wv; t < NT; t += gridDim.x * 8) {
        const int b = t >> 11;
        f32x4 v[8];
        if (mode == 0) { const float* xr = p.in[0] + (size_t)t * DM;
#pragma unroll
            for (int j = 0; j < 8; ++j) v[j] = *(const f32x4*)(xr + 4 * lane + 256 * j);
        } else { const bf16_t* xr = (const bf16_t*)(p.ws + WS_X2) + (size_t)t * DM;
#pragma unroll
            for (int j = 0; j < 8; ++j) { const u32x2 w = *(const u32x2*)(xr + 4 * lane + 256 * j); v[j] = (f32x4){bflo(w.x), bfhi(w.x), bflo(w.y), bfhi(w.y)}; }
        }
        if (mode != 0) {
            f32x4 macc[8];
#pragma unroll
            for (int j = 0; j < 8; ++j) macc[j] = (f32x4){0.f, 0.f, 0.f, 0.f};
            const int myslot = slot_of[(size_t)(lane & 15) * NT + t];
            unsigned m = (unsigned)(__ballot(myslot >= 0) & 0xffffull);
            while (m) {
                const int e0 = __builtin_ctz(m); m &= m - 1u;
                const bool two = m != 0u; const int e1 = two ? __builtin_ctz(m) : e0; if (two) m &= m - 1u;
                const int s0 = __builtin_amdgcn_readlane(myslot, e0), s1 = __builtin_amdgcn_readlane(myslot, e1);
                const float w1 = two ? 1.f : 0.f;
                const bf16_t* r0 = EO + (size_t)s0 * DM; const bf16_t* r1 = EO + (size_t)s1 * DM;
                u32x2 a[8], c[8];
#pragma unroll
                for (int j = 0; j < 8; ++j) { a[j] = *(const u32x2*)(r0 + 4 * lane + 256 * j); c[j] = *(const u32x2*)(r1 + 4 * lane + 256 * j); }
#pragma unroll
                for (int j = 0; j < 8; ++j) {
                    macc[j][0] += bflo(a[j].x) + w1 * bflo(c[j].x); macc[j][1] += bfhi(a[j].x) + w1 * bfhi(c[j].x);
                    macc[j][2] += bflo(a[j].y) + w1 * bflo(c[j].y); macc[j][3] += bfhi(a[j].y) + w1 * bfhi(c[j].y); }
            }
            const float* gf = mod + ((size_t)(mode - 1) * 4 + b) * 12288 + 5 * 2048;
#pragma unroll
            for (int j = 0; j < 8; ++j) { const f32x4 g = *(const f32x4*)(gf + 4 * lane + 256 * j); v[j] = v[j] + g * macc[j]; }
            if (mode == 1) {
                bf16_t* xo = (bf16_t*)(p.ws + WS_X) + (size_t)t * DM;
#pragma unroll
                for (int j = 0; j < 8; ++j) { u32x2 w; w.x = pk2(v[j][0], v[j][1]); w.y = pk2(v[j][2], v[j][3]); *(u32x2*)(xo + 4 * lane + 256 * j) = w;
                    v[j] = (f32x4){bflo(w.x), bfhi(w.x), bflo(w.y), bfhi(w.y)}; }
            }
        }
        float ss = 0.f;
#pragma unroll
        for (int j = 0; j < 8; ++j) ss += v[j][0] * v[j][0] + v[j][1] * v[j][1] + v[j][2] * v[j][2] + v[j][3] * v[j][3];
        const float r = 1.0f / sqrtf(wave_sum(ss) * (1.f / DM) + EPS);
        if (mode == 2) {
            float* o = p.out + (size_t)t * DM;
#pragma unroll
            for (int j = 0; j < 8; ++j) { const f32x4 g = *(const f32x4*)(p.in[19] + 4 * lane + 256 * j); *(f32x4*)(o + 4 * lane + 256 * j) = v[j] * r * g; }
        } else {
            const int l = mode;
            const float* g1 = p.in[5] + (size_t)l * DM;
            const float* sh = mod + ((size_t)l * 4 + b) * 12288;
            const float* sc = sh + 2048;
            bf16_t* ho = (bf16_t*)(p.ws + WS_H) + (size_t)t * DM;
#pragma unroll
            for (int j = 0; j < 8; ++j) {
                const f32x4 g = *(const f32x4*)(g1 + 4 * lane + 256 * j), s1 = *(const f32x4*)(sc + 4 * lane + 256 * j), s0 = *(const f32x4*)(sh + 4 * lane + 256 * j);
                const f32x4 h = (v[j] * r * g) * (s1 + 1.f) + s0;
                u32x2 w; w.x = pk2(h[0], h[1]); w.y = pk2(h[2], h[3]);
                *(u32x2*)(ho + 4 * lane + 256 * j) = w;
            }
        }
    }
}


__device__ __forceinline__ void ph_norm2_router_mfma(const Params& p, int l, LAS unsigned char* lds) {
    const int tid = opaque_tid(), lane = tid & 63, wv = tid >> 6, r = lane & 31, h = lane >> 5;
    LAS float* part = (LAS float*)lds;
    LAS float* lgs = (LAS float*)(lds + 8 * 32 * 17 * 4);
    const float* mod = (const float*)(p.ws + WS_MOD);
    const float* g2 = p.in[14] + (size_t)l * DM;
    const bf16_t* WRT = (const bf16_t*)(p.ws + WS_WRT) + (size_t)l * 16 * 2048;
    bf16_t* Hb = (bf16_t*)(p.ws + WS_H);
    float* aff = (float*)(p.ws + WS_AFF);
    for (int blk = blockIdx.x; blk < NT / 32; blk += gridDim.x) {
        const int t0 = blk * 32, b = t0 >> 11;
        const float* sh = mod + ((size_t)l * 4 + b) * 12288 + 3 * 2048;
        const float* sc = sh + 2048;
#pragma unroll 1
        for (int half = 0; half < 2; ++half) {
            const int ta = t0 + 4 * wv + 2 * half;
            const bf16_t* xa = (const bf16_t*)(p.ws + WS_X2) + (size_t)ta * DM;
            f32x4 va[8], vb[8];
#pragma unroll
            for (int j = 0; j < 8; ++j) { const u32x2 wa = *(const u32x2*)(xa + 4 * lane + 256 * j), wb = *(const u32x2*)(xa + DM + 4 * lane + 256 * j);
                va[j] = (f32x4){bflo(wa.x), bfhi(wa.x), bflo(wa.y), bfhi(wa.y)}; vb[j] = (f32x4){bflo(wb.x), bfhi(wb.x), bflo(wb.y), bfhi(wb.y)}; }
            float sa = 0.f, sb = 0.f;
#pragma unroll
            for (int j = 0; j < 8; ++j) { sa += va[j][0] * va[j][0] + va[j][1] * va[j][1] + va[j][2] * va[j][2] + va[j][3] * va[j][3]; sb += vb[j][0] * vb[j][0] + vb[j][1] * vb[j][1] + vb[j][2] * vb[j][2] + vb[j][3] * vb[j][3]; }
#pragma unroll
            for (int o = 1; o < 64; o <<= 1) { sa += __shfl_xor(sa, o); sb += __shfl_xor(sb, o); }
            const float ra = 1.0f / sqrtf(sa * (1.f / DM) + EPS), rb = 1.0f / sqrtf(sb * (1.f / DM) + EPS);
            bf16_t* ho = Hb + (size_t)ta * DM;
#pragma unroll
            for (int j = 0; j < 8; ++j) {
                const f32x4 g = *(const f32x4*)(g2 + 4 * lane + 256 * j), s1 = *(const f32x4*)(sc + 4 * lane + 256 * j), s0 = *(const f32x4*)(sh + 4 * lane + 256 * j);
                const f32x4 gg = g * (s1 + 1.f);
                const f32x4 ha = (va[j] * ra) * gg + s0, hb = (vb[j] * rb) * gg + s0;
                u32x2 wa; wa.x = pk2(ha[0], ha[1]); wa.y = pk2(ha[2], ha[3]);
                u32x2 wb; wb.x = pk2(hb[0], hb[1]); wb.y = pk2(hb[2], hb[3]);
                *(u32x2*)(ho + 4 * lane + 256 * j) = wa; *(u32x2*)(ho + DM + 4 * lane + 256 * j) = wb;
            }
        }
        asm volatile("s_waitcnt vmcnt(0)" ::: "memory");
        __syncthreads();
        {
            f32x16 acc;
#pragma unroll
            for (int q = 0; q < 16; ++q) acc[q] = 0.f;
            const bf16_t* bp = Hb + (size_t)(t0 + r) * DM + 256 * wv + 8 * h;
            const bf16_t* ap = WRT + (size_t)(r & 15) * 2048 + 256 * wv + 8 * h;
            bf16x8 bfr[16], afr[16];
#pragma unroll
            for (int s = 0; s < 16; ++s) { bfr[s] = *(const bf16x8*)(bp + 16 * s); afr[s] = *(const bf16x8*)(ap + 16 * s); }
#pragma unroll
            for (int s = 0; s < 16; ++s) { const bf16x8 a = (r < 16) ? afr[s] : (bf16x8){0, 0, 0, 0, 0, 0, 0, 0}; acc = __builtin_amdgcn_mfma_f32_32x32x16_bf16(a, bfr[s], acc, 0, 0, 0); }
#pragma unroll
            for (int q = 0; q < 8; ++q) { const int e = (q & 3) + 8 * (q >> 2) + 4 * h; part[(wv * 32 + r) * 17 + e] = acc[q]; }
        }
        __syncthreads();
        const int e = tid >> 5, tk = tid & 31;
        { float s = 0.f;
#pragma unroll
          for (int w = 0; w < 8; ++w) s += part[(w * 32 + tk) * 17 + e];
          lgs[e * 32 + tk] = s; }
        __syncthreads();
        { float lg[16]; float mx = -1e30f;
#pragma unroll
          for (int q = 0; q < 16; ++q) { lg[q] = lgs[q * 32 + tk]; mx = fmaxf(mx, lg[q]); }
          float den = 0.f, mine = 0.f;
#pragma unroll
          for (int q = 0; q < 16; ++q) { const float ex = expf(lg[q] - mx); den += ex; mine = (q == e) ? ex : mine; }
          aff[((size_t)b * 16 + e) * 2048 + (t0 & 2047) + tk] = mine / den; }
        __syncthreads();
    }
}

__device__ __forceinline__ unsigned block_excl_scan(unsigned cnt, LAS unsigned* wsum, int tid) {
    const int lane = tid & 63, wv = tid >> 6;
    unsigned inc = cnt;
#pragma unroll
    for (int o = 1; o < 64; o <<= 1) { const unsigned t = __shfl_up(inc, o); if (lane >= o) inc += t; }
    if (lane == 63) wsum[wv] = inc;
    __syncthreads();
    unsigned base = 0;
#pragma unroll
    for (int w = 0; w < 8; ++w) base += (w < wv) ? wsum[w] : 0u;
    __syncthreads();
    return base + inc - cnt;
}
__device__ __forceinline__ void ph_topk(const Params& p, LAS unsigned char* lds) {
    const int tid = opaque_tid();
    LAS unsigned* hist = (LAS unsigned*)lds;
    LAS unsigned* misc = hist + 256;
    LAS unsigned* wsum = hist + 320;
    const float* aff = (const float*)(p.ws + WS_AFF);
    int* idx = (int*)(p.ws + WS_IDX); float* gate = (float*)(p.ws + WS_IDX + 65536); int* slot_of = (int*)(p.ws + WS_IDX + 131072);
    for (int u = blockIdx.x; u < 64; u += gridDim.x) {
        const int b = u >> 4, e = u & 15;
        const f32x4 a = *(const f32x4*)(aff + (size_t)u * 2048 + 4 * tid);
        unsigned k[4];
#pragma unroll
        for (int i = 0; i < 4; ++i) k[i] = __float_as_uint(a[i]);
        unsigned prefix = 0, krem = CAP;
#pragma unroll 1
        for (int pass = 0; pass < 4; ++pass) {
            const int shift = 24 - 8 * pass;
            if (tid < 256) hist[tid] = 0;
            __syncthreads();
#pragma unroll
            for (int i = 0; i < 4; ++i) if (pass == 0 || (k[i] >> (shift + 8)) == prefix) __hip_atomic_fetch_add(&hist[(k[i] >> shift) & 255u], 1u, __ATOMIC_RELAXED, __HIP_MEMORY_SCOPE_WORKGROUP);
            __syncthreads();
            { const unsigned cnt = (tid < 256) ? hist[255 - tid] : 0u;
              const unsigned Sn = block_excl_scan(cnt, wsum, tid), S = Sn + cnt;
              if (tid < 256 && S >= krem && Sn < krem) { misc[0] = (prefix << 8) | (unsigned)(255 - tid); misc[1] = krem - Sn; } }
            __syncthreads();
            prefix = misc[0]; krem = misc[1];
            __syncthreads();
        }
        unsigned neq = 0;
#pragma unroll
        for (int i = 0; i < 4; ++i) neq += (k[i] == prefix) ? 1u : 0u;
        unsigned eqbase = block_excl_scan(neq, wsum, tid);
        unsigned sel[4]; unsigned nsel = 0;
#pragma unroll
        for (int i = 0; i < 4; ++i) { const bool eq = k[i] == prefix; sel[i] = (k[i] > prefix || (eq && eqbase < krem)) ? 1u : 0u; eqbase += eq ? 1u : 0u; nsel += sel[i]; }
        unsigned sb = block_excl_scan(nsel, wsum, tid);
#pragma unroll
        for (int i = 0; i < 4; ++i) {
            const int s = 4 * tid + i, t = b * 2048 + s;
            if (sel[i]) { const int row = e * 1024 + b * 256 + (int)sb; idx[row] = t; gate[row] = a[i]; slot_of[(size_t)e * NT + t] = row; ++sb; }
            else slot_of[(size_t)e * NT + t] = -1;
        }
        __syncthreads();
    }
}

__device__ __forceinline__ bf16x8 pack8(float a0, float a1, float a2, float a3, float a4, float a5, float a6, float a7) {
    u32x4 p;
    asm volatile("v_cvt_pk_bf16_f32 %0, %4, %5\n\tv_cvt_pk_bf16_f32 %1, %6, %7\n\tv_cvt_pk_bf16_f32 %2, %8, %9\n\tv_cvt_pk_bf16_f32 %3, %10, %11\n\ts_nop 1"
                 : "=&v"(p[0]), "=&v"(p[1]), "=&v"(p[2]), "=&v"(p[3]) : "v"(a0), "v"(a1), "v"(a2), "v"(a3), "v"(a4), "v"(a5), "v"(a6), "v"(a7));
    return __builtin_bit_cast(bf16x8, p);
}
template <int CH>
__device__ __forceinline__ void attn_prefetch(const bf16_t* qp, const bf16_t* kb, const size_t kst, const int lk0, const int ls, const int r, bf16x8 (&qf)[4], bf16x8 (&kf0)[CH][4]) {
#pragma unroll
    for (int s = 0; s < 4; ++s) qf[s] = *(const bf16x8*)(qp + 16 * s);
#pragma unroll
    for (int i = 0; i < CH; ++i) {
        int lkr = lk0 + 32 * i + r; lkr = lkr < 0 ? 0 : (lkr >= ls ? ls - 1 : lkr);
        const bf16_t* kp = kb + (size_t)lkr * kst;
#pragma unroll
        for (int s = 0; s < 4; ++s) kf0[i][s] = *(const bf16x8*)(kp + 16 * s);
    }
}
template <int NTILES, int CH, bool SYNC = true, bool KLDS = false>
__device__ __forceinline__ void attn_wave(const bf16x8 (&qf)[4], const bf16x8 (&kf0)[CH][4], const bf16_t* kb, const size_t kst, const int lk0, const int ls, const LAS bf16_t* vt, const int vts,
                                          float m_run, float l_run, f32x16& O0, f32x16& O1, float& m_out, float& l_out, const int r, const int h, const LAS bf16_t* kl = nullptr, const int kls = 0) {
#pragma unroll
    for (int i = 0; i < 16; ++i) { O0[i] = 0.f; O1[i] = 0.f; }
#pragma unroll
    for (int c0 = 0; c0 < NTILES; c0 += CH) {
        constexpr int dummy = 0; (void)dummy;
        f32x16 S[CH];
#pragma unroll
        for (int ii = 0; ii < CH; ++ii) {
            const int i = c0 + ii;
            if (i < NTILES) {
                int lkr = lk0 + 32 * i + r; lkr = lkr < 0 ? 0 : (lkr >= ls ? ls - 1 : lkr);
                const bf16_t* kp = kb + (size_t)lkr * kst;
                f32x16 a;
#pragma unroll
                for (int q = 0; q < 16; ++q) a[q] = 0.f;
#pragma unroll
                for (int s = 0; s < 4; ++s) {
                    bf16x8 kf;
                    if constexpr (KLDS) kf = *(const LAS bf16x8*)(kl + i * 32 * kls + 16 * s);
                    else { if (c0 == 0) kf = kf0[ii][s]; else kf = *(const bf16x8*)(kp + 16 * s); }
                    a = __builtin_amdgcn_mfma_f32_32x32x16_bf16(kf, qf[s], a, 0, 0, 0);
                }
                S[ii] = a;
            }
        }
        float mx = m_run;
#pragma unroll
        for (int ii = 0; ii < CH; ++ii) {
            const int i = c0 + ii;
            if (i < NTILES) {
                const bool edge = (lk0 + 32 * i < 0) || (lk0 + 32 * i + 32 > ls);
                if (edge || i == 0 || i == NTILES - 1) {
#pragma unroll
                    for (int q = 0; q < 16; ++q) {
                        const int row = (q & 3) + 8 * (q >> 2) + 4 * h;
                        const int lk = lk0 + 32 * i + row;
                        bool valid = (lk >= 0) && (lk < ls);
                        if (i == 0) valid = valid && (row >= r);
                        if (i == NTILES - 1) valid = valid && (row <= r);
                        const float sv = valid ? S[ii][q] : -1e30f;
                        S[ii][q] = sv;
                        mx = fmaxf(mx, sv);
                    }
                } else {
#pragma unroll
                    for (int q = 0; q < 16; ++q) mx = fmaxf(mx, S[ii][q]);
                }
            }
        }
        mx = fmaxf(mx, __shfl_xor(mx, 32));
        const float corr = __builtin_amdgcn_exp2f((m_run - mx) * 1.442695041f);
        float psum = 0.f;
#pragma unroll
        for (int ii = 0; ii < CH; ++ii) {
            const int i = c0 + ii;
            if (i < NTILES) {
#pragma unroll
                for (int q = 0; q < 16; ++q) { const float pv = __builtin_amdgcn_exp2f((S[ii][q] - mx) * 1.442695041f); S[ii][q] = pv; psum += pv; }
            }
        }
        psum += __shfl_xor(psum, 32);
        l_run = l_run * corr + psum;
        m_run = mx;
        if (c0 > 0) {
#pragma unroll
            for (int q = 0; q < 16; ++q) { O0[q] *= corr; O1[q] *= corr; }
        } else { if (SYNC) __syncthreads(); }
#pragma unroll
        for (int ii = 0; ii < CH; ++ii) {
            const int i = c0 + ii;
            if (i < NTILES) {
#pragma unroll
                for (int sp = 0; sp < 2; ++sp) {
                    const bf16x8 pf = pack8(S[ii][8 * sp + 0], S[ii][8 * sp + 1], S[ii][8 * sp + 2], S[ii][8 * sp + 3], S[ii][8 * sp + 4], S[ii][8 * sp + 5], S[ii][8 * sp + 6], S[ii][8 * sp + 7]);
                    const LAS bf16_t* v0 = vt + 32 * i + 16 * sp;
                    { const u32x2 a0 = *(const LAS u32x2*)(v0), a1 = *(const LAS u32x2*)(v0 + 8);
                      const u32x4 vw = (u32x4){a0.x, a0.y, a1.x, a1.y};
                      O0 = __builtin_amdgcn_mfma_f32_32x32x16_bf16(__builtin_bit_cast(bf16x8, vw), pf, O0, 0, 0, 0); }
                    { const u32x2 a0 = *(const LAS u32x2*)(v0 + 32 * vts), a1 = *(const LAS u32x2*)(v0 + 32 * vts + 8);
                      const u32x4 vw = (u32x4){a0.x, a0.y, a1.x, a1.y};
                      O1 = __builtin_amdgcn_mfma_f32_32x32x16_bf16(__builtin_bit_cast(bf16x8, vw), pf, O1, 0, 0, 0); }
                }
            }
        }
    }
    m_out = m_run; l_out = l_run;
}
__device__ __forceinline__ void ph_dilated_mfma(const Params& p, const int l, LAS unsigned char* lds) {
    constexpr int VTS = 260, VTSS = 292, KSTR = 72, ARENA = 78848, KOFF = 37376;
    const int hw = (opaque_tid() >> 8) & 1;
    const bf16_t* PROJ = (const bf16_t*)(p.ws + WS_PROJ);
    int ufirst, ucount, ustep;
    if (gridDim.x == 256) { if (blockIdx.x < 128) { ufirst = blockIdx.x * 2; ucount = 2; } else { ufirst = 256 + (blockIdx.x - 128) * 4; ucount = 4; } ustep = 1; }
    else { ufirst = blockIdx.x; ustep = gridDim.x; ucount = (768 - (int)blockIdx.x + (int)gridDim.x - 1) / (int)gridDim.x; }
    const int nsw = (256 - (int)blockIdx.x + (int)gridDim.x - 1) / (int)gridDim.x;
    const int ngm = (int)blockIdx.x < 128 ? (128 - (int)blockIdx.x + (int)gridDim.x - 1) / (int)gridDim.x : 0;
    const int nitems = ngm + nsw + ucount;
    constexpr int VTSG = 136;
    const bf16_t* SW = (const bf16_t*)(p.ws + WS_SGUW) + (size_t)l * 8 * 128 * 128;
    bf16x8 qf[4]; bf16x8 kdummy[5][4];
    for (int k = 0; k <= 2 * nitems; ++k) {
        const int tid = opaque_tid(), lane = tid & 63, w4 = (tid >> 6) & 3, tl = tid & 255, r = lane & 31, h = lane >> 5;
        LAS bf16_t* Vt = (LAS bf16_t*)(lds + hw * ARENA);
        LAS unsigned* Vt32 = (LAS unsigned*)Vt;
        LAS bf16_t* Ks = (LAS bf16_t*)(lds + hw * ARENA + KOFF);
        const int kk = k - hw, it0 = kk >> 1;
        if (kk >= 0 && it0 < nitems) {
            if (it0 < ngm) {
                const int u = blockIdx.x + it0 * gridDim.x;
                const int hg = u & 1, t0 = (u >> 1) * 128, hh2 = w4 >> 1, ph = w4 & 1, habs = hg * 4 + 2 * hw + hh2;
                if (!(kk & 1)) {
                    const int kp = tl & 63, ta = t0 + 2 * kp;
                    const float* vs = (const float*)(p.ws + WS_VSS) + (size_t)ta * 8;
                    const f32x4 sa0 = *(const f32x4*)vs, sa1 = *(const f32x4*)(vs + 4), sb0 = *(const f32x4*)(vs + 8), sb1 = *(const f32x4*)(vs + 12);
                    u32x4 va[4], vb[4]; f32x4 g0[4], g1[4];
                    const float* sn = p.in[8] + (size_t)l * 512 + hg * 256 + hw * 128;
#pragma unroll
                    for (int i = 0; i < 4; ++i) { const int dc = (tl >> 6) + 4 * i;
                        const bf16_t* src = PROJ + (size_t)ta * NPROJ + PC_V + hg * 256 + hw * 128 + 8 * dc;
                        va[i] = *(const u32x4*)src; vb[i] = *(const u32x4*)(src + NPROJ);
                        g0[i] = *(const f32x4*)(sn + 8 * dc); g1[i] = *(const f32x4*)(sn + 8 * dc + 4); }
                    const float ra = 1.0f / sqrtf((((sa0[0] + sa0[1]) + (sa0[2] + sa0[3])) + ((sa1[0] + sa1[1]) + (sa1[2] + sa1[3]))) * (1.f / 512.f) + EPS);
                    const float rb = 1.0f / sqrtf((((sb0[0] + sb0[1]) + (sb0[2] + sb0[3])) + ((sb1[0] + sb1[1]) + (sb1[2] + sb1[3]))) * (1.f / 512.f) + EPS);
#pragma unroll
                    for (int i = 0; i < 4; ++i) { const int dc = (tl >> 6) + 4 * i;
                        LAS unsigned* o = Vt32 + (8 * dc) * (VTSG / 2) + kp;
                        o[0 * (VTSG / 2)] = pk2(bflo(va[i].x) * ra * g0[i][0], bflo(vb[i].x) * rb * g0[i][0]); o[1 * (VTSG / 2)] = pk2(bfhi(va[i].x) * ra * g0[i][1], bfhi(vb[i].x) * rb * g0[i][1]);
                        o[2 * (VTSG / 2)] = pk2(bflo(va[i].y) * ra * g0[i][2], bflo(vb[i].y) * rb * g0[i][2]); o[3 * (VTSG / 2)] = pk2(bfhi(va[i].y) * ra * g0[i][3], bfhi(vb[i].y) * rb * g0[i][3]);
                        o[4 * (VTSG / 2)] = pk2(bflo(va[i].z) * ra * g1[i][0], bflo(vb[i].z) * rb * g1[i][0]); o[5 * (VTSG / 2)] = pk2(bfhi(va[i].z) * ra * g1[i][1], bfhi(vb[i].z) * rb * g1[i][1]);
                        o[6 * (VTSG / 2)] = pk2(bflo(va[i].w) * ra * g1[i][2], bflo(vb[i].w) * rb * g1[i][2]); o[7 * (VTSG / 2)] = pk2(bfhi(va[i].w) * ra * g1[i][3], bfhi(vb[i].w) * rb * g1[i][3]); }
                } else {
                    f32x16 acc[2][2];
#pragma unroll
                    for (int ct = 0; ct < 2; ++ct)
#pragma unroll
                        for (int pt = 0; pt < 2; ++pt)
#pragma unroll
                            for (int q = 0; q < 16; ++q) acc[ct][pt][q] = 0.f;
                    const LAS bf16_t* ap = Vt + (hh2 * 64 + r) * VTSG + 8 * h;
                    const bf16_t* wp = SW + ((size_t)habs * 128 + 64 * ph + r) * 128 + 8 * h;
#pragma unroll
                    for (int s2 = 0; s2 < 8; ++s2) {
                        bf16x8 afr[2], bfr[2];
#pragma unroll
                        for (int pt = 0; pt < 2; ++pt) bfr[pt] = *(const bf16x8*)(wp + (size_t)pt * 32 * 128 + 16 * s2);
#pragma unroll
                        for (int ct = 0; ct < 2; ++ct) afr[ct] = *(const LAS bf16x8*)(ap + ct * 32 * VTSG + 16 * s2);
#pragma unroll
                        for (int ct = 0; ct < 2; ++ct)
#pragma unroll
                            for (int pt = 0; pt < 2; ++pt) acc[ct][pt] = __builtin_amdgcn_mfma_f32_32x32x16_bf16(afr[ct], bfr[pt], acc[ct][pt], 0, 0, 0);
                    }
                    bf16_t* YB = (bf16_t*)(p.ws + WS_YB);
#pragma unroll
                    for (int pt = 0; pt < 2; ++pt) {
                        const int pp = 64 * ph + 32 * pt + r;
                        const float bias = p.in[10][((size_t)l * 8 + habs) * 128 + pp];
                        const bf16_t* us = PROJ + (size_t)(t0 + pp) * NPROJ + PC_U + habs * 64 + 4 * h;
                        bf16_t* o = YB + (size_t)(t0 + pp) * 512 + habs * 64 + 4 * h;
#pragma unroll
                        for (int ct = 0; ct < 2; ++ct)
#pragma unroll
                            for (int gg = 0; gg < 4; ++gg) {
                                const u32x2 uw = *(const u32x2*)(us + 32 * ct + 8 * gg);
                                u32x2 w; w.x = pk2(bflo(uw.x) * (acc[ct][pt][4 * gg] + bias), bfhi(uw.x) * (acc[ct][pt][4 * gg + 1] + bias));
                                w.y = pk2(bflo(uw.y) * (acc[ct][pt][4 * gg + 2] + bias), bfhi(uw.y) * (acc[ct][pt][4 * gg + 3] + bias));
                                *(u32x2*)(o + 32 * ct + 8 * gg) = w;
                            }
                    }
                }
            } else if (it0 < ngm + nsw) {
                const int it = it0 - ngm;
                const int u = blockIdx.x + it * gridDim.x;
                const int b = u >> 6, kvh = (u >> 5) & 1, q0 = (u & 31) * 64 + 32 * hw;
                const bf16_t* base = PROJ + (size_t)b * SEQ * NPROJ;
                const int head = kvh * 4 + w4, qpos = q0 + r, lk0 = q0 - 128;
                if (!(kk & 1)) {
                    u32x4 va[5], vb[5], kc[9];
#pragma unroll
                    for (int i = 0; i < 5; ++i) {
                        const int task = tl + 256 * i;
                        if (task < 1152) { const int kp = task % 144, dc = task / 144;
                            int kA = lk0 + 2 * kp; kA = kA < 0 ? 0 : (kA > SEQ - 2 ? SEQ - 2 : kA);
                            va[i] = *(const u32x4*)(base + (size_t)kA * NPROJ + PC_VC + kvh * 64 + 8 * dc);
                            vb[i] = *(const u32x4*)(base + (size_t)(kA + 1) * NPROJ + PC_VC + kvh * 64 + 8 * dc); }
                    }
#pragma unroll
                    for (int i = 0; i < 9; ++i) { const int id = tl + 256 * i, j = id >> 3, c8 = id & 7;
                        int kp2 = lk0 + j; kp2 = kp2 < 0 ? 0 : (kp2 >= SEQ ? SEQ - 1 : kp2);
                        kc[i] = *(const u32x4*)(base + (size_t)kp2 * NPROJ + PC_KC + kvh * 64 + 8 * c8); }
                    { const bf16_t* qp = base + (size_t)qpos * NPROJ + PC_QC + head * 64 + 8 * h;
#pragma unroll
                      for (int s2 = 0; s2 < 4; ++s2) qf[s2] = *(const bf16x8*)(qp + 16 * s2); }
#pragma unroll
                    for (int i = 0; i < 5; ++i) {
                        const int task = tl + 256 * i;
                        if (task < 1152) { const int kp = task % 144, dc = task / 144;
                            LAS unsigned* o = Vt32 + (8 * dc) * (VTSS / 2) + kp;
                            o[0 * (VTSS / 2)] = (va[i].x & 0xffffu) | (vb[i].x << 16); o[1 * (VTSS / 2)] = (va[i].x >> 16) | (vb[i].x & 0xffff0000u);
                            o[2 * (VTSS / 2)] = (va[i].y & 0xffffu) | (vb[i].y << 16); o[3 * (VTSS / 2)] = (va[i].y >> 16) | (vb[i].y & 0xffff0000u);
                            o[4 * (VTSS / 2)] = (va[i].z & 0xffffu) | (vb[i].z << 16); o[5 * (VTSS / 2)] = (va[i].z >> 16) | (vb[i].z & 0xffff0000u);
                            o[6 * (VTSS / 2)] = (va[i].w & 0xffffu) | (vb[i].w << 16); o[7 * (VTSS / 2)] = (va[i].w >> 16) | (vb[i].w & 0xffff0000u); }
                    }
#pragma unroll
                    for (int i = 0; i < 9; ++i) { const int id = tl + 256 * i, j = id >> 3, c8 = id & 7; *(LAS u32x4*)(Ks + j * KSTR + 8 * c8) = kc[i]; }
                } else {
                    const LAS bf16_t* vt = Vt + r * VTSS + 4 * h;
                    const LAS bf16_t* kl = Ks + r * KSTR + 8 * h;
                    f32x16 O0, O1; float m, lsum;
                    attn_wave<9, 5, false, true>(qf, kdummy, nullptr, (size_t)NPROJ, lk0, SEQ, vt, VTSS, p.in[11][l * 8 + head], 1.f, O0, O1, m, lsum, r, h, kl, KSTR);
                    const float inv = 1.f / lsum;
                    bf16_t* o = (bf16_t*)(p.ws + WS_YC) + ((size_t)b * SEQ + qpos) * 512 + head * 64 + 4 * h;
#pragma unroll
                    for (int gg = 0; gg < 4; ++gg) {
                        u32x2 w0; w0.x = pk2(O0[4 * gg] * inv, O0[4 * gg + 1] * inv); w0.y = pk2(O0[4 * gg + 2] * inv, O0[4 * gg + 3] * inv);
                        u32x2 w1; w1.x = pk2(O1[4 * gg] * inv, O1[4 * gg + 1] * inv); w1.y = pk2(O1[4 * gg + 2] * inv, O1[4 * gg + 3] * inv);
                        *(u32x2*)(o + 8 * gg) = w0; *(u32x2*)(o + 32 + 8 * gg) = w1;
                    }
                }
            } else {
                const int u = ufirst + (it0 - ngm - nsw) * ustep;
                const int cfg = u >> 8, r8 = u & 255, b = r8 >> 6, head = (r8 >> 3) & 7, blk = (r8 & 7) * 2 + hw;
                const int dsh = 2 * cfg, dil = 1 << dsh, ls = SEQ >> dsh, nblk = ls >> 7;
                const int res = blk / nblk, l0 = (blk % nblk) * 128;
                const bf16_t* base = PROJ + ((size_t)b * SEQ + res) * NPROJ;
                const size_t kst = (size_t)dil * NPROJ;
                const int lq = l0 + 32 * w4 + r;
                const int lk0 = l0 + 32 * w4 - 64;
                if (!(kk & 1)) {
                    u32x4 va[4], vb[4], kc[8];
#pragma unroll
                    for (int i = 0; i < 4; ++i) {
                        const int task = tl + 256 * i, kp = task & 127, dc = task >> 7;
                        int lkA = l0 - 64 + 2 * kp; lkA = lkA < 0 ? 0 : (lkA > ls - 2 ? ls - 2 : lkA);
                        va[i] = *(const u32x4*)(base + (size_t)lkA * kst + PC_VD + head * 64 + 8 * dc);
                        vb[i] = *(const u32x4*)(base + (size_t)(lkA + 1) * kst + PC_VD + head * 64 + 8 * dc);
                    }
#pragma unroll
                    for (int i = 0; i < 8; ++i) {
                        const int id = tl + 256 * i, j = id >> 3, c8 = id & 7;
                        int lk = l0 - 64 + j; lk = lk < 0 ? 0 : (lk >= ls ? ls - 1 : lk);
                        kc[i] = *(const u32x4*)(base + (size_t)lk * kst + PC_KD + head * 64 + 8 * c8);
                    }
                    { const bf16_t* qp = base + (size_t)lq * kst + PC_QD + head * 64 + 8 * h;
#pragma unroll
                      for (int s2 = 0; s2 < 4; ++s2) qf[s2] = *(const bf16x8*)(qp + 16 * s2); }
#pragma unroll
                    for (int i = 0; i < 4; ++i) {
                        const int task = tl + 256 * i, kp = task & 127, dc = task >> 7;
                        LAS unsigned* o = Vt32 + (8 * dc) * (VTS / 2) + kp;
                        o[0 * (VTS / 2)] = (va[i].x & 0xffffu) | (vb[i].x << 16); o[1 * (VTS / 2)] = (va[i].x >> 16) | (vb[i].x & 0xffff0000u);
                        o[2 * (VTS / 2)] = (va[i].y & 0xffffu) | (vb[i].y << 16); o[3 * (VTS / 2)] = (va[i].y >> 16) | (vb[i].y & 0xffff0000u);
                        o[4 * (VTS / 2)] = (va[i].z & 0xffffu) | (vb[i].z << 16); o[5 * (VTS / 2)] = (va[i].z >> 16) | (vb[i].z & 0xffff0000u);
                        o[6 * (VTS / 2)] = (va[i].w & 0xffffu) | (vb[i].w << 16); o[7 * (VTS / 2)] = (va[i].w >> 16) | (vb[i].w & 0xffff0000u);
                    }
#pragma unroll
                    for (int i = 0; i < 8; ++i) { const int id = tl + 256 * i, j = id >> 3, c8 = id & 7; *(LAS u32x4*)(Ks + j * KSTR + 8 * c8) = kc[i]; }
                } else {
                    const LAS bf16_t* vt = Vt + r * VTS + 32 * w4 + 4 * h;
                    const LAS bf16_t* kl = Ks + (32 * w4 + r) * KSTR + 8 * h;
                    f32x16 O0, O1; float m, lsm;
                    attn_wave<5, 5, false, true>(qf, kdummy, nullptr, kst, lk0, ls, vt, VTS, -1e30f, 0.f, O0, O1, m, lsm, r, h, kl, KSTR);
                    const float inv = 1.f / lsm;
                    const size_t tq = (size_t)b * SEQ + (size_t)lq * dil + res;
                    bf16_t* o = (bf16_t*)(p.ws + WS_YD) + ((size_t)cfg * NT + tq) * 512 + head * 64 + 4 * h;
#pragma unroll
                    for (int g = 0; g < 4; ++g) {
                        u32x2 w0; w0.x = pk2(O0[4 * g] * inv, O0[4 * g + 1] * inv); w0.y = pk2(O0[4 * g + 2] * inv, O0[4 * g + 3] * inv);
                        u32x2 w1; w1.x = pk2(O1[4 * g] * inv, O1[4 * g + 1] * inv); w1.y = pk2(O1[4 * g + 2] * inv, O1[4 * g + 3] * inv);
                        *(u32x2*)(o + 8 * g) = w0; *(u32x2*)(o + 32 + 8 * g) = w1;
                    }
                    if (h == 0) ((float*)(p.ws + WS_LSE))[((size_t)cfg * NT + tq) * 8 + head] = m + __logf(lsm);
                }
            }
        }
        __syncthreads();
    }
}

__device__ __forceinline__ void ph_swa_mfma(const Params& p, int l, LAS unsigned char* lds) {
    const int tid = opaque_tid(), lane = tid & 63, wv = tid >> 6, g = wv >> 1, ph = wv & 1, r = lane & 31, h = lane >> 5;
    constexpr int VTS = 324;
    LAS bf16_t* Vt = (LAS bf16_t*)lds;
    LAS unsigned* Vt32 = (LAS unsigned*)lds;
    const bf16_t* PROJ = (const bf16_t*)(p.ws + WS_PROJ);
    for (int u = blockIdx.x; u < 256; u += gridDim.x) {
        const int b = u >> 6, kvh = (u >> 5) & 1, q0 = (u & 31) * 64;
        const bf16_t* base = PROJ + (size_t)b * SEQ * NPROJ;
        u32x4 va[3], vb[3];
#pragma unroll
        for (int i = 0; i < 3; ++i) {
            const int task = tid + 512 * i;
            if (task < 1280) {
                const int kp = task % 160, dc = task / 160;
                int kA = q0 - 128 + 2 * kp; kA = kA < 0 ? 0 : (kA > SEQ - 2 ? SEQ - 2 : kA);
                va[i] = *(const u32x4*)(base + (size_t)kA * NPROJ + PC_VC + kvh * 64 + 8 * dc);
                vb[i] = *(const u32x4*)(base + (size_t)(kA + 1) * NPROJ + PC_VC + kvh * 64 + 8 * dc);
            }
        }
        const int head = kvh * 4 + g;
        const int qpos = q0 + 32 * ph + r;
        const int lk0 = q0 + 32 * ph - 128;
        const bf16_t* kb = base + PC_KC + kvh * 64 + 8 * h;
        bf16x8 qf[4], kf0[5][4];
        attn_prefetch<5>(base + (size_t)qpos * NPROJ + PC_QC + head * 64 + 8 * h, kb, (size_t)NPROJ, lk0, SEQ, r, qf, kf0);
#pragma unroll
        for (int i = 0; i < 3; ++i) {
            const int task = tid + 512 * i;
            if (task < 1280) {
                const int kp = task % 160, dc = task / 160;
                LAS unsigned* o = Vt32 + (8 * dc) * (VTS / 2) + kp;
                o[0 * (VTS / 2)] = (va[i].x & 0xffffu) | (vb[i].x << 16); o[1 * (VTS / 2)] = (va[i].x >> 16) | (vb[i].x & 0xffff0000u);
                o[2 * (VTS / 2)] = (va[i].y & 0xffffu) | (vb[i].y << 16); o[3 * (VTS / 2)] = (va[i].y >> 16) | (vb[i].y & 0xffff0000u);
                o[4 * (VTS / 2)] = (va[i].z & 0xffffu) | (vb[i].z << 16); o[5 * (VTS / 2)] = (va[i].z >> 16) | (vb[i].z & 0xffff0000u);
                o[6 * (VTS / 2)] = (va[i].w & 0xffffu) | (vb[i].w << 16); o[7 * (VTS / 2)] = (va[i].w >> 16) | (vb[i].w & 0xffff0000u);
            }
        }
        {
            const LAS bf16_t* vt = Vt + r * VTS + 32 * ph + 4 * h;
            f32x16 O0, O1; float m, lsum;
            attn_wave<9, 5>(qf, kf0, kb, (size_t)NPROJ, lk0, SEQ, vt, VTS, p.in[11][l * 8 + head], 1.f, O0, O1, m, lsum, r, h);
            const float inv = 1.f / lsum;
            bf16_t* o = (bf16_t*)(p.ws + WS_YC) + ((size_t)b * SEQ + qpos) * 512 + head * 64 + 4 * h;
#pragma unroll
            for (int gg = 0; gg < 4; ++gg) {
                u32x2 w0; w0.x = pk2(O0[4 * gg] * inv, O0[4 * gg + 1] * inv); w0.y = pk2(O0[4 * gg + 2] * inv, O0[4 * gg + 3] * inv);
                u32x2 w1; w1.x = pk2(O1[4 * gg] * inv, O1[4 * gg + 1] * inv); w1.y = pk2(O1[4 * gg + 2] * inv, O1[4 * gg + 3] * inv);
                *(u32x2*)(o + 8 * gg) = w0; *(u32x2*)(o + 32 + 8 * gg) = w1;
            }
        }
        __syncthreads();
    }
}

__device__ __forceinline__ void ph_gmlp_mfma(const Params& p, int l, LAS unsigned char* lds) {
    const int tid = opaque_tid(), lane = tid & 63, wv = tid >> 6, hh = wv >> 1, ph = wv & 1, r = lane & 31, h = lane >> 5;
    constexpr int VTS = 136;
    LAS bf16_t* Vt = (LAS bf16_t*)lds;
    LAS unsigned* Vt32 = (LAS unsigned*)lds;
    LAS float* rv = (LAS float*)(lds + 256 * VTS * 2);
    const bf16_t* PROJ = (const bf16_t*)(p.ws + WS_PROJ); bf16_t* YB = (bf16_t*)(p.ws + WS_YB);
    const bf16_t* SW = (const bf16_t*)(p.ws + WS_SGUW) + (size_t)l * 8 * 128 * 128;
    const float* sn = p.in[8] + (size_t)l * 512;
    for (int u = blockIdx.x; u < 128; u += gridDim.x) {
        const int hg = u & 1, t0 = (u >> 1) * 128;
        { u32x4 w[16]; float ss[16];
#pragma unroll
          for (int q = 0; q < 16; ++q) w[q] = *(const u32x4*)(PROJ + (size_t)(t0 + wv * 16 + q) * NPROJ + PC_V + 8 * lane);
#pragma unroll
          for (int q = 0; q < 16; ++q) ss[q] = bflo(w[q].x) * bflo(w[q].x) + bfhi(w[q].x) * bfhi(w[q].x) + bflo(w[q].y) * bflo(w[q].y) + bfhi(w[q].y) * bfhi(w[q].y) + bflo(w[q].z) * bflo(w[q].z) + bfhi(w[q].z) * bfhi(w[q].z) + bflo(w[q].w) * bflo(w[q].w) + bfhi(w[q].w) * bfhi(w[q].w);
#pragma unroll
          for (int o = 1; o < 64; o <<= 1)
#pragma unroll
              for (int q = 0; q < 16; ++q) ss[q] += __shfl_xor(ss[q], o);
          float mine = 0.f;
#pragma unroll
          for (int q = 0; q < 16; ++q) mine = (lane == q) ? ss[q] : mine;
          if (lane < 16) rv[wv * 16 + lane] = 1.0f / sqrtf(mine * (1.f / 512.f) + EPS); }
        __syncthreads();
#pragma unroll
        for (int i = 0; i < 4; ++i) {
            const int task = tid + 512 * i, kp = task & 63, dc = task >> 6;
            const bf16_t* src = PROJ + (size_t)(t0 + 2 * kp) * NPROJ + PC_V + hg * 256 + 8 * dc;
            const u32x4 va = *(const u32x4*)src, vb = *(const u32x4*)(src + NPROJ);
            const float ra = rv[2 * kp], rb = rv[2 * kp + 1];
            const f32x4 g0 = *(const f32x4*)(sn + hg * 256 + 8 * dc), g1 = *(const f32x4*)(sn + hg * 256 + 8 * dc + 4);
            LAS unsigned* o = Vt32 + (8 * dc) * (VTS / 2) + kp;
            o[0 * (VTS / 2)] = pk2(bflo(va.x) * ra * g0[0], bflo(vb.x) * rb * g0[0]); o[1 * (VTS / 2)] = pk2(bfhi(va.x) * ra * g0[1], bfhi(vb.x) * rb * g0[1]);
            o[2 * (VTS / 2)] = pk2(bflo(va.y) * ra * g0[2], bflo(vb.y) * rb * g0[2]); o[3 * (VTS / 2)] = pk2(bfhi(va.y) * ra * g0[3], bfhi(vb.y) * rb * g0[3]);
            o[4 * (VTS / 2)] = pk2(bflo(va.z) * ra * g1[0], bflo(vb.z) * rb * g1[0]); o[5 * (VTS / 2)] = pk2(bfhi(va.z) * ra * g1[1], bfhi(vb.z) * rb * g1[1]);
            o[6 * (VTS / 2)] = pk2(bflo(va.w) * ra * g1[2], bflo(vb.w) * rb * g1[2]); o[7 * (VTS / 2)] = pk2(bfhi(va.w) * ra * g1[3], bfhi(vb.w) * rb * g1[3]);
        }
        __syncthreads();
        {
            const int habs = hg * 4 + hh;
            f32x16 acc[2][2];
#pragma unroll
            for (int ct = 0; ct < 2; ++ct)
#pragma unroll
                for (int pt = 0; pt < 2; ++pt)
#pragma unroll
                    for (int q = 0; q < 16; ++q) acc[ct][pt][q] = 0.f;
            const bf16_t* wp = SW + ((size_t)habs * 128 + 64 * ph + r) * 128 + 8 * h;
            const LAS bf16_t* ap = Vt + (hh * 64 + r) * VTS + 8 * h;
#pragma unroll
            for (int s = 0; s < 8; ++s) {
                bf16x8 bfr[2], afr[2];
#pragma unroll
                for (int pt = 0; pt < 2; ++pt) bfr[pt] = *(const bf16x8*)(wp + (size_t)pt * 32 * 128 + 16 * s);
#pragma unroll
                for (int ct = 0; ct < 2; ++ct) afr[ct] = *(const LAS bf16x8*)(ap + ct * 32 * VTS + 16 * s);
#pragma unroll
                for (int ct = 0; ct < 2; ++ct)
#pragma unroll
                    for (int pt = 0; pt < 2; ++pt) acc[ct][pt] = __builtin_amdgcn_mfma_f32_32x32x16_bf16(afr[ct], bfr[pt], acc[ct][pt], 0, 0, 0);
            }
#pragma unroll
            for (int pt = 0; pt < 2; ++pt) {
                const int pp = 64 * ph + 32 * pt + r;
                const float bias = p.in[10][((size_t)l * 8 + habs) * 128 + pp];
                const bf16_t* us = PROJ + (size_t)(t0 + pp) * NPROJ + PC_U + habs * 64 + 4 * h;
                bf16_t* o = YB + (size_t)(t0 + pp) * 512 + habs * 64 + 4 * h;
#pragma unroll
                for (int ct = 0; ct < 2; ++ct)
#pragma unroll
                    for (int gg = 0; gg < 4; ++gg) {
                        const u32x2 uw = *(const u32x2*)(us + 32 * ct + 8 * gg);
                        u32x2 w; w.x = pk2(bflo(uw.x) * (acc[ct][pt][4 * gg] + bias), bfhi(uw.x) * (acc[ct][pt][4 * gg + 1] + bias));
                        w.y = pk2(bflo(uw.y) * (acc[ct][pt][4 * gg + 2] + bias), bfhi(uw.y) * (acc[ct][pt][4 * gg + 3] + bias));
                        *(u32x2*)(o + 32 * ct + 8 * gg) = w;
                    }
            }
        }
        __syncthreads();
    }
}

__device__ __forceinline__ void ph_merge(const Params& p, int l, LAS unsigned char* lds) {
    const int tid = opaque_tid(), lane = tid & 63, wv = tid >> 6, r = lane & 31, h2 = lane >> 5;
    LAS float* ssA = (LAS float*)lds;
    const bf16_t* UV = (const bf16_t*)(p.ws + WS_YA); const bf16_t* YB = (const bf16_t*)(p.ws + WS_YB); const bf16_t* YC = (const bf16_t*)(p.ws + WS_YC); const bf16_t* YD = (const bf16_t*)(p.ws + WS_YD);
    const float* LSE = (const float*)(p.ws + WS_LSE); bf16_t* YN = (bf16_t*)(p.ws + WS_YN);
    const bf16_t* ABT = (const bf16_t*)(p.ws + WS_ABT) + ((size_t)l * 8 + wv) * 64 * 128;
    for (int blk = blockIdx.x; blk < NT / 32; blk += gridDim.x) {
        const int t0 = blk * 32, b = t0 >> 11, s0 = t0 & 2047;
        f32x16 O0, O1;
        {
#pragma unroll
            for (int q = 0; q < 16; ++q) { O0[q] = 0.f; O1[q] = 0.f; }
            const size_t row = ((size_t)b * 4096 + 2 * (s0 + r)) * 512 + wv * 64 + 8 * h2;
            u32x4 u0[8], u1[8];
#pragma unroll
            for (int s = 0; s < 8; ++s) { const size_t o = row + (s >> 2) * 512 + 16 * (s & 3); u0[s] = *(const u32x4*)(UV + o); u1[s] = *(const u32x4*)(UV + (size_t)4 * 4096 * 512 + o); }
            bf16x8 af0[8], af1[8];
#pragma unroll
            for (int s = 0; s < 8; ++s) { af0[s] = *(const bf16x8*)(ABT + (size_t)r * 128 + 16 * s + 8 * h2); af1[s] = *(const bf16x8*)(ABT + (size_t)(32 + r) * 128 + 16 * s + 8 * h2); }
#pragma unroll
            for (int s = 0; s < 8; ++s) {
                const bf16x8 bfr = pack8(bflo(u0[s].x) + bflo(u1[s].x), bfhi(u0[s].x) + bfhi(u1[s].x), bflo(u0[s].y) + bflo(u1[s].y), bfhi(u0[s].y) + bfhi(u1[s].y),
                                         bflo(u0[s].z) + bflo(u1[s].z), bfhi(u0[s].z) + bfhi(u1[s].z), bflo(u0[s].w) + bflo(u1[s].w), bfhi(u0[s].w) + bfhi(u1[s].w));
                O0 = __builtin_amdgcn_mfma_f32_32x32x16_bf16(af0[s], bfr, O0, 0, 0, 0);
                O1 = __builtin_amdgcn_mfma_f32_32x32x16_bf16(af1[s], bfr, O1, 0, 0, 0);
            }
            float ss = 0.f;
#pragma unroll
            for (int q = 0; q < 16; ++q) ss += O0[q] * O0[q] + O1[q] * O1[q];
            ss += __shfl_xor(ss, 32);
            if (h2 == 0) ssA[wv * 32 + r] = ss;
        }
#pragma unroll 1
        for (int i = 0; i < 4; ++i) {
            const int t = t0 + 4 * wv + i;
            float y[3][8];
            { const u32x4 w = *(const u32x4*)(YB + (size_t)t * 512 + 8 * lane);
                y[0][0] = bflo(w.x); y[0][1] = bfhi(w.x); y[0][2] = bflo(w.y); y[0][3] = bfhi(w.y); y[0][4] = bflo(w.z); y[0][5] = bfhi(w.z); y[0][6] = bflo(w.w); y[0][7] = bfhi(w.w); }
            { const u32x4 w = *(const u32x4*)(YC + (size_t)t * 512 + 8 * lane);
                y[1][0] = bflo(w.x); y[1][1] = bfhi(w.x); y[1][2] = bflo(w.y); y[1][3] = bfhi(w.y); y[1][4] = bflo(w.z); y[1][5] = bfhi(w.z); y[1][6] = bflo(w.w); y[1][7] = bfhi(w.w); }
            { const int head = lane >> 3;
              const float l0 = LSE[(size_t)t * 8 + head], l1 = LSE[((size_t)NT + t) * 8 + head], l2 = LSE[((size_t)2 * NT + t) * 8 + head];
              const float mx = fmaxf(l0, fmaxf(l1, l2)); float w0 = __expf(l0 - mx), w1 = __expf(l1 - mx), w2 = __expf(l2 - mx); const float iv = 1.f / (w0 + w1 + w2); w0 *= iv; w1 *= iv; w2 *= iv;
              const u32x4 a = *(const u32x4*)(YD + (size_t)t * 512 + 8 * lane), bq = *(const u32x4*)(YD + ((size_t)NT + t) * 512 + 8 * lane), c = *(const u32x4*)(YD + ((size_t)2 * NT + t) * 512 + 8 * lane);
              y[2][0] = w0 * bflo(a.x) + w1 * bflo(bq.x) + w2 * bflo(c.x); y[2][1] = w0 * bfhi(a.x) + w1 * bfhi(bq.x) + w2 * bfhi(c.x);
              y[2][2] = w0 * bflo(a.y) + w1 * bflo(bq.y) + w2 * bflo(c.y); y[2][3] = w0 * bfhi(a.y) + w1 * bfhi(bq.y) + w2 * bfhi(c.y);
              y[2][4] = w0 * bflo(a.z) + w1 * bflo(bq.z) + w2 * bflo(c.z); y[2][5] = w0 * bfhi(a.z) + w1 * bfhi(bq.z) + w2 * bfhi(c.z);
              y[2][6] = w0 * bflo(a.w) + w1 * bflo(bq.w) + w2 * bflo(c.w); y[2][7] = w0 * bfhi(a.w) + w1 * bfhi(bq.w) + w2 * bfhi(c.w); }
#pragma unroll
            for (int g = 0; g < 3; ++g) {
                float ss = 0.f;
#pragma unroll
                for (int q = 0; q < 8; ++q) ss += y[g][q] * y[g][q];
                const float rr = 1.0f / sqrtf(wave_sum(ss) * (1.f / 512.f) + EPS);
                u32x4 w; w.x = pk2(y[g][0] * rr, y[g][1] * rr); w.y = pk2(y[g][2] * rr, y[g][3] * rr); w.z = pk2(y[g][4] * rr, y[g][5] * rr); w.w = pk2(y[g][6] * rr, y[g][7] * rr);
                *(u32x4*)(YN + (size_t)t * DM + (g + 1) * 512 + 8 * lane) = w;
            }
        }
        __syncthreads();
        {
            float tot = 0.f;
#pragma unroll
            for (int w = 0; w < 8; ++w) tot += ssA[w * 32 + r];
            const float rr = 1.0f / sqrtf(tot * (1.f / 512.f) + EPS);
            bf16_t* o = YN + (size_t)(t0 + r) * DM + wv * 64 + 4 * h2;
#pragma unroll
            for (int g = 0; g < 4; ++g) {
                u32x2 w0; w0.x = pk2(O0[4 * g] * rr, O0[4 * g + 1] * rr); w0.y = pk2(O0[4 * g + 2] * rr, O0[4 * g + 3] * rr);
                u32x2 w1; w1.x = pk2(O1[4 * g] * rr, O1[4 * g + 1] * rr); w1.y = pk2(O1[4 * g + 2] * rr, O1[4 * g + 3] * rr);
                *(u32x2*)(o + 8 * g) = w0; *(u32x2*)(o + 32 + 8 * g) = w1;
            }
        }
        __syncthreads();
    }
}

#ifndef PHASE_MASK
#define PHASE_MASK 0xFFFFFFu
#endif
#define EN(k) (((PHASE_MASK) >> (k)) & 1u)
#ifndef REP_MASK
#define REP_MASK 0u
#endif
#define REP(k) _Pragma("unroll") for (int rep_ = 0; rep_ < 1 + (int)(((REP_MASK) >> (k)) & 1u); ++rep_)
constexpr int MIX_GW = 128, MIX_A = 4400;
constexpr int NPHASE = 22;
__global__ void __launch_bounds__(512, 2) mk_fwd(Params p) {
    extern __shared__ __attribute__((aligned(16))) unsigned char lds_raw[];
    LAS unsigned char* lds = (LAS unsigned char*)lds_raw;
    const int tid = threadIdx.x, G = gridDim.x, bx = blockIdx.x;
    volatile LAS unsigned* misc = (volatile LAS unsigned*)(lds + MISC_OFF);
    if (tid < 16) misc[tid] = 0u;
    __syncthreads();
    const int lo = p.ph_lo, hi = p.ph_hi;
    XcdBarrier bar; bar.bar = (unsigned*)(p.ws + WS_CTL); bar.x = 0; bar.st = misc + 8;
    if (hi - lo > 1) bar = xcd_barrier_post((unsigned*)(p.ws + WS_CTL), misc + 8);
#define IN(k) (lo <= (k) && (k) < hi)
#define SEAM(k) do { if (IN(k) && IN((k) + 1)) xcd_barrier(bar); } while (0)
    if (IN(0)) { if (EN(0)) REP(0) ph_mod(p, lds); if (EN(1)) REP(1) ph_tables(p, lds); if (EN(2)) REP(2) { if (G == 256) { if (bx >= 192) ph_weights(p, lds, 0, 240, bx - 192, 64); } else ph_weights(p, lds, 0, 6880, bx, G); } }
    SEAM(0);
    for (int l = 0; l < 2; ++l) {
        const int pb = 1 + 10 * l;
        const char* H = (const char*)(p.ws + WS_H);
        if (EN(3) && IN(pb + 0)) REP(3) { ph_norm1(p, l); }
        SEAM(pb + 0);
        if (EN(4) && IN(pb + 1)) REP(4) {
            SchedProj S{H, (const char*)(p.ws + WS_WIN) + (size_t)l * NPROJ * 2048 * 2, (const char*)(p.ws + WS_WPQ) + (size_t)l * 512 * 2048 * 2, G, bx};
            EpiProj E{(bf16_t*)(p.ws + WS_PROJ), (bf16_t*)(p.ws + WS_PQT), (const float*)(p.ws + WS_ROPE), (const float*)(p.ws + WS_ROPE) + NT * 8};
            if (l == 0 && G == 256 && EN(2)) {
                if (bx < MIX_GW) { SchedProj S2{S.H, S.WIN, S.WPQ, MIX_GW, bx}; pg8::gemm_phase<EpiProj, SchedProj>(lds, 2048, 2048, 2048, S2, E); }
                else ph_weights(p, lds, 240, 240 + MIX_A, bx - MIX_GW, G - MIX_GW);
                __syncthreads();
                ph_weights(p, lds, 240 + MIX_A, 6880, bx, G);
            } else
            pg8::gemm_phase<EpiProj, SchedProj>(lds, 2048, 2048, 2048, S, E);
        }
        SEAM(pb + 1);
        if (IN(pb + 2)) {
            if (EN(5)) REP(5) { SchedDft S{(const char*)(p.ws + WS_DFT), (const char*)(p.ws + WS_PQT), G, bx};
              EpiBf16Plain E{(bf16_t*)(p.ws + WS_YA), 512, (size_t)4 * 4096 * 512};
              pg8::gemm_phase<EpiBf16Plain, SchedDft>(lds, 2048, 2048, 1024, S, E); }
            __syncthreads();
            if (EN(8)) REP(8) ph_dilated_mfma(p, l, lds);
        }
        SEAM(pb + 2);
        if (EN(9) && IN(pb + 3)) REP(9) { ph_merge(p, l, lds); }
        SEAM(pb + 3);
        if (EN(10) && IN(pb + 4)) REP(10) {
            SchedDense S{(const char*)(p.ws + WS_YN), (const char*)(p.ws + WS_WOUT) + (size_t)l * 2048 * 2048 * 2, 32, 8, 2048, G, bx};
            EpiWout E{l == 0 ? p.in[0] : nullptr, (const bf16_t*)(p.ws + WS_X), (bf16_t*)(p.ws + WS_X2), (const float*)(p.ws + WS_MOD) + (size_t)l * 4 * 12288 + 2 * 2048};
            pg8::gemm_phase<EpiWout, SchedDense>(lds, 2048, 2048, 2048, S, E);
        }
        SEAM(pb + 4);
        if (EN(11) && IN(pb + 5)) REP(11) { ph_norm2_router_mfma(p, l, lds); }
        SEAM(pb + 5);
        if (EN(12) && IN(pb + 6)) REP(12) { ph_topk(p, lds); }
        SEAM(pb + 6);
        if (EN(14) && IN(pb + 8)) REP(14) {
            SchedMoeG S{H, (const char*)(p.ws + WS_WGU) + (size_t)l * 16 * 2048 * 2048 * 2, 2048, G, bx};
            EpiGU E{(bf16_t*)(p.ws + WS_ACT)};
            pg8::gemm_phase<EpiGU, SchedMoeG, true>(lds, 2048, 2048, 2048, S, E, (const int*)(p.ws + WS_IDX));
        }
        SEAM(pb + 8);
        if (EN(15) && IN(pb + 9)) REP(15) {
            SchedMoe S{(const char*)(p.ws + WS_ACT), (const char*)(p.ws + WS_WD) + (size_t)l * 16 * 2048 * 1024 * 2, 1024, G, bx};
            EpiDown E{(bf16_t*)(p.ws + WS_EO), (const float*)(p.ws + WS_IDX + 65536)};
            pg8::gemm_phase<EpiDown, SchedMoe>(lds, 1024, 1024, 1024, S, E);
        }
        SEAM(pb + 9);
    }
    if (EN(16) && IN(21)) REP(16) { ph_norm1(p, 2); }
#undef IN
#undef SEAM
}

extern "C" void kernel_launch(void* const* d_in, const int* in_sizes, int n_in, void* d_out, int out_size, void* d_ws, size_t ws_size, hipStream_t stream) {
    static int grid = 0;
    if (grid == 0) {
        if (n_in != 20 || out_size != NT * DM || ws_size < WS_END) { fprintf(stderr, "kernel_launch: unexpected shapes (n_in %d out %d ws %zu)\n", n_in, out_size, ws_size); grid = -1; return; }
        int dev = 0, cus = 0, per_cu = 0;
        if (hipGetDevice(&dev) != hipSuccess || hipDeviceGetAttribute(&cus, hipDeviceAttributeMultiprocessorCount, dev) != hipSuccess) { grid = -1; return; }
        if (hipFuncSetAttribute((const void*)mk_fwd, hipFuncAttributeMaxDynamicSharedMemorySize, LDS_BYTES) != hipSuccess) { fprintf(stderr, "kernel_launch: hipFuncSetAttribute failed\n"); grid = -1; return; }
        if (hipOccupancyMaxActiveBlocksPerMultiprocessor(&per_cu, (const void*)mk_fwd, 512, LDS_BYTES) != hipSuccess || per_cu < 1) { fprintf(stderr, "kernel_launch: occupancy query says %d\n", per_cu); }
        (void)hipGetLastError();
        grid = cus;
    }
    if (grid < 0) return;
    (void)hipMemsetAsync((char*)d_ws + WS_CTL, 0, 64 * 1024, stream);
    Params p{};
    for (int i = 0; i < 20; ++i) p.in[i] = (const float*)d_in[i];
    p.out = (float*)d_out; p.ws = (unsigned char*)d_ws;
#if defined(MK_MULTI)
    for (int ph = 0; ph < NPHASE; ++ph) { p.ph_lo = ph; p.ph_hi = ph + 1; hipLaunchKernelGGL(mk_fwd, dim3(grid), dim3(512), LDS_BYTES, stream, p); }
#else
    p.ph_lo = 0; p.ph_hi = NPHASE; hipLaunchKernelGGL(mk_fwd, dim3(grid), dim3(512), LDS_BYTES, stream, p);
#endif
}
```

```cpp
#include <hip/hip_runtime.h>
#include <cstdio>
#include <cstdint>

#define LAS __attribute__((address_space(3)))
typedef unsigned short bf16_t;
typedef short bf16x8 __attribute__((ext_vector_type(8)));
typedef float f32x4 __attribute__((ext_vector_type(4)));
typedef float f32x2 __attribute__((ext_vector_type(2)));
typedef unsigned u32x4 __attribute__((ext_vector_type(4)));
typedef unsigned u32x2 __attribute__((ext_vector_type(2)));
typedef float f32x16 __attribute__((ext_vector_type(16)));

constexpr int NB = 4, SEQ = 2048, NT = NB * SEQ, DM = 2048, DIN = 3840, NPROJ = 3328, NE = 16, FF = 1024, CAP = 256;
constexpr float EPS = 1e-6f;
constexpr int PC_U = 0, PC_V = 512, PC_QC = 1024, PC_KC = 1536, PC_VC = 1664, PC_QD = 1792, PC_KD = 2304, PC_VD = 2816;

constexpr size_t MiB = (size_t)1 << 20;
constexpr size_t WS_CTL = 0;
constexpr size_t WS_MOD = 1 * MiB;
constexpr size_t WS_ROPE = WS_MOD + 512 * 1024;
constexpr size_t WS_DFT = 2 * MiB;
constexpr size_t WS_WIN = 18 * MiB;
constexpr size_t WS_WPQ = 44 * MiB;
constexpr size_t WS_WOUT = 52 * MiB;
constexpr size_t WS_WGU = 68 * MiB;
constexpr size_t WS_WD = 324 * MiB;
constexpr size_t WS_X = 452 * MiB;
constexpr size_t WS_X2 = 516 * MiB;
constexpr size_t WS_H = 580 * MiB;
constexpr size_t WS_PROJ = 612 * MiB;
constexpr size_t WS_PQT = 664 * MiB;
constexpr size_t WS_YA = 680 * MiB;
constexpr size_t WS_YB = 712 * MiB;
constexpr size_t WS_YC = 720 * MiB;
constexpr size_t WS_YD = 728 * MiB;
constexpr size_t WS_LSE = 752 * MiB;
constexpr size_t WS_YN = 753 * MiB;
constexpr size_t WS_AFF = 785 * MiB;
constexpr size_t WS_IDX = 786 * MiB;
constexpr size_t WS_XE = 787 * MiB;
constexpr size_t WS_ACT = 851 * MiB;
constexpr size_t WS_EO = 883 * MiB;
constexpr size_t WS_SGUW = 947 * MiB;
constexpr size_t WS_WRT = WS_SGUW + 512 * 1024;
constexpr size_t WS_ABT = WS_WRT + 128 * 1024;
constexpr size_t WS_VSS = WS_ABT + 256 * 1024;
constexpr size_t WS_END = 948 * MiB;

constexpr int LDS_BYTES = 163840;
constexpr int MISC_OFF = LDS_BYTES - 256;

struct Params { const float* in[20]; float* out; unsigned char* ws; int ph_lo, ph_hi; };

__device__ __forceinline__ unsigned pk2(float lo, float hi) { unsigned r; asm("v_cvt_pk_bf16_f32 %0, %1, %2" : "=v"(r) : "v"(lo), "v"(hi)); return r; }
__device__ __forceinline__ float bflo(unsigned u) { return __uint_as_float(u << 16); }
__device__ __forceinline__ float bfhi(unsigned u) { return __uint_as_float(u & 0xffff0000u); }
__device__ __forceinline__ float wave_sum(float v) {
#pragma unroll
    for (int o = 1; o < 64; o <<= 1) v += __shfl_xor(v, o);
    return v;
}
__device__ __forceinline__ float gelu_tanh(float x) { const float u = 0.7978845608f * (x + 0.044715f * x * x * x); return x * __builtin_amdgcn_rcpf(1.f + __builtin_amdgcn_exp2f(-2.885390082f * u)); }
__device__ __forceinline__ float silu_f(float x) { return x * __builtin_amdgcn_rcpf(1.f + __builtin_amdgcn_exp2f(-1.442695041f * x)); }

__device__ __forceinline__ int opaque_tid() { int t = threadIdx.x; asm volatile("" : "+v"(t)); return t; }
#define XB_TMO      128
#define XB_XCNT(j)  (256  + 64 * (j))
#define XB_XSUB(j)  (1280 + 64 * (j))
#define XB_XGEN(j)  (2304 + 64 * (j))
#define XB_TOP      3328
#define XB_TOPGEN   3392
#define XCD_BAR_WORDS 3456
#define XB_SPIN_CAP (1u << 18)
__device__ __forceinline__ unsigned xb_ld(unsigned* p)              { return __hip_atomic_load(p, __ATOMIC_RELAXED, __HIP_MEMORY_SCOPE_AGENT); }
__device__ __forceinline__ unsigned xb_add(unsigned* p, unsigned v) { return __hip_atomic_fetch_add(p, v, __ATOMIC_RELAXED, __HIP_MEMORY_SCOPE_AGENT); }
__device__ __forceinline__ unsigned xb_xcc_id() { return (unsigned)__builtin_amdgcn_s_getreg((3 << 11) | 20) & 0xFu; }
#define XB_SPIN(cond, bar) do { unsigned _sp = 0; while (cond) { __builtin_amdgcn_s_sleep(1); \
    if ((++_sp & 255u) == 0u) { if (xb_ld(&(bar)[XB_TMO])) break; if (_sp > XB_SPIN_CAP) { atomicAdd(&(bar)[XB_TMO], 1u); break; } } } } while (0)
struct XcdBarrier { unsigned* bar; unsigned x; volatile LAS unsigned* st; };
__device__ __forceinline__ XcdBarrier xcd_barrier_post(unsigned* bar, volatile LAS unsigned* st) {
    XcdBarrier b; b.bar = bar; b.x = xb_xcc_id(); b.st = st;
    if (threadIdx.x == 0) (void)xb_add(&bar[XB_XCNT(b.x)], 1u);
    return b;
}
__device__ __forceinline__ void xcd_barrier_complete(unsigned* bar, unsigned x, unsigned& nloc, unsigned& nx) {
    const unsigned G = gridDim.x * gridDim.y * gridDim.z;
    unsigned sum, cnt, mine, sp = 0u;
    for (;;) {
        sum = 0u; cnt = 0u; mine = 0u;
#pragma unroll
        for (unsigned j = 0; j < 16; ++j) { const unsigned c = xb_ld(&bar[XB_XCNT(j)]); sum += c; cnt += (c > 0u) ? 1u : 0u; mine = (j == x) ? c : mine; }
        if (sum == G) break;
        __builtin_amdgcn_s_sleep(1);
        if ((++sp & 255u) == 0u) { if (xb_ld(&bar[XB_TMO])) break; if (sp > XB_SPIN_CAP) { atomicAdd(&bar[XB_TMO], 1u); break; } }
    }
    nloc = mine > 0u ? mine : 1u; nx = cnt > 0u ? cnt : 1u;
}
__device__ __forceinline__ void xcd_barrier(const XcdBarrier& b) {
    asm volatile("s_waitcnt vmcnt(0)" ::: "memory");
    __syncthreads();
    if (threadIdx.x == 0) {
        unsigned* bar = b.bar;
        __builtin_amdgcn_s_waitcnt(0);
        unsigned nloc = b.st[0], nx = b.st[1];
        if (nloc == 0u) { xcd_barrier_complete(bar, b.x, nloc, nx); b.st[0] = nloc; b.st[1] = nx; }
        const unsigned old = xb_add(&bar[XB_XSUB(b.x)], 1u);
        const unsigned gen = old / nloc;
        if (old + 1u == (gen + 1u) * nloc) {
            __builtin_amdgcn_fence(__ATOMIC_RELEASE, "agent");
            asm volatile("s_waitcnt vmcnt(0)" ::: "memory");
            const unsigned og = xb_add(&bar[XB_TOP], 1u);
            const unsigned tg = og / nx;
            if (og + 1u == (tg + 1u) * nx) xb_add(&bar[XB_TOPGEN], 1u);
            else XB_SPIN(xb_ld(&bar[XB_TOPGEN]) == tg, bar);
            __builtin_amdgcn_fence(__ATOMIC_ACQUIRE, "agent");
            xb_add(&bar[XB_XGEN(b.x)], 1u);
            asm volatile("s_waitcnt vmcnt(0)" ::: "memory");
        } else {
            XB_SPIN(xb_ld(&bar[XB_XGEN(b.x)]) == gen, bar);
            __builtin_amdgcn_fence(__ATOMIC_ACQUIRE, "agent");
            asm volatile("s_waitcnt vmcnt(0)" ::: "memory");
        }
    }
    __syncthreads();
}

namespace pg8 {
constexpr int BM = 256, BK = 64, HALF = 128, HTB = HALF * BK * 2, STAGE_BYTES = 8 * HTB;
__host__ __device__ __forceinline__ int lds_byte(int r, int c) { const int st = (r >> 4) * 2 + (c >> 5), rr = r & 15, cc = c & 31, ob = rr * 64 + cc * 2; return st * 1024 + (ob ^ (((ob >> 9) & 1) << 5)); }
__host__ __device__ __forceinline__ void stage_rc(int b, int& R, int& C) { const int st = b / 1024, sb = b % 1024, swz = sb ^ (((sb >> 9) & 1) << 5); R = (st >> 1) * 16 + swz / 64; C = (st & 1) * 32 + (swz % 64) / 2; }
__host__ __device__ __forceinline__ int perm32(int rho) { const int n = rho >> 4, i = rho & 15; return 8 * (i >> 2) + 4 * n + (i & 3); }

struct GUnit { const char* a; const char* b; int pm, pn, z; };

__device__ __forceinline__ void dense_map(int L, int nM, int nN, int& pm, int& pn) {
    const int nwg = nM * nN;
    int wgid = L; { const int q = nwg / 8, r = nwg % 8, xcd = wgid % 8, off = wgid / 8; wgid = (xcd < r ? xcd * (q + 1) : r * (q + 1) + (xcd - r) * q) + off; }
    const int nig = 8 * nN, gid = wgid / nig, fm = gid * 8, gsz = (nM - fm) < 8 ? (nM - fm) : 8;
    pm = fm + ((wgid % nig) % gsz); pn = (wgid % nig) / gsz;
}

template <class Epi, class Sched, bool GATHER = false>
__device__ __forceinline__ void gemm_phase(LAS unsigned char* lds, const int lda, const int ldb, const int K, const Sched& S, const Epi& E, const int* gidx = nullptr) {
    int tid_ = threadIdx.x; asm volatile("" : "+v"(tid_));
    const int tid = tid_, wid = __builtin_amdgcn_readfirstlane(tid >> 6), lane = tid & 63, wr = wid >> 2, wc = wid & 3, fr = lane & 15, fq = lane >> 4;
    const int nt = K / BK;
    unsigned voffB[2]; int RA[2]; unsigned CA2[2];
#pragma unroll
    for (int i = 0; i < 2; ++i) { int R, C; stage_rc(tid * 16 + i * 8192, R, C); const int Rb = Epi::PERM ? ((R & ~31) + perm32(R & 31)) : R;
        RA[i] = R; CA2[i] = (unsigned)C * 2u; voffB[i] = (unsigned)(Rb * ldb + C) * 2u; }
    const size_t kstep = (size_t)(BK * 2);
    const size_t hstepB = (size_t)HALF * ldb * 2;
    const unsigned ldsw = (unsigned)wid * 1024u;
    const int aoff = lds_byte(wr * 64 + fr, fq * 8), boff = lds_byte(wc * 32 + fr, fq * 8);
#define PG8_AOFF(of, u) do { _Pragma("unroll") for (int hh_ = 0; hh_ < 2; ++hh_) _Pragma("unroll") for (int i_ = 0; i_ < 2; ++i_) { \
        if constexpr (GATHER) of[hh_][i_] = (unsigned)gidx[(u).pm * 256 + hh_ * 128 + RA[i_]] * (unsigned)(lda * 2) + CA2[i_]; \
        else of[hh_][i_] = (unsigned)((hh_ * HALF + RA[i_]) * lda) * 2u + CA2[i_]; } } while (0)
#define PG8_SA(b, h) (((b) * 2 + (h)) * HTB)
#define PG8_SB(b, h) ((4 + (b) * 2 + (h)) * HTB)
#define PG8_STAGE(bufoff, gbase, voff) do { _Pragma("unroll") for (int _i = 0; _i < 2; ++_i) \
        __builtin_amdgcn_global_load_lds((const unsigned*)((const char*)(gbase) + (voff)[_i]), (LAS unsigned*)(lds + (bufoff) + ldsw + _i * 8192), 16, 0, 0); } while (0)
#define PG8_LDA(dst, b, h) do { _Pragma("unroll") for (int m = 0; m < 4; ++m) _Pragma("unroll") for (int k = 0; k < 2; ++k) dst[m][k] = *(const LAS bf16x8*)(lds + PG8_SA(b, h) + aoff + m * 2048 + k * 1024); } while (0)
#define PG8_LDB(dst, b, h) do { _Pragma("unroll") for (int n = 0; n < 2; ++n) _Pragma("unroll") for (int k = 0; k < 2; ++k) dst[n][k] = *(const LAS bf16x8*)(lds + PG8_SB(b, h) + boff + n * 2048 + k * 1024); } while (0)
#define PG8_MMA(ai, bj, At, Bt) do { __builtin_amdgcn_s_setprio(1); _Pragma("unroll") for (int m = 0; m < 4; ++m) _Pragma("unroll") for (int n = 0; n < 2; ++n) _Pragma("unroll") for (int k = 0; k < 2; ++k) \
        acc[ai][bj][m][n] = __builtin_amdgcn_mfma_f32_16x16x32_bf16(Bt[n][k], At[m][k], acc[ai][bj][m][n], 0, 0, 0); __builtin_amdgcn_s_setprio(0); } while (0)
#define PG8_WAIT_V(n) asm volatile("s_waitcnt vmcnt(" #n ")" ::: "memory")
#define PG8_WAIT_L(n) asm volatile("s_waitcnt lgkmcnt(" #n ")" ::: "memory")
#define PG8_BAR __builtin_amdgcn_s_barrier()
#define PG8_SCHED __builtin_amdgcn_sched_barrier(0)
    GUnit cur, nxt; int ui = 0;
    if (!S.next(0, cur)) return;
    f32x4 acc[2][2][4][2];
#pragma unroll
    for (int a = 0; a < 2; ++a)
#pragma unroll
        for (int b = 0; b < 2; ++b)
#pragma unroll
            for (int m = 0; m < 4; ++m)
#pragma unroll
                for (int n = 0; n < 2; ++n) acc[a][b][m][n] = (f32x4){0.f, 0.f, 0.f, 0.f};
    bf16x8 At[4][2], B0[2][2], B1[2][2];
    unsigned ofc[2][2], ofn[2][2];
    PG8_AOFF(ofc, cur);
#pragma unroll
    for (int hh = 0; hh < 2; ++hh)
#pragma unroll
        for (int i = 0; i < 2; ++i) ofn[hh][i] = ofc[hh][i];
    const char* cA = cur.a; const char* cB = cur.b;
    PG8_STAGE(PG8_SB(0, 0), cB, voffB); PG8_STAGE(PG8_SB(0, 1), cB + hstepB, voffB); PG8_STAGE(PG8_SA(0, 0), cA, ofc[0]); PG8_STAGE(PG8_SA(0, 1), cA, ofc[1]);
    if (wr == 1) PG8_BAR;
    PG8_WAIT_V(2); PG8_BAR;
    PG8_STAGE(PG8_SB(1, 0), cB + kstep, voffB); PG8_STAGE(PG8_SA(1, 0), cA + kstep, ofc[0]); PG8_STAGE(PG8_SB(1, 1), cB + hstepB + kstep, voffB);
    PG8_WAIT_V(6); PG8_BAR;
    for (;;) {
        const bool has_next = S.next(ui + 1, nxt);
        const char* nA = has_next ? nxt.a : cA; const char* nB = has_next ? nxt.b : cB;
        for (int t = 0; t < nt; t += 2) {
            const bool last = (t == nt - 2);
            if constexpr (GATHER) { if (last && has_next) PG8_AOFF(ofn, nxt); }
            const char* a1 = cA + (size_t)(t + 1) * kstep;
            const char* a2 = last ? nA : cA + (size_t)(t + 2) * kstep; const char* b2 = last ? nB : cB + (size_t)(t + 2) * kstep;
            const char* a3 = a2 + kstep; const char* b3 = b2 + kstep;
            unsigned o2[2][2];
#pragma unroll
            for (int hh = 0; hh < 2; ++hh)
#pragma unroll
                for (int i = 0; i < 2; ++i) { if constexpr (GATHER) o2[hh][i] = last ? ofn[hh][i] : ofc[hh][i]; else o2[hh][i] = ofc[hh][i]; }
            PG8_LDB(B0, 0, 0); PG8_LDB(B1, 0, 1); PG8_SCHED; PG8_LDA(At, 0, 0); PG8_STAGE(PG8_SA(1, 1), a1, ofc[1]);
            PG8_WAIT_V(8); PG8_WAIT_L(0); PG8_BAR; PG8_MMA(0, 0, At, B0); PG8_MMA(0, 1, At, B1); PG8_BAR; PG8_SCHED;
            PG8_LDA(At, 0, 1); PG8_STAGE(PG8_SB(0, 0), b2, voffB); PG8_STAGE(PG8_SB(0, 1), b2 + hstepB, voffB); PG8_STAGE(PG8_SA(0, 0), a2, o2[0]);
            PG8_WAIT_V(8); PG8_WAIT_L(0); PG8_BAR; PG8_MMA(1, 0, At, B0); PG8_MMA(1, 1, At, B1); PG8_BAR; PG8_SCHED;
            PG8_LDB(B0, 1, 0); PG8_LDB(B1, 1, 1); PG8_SCHED; PG8_LDA(At, 1, 0); PG8_STAGE(PG8_SA(0, 1), a2, o2[1]);
            PG8_WAIT_V(8); PG8_WAIT_L(0); PG8_BAR; PG8_MMA(0, 0, At, B0); PG8_MMA(0, 1, At, B1); PG8_BAR; PG8_SCHED;
            PG8_LDA(At, 1, 1); PG8_STAGE(PG8_SB(1, 0), b3, voffB); PG8_STAGE(PG8_SB(1, 1), b3 + hstepB, voffB); PG8_STAGE(PG8_SA(1, 0), a3, o2[0]);
            PG8_WAIT_V(8); PG8_WAIT_L(0); PG8_BAR; PG8_MMA(1, 0, At, B0); PG8_MMA(1, 1, At, B1); PG8_BAR; PG8_SCHED;
        }
        if (wr == 0) PG8_BAR;
        E(acc, cur, wr, wc, fr, fq);
        if (!has_next) break;
#pragma unroll
        for (int a = 0; a < 2; ++a)
#pragma unroll
            for (int b = 0; b < 2; ++b)
#pragma unroll
                for (int m = 0; m < 4; ++m)
#pragma unroll
                    for (int n = 0; n < 2; ++n) acc[a][b][m][n] = (f32x4){0.f, 0.f, 0.f, 0.f};
        cur = nxt; cA = nA; cB = nB; ++ui;
        if constexpr (GATHER) {
#pragma unroll
            for (int hh = 0; hh < 2; ++hh)
#pragma unroll
                for (int i = 0; i < 2; ++i) ofc[hh][i] = ofn[hh][i];
        }
        if (wr == 1) PG8_BAR;
    }
    PG8_WAIT_V(0);
    PG8_BAR;
#undef PG8_AOFF
#undef PG8_SA
#undef PG8_SB
#undef PG8_STAGE
#undef PG8_LDA
#undef PG8_LDB
#undef PG8_MMA
#undef PG8_WAIT_V
#undef PG8_WAIT_L
#undef PG8_BAR
#undef PG8_SCHED
}
}
using pg8::GUnit;

struct SchedProj {
    const char* H; const char* WIN; const char* WPQ; int G, c;
    __device__ __forceinline__ bool next(int i, GUnit& u) const {
        const int L = i * G + c; if (L >= 480) return false;
        if (L < 416) { int pm, pn; pg8::dense_map(L, 32, 13, pm, pn); u.pm = pm; u.pn = pn; u.z = 0; u.a = H + (size_t)pm * 256 * 2048 * 2; u.b = WIN + (size_t)pn * 256 * 2048 * 2; }
        else { int pm, pn; pg8::dense_map(L - 416, 2, 32, pm, pn); u.pm = pm; u.pn = pn + 64; u.z = 0; u.a = WPQ + (size_t)pm * 256 * 2048 * 2; u.b = H + (size_t)pn * 256 * 2048 * 2; }
        return true;
    }
};
struct SchedDft {
    const char* DFT; const char* XAT; int G, c;
    __device__ __forceinline__ bool next(int i, GUnit& u) const {
        const int L = i * G + c; if (L >= 256) return false;
        const int Lp = (L & 7) * 32 + (L >> 3);
        const int ks = Lp & 1, pn = (Lp >> 1) & 1, pm = (Lp >> 2) & 15, b = Lp >> 6;
        u.pm = b * 16 + pm; u.pn = pn; u.z = ks;
        u.a = DFT + ((size_t)pm * 256 * 2048 + ks * 1024) * 2; u.b = XAT + (((size_t)b * 512 + pn * 256) * 2048 + ks * 1024) * 2;
        return true;
    }
};
struct SchedDense {
    const char* A; const char* B; int nM, nN, K, G, c;
    __device__ __forceinline__ bool next(int i, GUnit& u) const {
        const int L = i * G + c; if (L >= nM * nN) return false;
        int pm, pn; pg8::dense_map(L, nM, nN, pm, pn); u.pm = pm; u.pn = pn; u.z = 0;
        u.a = A + (size_t)pm * 256 * K * 2; u.b = B + (size_t)pn * 256 * K * 2; return true;
    }
};
struct SchedMoeG {
    const char* A; const char* B; int K, G, c;
    __device__ __forceinline__ bool next(int i, GUnit& u) const {
        const int L = i * G + c; if (L >= 512) return false;
        const int Lp = (L & 7) * 64 + (L >> 3);
        const int e = Lp >> 5, r = Lp & 31, pm = r & 3, pn = r >> 2;
        u.pm = e * 4 + pm; u.pn = pn; u.z = e;
        u.a = A; u.b = B + ((size_t)e * 2048 + pn * 256) * K * 2; return true;
    }
};
struct SchedMoe {
    const char* A; const char* B; int K, G, c;
    __device__ __forceinline__ bool next(int i, GUnit& u) const {
        const int L = i * G + c; if (L >= 512) return false;
        const int Lp = (L & 7) * 64 + (L >> 3);
        const int e = Lp >> 5, r = Lp & 31, pm = r & 3, pn = r >> 2;
        u.pm = e * 4 + pm; u.pn = pn; u.z = e;
        u.a = A + ((size_t)e * 1024 + pm * 256) * K * 2; u.b = B + ((size_t)e * 2048 + pn * 256) * K * 2; return true;
    }
};

typedef f32x4 AccT[2][2][4][2];
struct EpiProj {
    static constexpr bool PERM = true;
    bf16_t* PROJ; bf16_t* PQT; const float* ropec; const float* ropes;
    __device__ __forceinline__ void operator()(const AccT& acc, const GUnit& u, int wr, int wc, int fr, int fq) const {
        if (u.pn < 64) {
            const int pn = u.pn;
            const int row0 = u.pm * 256 + wr * 64 + fr;
#pragma unroll
            for (int ai = 0; ai < 2; ++ai)
#pragma unroll
                for (int m = 0; m < 4; ++m) {
                    const int row = row0 + ai * 128 + m * 16;
                    float vsq = 0.f;
#pragma unroll
                    for (int bj = 0; bj < 2; ++bj) {
                        f32x4 v0 = acc[ai][bj][m][0], v1 = acc[ai][bj][m][1];
                        const int colt = pn * 256 + bj * 128;
                        if (pn < 4) {
#pragma unroll
                            for (int j = 0; j < 4; ++j) { v0[j] = gelu_tanh(v0[j]); v1[j] = gelu_tanh(v1[j]); vsq += v0[j] * v0[j] + v1[j] * v1[j]; }
                        } else {
                            const bool isq = (colt >= PC_QC && colt < PC_KC) || (colt >= PC_QD && colt < PC_KD);
                            const bool isk = (colt >= PC_KC && colt < PC_VC) || (colt >= PC_KD && colt < PC_VD);
                            if (isq || isk) {
                                if ((wc & 1) == 0) {
                                    f32x4 o0, o1;
#pragma unroll
                                    for (int j = 0; j < 4; ++j) { o0[j] = __shfl_xor(v0[j], 16); o1[j] = __shfl_xor(v1[j], 16); }
                                    if (fq < 2) {
                                        const f32x4 c0 = *(const f32x4*)(ropec + (size_t)row * 8), c1 = *(const f32x4*)(ropec + (size_t)row * 8 + 4);
                                        const f32x4 s0 = *(const f32x4*)(ropes + (size_t)row * 8), s1 = *(const f32x4*)(ropes + (size_t)row * 8 + 4);
                                        const float sg = fq == 0 ? -1.f : 1.f;
#pragma unroll
                                        for (int j = 0; j < 4; ++j) { v0[j] = v0[j] * c0[j] + sg * o0[j] * s0[j]; v1[j] = v1[j] * c1[j] + sg * o1[j] * s1[j]; }
                                    }
                                }
                                if (isq) { v0 = v0 * 0.125f; v1 = v1 * 0.125f; }
                            }
                        }
                        u32x4 w; w.x = pk2(v0[0], v0[1]); w.y = pk2(v0[2], v0[3]); w.z = pk2(v1[0], v1[1]); w.w = pk2(v1[2], v1[3]);
                        *(u32x4*)(PROJ + (size_t)row * NPROJ + colt + wc * 32 + 8 * fq) = w;
                    }
                    if (pn == 2 || pn == 3) {
                        vsq += __shfl_xor(vsq, 16); vsq += __shfl_xor(vsq, 32);
                        if (fq == 0) ((float*)((char*)PROJ + (WS_VSS - WS_PROJ)))[(size_t)row * 8 + (pn - 2) * 4 + wc] = vsq;
                    }
                }
        } else {
#pragma unroll
            for (int ai = 0; ai < 2; ++ai)
#pragma unroll
                for (int m = 0; m < 4; ++m) {
                    const int c = u.pm * 256 + ai * 128 + wr * 64 + m * 16 + fr;
#pragma unroll
                    for (int bj = 0; bj < 2; ++bj) {
                        const int t = (u.pn - 64) * 256 + bj * 128 + wc * 32 + 8 * fq, b = t >> 11, s = t & 2047;
                        const f32x4 v0 = acc[ai][bj][m][0], v1 = acc[ai][bj][m][1];
                        u32x4 w; w.x = pk2(v0[0], v0[1]); w.y = pk2(v0[2], v0[3]); w.z = pk2(v1[0], v1[1]); w.w = pk2(v1[2], v1[3]);
                        *(u32x4*)(PQT + (((size_t)b * 512 + c) * 2048 + s)) = w;
                    }
                }
        }
    }
};
struct EpiBf16Plain {
    static constexpr bool PERM = true;
    bf16_t* O; int ldc; size_t zstride;
    __device__ __forceinline__ void operator()(const AccT& acc, const GUnit& u, int wr, int wc, int fr, int fq) const {
        bf16_t* base = O + (size_t)u.z * zstride;
#pragma unroll
        for (int ai = 0; ai < 2; ++ai)
#pragma unroll
            for (int m = 0; m < 4; ++m) {
                const int row = u.pm * 256 + ai * 128 + wr * 64 + m * 16 + fr;
#pragma unroll
                for (int bj = 0; bj < 2; ++bj) {
                    const f32x4 v0 = acc[ai][bj][m][0], v1 = acc[ai][bj][m][1];
                    u32x4 w; w.x = pk2(v0[0], v0[1]); w.y = pk2(v0[2], v0[3]); w.z = pk2(v1[0], v1[1]); w.w = pk2(v1[2], v1[3]);
                    *(u32x4*)(base + (size_t)row * ldc + u.pn * 256 + bj * 128 + wc * 32 + 8 * fq) = w;
                }
            }
    }
};
struct EpiWout {
    static constexpr bool PERM = true;
    const float* base32; const bf16_t* base16; bf16_t* X2; const float* gate;
    __device__ __forceinline__ void operator()(const AccT& acc, const GUnit& u, int wr, int wc, int fr, int fq) const {
        const int b = u.pm >> 3;
        const int col0 = u.pn * 256 + wc * 32 + 8 * fq;
        f32x4 g[2][2];
#pragma unroll
        for (int bj = 0; bj < 2; ++bj)
#pragma unroll
            for (int n = 0; n < 2; ++n) g[bj][n] = *(const f32x4*)(gate + (size_t)b * 12288 + col0 + bj * 128 + n * 4);
#pragma unroll
        for (int ai = 0; ai < 2; ++ai)
#pragma unroll
            for (int m = 0; m < 4; ++m) {
                const size_t ro = (size_t)(u.pm * 256 + ai * 128 + wr * 64 + m * 16 + fr) * DM + col0;
#pragma unroll
                for (int bj = 0; bj < 2; ++bj) {
                    f32x4 x0, x1;
                    if (base32) { x0 = *(const f32x4*)(base32 + ro + bj * 128); x1 = *(const f32x4*)(base32 + ro + bj * 128 + 4); }
                    else { const u32x4 w = *(const u32x4*)(base16 + ro + bj * 128); x0 = (f32x4){bflo(w.x), bfhi(w.x), bflo(w.y), bfhi(w.y)}; x1 = (f32x4){bflo(w.z), bfhi(w.z), bflo(w.w), bfhi(w.w)}; }
                    const f32x4 v0 = x0 + g[bj][0] * acc[ai][bj][m][0], v1 = x1 + g[bj][1] * acc[ai][bj][m][1];
                    u32x4 o; o.x = pk2(v0[0], v0[1]); o.y = pk2(v0[2], v0[3]); o.z = pk2(v1[0], v1[1]); o.w = pk2(v1[2], v1[3]);
                    *(u32x4*)(X2 + ro + bj * 128) = o;
                }
            }
    }
};
struct EpiGU {
    static constexpr bool PERM = true;
    bf16_t* ACT;
    __device__ __forceinline__ void operator()(const AccT& acc, const GUnit& u, int wr, int wc, int fr, int fq) const {
#pragma unroll
        for (int ai = 0; ai < 2; ++ai)
#pragma unroll
            for (int m = 0; m < 4; ++m) {
                const int row = u.pm * 256 + ai * 128 + wr * 64 + m * 16 + fr;
                f32x4 v0, v1;
#pragma unroll
                for (int j = 0; j < 4; ++j) { v0[j] = silu_f(acc[ai][0][m][0][j]) * acc[ai][1][m][0][j]; v1[j] = silu_f(acc[ai][0][m][1][j]) * acc[ai][1][m][1][j]; }
                u32x4 w; w.x = pk2(v0[0], v0[1]); w.y = pk2(v0[2], v0[3]); w.z = pk2(v1[0], v1[1]); w.w = pk2(v1[2], v1[3]);
                *(u32x4*)(ACT + (size_t)row * FF + u.pn * 128 + wc * 32 + 8 * fq) = w;
            }
    }
};
struct EpiDown {
    static constexpr bool PERM = true;
    bf16_t* EO; const float* gate;
    __device__ __forceinline__ void operator()(const AccT& acc, const GUnit& u, int wr, int wc, int fr, int fq) const {
#pragma unroll
        for (int ai = 0; ai < 2; ++ai)
#pragma unroll
            for (int m = 0; m < 4; ++m) {
                const int row = u.pm * 256 + ai * 128 + wr * 64 + m * 16 + fr;
                const float g = gate[row];
#pragma unroll
                for (int bj = 0; bj < 2; ++bj) {
                    const f32x4 v0 = acc[ai][bj][m][0] * g, v1 = acc[ai][bj][m][1] * g;
                    u32x4 w; w.x = pk2(v0[0], v0[1]); w.y = pk2(v0[2], v0[3]); w.z = pk2(v1[0], v1[1]); w.w = pk2(v1[2], v1[3]);
                    *(u32x4*)(EO + (size_t)row * DM + u.pn * 256 + bj * 128 + wc * 32 + 8 * fq) = w;
                }
            }
    }
};

__device__ __forceinline__ void ph_mod(const Params& p, LAS unsigned char* lds) {
    LAS float* sl = (LAS float*)lds;
    LAS float* red = (LAS float*)(lds + 32768);
    const int tid = opaque_tid();
    const float* c = p.in[1];
    float* mod = (float*)(p.ws + WS_MOD);
    for (int i = tid; i < 8192; i += 512) { const float v = c[i]; sl[i] = v / (1.f + expf(-v)); }
    __syncthreads();
    const int cl = tid & 31, ks = tid >> 5;
    for (int u = blockIdx.x; u < 192; u += gridDim.x) {
        const int l = u / 96, cc = u % 96;
        const float* W = p.in[3] + (size_t)l * 2048 * 12288 + cc * 128 + cl * 4;
        float acc[4][4];
#pragma unroll
        for (int b = 0; b < 4; ++b)
#pragma unroll
            for (int j = 0; j < 4; ++j) acc[b][j] = 0.f;
#pragma unroll 8
        for (int k = ks; k < 2048; k += 16) {
            const f32x4 w = __builtin_nontemporal_load((const f32x4*)(W + (size_t)k * 12288));
#pragma unroll
            for (int b = 0; b < 4; ++b) { const float s = sl[b * 2048 + k];
#pragma unroll
                for (int j = 0; j < 4; ++j) acc[b][j] += s * w[j]; }
        }
#pragma unroll
        for (int b = 0; b < 4; ++b)
#pragma unroll
            for (int j = 0; j < 4; ++j) red[((b * 4 + j) * 16 + ks) * 32 + cl] = acc[b][j];
        __syncthreads();
        { const int b = tid >> 7, col = tid & 127; float s = 0.f;
#pragma unroll
          for (int q = 0; q < 16; ++q) s += red[((b * 4 + (col & 3)) * 16 + q) * 32 + (col >> 2)];
          mod[(size_t)(l * 4 + b) * 12288 + cc * 128 + col] = s + p.in[4][(size_t)l * 12288 + cc * 128 + col]; }
        __syncthreads();
    }
}
__device__ __forceinline__ void ph_tables(const Params& p, LAS unsigned char* lds) {
    const int tid = opaque_tid();
    const int gt = blockIdx.x * 512 + tid, ngt = gridDim.x * 512;
    LAS float* ct = (LAS float*)lds;
    LAS float* c64 = ct + 2048;
    for (int m = tid; m < 2048; m += 512) ct[m] = cospif((float)m * (1.f / 1024.f));
    if (tid < 64) { c64[tid] = cospif((float)tid * (1.f / 32.f)); c64[64 + tid] = sinpif((float)tid * (1.f / 32.f)); }
    __syncthreads();
    float* rc = (float*)(p.ws + WS_ROPE); float* rs = rc + NT * 8;
    const int* pos = (const int*)p.in[2];
    for (int i = gt; i < NT * 8; i += ngt) {
        const int t = i >> 3, j = i & 7;
        float inv;
        switch (j) { case 0: inv = 1.0f; break; case 1: inv = 0.1939227432012558f; break; case 2: inv = 0.03760603070259094f; break; case 3: inv = 0.007292664609849453f; break;
                     case 4: inv = 0.0014142135623842478f; break; case 5: inv = 0.00027424818836152554f; break; case 6: inv = 5.318296098266728e-05f; break; default: inv = 1.0313386155758053e-05f; break; }
        const float ang = (float)pos[t] * inv;
        double r = (double)ang * 0.15915494309189535; r -= floor(r);
        const float a = (float)(2.0 * r);
        rc[i] = cospif(a); rs[i] = sinpif(a);
    }
    { bf16_t* sw = (bf16_t*)(p.ws + WS_SGUW);
      for (int i = gt; i < 2 * 8 * 128 * 128 / 4; i += ngt) { const f32x4 w = *(const f32x4*)(p.in[9] + (size_t)i * 4); u32x2 o; o.x = pk2(w[0], w[1]); o.y = pk2(w[2], w[3]); *(u32x2*)(sw + (size_t)i * 4) = o; } }
    { bf16_t* wrt = (bf16_t*)(p.ws + WS_WRT);
      for (int i = gt; i < 2 * 16 * 2048; i += ngt) { const int l = i >> 15, e = (i >> 11) & 15, k = i & 2047; wrt[i] = (bf16_t)(pk2(p.in[15][((size_t)l * 2048 + k) * 16 + e], 0.f) & 0xffffu); } }
    { bf16_t* abt = (bf16_t*)(p.ws + WS_ABT);
      for (int i = gt; i < 2 * 8 * 64 * 128; i += ngt) { const int k = i & 127, d = (i >> 7) & 63, lh = i >> 13, c = k & 63; const float* fw = p.in[7] + (size_t)lh * 4096;
          float sacc = 0.f;
          for (int cp = 0; cp < 64; ++cp) sacc += c64[(k < 64 ? 0 : 64) + ((c * cp) & 63)] * fw[cp * 64 + d];
          abt[i] = (bf16_t)(pk2(sacc * 0.125f, 0.f) & 0xffffu); } }
    bf16_t* dft = (bf16_t*)(p.ws + WS_DFT);
    for (int i = gt; i < 2048 * 512; i += ngt) {
        const int sp = i >> 9, k8 = (i & 511) * 8;
        float v[8];
#pragma unroll
        for (int e = 0; e < 8; ++e) { const int k = k8 + e, part = k >> 11, s = k & 2047, m = (s * sp + part * 512) & 2047;
            v[e] = ct[m] * 0.022097086912079608f; }
        u32x4 w; w.x = pk2(v[0], v[1]); w.y = pk2(v[2], v[3]); w.z = pk2(v[4], v[5]); w.w = pk2(v[6], v[7]);
        *(u32x4*)(dft + (size_t)sp * 4096 + k8) = w;
    }
    __syncthreads();
}
struct TDesc { const float* src; bf16_t* dst; const float* ksc; int lds_, ldd; };
__device__ __forceinline__ bool tdecode(const Params& p, int it, TDesc& d) {
    if (it >= 2 * 6880) return false;
    const int l = it / 6880; int r = it % 6880;
    d.ksc = nullptr;
    if (r < 480) { const int kt = r / 30, nt = r % 30;
        d.src = p.in[6] + ((size_t)l * 2048 + kt * 128) * DIN + nt * 128; d.lds_ = DIN;
        d.dst = (nt < 4 ? (bf16_t*)(p.ws + WS_WPQ) + ((size_t)l * 512 + nt * 128) * 2048 : (bf16_t*)(p.ws + WS_WIN) + ((size_t)l * NPROJ + (nt - 4) * 128) * 2048) + kt * 128; d.ldd = 2048; return true; }
    r -= 480;
    if (r < 256) { const int kt = r / 16, nt = r % 16;
        d.src = p.in[13] + ((size_t)l * 2048 + kt * 128) * 2048 + nt * 128; d.lds_ = 2048; d.ksc = p.in[12] + (size_t)l * 2048 + kt * 128;
        d.dst = (bf16_t*)(p.ws + WS_WOUT) + ((size_t)l * 2048 + nt * 128) * 2048 + kt * 128; d.ldd = 2048; return true; }
    r -= 256;
    if (r < 4096) { const int isup = r / 2048, r2 = r % 2048, e = r2 / 128, kt = (r2 % 128) / 8, nt = r2 % 8;
        d.src = p.in[isup ? 17 : 16] + (((size_t)l * 16 + e) * 2048 + kt * 128) * 1024 + nt * 128; d.lds_ = 1024;
        d.dst = (bf16_t*)(p.ws + WS_WGU) + (((size_t)l * 16 + e) * 2048 + nt * 256 + isup * 128) * 2048 + kt * 128; d.ldd = 2048; return true; }
    r -= 4096;
    { const int e = r / 128, kt = (r % 128) / 16, nt = r % 16;
        d.src = p.in[18] + (((size_t)l * 16 + e) * 1024 + kt * 128) * 2048 + nt * 128; d.lds_ = 2048;
        d.dst = (bf16_t*)(p.ws + WS_WD) + (((size_t)l * 16 + e) * 2048 + nt * 128) * 1024 + kt * 128; d.ldd = 1024; return true; }
}
__device__ __forceinline__ void ph_weights(const Params& p, LAS unsigned char* lds, const int p0, const int p1, const int wi, const int wn) {
    const int tid = opaque_tid();
    LAS unsigned* l32 = (LAS unsigned*)lds;
    LAS bf16_t* l16 = (LAS bf16_t*)lds;
    TDesc dA0, dA1, dB0, dB1; f32x4 a0[8], a1[8], b0[8], b1[8];
#define PW_LOAD(pi, D0, D1, V0, V1, HAVE) do { HAVE = (pi) < p1; if (HAVE) { tdecode(p, 2 * (pi), D0); tdecode(p, 2 * (pi) + 1, D1); \
        _Pragma("unroll") for (int i = 0; i < 8; ++i) { const int f = tid + 512 * i, k = f >> 5, c4 = f & 31; \
            V0[i] = __builtin_nontemporal_load((const f32x4*)(D0.src + (size_t)k * D0.lds_ + c4 * 4)); V1[i] = __builtin_nontemporal_load((const f32x4*)(D1.src + (size_t)k * D1.lds_ + c4 * 4)); } } } while (0)
#define PW_TOLDS(D0, V0, V1) do { _Pragma("unroll") for (int i = 0; i < 8; ++i) { const int f = tid + 512 * i, k = f >> 5, c4 = f & 31; const float sc = D0.ksc ? D0.ksc[k] : 1.f; \
        const int sw = ((k >> 3) & 15) * 2; u32x2 w; w.x = pk2(V0[i][0] * sc, V0[i][1] * sc); w.y = pk2(V0[i][2] * sc, V0[i][3] * sc); \
        *(LAS u32x2*)(l32 + k * 64 + ((2 * c4) ^ sw)) = w; \
        u32x2 w2; w2.x = pk2(V1[i][0] * sc, V1[i][1] * sc); w2.y = pk2(V1[i][2] * sc, V1[i][3] * sc); \
        *(LAS u32x2*)(l32 + 8192 + k * 64 + ((2 * c4) ^ sw)) = w2; } } while (0)
#define PW_STORE(DS0, DS1) do { _Pragma("unroll") for (int i = 0; i < 4; ++i) { \
        const int n = (tid >> 4) + 32 * i, kc = tid & 15, cd = (n >> 1) ^ (2 * kc), hf = n & 1; \
        unsigned short e[8], g[8]; \
        _Pragma("unroll") for (int q = 0; q < 8; ++q) { e[q] = l16[((8 * kc + q) * 64 + cd) * 2 + hf]; g[q] = l16[16384 + ((8 * kc + q) * 64 + cd) * 2 + hf]; } \
        u32x4 w; w.x = e[0] | ((unsigned)e[1] << 16); w.y = e[2] | ((unsigned)e[3] << 16); w.z = e[4] | ((unsigned)e[5] << 16); w.w = e[6] | ((unsigned)e[7] << 16); \
        __builtin_nontemporal_store(w, (u32x4*)(DS0.dst + (size_t)n * DS0.ldd + 8 * kc)); \
        u32x4 w2; w2.x = g[0] | ((unsigned)g[1] << 16); w2.y = g[2] | ((unsigned)g[3] << 16); w2.z = g[4] | ((unsigned)g[5] << 16); w2.w = g[6] | ((unsigned)g[7] << 16); \
        __builtin_nontemporal_store(w2, (u32x4*)(DS1.dst + (size_t)n * DS1.ldd + 8 * kc)); } } while (0)
    int pi = p0 + wi; bool hA, hB;
    PW_LOAD(pi, dA0, dA1, a0, a1, hA);
    PW_LOAD(pi + wn, dB0, dB1, b0, b1, hB);
    while (hA) {
        { PW_TOLDS(dA0, a0, a1); __syncthreads(); const TDesc s0 = dA0, s1 = dA1; PW_LOAD(pi + 2 * wn, dA0, dA1, a0, a1, hA); PW_STORE(s0, s1); __syncthreads(); }
        if (!hB) break;
        { PW_TOLDS(dB0, b0, b1); __syncthreads(); const TDesc s0 = dB0, s1 = dB1; PW_LOAD(pi + 3 * wn, dB0, dB1, b0, b1, hB); PW_STORE(s0, s1); __syncthreads(); }
        pi += 2 * wn;
    }
#undef PW_LOAD
#undef PW_TOLDS
#undef PW_STORE
}

__device__ __forceinline__ void ph_norm1(const Params& p, int mode) {
    const int tid = opaque_tid(), lane = tid & 63, wv = tid >> 6;
    const float* mod = (const float*)(p.ws + WS_MOD);
    const int* slot_of = (const int*)(p.ws + WS_IDX + 131072);
    const bf16_t* EO = (const bf16_t*)(p.ws + WS_EO);
    for (int t = blockIdx.x * 8 + wv; t < NT; t += gridDim.x * 8) {
        const int b = t >> 11;
        f32x4 v[8];
        if (mode == 0) { const float* xr = p.in[0] + (size_t)t * DM;
#pragma unroll
            for (int j = 0; j < 8; ++j) v[j] = *(const f32x4*)(xr + 4 * lane + 256 * j);
        } else { const bf16_t* xr = (const bf16_t*)(p.ws + WS_X2) + (size_t)t * DM;
#pragma unroll
            for (int j = 0; j < 8; ++j) { const u32x2 w = *(const u32x2*)(xr + 4 * lane + 256 * j); v[j] = (f32x4){bflo(w.x), bfhi(w.x), bflo(w.y), bfhi(w.y)}; }
        }
        if (mode != 0) {
            f32x4 macc[8];
#pragma unroll
            for (int j = 0; j < 8; ++j) macc[j] = (f32x4){0.f, 0.f, 0.f, 0.f};
            const int myslot = slot_of[(size_t)(lane & 15) * NT + t];
            unsigned m = (unsigned)(__ballot(myslot >= 0) & 0xffffull);
            while (m) {
                const int e0 = __builtin_ctz(m); m &= m - 1u;
                const bool two = m != 0u; const int e1 = two ? __builtin_ctz(m) : e0; if (two) m &= m - 1u;
                const int s0 = __builtin_amdgcn_readlane(myslot, e0), s1 = __builtin_amdgcn_readlane(myslot, e1);
                const float w1 = two ? 1.f : 0.f;
                const bf16_t* r0 = EO + (size_t)s0 * DM; const bf16_t* r1 = EO + (size_t)s1 * DM;
                u32x2 a[8], c[8];
#pragma unroll
                for (int j = 0; j < 8; ++j) { a[j] = *(const u32x2*)(r0 + 4 * lane + 256 * j); c[j] = *(const u32x2*)(r1 + 4 * lane + 256 * j); }
#pragma unroll
                for (int j = 0; j < 8; ++j) {
                    macc[j][0] += bflo(a[j].x) + w1 * bflo(c[j].x); macc[j][1] += bfhi(a[j].x) + w1 * bfhi(c[j].x);
                    macc[j][2] += bflo(a[j].y) + w1 * bflo(c[j].y); macc[j][3] += bfhi(a[j].y) + w1 * bfhi(c[j].y); }
            }
            const float* gf = mod + ((size_t)(mode - 1) * 4 + b) * 12288 + 5 * 2048;
#pragma unroll
            for (int j = 0; j < 8; ++j) { const f32x4 g = *(const f32x4*)(gf + 4 * lane + 256 * j); v[j] = v[j] + g * macc[j]; }
            if (mode == 1) {
                bf16_t* xo = (bf16_t*)(p.ws + WS_X) + (size_t)t * DM;
#pragma unroll
                for (int j = 0; j < 8; ++j) { u32x2 w; w.x = pk2(v[j][0], v[j][1]); w.y = pk2(v[j][2], v[j][3]); *(u32x2*)(xo + 4 * lane + 256 * j) = w;
                    v[j] = (f32x4){bflo(w.x), bfhi(w.x), bflo(w.y), bfhi(w.y)}; }
            }
        }
        float ss = 0.f;
#pragma unroll
        for (int j = 0; j < 8; ++j) ss += v[j][0] * v[j][0] + v[j][1] * v[j][1] + v[j][2] * v[j][2] + v[j][3] * v[j][3];
        const float r = 1.0f / sqrtf(wave_sum(ss) * (1.f / DM) + EPS);
        if (mode == 2) {
            float* o = p.out + (size_t)t * DM;
#pragma unroll
            for (int j = 0; j < 8; ++j) { const f32x4 g = *(const f32x4*)(p.in[19] + 4 * lane + 256 * j); *(f32x4*)(o + 4 * lane + 256 * j) = v[j] * r * g; }
        } else {
            const int l = mode;
            const float* g1 = p.in[5] + (size_t)l * DM;
            const float* sh = mod + ((size_t)l * 4 + b) * 12288;
            const float* sc = sh + 2048;
            bf16_t* ho = (bf16_t*)(p.ws + WS_H) + (size_t)t * DM;
#pragma unroll
            for (int j = 0; j < 8; ++j) {
                const f32x4 g = *(const f32x4*)(g1 + 4 * lane + 256 * j), s1 = *(const f32x4*)(sc + 4 * lane + 256 * j), s0 = *(const f32x4*)(sh + 4 * lane + 256 * j);
                const f32x4 h = (v[j] * r * g) * (s1 + 1.f) + s0;
                u32x2 w; w.x = pk2(h[0], h[1]); w.y = pk2(h[2], h[3]);
                *(u32x2*)(ho + 4 * lane + 256 * j) = w;
            }
        }
    }
}


__device__ __forceinline__ void ph_norm2_router_mfma(const Params& p, int l, LAS unsigned char* lds) {
    const int tid = opaque_tid(), lane = tid & 63, wv = tid >> 6, r = lane & 31, h = lane >> 5;
    LAS float* part = (LAS float*)lds;
    LAS float* lgs = (LAS float*)(lds + 8 * 32 * 17 * 4);
    const float* mod = (const float*)(p.ws + WS_MOD);
    const float* g2 = p.in[14] + (size_t)l * DM;
    const bf16_t* WRT = (const bf16_t*)(p.ws + WS_WRT) + (size_t)l * 16 * 2048;
    bf16_t* Hb = (bf16_t*)(p.ws + WS_H);
    float* aff = (float*)(p.ws + WS_AFF);
    for (int blk = blockIdx.x; blk < NT / 32; blk += gridDim.x) {
        const int t0 = blk * 32, b = t0 >> 11;
        const float* sh = mod + ((size_t)l * 4 + b) * 12288 + 3 * 2048;
        const float* sc = sh + 2048;
#pragma unroll 1
        for (int half = 0; half < 2; ++half) {
            const int ta = t0 + 4 * wv + 2 * half;
            const bf16_t* xa = (const bf16_t*)(p.ws + WS_X2) + (size_t)ta * DM;
            f32x4 va[8], vb[8];
#pragma unroll
            for (int j = 0; j < 8; ++j) { const u32x2 wa = *(const u32x2*)(xa + 4 * lane + 256 * j), wb = *(const u32x2*)(xa + DM + 4 * lane + 256 * j);
                va[j] = (f32x4){bflo(wa.x), bfhi(wa.x), bflo(wa.y), bfhi(wa.y)}; vb[j] = (f32x4){bflo(wb.x), bfhi(wb.x), bflo(wb.y), bfhi(wb.y)}; }
            float sa = 0.f, sb = 0.f;
#pragma unroll
            for (int j = 0; j < 8; ++j) { sa += va[j][0] * va[j][0] + va[j][1] * va[j][1] + va[j][2] * va[j][2] + va[j][3] * va[j][3]; sb += vb[j][0] * vb[j][0] + vb[j][1] * vb[j][1] + vb[j][2] * vb[j][2] + vb[j][3] * vb[j][3]; }
#pragma unroll
            for (int o = 1; o < 64; o <<= 1) { sa += __shfl_xor(sa, o); sb += __shfl_xor(sb, o); }
            const float ra = 1.0f / sqrtf(sa * (1.f / DM) + EPS), rb = 1.0f / sqrtf(sb * (1.f / DM) + EPS);
            bf16_t* ho = Hb + (size_t)ta * DM;
#pragma unroll
            for (int j = 0; j < 8; ++j) {
                const f32x4 g = *(const f32x4*)(g2 + 4 * lane + 256 * j), s1 = *(const f32x4*)(sc + 4 * lane + 256 * j), s0 = *(const f32x4*)(sh + 4 * lane + 256 * j);
                const f32x4 gg = g * (s1 + 1.f);
                const f32x4 ha = (va[j] * ra) * gg + s0, hb = (vb[j] * rb) * gg + s0;
                u32x2 wa; wa.x = pk2(ha[0], ha[1]); wa.y = pk2(ha[2], ha[3]);
                u32x2 wb; wb.x = pk2(hb[0], hb[1]); wb.y = pk2(hb[2], hb[3]);
                *(u32x2*)(ho + 4 * lane + 256 * j) = wa; *(u32x2*)(ho + DM + 4 * lane + 256 * j) = wb;
            }
        }
        asm volatile("s_waitcnt vmcnt(0)" ::: "memory");
        __syncthreads();
        {
            f32x16 acc;
#pragma unroll
            for (int q = 0; q < 16; ++q) acc[q] = 0.f;
            const bf16_t* bp = Hb + (size_t)(t0 + r) * DM + 256 * wv + 8 * h;
            const bf16_t* ap = WRT + (size_t)(r & 15) * 2048 + 256 * wv + 8 * h;
            bf16x8 bfr[16], afr[16];
#pragma unroll
            for (int s = 0; s < 16; ++s) { bfr[s] = *(const bf16x8*)(bp + 16 * s); afr[s] = *(const bf16x8*)(ap + 16 * s); }
#pragma unroll
            for (int s = 0; s < 16; ++s) { const bf16x8 a = (r < 16) ? afr[s] : (bf16x8){0, 0, 0, 0, 0, 0, 0, 0}; acc = __builtin_amdgcn_mfma_f32_32x32x16_bf16(a, bfr[s], acc, 0, 0, 0); }
#pragma unroll
            for (int q = 0; q < 8; ++q) { const int e = (q & 3) + 8 * (q >> 2) + 4 * h; part[(wv * 32 + r) * 17 + e] = acc[q]; }
        }
        __syncthreads();
        const int e = tid >> 5, tk = tid & 31;
        { float s = 0.f;
#pragma unroll
          for (int w = 0; w < 8; ++w) s += part[(w * 32 + tk) * 17 + e];
          lgs[e * 32 + tk] = s; }
        __syncthreads();
        { float lg[16]; float mx = -1e30f;
#pragma unroll
          for (int q = 0; q < 16; ++q) { lg[q] = lgs[q * 32 + tk]; mx = fmaxf(mx, lg[q]); }
          float den = 0.f, mine = 0.f;
#pragma unroll
          for (int q = 0; q < 16; ++q) { const float ex = expf(lg[q] - mx); den += ex; mine = (q == e) ? ex : mine; }
          aff[((size_t)b * 16 + e) * 2048 + (t0 & 2047) + tk] = mine / den; }
        __syncthreads();
    }
}

__device__ __forceinline__ unsigned block_excl_scan(unsigned cnt, LAS unsigned* wsum, int tid) {
    const int lane = tid & 63, wv = tid >> 6;
    unsigned inc = cnt;
#pragma unroll
    for (int o = 1; o < 64; o <<= 1) { const unsigned t = __shfl_up(inc, o); if (lane >= o) inc += t; }
    if (lane == 63) wsum[wv] = inc;
    __syncthreads();
    unsigned base = 0;
#pragma unroll
    for (int w = 0; w < 8; ++w) base += (w < wv) ? wsum[w] : 0u;
    __syncthreads();
    return base + inc - cnt;
}
__device__ __forceinline__ void ph_topk(const Params& p, LAS unsigned char* lds) {
    const int tid = opaque_tid();
    LAS unsigned* hist = (LAS unsigned*)lds;
    LAS unsigned* misc = hist + 256;
    LAS unsigned* wsum = hist + 320;
    const float* aff = (const float*)(p.ws + WS_AFF);
    int* idx = (int*)(p.ws + WS_IDX); float* gate = (float*)(p.ws + WS_IDX + 65536); int* slot_of = (int*)(p.ws + WS_IDX + 131072);
    for (int u = blockIdx.x; u < 64; u += gridDim.x) {
        const int b = u >> 4, e = u & 15;
        const f32x4 a = *(const f32x4*)(aff + (size_t)u * 2048 + 4 * tid);
        unsigned k[4];
#pragma unroll
        for (int i = 0; i < 4; ++i) k[i] = __float_as_uint(a[i]);
        unsigned prefix = 0, krem = CAP;
#pragma unroll 1
        for (int pass = 0; pass < 4; ++pass) {
            const int shift = 24 - 8 * pass;
            if (tid < 256) hist[tid] = 0;
            __syncthreads();
#pragma unroll
            for (int i = 0; i < 4; ++i) if (pass == 0 || (k[i] >> (shift + 8)) == prefix) __hip_atomic_fetch_add(&hist[(k[i] >> shift) & 255u], 1u, __ATOMIC_RELAXED, __HIP_MEMORY_SCOPE_WORKGROUP);
            __syncthreads();
            { const unsigned cnt = (tid < 256) ? hist[255 - tid] : 0u;
              const unsigned Sn = block_excl_scan(cnt, wsum, tid), S = Sn + cnt;
              if (tid < 256 && S >= krem && Sn < krem) { misc[0] = (prefix << 8) | (unsigned)(255 - tid); misc[1] = krem - Sn; } }
            __syncthreads();
            prefix = misc[0]; krem = misc[1];
            __syncthreads();
        }
        unsigned neq = 0;
#pragma unroll
        for (int i = 0; i < 4; ++i) neq += (k[i] == prefix) ? 1u : 0u;
        unsigned eqbase = block_excl_scan(neq, wsum, tid);
        unsigned sel[4]; unsigned nsel = 0;
#pragma unroll
        for (int i = 0; i < 4; ++i) { const bool eq = k[i] == prefix; sel[i] = (k[i] > prefix || (eq && eqbase < krem)) ? 1u : 0u; eqbase += eq ? 1u : 0u; nsel += sel[i]; }
        unsigned sb = block_excl_scan(nsel, wsum, tid);
#pragma unroll
        for (int i = 0; i < 4; ++i) {
            const int s = 4 * tid + i, t = b * 2048 + s;
            if (sel[i]) { const int row = e * 1024 + b * 256 + (int)sb; idx[row] = t; gate[row] = a[i]; slot_of[(size_t)e * NT + t] = row; ++sb; }
            else slot_of[(size_t)e * NT + t] = -1;
        }
        __syncthreads();
    }
}

__device__ __forceinline__ bf16x8 pack8(float a0, float a1, float a2, float a3, float a4, float a5, float a6, float a7) {
    u32x4 p;
    asm volatile("v_cvt_pk_bf16_f32 %0, %4, %5\n\tv_cvt_pk_bf16_f32 %1, %6, %7\n\tv_cvt_pk_bf16_f32 %2, %8, %9\n\tv_cvt_pk_bf16_f32 %3, %10, %11\n\ts_nop 1"
                 : "=&v"(p[0]), "=&v"(p[1]), "=&v"(p[2]), "=&v"(p[3]) : "v"(a0), "v"(a1), "v"(a2), "v"(a3), "v"(a4), "v"(a5), "v"(a6), "v"(a7));
    return __builtin_bit_cast(bf16x8, p);
}
template <int CH>
__device__ __forceinline__ void attn_prefetch(const bf16_t* qp, const bf16_t* kb, const size_t kst, const int lk0, const int ls, const int r, bf16x8 (&qf)[4], bf16x8 (&kf0)[CH][4]) {
#pragma unroll
    for (int s = 0; s < 4; ++s) qf[s] = *(const bf16x8*)(qp + 16 * s);
#pragma unroll
    for (int i = 0; i < CH; ++i) {
        int lkr = lk0 + 32 * i + r; lkr = lkr < 0 ? 0 : (lkr >= ls ? ls - 1 : lkr);
        const bf16_t* kp = kb + (size_t)lkr * kst;
#pragma unroll
        for (int s = 0; s < 4; ++s) kf0[i][s] = *(const bf16x8*)(kp + 16 * s);
    }
}
template <int NTILES, int CH, bool SYNC = true, bool KLDS = false>
__device__ __forceinline__ void attn_wave(const bf16x8 (&qf)[4], const bf16x8 (&kf0)[CH][4], const bf16_t* kb, const size_t kst, const int lk0, const int ls, const LAS bf16_t* vt, const int vts,
                                          float m_run, float l_run, f32x16& O0, f32x16& O1, float& m_out, float& l_out, const int r, const int h, const LAS bf16_t* kl = nullptr, const int kls = 0) {
#pragma unroll
    for (int i = 0; i < 16; ++i) { O0[i] = 0.f; O1[i] = 0.f; }
#pragma unroll
    for (int c0 = 0; c0 < NTILES; c0 += CH) {
        constexpr int dummy = 0; (void)dummy;
        f32x16 S[CH];
#pragma unroll
        for (int ii = 0; ii < CH; ++ii) {
            const int i = c0 + ii;
            if (i < NTILES) {
                int lkr = lk0 + 32 * i + r; lkr = lkr < 0 ? 0 : (lkr >= ls ? ls - 1 : lkr);
                const bf16_t* kp = kb + (size_t)lkr * kst;
                f32x16 a;
#pragma unroll
                for (int q = 0; q < 16; ++q) a[q] = 0.f;
#pragma unroll
                for (int s = 0; s < 4; ++s) {
                    bf16x8 kf;
                    if constexpr (KLDS) kf = *(const LAS bf16x8*)(kl + i * 32 * kls + 16 * s);
                    else { if (c0 == 0) kf = kf0[ii][s]; else kf = *(const bf16x8*)(kp + 16 * s); }
                    a = __builtin_amdgcn_mfma_f32_32x32x16_bf16(kf, qf[s], a, 0, 0, 0);
                }
                S[ii] = a;
            }
        }
        float mx = m_run;
#pragma unroll
        for (int ii = 0; ii < CH; ++ii) {
            const int i = c0 + ii;
            if (i < NTILES) {
                const bool edge = (lk0 + 32 * i < 0) || (lk0 + 32 * i + 32 > ls);
                if (edge || i == 0 || i == NTILES - 1) {
#pragma unroll
                    for (int q = 0; q < 16; ++q) {
                        const int row = (q & 3) + 8 * (q >> 2) + 4 * h;
                        const int lk = lk0 + 32 * i + row;
                        bool valid = (lk >= 0) && (lk < ls);
                        if (i == 0) valid = valid && (row >= r);
                        if (i == NTILES - 1) valid = valid && (row <= r);
                        const float sv = valid ? S[ii][q] : -1e30f;
                        S[ii][q] = sv;
                        mx = fmaxf(mx, sv);
                    }
                } else {
#pragma unroll
                    for (int q = 0; q < 16; ++q) mx = fmaxf(mx, S[ii][q]);
                }
            }
        }
        mx = fmaxf(mx, __shfl_xor(mx, 32));
        const float corr = __builtin_amdgcn_exp2f((m_run - mx) * 1.442695041f);
        float psum = 0.f;
#pragma unroll
        for (int ii = 0; ii < CH; ++ii) {
            const int i = c0 + ii;
            if (i < NTILES) {
#pragma unroll
                for (int q = 0; q < 16; ++q) { const float pv = __builtin_amdgcn_exp2f((S[ii][q] - mx) * 1.442695041f); S[ii][q] = pv; psum += pv; }
            }
        }
        psum += __shfl_xor(psum, 32);
        l_run = l_run * corr + psum;
        m_run = mx;
        if (c0 > 0) {
#pragma unroll
            for (int q = 0; q < 16; ++q) { O0[q] *= corr; O1[q] *= corr; }
        } else { if (SYNC) __syncthreads(); }
#pragma unroll
        for (int ii = 0; ii < CH; ++ii) {
            const int i = c0 + ii;
            if (i < NTILES) {
#pragma unroll
                for (int sp = 0; sp < 2; ++sp) {
                    const bf16x8 pf = pack8(S[ii][8 * sp + 0], S[ii][8 * sp + 1], S[ii][8 * sp + 2], S[ii][8 * sp + 3], S[ii][8 * sp + 4], S[ii][8 * sp + 5], S[ii][8 * sp + 6], S[ii][8 * sp + 7]);
                    const LAS bf16_t* v0 = vt + 32 * i + 16 * sp;
                    { const u32x2 a0 = *(const LAS u32x2*)(v0), a1 = *(const LAS u32x2*)(v0 + 8);
                      const u32x4 vw = (u32x4){a0.x, a0.y, a1.x, a1.y};
                      O0 = __builtin_amdgcn_mfma_f32_32x32x16_bf16(__builtin_bit_cast(bf16x8, vw), pf, O0, 0, 0, 0); }
                    { const u32x2 a0 = *(const LAS u32x2*)(v0 + 32 * vts), a1 = *(const LAS u32x2*)(v0 + 32 * vts + 8);
                      const u32x4 vw = (u32x4){a0.x, a0.y, a1.x, a1.y};
                      O1 = __builtin_amdgcn_mfma_f32_32x32x16_bf16(__builtin_bit_cast(bf16x8, vw), pf, O1, 0, 0, 0); }
                }
            }
        }
    }
    m_out = m_run; l_out = l_run;
}
__device__ __forceinline__ void ph_dilated_mfma(const Params& p, const int l, LAS unsigned char* lds) {
    constexpr int VTS = 260, VTSS = 292, KSTR = 72, ARENA = 78848, KOFF = 37376;
    const int hw = (opaque_tid() >> 8) & 1;
    const bf16_t* PROJ = (const bf16_t*)(p.ws + WS_PROJ);
    int ufirst, ucount, ustep;
    if (gridDim.x == 256) { if (blockIdx.x < 128) { ufirst = blockIdx.x * 2; ucount = 2; } else { ufirst = 256 + (blockIdx.x - 128) * 4; ucount = 4; } ustep = 1; }
    else { ufirst = blockIdx.x; ustep = gridDim.x; ucount = (768 - (int)blockIdx.x + (int)gridDim.x - 1) / (int)gridDim.x; }
    const int nsw = (256 - (int)blockIdx.x + (int)gridDim.x - 1) / (int)gridDim.x;
    const int ngm = (int)blockIdx.x < 128 ? (128 - (int)blockIdx.x + (int)gridDim.x - 1) / (int)gridDim.x : 0;
    const int nitems = ngm + nsw + ucount;
    constexpr int VTSG = 136;
    const bf16_t* SW = (const bf16_t*)(p.ws + WS_SGUW) + (size_t)l * 8 * 128 * 128;
    bf16x8 qf[4]; bf16x8 kdummy[5][4];
    for (int k = 0; k <= 2 * nitems; ++k) {
        const int tid = opaque_tid(), lane = tid & 63, w4 = (tid >> 6) & 3, tl = tid & 255, r = lane & 31, h = lane >> 5;
        LAS bf16_t* Vt = (LAS bf16_t*)(lds + hw * ARENA);
        LAS unsigned* Vt32 = (LAS unsigned*)Vt;
        LAS bf16_t* Ks = (LAS bf16_t*)(lds + hw * ARENA + KOFF);
        const int kk = k - hw, it0 = kk >> 1;
        if (kk >= 0 && it0 < nitems) {
            if (it0 < ngm) {
                const int u = blockIdx.x + it0 * gridDim.x;
                const int hg = u & 1, t0 = (u >> 1) * 128, hh2 = w4 >> 1, ph = w4 & 1, habs = hg * 4 + 2 * hw + hh2;
                if (!(kk & 1)) {
                    const int kp = tl & 63, ta = t0 + 2 * kp;
                    const float* vs = (const float*)(p.ws + WS_VSS) + (size_t)ta * 8;
                    const f32x4 sa0 = *(const f32x4*)vs, sa1 = *(const f32x4*)(vs + 4), sb0 = *(const f32x4*)(vs + 8), sb1 = *(const f32x4*)(vs + 12);
                    u32x4 va[4], vb[4]; f32x4 g0[4], g1[4];
                    const float* sn = p.in[8] + (size_t)l * 512 + hg * 256 + hw * 128;
#pragma unroll
                    for (int i = 0; i < 4; ++i) { const int dc = (tl >> 6) + 4 * i;
                        const bf16_t* src = PROJ + (size_t)ta * NPROJ + PC_V + hg * 256 + hw * 128 + 8 * dc;
                        va[i] = *(const u32x4*)src; vb[i] = *(const u32x4*)(src + NPROJ);
                        g0[i] = *(const f32x4*)(sn + 8 * dc); g1[i] = *(const f32x4*)(sn + 8 * dc + 4); }
                    const float ra = 1.0f / sqrtf((((sa0[0] + sa0[1]) + (sa0[2] + sa0[3])) + ((sa1[0] + sa1[1]) + (sa1[2] + sa1[3]))) * (1.f / 512.f) + EPS);
                    const float rb = 1.0f / sqrtf((((sb0[0] + sb0[1]) + (sb0[2] + sb0[3])) + ((sb1[0] + sb1[1]) + (sb1[2] + sb1[3]))) * (1.f / 512.f) + EPS);
#pragma unroll
                    for (int i = 0; i < 4; ++i) { const int dc = (tl >> 6) + 4 * i;
                        LAS unsigned* o = Vt32 + (8 * dc) * (VTSG / 2) + kp;
                        o[0 * (VTSG / 2)] = pk2(bflo(va[i].x) * ra * g0[i][0], bflo(vb[i].x) * rb * g0[i][0]); o[1 * (VTSG / 2)] = pk2(bfhi(va[i].x) * ra * g0[i][1], bfhi(vb[i].x) * rb * g0[i][1]);
                        o[2 * (VTSG / 2)] = pk2(bflo(va[i].y) * ra * g0[i][2], bflo(vb[i].y) * rb * g0[i][2]); o[3 * (VTSG / 2)] = pk2(bfhi(va[i].y) * ra * g0[i][3], bfhi(vb[i].y) * rb * g0[i][3]);
                        o[4 * (VTSG / 2)] = pk2(bflo(va[i].z) * ra * g1[i][0], bflo(vb[i].z) * rb * g1[i][0]); o[5 * (VTSG / 2)] = pk2(bfhi(va[i].z) * ra * g1[i][1], bfhi(vb[i].z) * rb * g1[i][1]);
                        o[6 * (VTSG / 2)] = pk2(bflo(va[i].w) * ra * g1[i][2], bflo(vb[i].w) * rb * g1[i][2]); o[7 * (VTSG / 2)] = pk2(bfhi(va[i].w) * ra * g1[i][3], bfhi(vb[i].w) * rb * g1[i][3]); }
                } else {
                    f32x16 acc[2][2];
#pragma unroll
                    for (int ct = 0; ct < 2; ++ct)
#pragma unroll
                        for (int pt = 0; pt < 2; ++pt)
#pragma unroll
                            for (int q = 0; q < 16; ++q) acc[ct][pt][q] = 0.f;
                    const LAS bf16_t* ap = Vt + (hh2 * 64 + r) * VTSG + 8 * h;
                    const bf16_t* wp = SW + ((size_t)habs * 128 + 64 * ph + r) * 128 + 8 * h;
#pragma unroll
                    for (int s2 = 0; s2 < 8; ++s2) {
                        bf16x8 afr[2], bfr[2];
#pragma unroll
                        for (int pt = 0; pt < 2; ++pt) bfr[pt] = *(const bf16x8*)(wp + (size_t)pt * 32 * 128 + 16 * s2);
#pragma unroll
                        for (int ct = 0; ct < 2; ++ct) afr[ct] = *(const LAS bf16x8*)(ap + ct * 32 * VTSG + 16 * s2);
#pragma unroll
                        for (int ct = 0; ct < 2; ++ct)
#pragma unroll
                            for (int pt = 0; pt < 2; ++pt) acc[ct][pt] = __builtin_amdgcn_mfma_f32_32x32x16_bf16(afr[ct], bfr[pt], acc[ct][pt], 0, 0, 0);
                    }
                    bf16_t* YB = (bf16_t*)(p.ws + WS_YB);
#pragma unroll
                    for (int pt = 0; pt < 2; ++pt) {
                        const int pp = 64 * ph + 32 * pt + r;
                        const float bias = p.in[10][((size_t)l * 8 + habs) * 128 + pp];
                        const bf16_t* us = PROJ + (size_t)(t0 + pp) * NPROJ + PC_U + habs * 64 + 4 * h;
                        bf16_t* o = YB + (size_t)(t0 + pp) * 512 + habs * 64 + 4 * h;
#pragma unroll
                        for (int ct = 0; ct < 2; ++ct)
#pragma unroll
                            for (int gg = 0; gg < 4; ++gg) {
                                const u32x2 uw = *(const u32x2*)(us + 32 * ct + 8 * gg);
                                u32x2 w; w.x = pk2(bflo(uw.x) * (acc[ct][pt][4 * gg] + bias), bfhi(uw.x) * (acc[ct][pt][4 * gg + 1] + bias));
                                w.y = pk2(bflo(uw.y) * (acc[ct][pt][4 * gg + 2] + bias), bfhi(uw.y) * (acc[ct][pt][4 * gg + 3] + bias));
                                *(u32x2*)(o + 32 * ct + 8 * gg) = w;
                            }
                    }
                }
            } else if (it0 < ngm + nsw) {
                const int it = it0 - ngm;
                const int u = blockIdx.x + it * gridDim.x;
                const int b = u >> 6, kvh = (u >> 5) & 1, q0 = (u & 31) * 64 + 32 * hw;
                const bf16_t* base = PROJ + (size_t)b * SEQ * NPROJ;
                const int head = kvh * 4 + w4, qpos = q0 + r, lk0 = q0 - 128;
                if (!(kk & 1)) {
                    u32x4 va[5], vb[5], kc[9];
#pragma unroll
                    for (int i = 0; i < 5; ++i) {
                        const int task = tl + 256 * i;
                        if (task < 1152) { const int kp = task % 144, dc = task / 144;
                            int kA = lk0 + 2 * kp; kA = kA < 0 ? 0 : (kA > SEQ - 2 ? SEQ - 2 : kA);
                            va[i] = *(const u32x4*)(base + (size_t)kA * NPROJ + PC_VC + kvh * 64 + 8 * dc);
                            vb[i] = *(const u32x4*)(base + (size_t)(kA + 1) * NPROJ + PC_VC + kvh * 64 + 8 * dc); }
                    }
#pragma unroll
                    for (int i = 0; i < 9; ++i) { const int id = tl + 256 * i, j = id >> 3, c8 = id & 7;
                        int kp2 = lk0 + j; kp2 = kp2 < 0 ? 0 : (kp2 >= SEQ ? SEQ - 1 : kp2);
                        kc[i] = *(const u32x4*)(base + (size_t)kp2 * NPROJ + PC_KC + kvh * 64 + 8 * c8); }
                    { const bf16_t* qp = base + (size_t)qpos * NPROJ + PC_QC + head * 64 + 8 * h;
#pragma unroll
                      for (int s2 = 0; s2 < 4; ++s2) qf[s2] = *(const bf16x8*)(qp + 16 * s2); }
#pragma unroll
                    for (int i = 0; i < 5; ++i) {
                        const int task = tl + 256 * i;
                        if (task < 1152) { const int kp = task % 144, dc = task / 144;
                            LAS unsigned* o = Vt32 + (8 * dc) * (VTSS / 2) + kp;
                            o[0 * (VTSS / 2)] = (va[i].x & 0xffffu) | (vb[i].x << 16); o[1 * (VTSS / 2)] = (va[i].x >> 16) | (vb[i].x & 0xffff0000u);
                            o[2 * (VTSS / 2)] = (va[i].y & 0xffffu) | (vb[i].y << 16); o[3 * (VTSS / 2)] = (va[i].y >> 16) | (vb[i].y & 0xffff0000u);
                            o[4 * (VTSS / 2)] = (va[i].z & 0xffffu) | (vb[i].z << 16); o[5 * (VTSS / 2)] = (va[i].z >> 16) | (vb[i].z & 0xffff0000u);
                            o[6 * (VTSS / 2)] = (va[i].w & 0xffffu) | (vb[i].w << 16); o[7 * (VTSS / 2)] = (va[i].w >> 16) | (vb[i].w & 0xffff0000u); }
                    }
#pragma unroll
                    for (int i = 0; i < 9; ++i) { const int id = tl + 256 * i, j = id >> 3, c8 = id & 7; *(LAS u32x4*)(Ks + j * KSTR + 8 * c8) = kc[i]; }
                } else {
                    const LAS bf16_t* vt = Vt + r * VTSS + 4 * h;
                    const LAS bf16_t* kl = Ks + r * KSTR + 8 * h;
                    f32x16 O0, O1; float m, lsum;
                    attn_wave<9, 5, false, true>(qf, kdummy, nullptr, (size_t)NPROJ, lk0, SEQ, vt, VTSS, p.in[11][l * 8 + head], 1.f, O0, O1, m, lsum, r, h, kl, KSTR);
                    const float inv = 1.f / lsum;
                    bf16_t* o = (bf16_t*)(p.ws + WS_YC) + ((size_t)b * SEQ + qpos) * 512 + head * 64 + 4 * h;
#pragma unroll
                    for (int gg = 0; gg < 4; ++gg) {
                        u32x2 w0; w0.x = pk2(O0[4 * gg] * inv, O0[4 * gg + 1] * inv); w0.y = pk2(O0[4 * gg + 2] * inv, O0[4 * gg + 3] * inv);
                        u32x2 w1; w1.x = pk2(O1[4 * gg] * inv, O1[4 * gg + 1] * inv); w1.y = pk2(O1[4 * gg + 2] * inv, O1[4 * gg + 3] * inv);
                        *(u32x2*)(o + 8 * gg) = w0; *(u32x2*)(o + 32 + 8 * gg) = w1;
                    }
                }
            } else {
                const int u = ufirst + (it0 - ngm - nsw) * ustep;
                const int cfg = u >> 8, r8 = u & 255, b = r8 >> 6, head = (r8 >> 3) & 7, blk = (r8 & 7) * 2 + hw;
                const int dsh = 2 * cfg, dil = 1 << dsh, ls = SEQ >> dsh, nblk = ls >> 7;
                const int res = blk / nblk, l0 = (blk % nblk) * 128;
                const bf16_t* base = PROJ + ((size_t)b * SEQ + res) * NPROJ;
                const size_t kst = (size_t)dil * NPROJ;
                const int lq = l0 + 32 * w4 + r;
                const int lk0 = l0 + 32 * w4 - 64;
                if (!(kk & 1)) {
                    u32x4 va[4], vb[4], kc[8];
#pragma unroll
                    for (int i = 0; i < 4; ++i) {
                        const int task = tl + 256 * i, kp = task & 127, dc = task >> 7;
                        int lkA = l0 - 64 + 2 * kp; lkA = lkA < 0 ? 0 : (lkA > ls - 2 ? ls - 2 : lkA);
                        va[i] = *(const u32x4*)(base + (size_t)lkA * kst + PC_VD + head * 64 + 8 * dc);
                        vb[i] = *(const u32x4*)(base + (size_t)(lkA + 1) * kst + PC_VD + head * 64 + 8 * dc);
                    }
#pragma unroll
                    for (int i = 0; i < 8; ++i) {
                        const int id = tl + 256 * i, j = id >> 3, c8 = id & 7;
                        int lk = l0 - 64 + j; lk = lk < 0 ? 0 : (lk >= ls ? ls - 1 : lk);
                        kc[i] = *(const u32x4*)(base + (size_t)lk * kst + PC_KD + head * 64 + 8 * c8);
                    }
                    { const bf16_t* qp = base + (size_t)lq * kst + PC_QD + head * 64 + 8 * h;
#pragma unroll
                      for (int s2 = 0; s2 < 4; ++s2) qf[s2] = *(const bf16x8*)(qp + 16 * s2); }
#pragma unroll
                    for (int i = 0; i < 4; ++i) {
                        const int task = tl + 256 * i, kp = task & 127, dc = task >> 7;
                        LAS unsigned* o = Vt32 + (8 * dc) * (VTS / 2) + kp;
                        o[0 * (VTS / 2)] = (va[i].x & 0xffffu) | (vb[i].x << 16); o[1 * (VTS / 2)] = (va[i].x >> 16) | (vb[i].x & 0xffff0000u);
                        o[2 * (VTS / 2)] = (va[i].y & 0xffffu) | (vb[i].y << 16); o[3 * (VTS / 2)] = (va[i].y >> 16) | (vb[i].y & 0xffff0000u);
                        o[4 * (VTS / 2)] = (va[i].z & 0xffffu) | (vb[i].z << 16); o[5 * (VTS / 2)] = (va[i].z >> 16) | (vb[i].z & 0xffff0000u);
                        o[6 * (VTS / 2)] = (va[i].w & 0xffffu) | (vb[i].w << 16); o[7 * (VTS / 2)] = (va[i].w >> 16) | (vb[i].w & 0xffff0000u);
                    }
#pragma unroll
                    for (int i = 0; i < 8; ++i) { const int id = tl + 256 * i, j = id >> 3, c8 = id & 7; *(LAS u32x4*)(Ks + j * KSTR + 8 * c8) = kc[i]; }
                } else {
                    const LAS bf16_t* vt = Vt + r * VTS + 32 * w4 + 4 * h;
                    const LAS bf16_t* kl = Ks + (32 * w4 + r) * KSTR + 8 * h;
                    f32x16 O0, O1; float m, lsm;
                    attn_wave<5, 5, false, true>(qf, kdummy, nullptr, kst, lk0, ls, vt, VTS, -1e30f, 0.f, O0, O1, m, lsm, r, h, kl, KSTR);
                    const float inv = 1.f / lsm;
                    const size_t tq = (size_t)b * SEQ + (size_t)lq * dil + res;
                    bf16_t* o = (bf16_t*)(p.ws + WS_YD) + ((size_t)cfg * NT + tq) * 512 + head * 64 + 4 * h;
#pragma unroll
                    for (int g = 0; g < 4; ++g) {
                        u32x2 w0; w0.x = pk2(O0[4 * g] * inv, O0[4 * g + 1] * inv); w0.y = pk2(O0[4 * g + 2] * inv, O0[4 * g + 3] * inv);
                        u32x2 w1; w1.x = pk2(O1[4 * g] * inv, O1[4 * g + 1] * inv); w1.y = pk2(O1[4 * g + 2] * inv, O1[4 * g + 3] * inv);
                        *(u32x2*)(o + 8 * g) = w0; *(u32x2*)(o + 32 + 8 * g) = w1;
                    }
                    if (h == 0) ((float*)(p.ws + WS_LSE))[((size_t)cfg * NT + tq) * 8 + head] = m + __logf(lsm);
                }
            }
        }
        __syncthreads();
    }
}

__device__ __forceinline__ void ph_swa_mfma(const Params& p, int l, LAS unsigned char* lds) {
    const int tid = opaque_tid(), lane = tid & 63, wv = tid >> 6, g = wv >> 1, ph = wv & 1, r = lane & 31, h = lane >> 5;
    constexpr int VTS = 324;
    LAS bf16_t* Vt = (LAS bf16_t*)lds;
    LAS unsigned* Vt32 = (LAS unsigned*)lds;
    const bf16_t* PROJ = (const bf16_t*)(p.ws + WS_PROJ);
    for (int u = blockIdx.x; u < 256; u += gridDim.x) {
        const int b = u >> 6, kvh = (u >> 5) & 1, q0 = (u & 31) * 64;
        const bf16_t* base = PROJ + (size_t)b * SEQ * NPROJ;
        u32x4 va[3], vb[3];
#pragma unroll
        for (int i = 0; i < 3; ++i) {
            const int task = tid + 512 * i;
            if (task < 1280) {
                const int kp = task % 160, dc = task / 160;
                int kA = q0 - 128 + 2 * kp; kA = kA < 0 ? 0 : (kA > SEQ - 2 ? SEQ - 2 : kA);
                va[i] = *(const u32x4*)(base + (size_t)kA * NPROJ + PC_VC + kvh * 64 + 8 * dc);
                vb[i] = *(const u32x4*)(base + (size_t)(kA + 1) * NPROJ + PC_VC + kvh * 64 + 8 * dc);
            }
        }
        const int head = kvh * 4 + g;
        const int qpos = q0 + 32 * ph + r;
        const int lk0 = q0 + 32 * ph - 128;
        const bf16_t* kb = base + PC_KC + kvh * 64 + 8 * h;
        bf16x8 qf[4], kf0[5][4];
        attn_prefetch<5>(base + (size_t)qpos * NPROJ + PC_QC + head * 64 + 8 * h, kb, (size_t)NPROJ, lk0, SEQ, r, qf, kf0);
#pragma unroll
        for (int i = 0; i < 3; ++i) {
            const int task = tid + 512 * i;
            if (task < 1280) {
                const int kp = task % 160, dc = task / 160;
                LAS unsigned* o = Vt32 + (8 * dc) * (VTS / 2) + kp;
                o[0 * (VTS / 2)] = (va[i].x & 0xffffu) | (vb[i].x << 16); o[1 * (VTS / 2)] = (va[i].x >> 16) | (vb[i].x & 0xffff0000u);
                o[2 * (VTS / 2)] = (va[i].y & 0xffffu) | (vb[i].y << 16); o[3 * (VTS / 2)] = (va[i].y >> 16) | (vb[i].y & 0xffff0000u);
                o[4 * (VTS / 2)] = (va[i].z & 0xffffu) | (vb[i].z << 16); o[5 * (VTS / 2)] = (va[i].z >> 16) | (vb[i].z & 0xffff0000u);
                o[6 * (VTS / 2)] = (va[i].w & 0xffffu) | (vb[i].w << 16); o[7 * (VTS / 2)] = (va[i].w >> 16) | (vb[i].w & 0xffff0000u);
            }
        }
        {
            const LAS bf16_t* vt = Vt + r * VTS + 32 * ph + 4 * h;
            f32x16 O0, O1; float m, lsum;
            attn_wave<9, 5>(qf, kf0, kb, (size_t)NPROJ, lk0, SEQ, vt, VTS, p.in[11][l * 8 + head], 1.f, O0, O1, m, lsum, r, h);
            const float inv = 1.f / lsum;
            bf16_t* o = (bf16_t*)(p.ws + WS_YC) + ((size_t)b * SEQ + qpos) * 512 + head * 64 + 4 * h;
#pragma unroll
            for (int gg = 0; gg < 4; ++gg) {
                u32x2 w0; w0.x = pk2(O0[4 * gg] * inv, O0[4 * gg + 1] * inv); w0.y = pk2(O0[4 * gg + 2] * inv, O0[4 * gg + 3] * inv);
                u32x2 w1; w1.x = pk2(O1[4 * gg] * inv, O1[4 * gg + 1] * inv); w1.y = pk2(O1[4 * gg + 2] * inv, O1[4 * gg + 3] * inv);
                *(u32x2*)(o + 8 * gg) = w0; *(u32x2*)(o + 32 + 8 * gg) = w1;
            }
        }
        __syncthreads();
    }
}

__device__ __forceinline__ void ph_gmlp_mfma(const Params& p, int l, LAS unsigned char* lds) {
    const int tid = opaque_tid(), lane = tid & 63, wv = tid >> 6, hh = wv >> 1, ph = wv & 1, r = lane & 31, h = lane >> 5;
    constexpr int VTS = 136;
    LAS bf16_t* Vt = (LAS bf16_t*)lds;
    LAS unsigned* Vt32 = (LAS unsigned*)lds;
    LAS float* rv = (LAS float*)(lds + 256 * VTS * 2);
    const bf16_t* PROJ = (const bf16_t*)(p.ws + WS_PROJ); bf16_t* YB = (bf16_t*)(p.ws + WS_YB);
    const bf16_t* SW = (const bf16_t*)(p.ws + WS_SGUW) + (size_t)l * 8 * 128 * 128;
    const float* sn = p.in[8] + (size_t)l * 512;
    for (int u = blockIdx.x; u < 128; u += gridDim.x) {
        const int hg = u & 1, t0 = (u >> 1) * 128;
        { u32x4 w[16]; float ss[16];
#pragma unroll
          for (int q = 0; q < 16; ++q) w[q] = *(const u32x4*)(PROJ + (size_t)(t0 + wv * 16 + q) * NPROJ + PC_V + 8 * lane);
#pragma unroll
          for (int q = 0; q < 16; ++q) ss[q] = bflo(w[q].x) * bflo(w[q].x) + bfhi(w[q].x) * bfhi(w[q].x) + bflo(w[q].y) * bflo(w[q].y) + bfhi(w[q].y) * bfhi(w[q].y) + bflo(w[q].z) * bflo(w[q].z) + bfhi(w[q].z) * bfhi(w[q].z) + bflo(w[q].w) * bflo(w[q].w) + bfhi(w[q].w) * bfhi(w[q].w);
#pragma unroll
          for (int o = 1; o < 64; o <<= 1)
#pragma unroll
              for (int q = 0; q < 16; ++q) ss[q] += __shfl_xor(ss[q], o);
          float mine = 0.f;
#pragma unroll
          for (int q = 0; q < 16; ++q) mine = (lane == q) ? ss[q] : mine;
          if (lane < 16) rv[wv * 16 + lane] = 1.0f / sqrtf(mine * (1.f / 512.f) + EPS); }
        __syncthreads();
#pragma unroll
        for (int i = 0; i < 4; ++i) {
            const int task = tid + 512 * i, kp = task & 63, dc = task >> 6;
            const bf16_t* src = PROJ + (size_t)(t0 + 2 * kp) * NPROJ + PC_V + hg * 256 + 8 * dc;
            const u32x4 va = *(const u32x4*)src, vb = *(const u32x4*)(src + NPROJ);
            const float ra = rv[2 * kp], rb = rv[2 * kp + 1];
            const f32x4 g0 = *(const f32x4*)(sn + hg * 256 + 8 * dc), g1 = *(const f32x4*)(sn + hg * 256 + 8 * dc + 4);
            LAS unsigned* o = Vt32 + (8 * dc) * (VTS / 2) + kp;
            o[0 * (VTS / 2)] = pk2(bflo(va.x) * ra * g0[0], bflo(vb.x) * rb * g0[0]); o[1 * (VTS / 2)] = pk2(bfhi(va.x) * ra * g0[1], bfhi(vb.x) * rb * g0[1]);
            o[2 * (VTS / 2)] = pk2(bflo(va.y) * ra * g0[2], bflo(vb.y) * rb * g0[2]); o[3 * (VTS / 2)] = pk2(bfhi(va.y) * ra * g0[3], bfhi(vb.y) * rb * g0[3]);
            o[4 * (VTS / 2)] = pk2(bflo(va.z) * ra * g1[0], bflo(vb.z) * rb * g1[0]); o[5 * (VTS / 2)] = pk2(bfhi(va.z) * ra * g1[1], bfhi(vb.z) * rb * g1[1]);
            o[6 * (VTS / 2)] = pk2(bflo(va.w) * ra * g1[2], bflo(vb.w) * rb * g1[2]); o[7 * (VTS / 2)] = pk2(bfhi(va.w) * ra * g1[3], bfhi(vb.w) * rb * g1[3]);
        }
        __syncthreads();
        {
            const int habs = hg * 4 + hh;
            f32x16 acc[2][2];
#pragma unroll
            for (int ct = 0; ct < 2; ++ct)
#pragma unroll
                for (int pt = 0; pt < 2; ++pt)
#pragma unroll
                    for (int q = 0; q < 16; ++q) acc[ct][pt][q] = 0.f;
            const bf16_t* wp = SW + ((size_t)habs * 128 + 64 * ph + r) * 128 + 8 * h;
            const LAS bf16_t* ap = Vt + (hh * 64 + r) * VTS + 8 * h;
#pragma unroll
            for (int s = 0; s < 8; ++s) {
                bf16x8 bfr[2], afr[2];
#pragma unroll
                for (int pt = 0; pt < 2; ++pt) bfr[pt] = *(const bf16x8*)(wp + (size_t)pt * 32 * 128 + 16 * s);
#pragma unroll
                for (int ct = 0; ct < 2; ++ct) afr[ct] = *(const LAS bf16x8*)(ap + ct * 32 * VTS + 16 * s);
#pragma unroll
                for (int ct = 0; ct < 2; ++ct)
#pragma unroll
                    for (int pt = 0; pt < 2; ++pt) acc[ct][pt] = __builtin_amdgcn_mfma_f32_32x32x16_bf16(afr[ct], bfr[pt], acc[ct][pt], 0, 0, 0);
            }
#pragma unroll
            for (int pt = 0; pt < 2; ++pt) {
                const int pp = 64 * ph + 32 * pt + r;
                const float bias = p.in[10][((size_t)l * 8 + habs) * 128 + pp];
                const bf16_t* us = PROJ + (size_t)(t0 + pp) * NPROJ + PC_U + habs * 64 + 4 * h;
                bf16_t* o = YB + (size_t)(t0 + pp) * 512 + habs * 64 + 4 * h;
#pragma unroll
                for (int ct = 0; ct < 2; ++ct)
#pragma unroll
                    for (int gg = 0; gg < 4; ++gg) {
                        const u32x2 uw = *(const u32x2*)(us + 32 * ct + 8 * gg);
                        u32x2 w; w.x = pk2(bflo(uw.x) * (acc[ct][pt][4 * gg] + bias), bfhi(uw.x) * (acc[ct][pt][4 * gg + 1] + bias));
                        w.y = pk2(bflo(uw.y) * (acc[ct][pt][4 * gg + 2] + bias), bfhi(uw.y) * (acc[ct][pt][4 * gg + 3] + bias));
                        *(u32x2*)(o + 32 * ct + 8 * gg) = w;
                    }
            }
        }
        __syncthreads();
    }
}

__device__ __forceinline__ void ph_merge(const Params& p, int l, LAS unsigned char* lds) {
    const int tid = opaque_tid(), lane = tid & 63, wv = tid >> 6, r = lane & 31, h2 = lane >> 5;
    LAS float* ssA = (LAS float*)lds;
    const bf16_t* UV = (const bf16_t*)(p.ws + WS_YA); const bf16_t* YB = (const bf16_t*)(p.ws + WS_YB); const bf16_t* YC = (const bf16_t*)(p.ws + WS_YC); const bf16_t* YD = (const bf16_t*)(p.ws + WS_YD);
    const float* LSE = (const float*)(p.ws + WS_LSE); bf16_t* YN = (bf16_t*)(p.ws + WS_YN);
    const bf16_t* ABT = (const bf16_t*)(p.ws + WS_ABT) + ((size_t)l * 8 + wv) * 64 * 128;
    for (int blk = blockIdx.x; blk < NT / 32; blk += gridDim.x) {
        const int t0 = blk * 32, b = t0 >> 11, s0 = t0 & 2047;
        f32x16 O0, O1;
        {
#pragma unroll
            for (int q = 0; q < 16; ++q) { O0[q] = 0.f; O1[q] = 0.f; }
            const size_t row = ((size_t)b * 4096 + 2 * (s0 + r)) * 512 + wv * 64 + 8 * h2;
            u32x4 u0[8], u1[8];
#pragma unroll
            for (int s = 0; s < 8; ++s) { const size_t o = row + (s >> 2) * 512 + 16 * (s & 3); u0[s] = *(const u32x4*)(UV + o); u1[s] = *(const u32x4*)(UV + (size_t)4 * 4096 * 512 + o); }
            bf16x8 af0[8], af1[8];
#pragma unroll
            for (int s = 0; s < 8; ++s) { af0[s] = *(const bf16x8*)(ABT + (size_t)r * 128 + 16 * s + 8 * h2); af1[s] = *(const bf16x8*)(ABT + (size_t)(32 + r) * 128 + 16 * s + 8 * h2); }
#pragma unroll
            for (int s = 0; s < 8; ++s) {
                const bf16x8 bfr = pack8(bflo(u0[s].x) + bflo(u1[s].x), bfhi(u0[s].x) + bfhi(u1[s].x), bflo(u0[s].y) + bflo(u1[s].y), bfhi(u0[s].y) + bfhi(u1[s].y),
                                         bflo(u0[s].z) + bflo(u1[s].z), bfhi(u0[s].z) + bfhi(u1[s].z), bflo(u0[s].w) + bflo(u1[s].w), bfhi(u0[s].w) + bfhi(u1[s].w));
                O0 = __builtin_amdgcn_mfma_f32_32x32x16_bf16(af0[s], bfr, O0, 0, 0, 0);
                O1 = __builtin_amdgcn_mfma_f32_32x32x16_bf16(af1[s], bfr, O1, 0, 0, 0);
            }
            float ss = 0.f;
#pragma unroll
            for (int q = 0; q < 16; ++q) ss += O0[q] * O0[q] + O1[q] * O1[q];
            ss += __shfl_xor(ss, 32);
            if (h2 == 0) ssA[wv * 32 + r] = ss;
        }
        {
            u32x4 lb[4], lc[4], ld0[4], ld1[4], ld2[4]; float e0[4], e1[4], e2[4];
#pragma unroll
            for (int i = 0; i < 4; ++i) {
                const int t = t0 + 4 * wv + i, head = lane >> 3;
                lb[i] = *(const u32x4*)(YB + (size_t)t * 512 + 8 * lane); lc[i] = *(const u32x4*)(YC + (size_t)t * 512 + 8 * lane);
                ld0[i] = *(const u32x4*)(YD + (size_t)t * 512 + 8 * lane); ld1[i] = *(const u32x4*)(YD + ((size_t)NT + t) * 512 + 8 * lane); ld2[i] = *(const u32x4*)(YD + ((size_t)2 * NT + t) * 512 + 8 * lane);
                e0[i] = LSE[(size_t)t * 8 + head]; e1[i] = LSE[((size_t)NT + t) * 8 + head]; e2[i] = LSE[((size_t)2 * NT + t) * 8 + head];
            }
#pragma unroll
            for (int i = 0; i < 4; ++i) {
                const int t = t0 + 4 * wv + i;
                float y[3][8];
                { const u32x4 w = lb[i];
                    y[0][0] = bflo(w.x); y[0][1] = bfhi(w.x); y[0][2] = bflo(w.y); y[0][3] = bfhi(w.y); y[0][4] = bflo(w.z); y[0][5] = bfhi(w.z); y[0][6] = bflo(w.w); y[0][7] = bfhi(w.w); }
                { const u32x4 w = lc[i];
                    y[1][0] = bflo(w.x); y[1][1] = bfhi(w.x); y[1][2] = bflo(w.y); y[1][3] = bfhi(w.y); y[1][4] = bflo(w.z); y[1][5] = bfhi(w.z); y[1][6] = bflo(w.w); y[1][7] = bfhi(w.w); }
                { const float l0 = e0[i], l1 = e1[i], l2 = e2[i];
                  const float mx = fmaxf(l0, fmaxf(l1, l2)); float w0 = __expf(l0 - mx), w1 = __expf(l1 - mx), w2 = __expf(l2 - mx); const float iv = 1.f / (w0 + w1 + w2); w0 *= iv; w1 *= iv; w2 *= iv;
                  const u32x4 a = ld0[i], bq = ld1[i], c = ld2[i];
                  y[2][0] = w0 * bflo(a.x) + w1 * bflo(bq.x) + w2 * bflo(c.x); y[2][1] = w0 * bfhi(a.x) + w1 * bfhi(bq.x) + w2 * bfhi(c.x);
                  y[2][2] = w0 * bflo(a.y) + w1 * bflo(bq.y) + w2 * bflo(c.y); y[2][3] = w0 * bfhi(a.y) + w1 * bfhi(bq.y) + w2 * bfhi(c.y);
                  y[2][4] = w0 * bflo(a.z) + w1 * bflo(bq.z) + w2 * bflo(c.z); y[2][5] = w0 * bfhi(a.z) + w1 * bfhi(bq.z) + w2 * bfhi(c.z);
                  y[2][6] = w0 * bflo(a.w) + w1 * bflo(bq.w) + w2 * bflo(c.w); y[2][7] = w0 * bfhi(a.w) + w1 * bfhi(bq.w) + w2 * bfhi(c.w); }
#pragma unroll
                for (int g = 0; g < 3; ++g) {
                    float ss = 0.f;
#pragma unroll
                    for (int q = 0; q < 8; ++q) ss += y[g][q] * y[g][q];
                    const float rr = 1.0f / sqrtf(wave_sum(ss) * (1.f / 512.f) + EPS);
                    u32x4 w; w.x = pk2(y[g][0] * rr, y[g][1] * rr); w.y = pk2(y[g][2] * rr, y[g][3] * rr); w.z = pk2(y[g][4] * rr, y[g][5] * rr); w.w = pk2(y[g][6] * rr, y[g][7] * rr);
                    *(u32x4*)(YN + (size_t)t * DM + (g + 1) * 512 + 8 * lane) = w;
                }
            }
        }
        __syncthreads();
        {
            float tot = 0.f;
#pragma unroll
            for (int w = 0; w < 8; ++w) tot += ssA[w * 32 + r];
            const float rr = 1.0f / sqrtf(tot * (1.f / 512.f) + EPS);
            bf16_t* o = YN + (size_t)(t0 + r) * DM + wv * 64 + 4 * h2;
#pragma unroll
            for (int g = 0; g < 4; ++g) {
                u32x2 w0; w0.x = pk2(O0[4 * g] * rr, O0[4 * g + 1] * rr); w0.y = pk2(O0[4 * g + 2] * rr, O0[4 * g + 3] * rr);
                u32x2 w1; w1.x = pk2(O1[4 * g] * rr, O1[4 * g + 1] * rr); w1.y = pk2(O1[4 * g + 2] * rr, O1[4 * g + 3] * rr);
                *(u32x2*)(o + 8 * g) = w0; *(u32x2*)(o + 32 + 8 * g) = w1;
            }
        }
        __syncthreads();
    }
}

#ifndef PHASE_MASK
#define PHASE_MASK 0xFFFFFFu
#endif
#define EN(k) (((PHASE_MASK) >> (k)) & 1u)
#ifndef REP_MASK
#define REP_MASK 0u
#endif
#define REP(k) _Pragma("unroll") for (int rep_ = 0; rep_ < 1 + (int)(((REP_MASK) >> (k)) & 1u); ++rep_)
constexpr int MIX_GW = 128, MIX_A = 4400;
constexpr int NPHASE = 22;
__global__ void __launch_bounds__(512, 2) mk_fwd(Params p) {
    extern __shared__ __attribute__((aligned(16))) unsigned char lds_raw[];
    LAS unsigned char* lds = (LAS unsigned char*)lds_raw;
    const int tid = threadIdx.x, G = gridDim.x, bx = blockIdx.x;
    volatile LAS unsigned* misc = (volatile LAS unsigned*)(lds + MISC_OFF);
    if (tid < 16) misc[tid] = 0u;
    __syncthreads();
    const int lo = p.ph_lo, hi = p.ph_hi;
    XcdBarrier bar; bar.bar = (unsigned*)(p.ws + WS_CTL); bar.x = 0; bar.st = misc + 8;
    if (hi - lo > 1) bar = xcd_barrier_post((unsigned*)(p.ws + WS_CTL), misc + 8);
#define IN(k) (lo <= (k) && (k) < hi)
#define SEAM(k) do { if (IN(k) && IN((k) + 1)) xcd_barrier(bar); } while (0)
    if (IN(0)) { if (EN(0)) REP(0) ph_mod(p, lds); if (EN(1)) REP(1) ph_tables(p, lds); if (EN(2)) REP(2) { if (G == 256) { if (bx >= 192) ph_weights(p, lds, 0, 240, bx - 192, 64); } else ph_weights(p, lds, 0, 6880, bx, G); } }
    SEAM(0);
    for (int l = 0; l < 2; ++l) {
        const int pb = 1 + 10 * l;
        const char* H = (const char*)(p.ws + WS_H);
        if (EN(3) && IN(pb + 0)) REP(3) { ph_norm1(p, l); }
        SEAM(pb + 0);
        if (EN(4) && IN(pb + 1)) REP(4) {
            SchedProj S{H, (const char*)(p.ws + WS_WIN) + (size_t)l * NPROJ * 2048 * 2, (const char*)(p.ws + WS_WPQ) + (size_t)l * 512 * 2048 * 2, G, bx};
            EpiProj E{(bf16_t*)(p.ws + WS_PROJ), (bf16_t*)(p.ws + WS_PQT), (const float*)(p.ws + WS_ROPE), (const float*)(p.ws + WS_ROPE) + NT * 8};
            if (l == 0 && G == 256 && EN(2)) {
                if (bx < MIX_GW) { SchedProj S2{S.H, S.WIN, S.WPQ, MIX_GW, bx}; pg8::gemm_phase<EpiProj, SchedProj>(lds, 2048, 2048, 2048, S2, E); }
                else ph_weights(p, lds, 240, 240 + MIX_A, bx - MIX_GW, G - MIX_GW);
                __syncthreads();
                ph_weights(p, lds, 240 + MIX_A, 6880, bx, G);
            } else
            pg8::gemm_phase<EpiProj, SchedProj>(lds, 2048, 2048, 2048, S, E);
        }
        SEAM(pb + 1);
        if (IN(pb + 2)) {
            if (EN(5)) REP(5) { SchedDft S{(const char*)(p.ws + WS_DFT), (const char*)(p.ws + WS_PQT), G, bx};
              EpiBf16Plain E{(bf16_t*)(p.ws + WS_YA), 512, (size_t)4 * 4096 * 512};
              pg8::gemm_phase<EpiBf16Plain, SchedDft>(lds, 2048, 2048, 1024, S, E); }
            __syncthreads();
            if (EN(8)) REP(8) ph_dilated_mfma(p, l, lds);
        }
        SEAM(pb + 2);
        if (EN(9) && IN(pb + 3)) REP(9) { ph_merge(p, l, lds); }
        SEAM(pb + 3);
        if (EN(10) && IN(pb + 4)) REP(10) {
            SchedDense S{(const char*)(p.ws + WS_YN), (const char*)(p.ws + WS_WOUT) + (size_t)l * 2048 * 2048 * 2, 32, 8, 2048, G, bx};
            EpiWout E{l == 0 ? p.in[0] : nullptr, (const bf16_t*)(p.ws + WS_X), (bf16_t*)(p.ws + WS_X2), (const float*)(p.ws + WS_MOD) + (size_t)l * 4 * 12288 + 2 * 2048};
            pg8::gemm_phase<EpiWout, SchedDense>(lds, 2048, 2048, 2048, S, E);
        }
        SEAM(pb + 4);
        if (EN(11) && IN(pb + 5)) REP(11) { ph_norm2_router_mfma(p, l, lds); }
        SEAM(pb + 5);
        if (EN(12) && IN(pb + 6)) REP(12) { ph_topk(p, lds); }
        SEAM(pb + 6);
        if (EN(14) && IN(pb + 8)) REP(14) {
            SchedMoeG S{H, (const char*)(p.ws + WS_WGU) + (size_t)l * 16 * 2048 * 2048 * 2, 2048, G, bx};
            EpiGU E{(bf16_t*)(p.ws + WS_ACT)};
            pg8::gemm_phase<EpiGU, SchedMoeG, true>(lds, 2048, 2048, 2048, S, E, (const int*)(p.ws + WS_IDX));
        }
        SEAM(pb + 8);
        if (EN(15) && IN(pb + 9)) REP(15) {
            SchedMoe S{(const char*)(p.ws + WS_ACT), (const char*)(p.ws + WS_WD) + (size_t)l * 16 * 2048 * 1024 * 2, 1024, G, bx};
            EpiDown E{(bf16_t*)(p.ws + WS_EO), (const float*)(p.ws + WS_IDX + 65536)};
            pg8::gemm_phase<EpiDown, SchedMoe>(lds, 1024, 1024, 1024, S, E);
        }
        SEAM(pb + 9);
    }
    if (EN(16) && IN(21)) REP(16) { ph_norm1(p, 2); }
#undef IN
#undef SEAM
}

extern "C" void kernel_launch(void* const* d_in, const int* in_sizes, int n_in, void* d_out, int out_size, void* d_ws, size_t ws_size, hipStream_t stream) {
    static int grid = 0;
    if (grid == 0) {
        if (n_in != 20 || out_size != NT * DM || ws_size < WS_END) { fprintf(stderr, "kernel_launch: unexpected shapes (n_in %d out %d ws %zu)\n", n_in, out_size, ws_size); grid = -1; return; }
        int dev = 0, cus = 0, per_cu = 0;
        if (hipGetDevice(&dev) != hipSuccess || hipDeviceGetAttribute(&cus, hipDeviceAttributeMultiprocessorCount, dev) != hipSuccess) { grid = -1; return; }
        if (hipFuncSetAttribute((const void*)mk_fwd, hipFuncAttributeMaxDynamicSharedMemorySize, LDS_BYTES) != hipSuccess) { fprintf(stderr, "kernel_launch: hipFuncSetAttribute failed\n"); grid = -1; return; }
        if (hipOccupancyMaxActiveBlocksPerMultiprocessor(&per_cu, (const void*)mk_fwd, 512, LDS_BYTES) != hipSuccess || per_cu < 1) { fprintf(stderr, "kernel_launch: occupancy query says %d\n", per_cu); }
        (void)hipGetLastError();
        grid = cus;
    }
    if (grid < 0) return;
    (void)hipMemsetAsync((char*)d_ws + WS_CTL, 0, 64 * 1024, stream);
    Params p{};
    for (int i = 0; i < 20; ++i) p.in[i] = (const float*)d_in[i];
    p.out = (float*)d_out; p.ws = (unsigned char*)d_ws;
#if defined(MK_MULTI)
    for (int ph = 0; ph < NPHASE; ++ph) { p.ph_lo = ph; p.ph_hi = ph + 1; hipLaunchKernelGGL(mk_fwd, dim3(grid), dim3(512), LDS_BYTES, stream, p); }
#else
    p.ph_lo = 0; p.ph_hi = NPHASE; hipLaunchKernelGGL(mk_fwd, dim3(grid), dim3(512), LDS_BYTES, stream, p);
#endif
}
```

```cpp
#include <hip/hip_runtime.h>
#include <cstdio>
#include <cstdint>

#define LAS __attribute__((address_space(3)))
typedef unsigned short bf16_t;
typedef short bf16x8 __attribute__((ext_vector_type(8)));
typedef float f32x4 __attribute__((ext_vector_type(4)));
typedef float f32x2 __attribute__((ext_vector_type(2)));
typedef unsigned u32x4 __attribute__((ext_vector_type(4)));
typedef unsigned u32x2 __attribute__((ext_vector_type(2)));
typedef float f32x16 __attribute__((ext_vector_type(16)));

constexpr int NB = 4, SEQ = 2048, NT = NB * SEQ, DM = 2048, DIN = 3840, NPROJ = 3328, NE = 16, FF = 1024, CAP = 256;
constexpr float EPS = 1e-6f;
constexpr int PC_U = 0, PC_V = 512, PC_QC = 1024, PC_KC = 1536, PC_VC = 1664, PC_QD = 1792, PC_KD = 2304, PC_VD = 2816;

constexpr size_t MiB = (size_t)1 << 20;
constexpr size_t WS_CTL = 0;
constexpr size_t WS_MOD = 1 * MiB;
constexpr size_t WS_ROPE = WS_MOD + 512 * 1024;
constexpr size_t WS_DFT = 2 * MiB;
constexpr size_t WS_WIN = 18 * MiB;
constexpr size_t WS_WPQ = 44 * MiB;
constexpr size_t WS_WOUT = 52 * MiB;
constexpr size_t WS_WGU = 68 * MiB;
constexpr size_t WS_WD = 324 * MiB;
constexpr size_t WS_X = 452 * MiB;
constexpr size_t WS_X2 = 516 * MiB;
constexpr size_t WS_H = 580 * MiB;
constexpr size_t WS_PROJ = 612 * MiB;
constexpr size_t WS_PQT = 664 * MiB;
constexpr size_t WS_YA = 680 * MiB;
constexpr size_t WS_YB = 712 * MiB;
constexpr size_t WS_YC = 720 * MiB;
constexpr size_t WS_YD = 728 * MiB;
constexpr size_t WS_LSE = 752 * MiB;
constexpr size_t WS_YN = 753 * MiB;
constexpr size_t WS_AFF = 785 * MiB;
constexpr size_t WS_IDX = 786 * MiB;
constexpr size_t WS_XE = 787 * MiB;
constexpr size_t WS_ACT = 851 * MiB;
constexpr size_t WS_EO = 883 * MiB;
constexpr size_t WS_SGUW = 947 * MiB;
constexpr size_t WS_WRT = WS_SGUW + 512 * 1024;
constexpr size_t WS_ABT = WS_WRT + 128 * 1024;
constexpr size_t WS_VSS = WS_ABT + 256 * 1024;
constexpr size_t WS_END = 948 * MiB;

constexpr int LDS_BYTES = 163840;
constexpr int MISC_OFF = LDS_BYTES - 256;

struct Params { const float* in[20]; float* out; unsigned char* ws; int ph_lo, ph_hi; };

__device__ __forceinline__ unsigned pk2(float lo, float hi) { unsigned r; asm("v_cvt_pk_bf16_f32 %0, %1, %2" : "=v"(r) : "v"(lo), "v"(hi)); return r; }
__device__ __forceinline__ float bflo(unsigned u) { return __uint_as_float(u << 16); }
__device__ __forceinline__ float bfhi(unsigned u) { return __uint_as_float(u & 0xffff0000u); }
__device__ __forceinline__ float wave_sum(float v) {
#pragma unroll
    for (int o = 1; o < 64; o <<= 1) v += __shfl_xor(v, o);
    return v;
}
__device__ __forceinline__ float gelu_tanh(float x) { const float u = 0.7978845608f * (x + 0.044715f * x * x * x); return x * __builtin_amdgcn_rcpf(1.f + __builtin_amdgcn_exp2f(-2.885390082f * u)); }
__device__ __forceinline__ float silu_f(float x) { return x * __builtin_amdgcn_rcpf(1.f + __builtin_amdgcn_exp2f(-1.442695041f * x)); }

__device__ __forceinline__ int opaque_tid() { int t = threadIdx.x; asm volatile("" : "+v"(t)); return t; }
#define XB_TMO      128
#define XB_XCNT(j)  (256  + 64 * (j))
#define XB_XSUB(j)  (1280 + 64 * (j))
#define XB_XGEN(j)  (2304 + 64 * (j))
#define XB_TOP      3328
#define XB_TOPGEN   3392
#define XCD_BAR_WORDS 3456
#define XB_SPIN_CAP (1u << 18)
__device__ __forceinline__ unsigned xb_ld(unsigned* p)              { return __hip_atomic_load(p, __ATOMIC_RELAXED, __HIP_MEMORY_SCOPE_AGENT); }
__device__ __forceinline__ unsigned xb_add(unsigned* p, unsigned v) { return __hip_atomic_fetch_add(p, v, __ATOMIC_RELAXED, __HIP_MEMORY_SCOPE_AGENT); }
__device__ __forceinline__ unsigned xb_xcc_id() { return (unsigned)__builtin_amdgcn_s_getreg((3 << 11) | 20) & 0xFu; }
#define XB_SPIN(cond, bar) do { unsigned _sp = 0; while (cond) { __builtin_amdgcn_s_sleep(1); \
    if ((++_sp & 255u) == 0u) { if (xb_ld(&(bar)[XB_TMO])) break; if (_sp > XB_SPIN_CAP) { atomicAdd(&(bar)[XB_TMO], 1u); break; } } } } while (0)
struct XcdBarrier { unsigned* bar; unsigned x; volatile LAS unsigned* st; };
__device__ __forceinline__ XcdBarrier xcd_barrier_post(unsigned* bar, volatile LAS unsigned* st) {
    XcdBarrier b; b.bar = bar; b.x = xb_xcc_id(); b.st = st;
    if (threadIdx.x == 0) (void)xb_add(&bar[XB_XCNT(b.x)], 1u);
    return b;
}
__device__ __forceinline__ void xcd_barrier_complete(unsigned* bar, unsigned x, unsigned& nloc, unsigned& nx) {
    const unsigned G = gridDim.x * gridDim.y * gridDim.z;
    unsigned sum, cnt, mine, sp = 0u;
    for (;;) {
        sum = 0u; cnt = 0u; mine = 0u;
#pragma unroll
        for (unsigned j = 0; j < 16; ++j) { const unsigned c = xb_ld(&bar[XB_XCNT(j)]); sum += c; cnt += (c > 0u) ? 1u : 0u; mine = (j == x) ? c : mine; }
        if (sum == G) break;
        __builtin_amdgcn_s_sleep(1);
        if ((++sp & 255u) == 0u) { if (xb_ld(&bar[XB_TMO])) break; if (sp > XB_SPIN_CAP) { atomicAdd(&bar[XB_TMO], 1u); break; } }
    }
    nloc = mine > 0u ? mine : 1u; nx = cnt > 0u ? cnt : 1u;
}
__device__ __forceinline__ void xcd_barrier(const XcdBarrier& b) {
    asm volatile("s_waitcnt vmcnt(0)" ::: "memory");
    __syncthreads();
    if (threadIdx.x == 0) {
        unsigned* bar = b.bar;
        __builtin_amdgcn_s_waitcnt(0);
        unsigned nloc = b.st[0], nx = b.st[1];
        if (nloc == 0u) { xcd_barrier_complete(bar, b.x, nloc, nx); b.st[0] = nloc; b.st[1] = nx; }
        const unsigned old = xb_add(&bar[XB_XSUB(b.x)], 1u);
        const unsigned gen = old / nloc;
        if (old + 1u == (gen + 1u) * nloc) {
            __builtin_amdgcn_fence(__ATOMIC_RELEASE, "agent");
            asm volatile("s_waitcnt vmcnt(0)" ::: "memory");
            const unsigned og = xb_add(&bar[XB_TOP], 1u);
            const unsigned tg = og / nx;
            if (og + 1u == (tg + 1u) * nx) xb_add(&bar[XB_TOPGEN], 1u);
            else XB_SPIN(xb_ld(&bar[XB_TOPGEN]) == tg, bar);
            __builtin_amdgcn_fence(__ATOMIC_ACQUIRE, "agent");
            xb_add(&bar[XB_XGEN(b.x)], 1u);
            asm volatile("s_waitcnt vmcnt(0)" ::: "memory");
        } else {
            XB_SPIN(xb_ld(&bar[XB_XGEN(b.x)]) == gen, bar);
            __builtin_amdgcn_fence(__ATOMIC_ACQUIRE, "agent");
            asm volatile("s_waitcnt vmcnt(0)" ::: "memory");
        }
    }
    __syncthreads();
}

namespace pg8 {
constexpr int BM = 256, BK = 64, HALF = 128, HTB = HALF * BK * 2, STAGE_BYTES = 8 * HTB;
__host__ __device__ __forceinline__ int lds_byte(int r, int c) { const int st = (r >> 4) * 2 + (c >> 5), rr = r & 15, cc = c & 31, ob = rr * 64 + cc * 2; return st * 1024 + (ob ^ (((ob >> 9) & 1) << 5)); }
__host__ __device__ __forceinline__ void stage_rc(int b, int& R, int& C) { const int st = b / 1024, sb = b % 1024, swz = sb ^ (((sb >> 9) & 1) << 5); R = (st >> 1) * 16 + swz / 64; C = (st & 1) * 32 + (swz % 64) / 2; }
__host__ __device__ __forceinline__ int perm32(int rho) { const int n = rho >> 4, i = rho & 15; return 8 * (i >> 2) + 4 * n + (i & 3); }

struct GUnit { const char* a; const char* b; int pm, pn, z; };

__device__ __forceinline__ void dense_map(int L, int nM, int nN, int& pm, int& pn) {
    const int nwg = nM * nN;
    int wgid = L; { const int q = nwg / 8, r = nwg % 8, xcd = wgid % 8, off = wgid / 8; wgid = (xcd < r ? xcd * (q + 1) : r * (q + 1) + (xcd - r) * q) + off; }
    const int nig = 8 * nN, gid = wgid / nig, fm = gid * 8, gsz = (nM - fm) < 8 ? (nM - fm) : 8;
    pm = fm + ((wgid % nig) % gsz); pn = (wgid % nig) / gsz;
}

template <class Epi, class Sched, bool GATHER = false>
__device__ __forceinline__ void gemm_phase(LAS unsigned char* lds, const int lda, const int ldb, const int K, const Sched& S, const Epi& E, const int* gidx = nullptr) {
    int tid_ = threadIdx.x; asm volatile("" : "+v"(tid_));
    const int tid = tid_, wid = __builtin_amdgcn_readfirstlane(tid >> 6), lane = tid & 63, wr = wid >> 2, wc = wid & 3, fr = lane & 15, fq = lane >> 4;
    const int nt = K / BK;
    unsigned voffB[2]; int RA[2]; unsigned CA2[2];
#pragma unroll
    for (int i = 0; i < 2; ++i) { int R, C; stage_rc(tid * 16 + i * 8192, R, C); const int Rb = Epi::PERM ? ((R & ~31) + perm32(R & 31)) : R;
        RA[i] = R; CA2[i] = (unsigned)C * 2u; voffB[i] = (unsigned)(Rb * ldb + C) * 2u; }
    const size_t kstep = (size_t)(BK * 2);
    const size_t hstepB = (size_t)HALF * ldb * 2;
    const unsigned ldsw = (unsigned)wid * 1024u;
    const int aoff = lds_byte(wr * 64 + fr, fq * 8), boff = lds_byte(wc * 32 + fr, fq * 8);
#define PG8_AOFF(of, u) do { _Pragma("unroll") for (int hh_ = 0; hh_ < 2; ++hh_) _Pragma("unroll") for (int i_ = 0; i_ < 2; ++i_) { \
        if constexpr (GATHER) of[hh_][i_] = (unsigned)gidx[(u).pm * 256 + hh_ * 128 + RA[i_]] * (unsigned)(lda * 2) + CA2[i_]; \
        else of[hh_][i_] = (unsigned)((hh_ * HALF + RA[i_]) * lda) * 2u + CA2[i_]; } } while (0)
#define PG8_SA(b, h) (((b) * 2 + (h)) * HTB)
#define PG8_SB(b, h) ((4 + (b) * 2 + (h)) * HTB)
#define PG8_STAGE(bufoff, gbase, voff) do { _Pragma("unroll") for (int _i = 0; _i < 2; ++_i) \
        __builtin_amdgcn_global_load_lds((const unsigned*)((const char*)(gbase) + (voff)[_i]), (LAS unsigned*)(lds + (bufoff) + ldsw + _i * 8192), 16, 0, 0); } while (0)
#define PG8_LDA(dst, b, h) do { _Pragma("unroll") for (int m = 0; m < 4; ++m) _Pragma("unroll") for (int k = 0; k < 2; ++k) dst[m][k] = *(const LAS bf16x8*)(lds + PG8_SA(b, h) + aoff + m * 2048 + k * 1024); } while (0)
#define PG8_LDB(dst, b, h) do { _Pragma("unroll") for (int n = 0; n < 2; ++n) _Pragma("unroll") for (int k = 0; k < 2; ++k) dst[n][k] = *(const LAS bf16x8*)(lds + PG8_SB(b, h) + boff + n * 2048 + k * 1024); } while (0)
#define PG8_MMA(ai, bj, At, Bt) do { __builtin_amdgcn_s_setprio(1); _Pragma("unroll") for (int m = 0; m < 4; ++m) _Pragma("unroll") for (int n = 0; n < 2; ++n) _Pragma("unroll") for (int k = 0; k < 2; ++k) \
        acc[ai][bj][m][n] = __builtin_amdgcn_mfma_f32_16x16x32_bf16(Bt[n][k], At[m][k], acc[ai][bj][m][n], 0, 0, 0); __builtin_amdgcn_s_setprio(0); } while (0)
#define PG8_WAIT_V(n) asm volatile("s_waitcnt vmcnt(" #n ")" ::: "memory")
#define PG8_WAIT_L(n) asm volatile("s_waitcnt lgkmcnt(" #n ")" ::: "memory")
#define PG8_BAR __builtin_amdgcn_s_barrier()
#define PG8_SCHED __builtin_amdgcn_sched_barrier(0)
    GUnit cur, nxt; int ui = 0;
    if (!S.next(0, cur)) return;
    f32x4 acc[2][2][4][2];
#pragma unroll
    for (int a = 0; a < 2; ++a)
#pragma unroll
        for (int b = 0; b < 2; ++b)
#pragma unroll
            for (int m = 0; m < 4; ++m)
#pragma unroll
                for (int n = 0; n < 2; ++n) acc[a][b][m][n] = (f32x4){0.f, 0.f, 0.f, 0.f};
    bf16x8 At[4][2], B0[2][2], B1[2][2];
    unsigned ofc[2][2], ofn[2][2];
    PG8_AOFF(ofc, cur);
#pragma unroll
    for (int hh = 0; hh < 2; ++hh)
#pragma unroll
        for (int i = 0; i < 2; ++i) ofn[hh][i] = ofc[hh][i];
    const char* cA = cur.a; const char* cB = cur.b;
    PG8_STAGE(PG8_SB(0, 0), cB, voffB); PG8_STAGE(PG8_SB(0, 1), cB + hstepB, voffB); PG8_STAGE(PG8_SA(0, 0), cA, ofc[0]); PG8_STAGE(PG8_SA(0, 1), cA, ofc[1]);
    if (wr == 1) PG8_BAR;
    PG8_WAIT_V(2); PG8_BAR;
    PG8_STAGE(PG8_SB(1, 0), cB + kstep, voffB); PG8_STAGE(PG8_SA(1, 0), cA + kstep, ofc[0]); PG8_STAGE(PG8_SB(1, 1), cB + hstepB + kstep, voffB);
    PG8_WAIT_V(6); PG8_BAR;
    for (;;) {
        const bool has_next = S.next(ui + 1, nxt);
        const char* nA = has_next ? nxt.a : cA; const char* nB = has_next ? nxt.b : cB;
        for (int t = 0; t < nt; t += 2) {
            const bool last = (t == nt - 2);
            if constexpr (GATHER) { if (last && has_next) PG8_AOFF(ofn, nxt); }
            const char* a1 = cA + (size_t)(t + 1) * kstep;
            const char* a2 = last ? nA : cA + (size_t)(t + 2) * kstep; const char* b2 = last ? nB : cB + (size_t)(t + 2) * kstep;
            const char* a3 = a2 + kstep; const char* b3 = b2 + kstep;
            unsigned o2[2][2];
#pragma unroll
            for (int hh = 0; hh < 2; ++hh)
#pragma unroll
                for (int i = 0; i < 2; ++i) { if constexpr (GATHER) o2[hh][i] = last ? ofn[hh][i] : ofc[hh][i]; else o2[hh][i] = ofc[hh][i]; }
            PG8_LDB(B0, 0, 0); PG8_LDB(B1, 0, 1); PG8_SCHED; PG8_LDA(At, 0, 0); PG8_STAGE(PG8_SA(1, 1), a1, ofc[1]);
            PG8_WAIT_V(8); PG8_WAIT_L(0); PG8_BAR; PG8_MMA(0, 0, At, B0); PG8_MMA(0, 1, At, B1); PG8_BAR; PG8_SCHED;
            PG8_LDA(At, 0, 1); PG8_STAGE(PG8_SB(0, 0), b2, voffB); PG8_STAGE(PG8_SB(0, 1), b2 + hstepB, voffB); PG8_STAGE(PG8_SA(0, 0), a2, o2[0]);
            PG8_WAIT_V(8); PG8_WAIT_L(0); PG8_BAR; PG8_MMA(1, 0, At, B0); PG8_MMA(1, 1, At, B1); PG8_BAR; PG8_SCHED;
            PG8_LDB(B0, 1, 0); PG8_LDB(B1, 1, 1); PG8_SCHED; PG8_LDA(At, 1, 0); PG8_STAGE(PG8_SA(0, 1), a2, o2[1]);
            PG8_WAIT_V(8); PG8_WAIT_L(0); PG8_BAR; PG8_MMA(0, 0, At, B0); PG8_MMA(0, 1, At, B1); PG8_BAR; PG8_SCHED;
            PG8_LDA(At, 1, 1); PG8_STAGE(PG8_SB(1, 0), b3, voffB); PG8_STAGE(PG8_SB(1, 1), b3 + hstepB, voffB); PG8_STAGE(PG8_SA(1, 0), a3, o2[0]);
            PG8_WAIT_V(8); PG8_WAIT_L(0); PG8_BAR; PG8_MMA(1, 0, At, B0); PG8_MMA(1, 1, At, B1); PG8_BAR; PG8_SCHED;
        }
        if (wr == 0) PG8_BAR;
        E(acc, cur, wr, wc, fr, fq);
        if (!has_next) break;
#pragma unroll
        for (int a = 0; a < 2; ++a)
#pragma unroll
            for (int b = 0; b < 2; ++b)
#pragma unroll
                for (int m = 0; m < 4; ++m)
#pragma unroll
                    for (int n = 0; n < 2; ++n) acc[a][b][m][n] = (f32x4){0.f, 0.f, 0.f, 0.f};
        cur = nxt; cA = nA; cB = nB; ++ui;
        if constexpr (GATHER) {
#pragma unroll
            for (int hh = 0; hh < 2; ++hh)
#pragma unroll
                for (int i = 0; i < 2; ++i) ofc[hh][i] = ofn[hh][i];
        }
        if (wr == 1) PG8_BAR;
    }
    PG8_WAIT_V(0);
    PG8_BAR;
#undef PG8_AOFF
#undef PG8_SA
#undef PG8_SB
#undef PG8_STAGE
#undef PG8_LDA
#undef PG8_LDB
#undef PG8_MMA
#undef PG8_WAIT_V
#undef PG8_WAIT_L
#undef PG8_BAR
#undef PG8_SCHED
}
}
using pg8::GUnit;

struct SchedProj {
    const char* H; const char* WIN; const char* WPQ; int G, c;
    __device__ __forceinline__ bool next(int i, GUnit& u) const {
        const int L = i * G + c; if (L >= 480) return false;
        if (L < 416) { int pm, pn; pg8::dense_map(L, 32, 13, pm, pn); u.pm = pm; u.pn = pn; u.z = 0; u.a = H + (size_t)pm * 256 * 2048 * 2; u.b = WIN + (size_t)pn * 256 * 2048 * 2; }
        else { int pm, pn; pg8::dense_map(L - 416, 2, 32, pm, pn); u.pm = pm; u.pn = pn + 64; u.z = 0; u.a = WPQ + (size_t)pm * 256 * 2048 * 2; u.b = H + (size_t)pn * 256 * 2048 * 2; }
        return true;
    }
};
struct SchedDft {
    const char* DFT; const char* XAT; int G, c;
    __device__ __forceinline__ bool next(int i, GUnit& u) const {
        const int L = i * G + c; if (L >= 256) return false;
        const int Lp = (L & 7) * 32 + (L >> 3);
        const int ks = Lp & 1, pn = (Lp >> 1) & 1, pm = (Lp >> 2) & 15, b = Lp >> 6;
        u.pm = b * 16 + pm; u.pn = pn; u.z = ks;
        u.a = DFT + ((size_t)pm * 256 * 2048 + ks * 1024) * 2; u.b = XAT + (((size_t)b * 512 + pn * 256) * 2048 + ks * 1024) * 2;
        return true;
    }
};
struct SchedDense {
    const char* A; const char* B; int nM, nN, K, G, c;
    __device__ __forceinline__ bool next(int i, GUnit& u) const {
        const int L = i * G + c; if (L >= nM * nN) return false;
        int pm, pn; pg8::dense_map(L, nM, nN, pm, pn); u.pm = pm; u.pn = pn; u.z = 0;
        u.a = A + (size_t)pm * 256 * K * 2; u.b = B + (size_t)pn * 256 * K * 2; return true;
    }
};
struct SchedMoeG {
    const char* A; const char* B; int K, G, c;
    __device__ __forceinline__ bool next(int i, GUnit& u) const {
        const int L = i * G + c; if (L >= 512) return false;
        const int Lp = (L & 7) * 64 + (L >> 3);
        const int e = Lp >> 5, r = Lp & 31, pm = r & 3, pn = r >> 2;
        u.pm = e * 4 + pm; u.pn = pn; u.z = e;
        u.a = A; u.b = B + ((size_t)e * 2048 + pn * 256) * K * 2; return true;
    }
};
struct SchedMoe {
    const char* A; const char* B; int K, G, c;
    __device__ __forceinline__ bool next(int i, GUnit& u) const {
        const int L = i * G + c; if (L >= 512) return false;
        const int Lp = (L & 7) * 64 + (L >> 3);
        const int e = Lp >> 5, r = Lp & 31, pm = r & 3, pn = r >> 2;
        u.pm = e * 4 + pm; u.pn = pn; u.z = e;
        u.a = A + ((size_t)e * 1024 + pm * 256) * K * 2; u.b = B + ((size_t)e * 2048 + pn * 256) * K * 2; return true;
    }
};

typedef f32x4 AccT[2][2][4][2];
struct EpiProj {
    static constexpr bool PERM = true;
    bf16_t* PROJ; bf16_t* PQT; const float* ropec; const float* ropes;
    __device__ __forceinline__ void operator()(const AccT& acc, const GUnit& u, int wr, int wc, int fr, int fq) const {
        if (u.pn < 64) {
            const int pn = u.pn;
            const int row0 = u.pm * 256 + wr * 64 + fr;
#pragma unroll
            for (int ai = 0; ai < 2; ++ai)
#pragma unroll
                for (int m = 0; m < 4; ++m) {
                    const int row = row0 + ai * 128 + m * 16;
                    float vsq = 0.f;
#pragma unroll
                    for (int bj = 0; bj < 2; ++bj) {
                        f32x4 v0 = acc[ai][bj][m][0], v1 = acc[ai][bj][m][1];
                        const int colt = pn * 256 + bj * 128;
                        if (pn < 4) {
#pragma unroll
                            for (int j = 0; j < 4; ++j) { v0[j] = gelu_tanh(v0[j]); v1[j] = gelu_tanh(v1[j]); vsq += v0[j] * v0[j] + v1[j] * v1[j]; }
                        } else {
                            const bool isq = (colt >= PC_QC && colt < PC_KC) || (colt >= PC_QD && colt < PC_KD);
                            const bool isk = (colt >= PC_KC && colt < PC_VC) || (colt >= PC_KD && colt < PC_VD);
                            if (isq || isk) {
                                if ((wc & 1) == 0) {
                                    f32x4 o0, o1;
#pragma unroll
                                    for (int j = 0; j < 4; ++j) { o0[j] = __shfl_xor(v0[j], 16); o1[j] = __shfl_xor(v1[j], 16); }
                                    if (fq < 2) {
                                        const f32x4 c0 = *(const f32x4*)(ropec + (size_t)row * 8), c1 = *(const f32x4*)(ropec + (size_t)row * 8 + 4);
                                        const f32x4 s0 = *(const f32x4*)(ropes + (size_t)row * 8), s1 = *(const f32x4*)(ropes + (size_t)row * 8 + 4);
                                        const float sg = fq == 0 ? -1.f : 1.f;
#pragma unroll
                                        for (int j = 0; j < 4; ++j) { v0[j] = v0[j] * c0[j] + sg * o0[j] * s0[j]; v1[j] = v1[j] * c1[j] + sg * o1[j] * s1[j]; }
                                    }
                                }
                                if (isq) { v0 = v0 * 0.125f; v1 = v1 * 0.125f; }
                            }
                        }
                        u32x4 w; w.x = pk2(v0[0], v0[1]); w.y = pk2(v0[2], v0[3]); w.z = pk2(v1[0], v1[1]); w.w = pk2(v1[2], v1[3]);
                        *(u32x4*)(PROJ + (size_t)row * NPROJ + colt + wc * 32 + 8 * fq) = w;
                    }
                    if (pn == 2 || pn == 3) {
                        vsq += __shfl_xor(vsq, 16); vsq += __shfl_xor(vsq, 32);
                        if (fq == 0) ((float*)((char*)PROJ + (WS_VSS - WS_PROJ)))[(size_t)row * 8 + (pn - 2) * 4 + wc] = vsq;
                    }
                }
        } else {
#pragma unroll
            for (int ai = 0; ai < 2; ++ai)
#pragma unroll
                for (int m = 0; m < 4; ++m) {
                    const int c = u.pm * 256 + ai * 128 + wr * 64 + m * 16 + fr;
#pragma unroll
                    for (int bj = 0; bj < 2; ++bj) {
                        const int t = (u.pn - 64) * 256 + bj * 128 + wc * 32 + 8 * fq, b = t >> 11, s = t & 2047;
                        const f32x4 v0 = acc[ai][bj][m][0], v1 = acc[ai][bj][m][1];
                        u32x4 w; w.x = pk2(v0[0], v0[1]); w.y = pk2(v0[2], v0[3]); w.z = pk2(v1[0], v1[1]); w.w = pk2(v1[2], v1[3]);
                        *(u32x4*)(PQT + (((size_t)b * 512 + c) * 2048 + s)) = w;
                    }
                }
        }
    }
};
struct EpiBf16Plain {
    static constexpr bool PERM = true;
    bf16_t* O; int ldc; size_t zstride;
    __device__ __forceinline__ void operator()(const AccT& acc, const GUnit& u, int wr, int wc, int fr, int fq) const {
        bf16_t* base = O + (size_t)u.z * zstride;
#pragma unroll
        for (int ai = 0; ai < 2; ++ai)
#pragma unroll
            for (int m = 0; m < 4; ++m) {
                const int row = u.pm * 256 + ai * 128 + wr * 64 + m * 16 + fr;
#pragma unroll
                for (int bj = 0; bj < 2; ++bj) {
                    const f32x4 v0 = acc[ai][bj][m][0], v1 = acc[ai][bj][m][1];
                    u32x4 w; w.x = pk2(v0[0], v0[1]); w.y = pk2(v0[2], v0[3]); w.z = pk2(v1[0], v1[1]); w.w = pk2(v1[2], v1[3]);
                    *(u32x4*)(base + (size_t)row * ldc + u.pn * 256 + bj * 128 + wc * 32 + 8 * fq) = w;
                }
            }
    }
};
struct EpiWout {
    static constexpr bool PERM = true;
    const float* base32; const bf16_t* base16; bf16_t* X2; const float* gate;
    __device__ __forceinline__ void operator()(const AccT& acc, const GUnit& u, int wr, int wc, int fr, int fq) const {
        const int b = u.pm >> 3;
        const int col0 = u.pn * 256 + wc * 32 + 8 * fq;
        f32x4 g[2][2];
#pragma unroll
        for (int bj = 0; bj < 2; ++bj)
#pragma unroll
            for (int n = 0; n < 2; ++n) g[bj][n] = *(const f32x4*)(gate + (size_t)b * 12288 + col0 + bj * 128 + n * 4);
#pragma unroll
        for (int ai = 0; ai < 2; ++ai)
#pragma unroll
            for (int m = 0; m < 4; ++m) {
                const size_t ro = (size_t)(u.pm * 256 + ai * 128 + wr * 64 + m * 16 + fr) * DM + col0;
#pragma unroll
                for (int bj = 0; bj < 2; ++bj) {
                    f32x4 x0, x1;
                    if (base32) { x0 = *(const f32x4*)(base32 + ro + bj * 128); x1 = *(const f32x4*)(base32 + ro + bj * 128 + 4); }
                    else { const u32x4 w = *(const u32x4*)(base16 + ro + bj * 128); x0 = (f32x4){bflo(w.x), bfhi(w.x), bflo(w.y), bfhi(w.y)}; x1 = (f32x4){bflo(w.z), bfhi(w.z), bflo(w.w), bfhi(w.w)}; }
                    const f32x4 v0 = x0 + g[bj][0] * acc[ai][bj][m][0], v1 = x1 + g[bj][1] * acc[ai][bj][m][1];
                    u32x4 o; o.x = pk2(v0[0], v0[1]); o.y = pk2(v0[2], v0[3]); o.z = pk2(v1[0], v1[1]); o.w = pk2(v1[2], v1[3]);
                    *(u32x4*)(X2 + ro + bj * 128) = o;
                }
            }
    }
};
struct EpiGU {
    static constexpr bool PERM = true;
    bf16_t* ACT;
    __device__ __forceinline__ void operator()(const AccT& acc, const GUnit& u, int wr, int wc, int fr, int fq) const {
#pragma unroll
        for (int ai = 0; ai < 2; ++ai)
#pragma unroll
            for (int m = 0; m < 4; ++m) {
                const int row = u.pm * 256 + ai * 128 + wr * 64 + m * 16 + fr;
                f32x4 v0, v1;
#pragma unroll
                for (int j = 0; j < 4; ++j) { v0[j] = silu_f(acc[ai][0][m][0][j]) * acc[ai][1][m][0][j]; v1[j] = silu_f(acc[ai][0][m][1][j]) * acc[ai][1][m][1][j]; }
                u32x4 w; w.x = pk2(v0[0], v0[1]); w.y = pk2(v0[2], v0[3]); w.z = pk2(v1[0], v1[1]); w.w = pk2(v1[2], v1[3]);
                *(u32x4*)(ACT + (size_t)row * FF + u.pn * 128 + wc * 32 + 8 * fq) = w;
            }
    }
};
struct EpiDown {
    static constexpr bool PERM = true;
    bf16_t* EO; const float* gate;
    __device__ __forceinline__ void operator()(const AccT& acc, const GUnit& u, int wr, int wc, int fr, int fq) const {
#pragma unroll
        for (int ai = 0; ai < 2; ++ai)
#pragma unroll
            for (int m = 0; m < 4; ++m) {
                const int row = u.pm * 256 + ai * 128 + wr * 64 + m * 16 + fr;
                const float g = gate[row];
#pragma unroll
                for (int bj = 0; bj < 2; ++bj) {
                    const f32x4 v0 = acc[ai][bj][m][0] * g, v1 = acc[ai][bj][m][1] * g;
                    u32x4 w; w.x = pk2(v0[0], v0[1]); w.y = pk2(v0[2], v0[3]); w.z = pk2(v1[0], v1[1]); w.w = pk2(v1[2], v1[3]);
                    *(u32x4*)(EO + (size_t)row * DM + u.pn * 256 + bj * 128 + wc * 32 + 8 * fq) = w;
                }
            }
    }
};

__device__ __forceinline__ void ph_mod(const Params& p, LAS unsigned char* lds) {
    LAS float* sl = (LAS float*)lds;
    LAS float* red = (LAS float*)(lds + 32768);
    const int tid = opaque_tid();
    const float* c = p.in[1];
    float* mod = (float*)(p.ws + WS_MOD);
    for (int i = tid; i < 8192; i += 512) { const float v = c[i]; sl[i] = v / (1.f + expf(-v)); }
    __syncthreads();
    const int cl = tid & 31, ks = tid >> 5;
    for (int u = blockIdx.x; u < 192; u += gridDim.x) {
        const int l = u / 96, cc = u % 96;
        const float* W = p.in[3] + (size_t)l * 2048 * 12288 + cc * 128 + cl * 4;
        float acc[4][4];
#pragma unroll
        for (int b = 0; b < 4; ++b)
#pragma unroll
            for (int j = 0; j < 4; ++j) acc[b][j] = 0.f;
#pragma unroll 8
        for (int k = ks; k < 2048; k += 16) {
            const f32x4 w = __builtin_nontemporal_load((const f32x4*)(W + (size_t)k * 12288));
#pragma unroll
            for (int b = 0; b < 4; ++b) { const float s = sl[b * 2048 + k];
#pragma unroll
                for (int j = 0; j < 4; ++j) acc[b][j] += s * w[j]; }
        }
#pragma unroll
        for (int b = 0; b < 4; ++b)
#pragma unroll
            for (int j = 0; j < 4; ++j) red[((b * 4 + j) * 16 + ks) * 32 + cl] = acc[b][j];
        __syncthreads();
        { const int b = tid >> 7, col = tid & 127; float s = 0.f;
#pragma unroll
          for (int q = 0; q < 16; ++q) s += red[((b * 4 + (col & 3)) * 16 + q) * 32 + (col >> 2)];
          mod[(size_t)(l * 4 + b) * 12288 + cc * 128 + col] = s + p.in[4][(size_t)l * 12288 + cc * 128 + col]; }
        __syncthreads();
    }
}
__device__ __forceinline__ void ph_tables(const Params& p, LAS unsigned char* lds) {
    const int tid = opaque_tid();
    const int gt = blockIdx.x * 512 + tid, ngt = gridDim.x * 512;
    LAS float* ct = (LAS float*)lds;
    LAS float* c64 = ct + 2048;
    for (int m = tid; m < 2048; m += 512) ct[m] = cospif((float)m * (1.f / 1024.f));
    if (tid < 64) { c64[tid] = cospif((float)tid * (1.f / 32.f)); c64[64 + tid] = sinpif((float)tid * (1.f / 32.f)); }
    __syncthreads();
    float* rc = (float*)(p.ws + WS_ROPE); float* rs = rc + NT * 8;
    const int* pos = (const int*)p.in[2];
    for (int i = gt; i < NT * 8; i += ngt) {
        const int t = i >> 3, j = i & 7;
        float inv;
        switch (j) { case 0: inv = 1.0f; break; case 1: inv = 0.1939227432012558f; break; case 2: inv = 0.03760603070259094f; break; case 3: inv = 0.007292664609849453f; break;
                     case 4: inv = 0.0014142135623842478f; break; case 5: inv = 0.00027424818836152554f; break; case 6: inv = 5.318296098266728e-05f; break; default: inv = 1.0313386155758053e-05f; break; }
        const float ang = (float)pos[t] * inv;
        double r = (double)ang * 0.15915494309189535; r -= floor(r);
        const float a = (float)(2.0 * r);
        rc[i] = cospif(a); rs[i] = sinpif(a);
    }
    { bf16_t* sw = (bf16_t*)(p.ws + WS_SGUW);
      for (int i = gt; i < 2 * 8 * 128 * 128 / 4; i += ngt) { const f32x4 w = *(const f32x4*)(p.in[9] + (size_t)i * 4); u32x2 o; o.x = pk2(w[0], w[1]); o.y = pk2(w[2], w[3]); *(u32x2*)(sw + (size_t)i * 4) = o; } }
    { bf16_t* wrt = (bf16_t*)(p.ws + WS_WRT);
      for (int i = gt; i < 2 * 16 * 2048; i += ngt) { const int l = i >> 15, e = (i >> 11) & 15, k = i & 2047; wrt[i] = (bf16_t)(pk2(p.in[15][((size_t)l * 2048 + k) * 16 + e], 0.f) & 0xffffu); } }
    { bf16_t* abt = (bf16_t*)(p.ws + WS_ABT);
      for (int i = gt; i < 2 * 8 * 64 * 128; i += ngt) { const int k = i & 127, d = (i >> 7) & 63, lh = i >> 13, c = k & 63; const float* fw = p.in[7] + (size_t)lh * 4096;
          float sacc = 0.f;
          for (int cp = 0; cp < 64; ++cp) sacc += c64[(k < 64 ? 0 : 64) + ((c * cp) & 63)] * fw[cp * 64 + d];
          abt[i] = (bf16_t)(pk2(sacc * 0.125f, 0.f) & 0xffffu); } }
    bf16_t* dft = (bf16_t*)(p.ws + WS_DFT);
    for (int i = gt; i < 2048 * 512; i += ngt) {
        const int sp = i >> 9, k8 = (i & 511) * 8;
        float v[8];
#pragma unroll
        for (int e = 0; e < 8; ++e) { const int k = k8 + e, part = k >> 11, s = k & 2047, m = (s * sp + part * 512) & 2047;
            v[e] = ct[m] * 0.022097086912079608f; }
        u32x4 w; w.x = pk2(v[0], v[1]); w.y = pk2(v[2], v[3]); w.z = pk2(v[4], v[5]); w.w = pk2(v[6], v[7]);
        *(u32x4*)(dft + (size_t)sp * 4096 + k8) = w;
    }
    __syncthreads();
}
struct TDesc { const float* src; bf16_t* dst; const float* ksc; int lds_, ldd; };
__device__ __forceinline__ bool tdecode(const Params& p, int it, TDesc& d) {
    if (it >= 2 * 6880) return false;
    const int l = it / 6880; int r = it % 6880;
    d.ksc = nullptr;
    if (r < 480) { const int kt = r / 30, nt = r % 30;
        d.src = p.in[6] + ((size_t)l * 2048 + kt * 128) * DIN + nt * 128; d.lds_ = DIN;
        d.dst = (nt < 4 ? (bf16_t*)(p.ws + WS_WPQ) + ((size_t)l * 512 + nt * 128) * 2048 : (bf16_t*)(p.ws + WS_WIN) + ((size_t)l * NPROJ + (nt - 4) * 128) * 2048) + kt * 128; d.ldd = 2048; return true; }
    r -= 480;
    if (r < 256) { const int kt = r / 16, nt = r % 16;
        d.src = p.in[13] + ((size_t)l * 2048 + kt * 128) * 2048 + nt * 128; d.lds_ = 2048; d.ksc = p.in[12] + (size_t)l * 2048 + kt * 128;
        d.dst = (bf16_t*)(p.ws + WS_WOUT) + ((size_t)l * 2048 + nt * 128) * 2048 + kt * 128; d.ldd = 2048; return true; }
    r -= 256;
    if (r < 4096) { const int isup = r / 2048, r2 = r % 2048, e = r2 / 128, kt = (r2 % 128) / 8, nt = r2 % 8;
        d.src = p.in[isup ? 17 : 16] + (((size_t)l * 16 + e) * 2048 + kt * 128) * 1024 + nt * 128; d.lds_ = 1024;
        d.dst = (bf16_t*)(p.ws + WS_WGU) + (((size_t)l * 16 + e) * 2048 + nt * 256 + isup * 128) * 2048 + kt * 128; d.ldd = 2048; return true; }
    r -= 4096;
    { const int e = r / 128, kt = (r % 128) / 16, nt = r % 16;
        d.src = p.in[18] + (((size_t)l * 16 + e) * 1024 + kt * 128) * 2048 + nt * 128; d.lds_ = 2048;
        d.dst = (bf16_t*)(p.ws + WS_WD) + (((size_t)l * 16 + e) * 2048 + nt * 128) * 1024 + kt * 128; d.ldd = 1024; return true; }
}
__device__ __forceinline__ void ph_weights(const Params& p, LAS unsigned char* lds, const int p0, const int p1, const int wi, const int wn) {
    const int tid = opaque_tid();
    LAS unsigned* l32 = (LAS unsigned*)lds;
    LAS bf16_t* l16 = (LAS bf16_t*)lds;
    TDesc dA0, dA1, dB0, dB1; f32x4 a0[8], a1[8], b0[8], b1[8];
#define PW_LOAD(pi, D0, D1, V0, V1, HAVE) do { HAVE = (pi) < p1; if (HAVE) { tdecode(p, 2 * (pi), D0); tdecode(p, 2 * (pi) + 1, D1); \
        _Pragma("unroll") for (int i = 0; i < 8; ++i) { const int f = tid + 512 * i, k = f >> 5, c4 = f & 31; \
            V0[i] = __builtin_nontemporal_load((const f32x4*)(D0.src + (size_t)k * D0.lds_ + c4 * 4)); V1[i] = __builtin_nontemporal_load((const f32x4*)(D1.src + (size_t)k * D1.lds_ + c4 * 4)); } } } while (0)
#define PW_TOLDS(D0, V0, V1) do { _Pragma("unroll") for (int i = 0; i < 8; ++i) { const int f = tid + 512 * i, k = f >> 5, c4 = f & 31; const float sc = D0.ksc ? D0.ksc[k] : 1.f; \
        const int sw = ((k >> 3) & 15) * 2; u32x2 w; w.x = pk2(V0[i][0] * sc, V0[i][1] * sc); w.y = pk2(V0[i][2] * sc, V0[i][3] * sc); \
        *(LAS u32x2*)(l32 + k * 64 + ((2 * c4) ^ sw)) = w; \
        u32x2 w2; w2.x = pk2(V1[i][0] * sc, V1[i][1] * sc); w2.y = pk2(V1[i][2] * sc, V1[i][3] * sc); \
        *(LAS u32x2*)(l32 + 8192 + k * 64 + ((2 * c4) ^ sw)) = w2; } } while (0)
#define PW_STORE(DS0, DS1) do { _Pragma("unroll") for (int i = 0; i < 4; ++i) { \
        const int n = (tid >> 4) + 32 * i, kc = tid & 15, cd = (n >> 1) ^ (2 * kc), hf = n & 1; \
        unsigned short e[8], g[8]; \
        _Pragma("unroll") for (int q = 0; q < 8; ++q) { e[q] = l16[((8 * kc + q) * 64 + cd) * 2 + hf]; g[q] = l16[16384 + ((8 * kc + q) * 64 + cd) * 2 + hf]; } \
        u32x4 w; w.x = e[0] | ((unsigned)e[1] << 16); w.y = e[2] | ((unsigned)e[3] << 16); w.z = e[4] | ((unsigned)e[5] << 16); w.w = e[6] | ((unsigned)e[7] << 16); \
        __builtin_nontemporal_store(w, (u32x4*)(DS0.dst + (size_t)n * DS0.ldd + 8 * kc)); \
        u32x4 w2; w2.x = g[0] | ((unsigned)g[1] << 16); w2.y = g[2] | ((unsigned)g[3] << 16); w2.z = g[4] | ((unsigned)g[5] << 16); w2.w = g[6] | ((unsigned)g[7] << 16); \
        __builtin_nontemporal_store(w2, (u32x4*)(DS1.dst + (size_t)n * DS1.ldd + 8 * kc)); } } while (0)
    int pi = p0 + wi; bool hA, hB;
    PW_LOAD(pi, dA0, dA1, a0, a1, hA);
    PW_LOAD(pi + wn, dB0, dB1, b0, b1, hB);
    while (hA) {
        { PW_TOLDS(dA0, a0, a1); __syncthreads(); const TDesc s0 = dA0, s1 = dA1; PW_LOAD(pi + 2 * wn, dA0, dA1, a0, a1, hA); PW_STORE(s0, s1); __syncthreads(); }
        if (!hB) break;
        { PW_TOLDS(dB0, b0, b1); __syncthreads(); const TDesc s0 = dB0, s1 = dB1; PW_LOAD(pi + 3 * wn, dB0, dB1, b0, b1, hB); PW_STORE(s0, s1); __syncthreads(); }
        pi += 2 * wn;
    }
#undef PW_LOAD
#undef PW_TOLDS
#undef PW_STORE
}

__device__ __forceinline__ void ph_norm1(const Params& p, int mode) {
    const int tid = opaque_tid(), lane = tid & 63, wv = tid >> 6;
    const float* mod = (const float*)(p.ws + WS_MOD);
    const int* slot_of = (const int*)(p.ws + WS_IDX + 131072);
    const bf16_t* EO = (const bf16_t*)(p.ws + WS_EO);
    for (int t = blockIdx.x * 8 + wv; t < NT; t += gridDim.x * 8) {
        const int b = t >> 11;
        f32x4 v[8];
        if (mode == 0) { const float* xr = p.in[0] + (size_t)t * DM;
#pragma unroll
            for (int j = 0; j < 8; ++j) v[j] = *(const f32x4*)(xr + 4 * lane + 256 * j);
        } else { const bf16_t* xr = (const bf16_t*)(p.ws + WS_X2) + (size_t)t * DM;
#pragma unroll
            for (int j = 0; j < 8; ++j) { const u32x2 w = *(const u32x2*)(xr + 4 * lane + 256 * j); v[j] = (f32x4){bflo(w.x), bfhi(w.x), bflo(w.y), bfhi(w.y)}; }
        }
        if (mode != 0) {
            f32x4 macc[8];
#pragma unroll
            for (int j = 0; j < 8; ++j) macc[j] = (f32x4){0.f, 0.f, 0.f, 0.f};
            const int myslot = slot_of[(size_t)(lane & 15) * NT + t];
            unsigned m = (unsigned)(__ballot(myslot >= 0) & 0xffffull);
            while (m) {
                const int e0 = __builtin_ctz(m); m &= m - 1u;
                const bool two = m != 0u; const int e1 = two ? __builtin_ctz(m) : e0; if (two) m &= m - 1u;
                const int s0 = __builtin_amdgcn_readlane(myslot, e0), s1 = __builtin_amdgcn_readlane(myslot, e1);
                const float w1 = two ? 1.f : 0.f;
                const bf16_t* r0 = EO + (size_t)s0 * DM; const bf16_t* r1 = EO + (size_t)s1 * DM;
                u32x2 a[8], c[8];
#pragma unroll
                for (int j = 0; j < 8; ++j) { a[j] = *(const u32x2*)(r0 + 4 * lane + 256 * j); c[j] = *(const u32x2*)(r1 + 4 * lane + 256 * j); }
#pragma unroll
                for (int j = 0; j < 8; ++j) {
                    macc[j][0] += bflo(a[j].x) + w1 * bflo(c[j].x); macc[j][1] += bfhi(a[j].x) + w1 * bfhi(c[j].x);
                    macc[j][2] += bflo(a[j].y) + w1 * bflo(c[j].y); macc[j][3] += bfhi(a[j].y) + w1 * bfhi(c[j].y); }
            }
            const float* gf = mod + ((size_t)(mode - 1) * 4 + b) * 12288 + 5 * 2048;
#pragma unroll
            for (int j = 0; j < 8; ++j) { const f32x4 g = *(const f32x4*)(gf + 4 * lane + 256 * j); v[j] = v[j] + g * macc[j]; }
            if (mode == 1) {
                bf16_t* xo = (bf16_t*)(p.ws + WS_X) + (size_t)t * DM;
#pragma unroll
                for (int j = 0; j < 8; ++j) { u32x2 w; w.x = pk2(v[j][0], v[j][1]); w.y = pk2(v[j][2], v[j][3]); *(u32x2*)(xo + 4 * lane + 256 * j) = w;
                    v[j] = (f32x4){bflo(w.x), bfhi(w.x), bflo(w.y), bfhi(w.y)}; }
            }
        }
        float ss = 0.f;
#pragma unroll
        for (int j = 0; j < 8; ++j) ss += v[j][0] * v[j][0] + v[j][1] * v[j][1] + v[j][2] * v[j][2] + v[j][3] * v[j][3];
        const float r = 1.0f / sqrtf(wave_sum(ss) * (1.f / DM) + EPS);
        if (mode == 2) {
            float* o = p.out + (size_t)t * DM;
#pragma unroll
            for (int j = 0; j < 8; ++j) { const f32x4 g = *(const f32x4*)(p.in[19] + 4 * lane + 256 * j); *(f32x4*)(o + 4 * lane + 256 * j) = v[j] * r * g; }
        } else {
            const int l = mode;
            const float* g1 = p.in[5] + (size_t)l * DM;
            const float* sh = mod + ((size_t)l * 4 + b) * 12288;
            const float* sc = sh + 2048;
            bf16_t* ho = (bf16_t*)(p.ws + WS_H) + (size_t)t * DM;
#pragma unroll
            for (int j = 0; j < 8; ++j) {
                const f32x4 g = *(const f32x4*)(g1 + 4 * lane + 256 * j), s1 = *(const f32x4*)(sc + 4 * lane + 256 * j), s0 = *(const f32x4*)(sh + 4 * lane + 256 * j);
                const f32x4 h = (v[j] * r * g) * (s1 + 1.f) + s0;
                u32x2 w; w.x = pk2(h[0], h[1]); w.y = pk2(h[2], h[3]);
                *(u32x2*)(ho + 4 * lane + 256 * j) = w;
            }
        }
    }
}


__device__ __forceinline__ void ph_norm2_router_mfma(const Params& p, int l, LAS unsigned char* lds) {
    const int tid = opaque_tid(), lane = tid & 63, wv = tid >> 6, r = lane & 31, h = lane >> 5;
    LAS float* part = (LAS float*)lds;
    LAS float* lgs = (LAS float*)(lds + 8 * 32 * 17 * 4);
    const float* mod = (const float*)(p.ws + WS_MOD);
    const float* g2 = p.in[14] + (size_t)l * DM;
    const bf16_t* WRT = (const bf16_t*)(p.ws + WS_WRT) + (size_t)l * 16 * 2048;
    bf16_t* Hb = (bf16_t*)(p.ws + WS_H);
    float* aff = (float*)(p.ws + WS_AFF);
    for (int blk = blockIdx.x; blk < NT / 32; blk += gridDim.x) {
        const int t0 = blk * 32, b = t0 >> 11;
        const float* sh = mod + ((size_t)l * 4 + b) * 12288 + 3 * 2048;
        const float* sc = sh + 2048;
#pragma unroll 1
        for (int half = 0; half < 2; ++half) {
            const int ta = t0 + 4 * wv + 2 * half;
            const bf16_t* xa = (const bf16_t*)(p.ws + WS_X2) + (size_t)ta * DM;
            f32x4 va[8], vb[8];
#pragma unroll
            for (int j = 0; j < 8; ++j) { const u32x2 wa = *(const u32x2*)(xa + 4 * lane + 256 * j), wb = *(const u32x2*)(xa + DM + 4 * lane + 256 * j);
                va[j] = (f32x4){bflo(wa.x), bfhi(wa.x), bflo(wa.y), bfhi(wa.y)}; vb[j] = (f32x4){bflo(wb.x), bfhi(wb.x), bflo(wb.y), bfhi(wb.y)}; }
            float sa = 0.f, sb = 0.f;
#pragma unroll
            for (int j = 0; j < 8; ++j) { sa += va[j][0] * va[j][0] + va[j][1] * va[j][1] + va[j][2] * va[j][2] + va[j][3] * va[j][3]; sb += vb[j][0] * vb[j][0] + vb[j][1] * vb[j][1] + vb[j][2] * vb[j][2] + vb[j][3] * vb[j][3]; }
#pragma unroll
            for (int o = 1; o < 64; o <<= 1) { sa += __shfl_xor(sa, o); sb += __shfl_xor(sb, o); }
            const float ra = 1.0f / sqrtf(sa * (1.f / DM) + EPS), rb = 1.0f / sqrtf(sb * (1.f / DM) + EPS);
            bf16_t* ho = Hb + (size_t)ta * DM;
#pragma unroll
            for (int j = 0; j < 8; ++j) {
                const f32x4 g = *(const f32x4*)(g2 + 4 * lane + 256 * j), s1 = *(const f32x4*)(sc + 4 * lane + 256 * j), s0 = *(const f32x4*)(sh + 4 * lane + 256 * j);
                const f32x4 gg = g * (s1 + 1.f);
                const f32x4 ha = (va[j] * ra) * gg + s0, hb = (vb[j] * rb) * gg + s0;
                u32x2 wa; wa.x = pk2(ha[0], ha[1]); wa.y = pk2(ha[2], ha[3]);
                u32x2 wb; wb.x = pk2(hb[0], hb[1]); wb.y = pk2(hb[2], hb[3]);
                *(u32x2*)(ho + 4 * lane + 256 * j) = wa; *(u32x2*)(ho + DM + 4 * lane + 256 * j) = wb;
            }
        }
        asm volatile("s_waitcnt vmcnt(0)" ::: "memory");
        __syncthreads();
        {
            f32x16 acc;
#pragma unroll
            for (int q = 0; q < 16; ++q) acc[q] = 0.f;
            const bf16_t* bp = Hb + (size_t)(t0 + r) * DM + 256 * wv + 8 * h;
            const bf16_t* ap = WRT + (size_t)(r & 15) * 2048 + 256 * wv + 8 * h;
            bf16x8 bfr[16], afr[16];
#pragma unroll
            for (int s = 0; s < 16; ++s) { bfr[s] = *(const bf16x8*)(bp + 16 * s); afr[s] = *(const bf16x8*)(ap + 16 * s); }
#pragma unroll
            for (int s = 0; s < 16; ++s) { const bf16x8 a = (r < 16) ? afr[s] : (bf16x8){0, 0, 0, 0, 0, 0, 0, 0}; acc = __builtin_amdgcn_mfma_f32_32x32x16_bf16(a, bfr[s], acc, 0, 0, 0); }
#pragma unroll
            for (int q = 0; q < 8; ++q) { const int e = (q & 3) + 8 * (q >> 2) + 4 * h; part[(wv * 32 + r) * 17 + e] = acc[q]; }
        }
        __syncthreads();
        const int e = tid >> 5, tk = tid & 31;
        { float s = 0.f;
#pragma unroll
          for (int w = 0; w < 8; ++w) s += part[(w * 32 + tk) * 17 + e];
          lgs[e * 32 + tk] = s; }
        __syncthreads();
        { float lg[16]; float mx = -1e30f;
#pragma unroll
          for (int q = 0; q < 16; ++q) { lg[q] = lgs[q * 32 + tk]; mx = fmaxf(mx, lg[q]); }
          float den = 0.f, mine = 0.f;
#pragma unroll
          for (int q = 0; q < 16; ++q) { const float ex = expf(lg[q] - mx); den += ex; mine = (q == e) ? ex : mine; }
          aff[((size_t)b * 16 + e) * 2048 + (t0 & 2047) + tk] = mine / den; }
        __syncthreads();
    }
}

__device__ __forceinline__ unsigned block_excl_scan(unsigned cnt, LAS unsigned* wsum, int tid) {
    const int lane = tid & 63, wv = tid >> 6;
    unsigned inc = cnt;
#pragma unroll
    for (int o = 1; o < 64; o <<= 1) { const unsigned t = __shfl_up(inc, o); if (lane >= o) inc += t; }
    if (lane == 63) wsum[wv] = inc;
    __syncthreads();
    unsigned base = 0;
#pragma unroll
    for (int w = 0; w < 8; ++w) base += (w < wv) ? wsum[w] : 0u;
    __syncthreads();
    return base + inc - cnt;
}
__device__ __forceinline__ void ph_topk(const Params& p, LAS unsigned char* lds) {
    const int tid = opaque_tid();
    LAS unsigned* hist = (LAS unsigned*)lds;
    LAS unsigned* misc = hist + 256;
    LAS unsigned* wsum = hist + 320;
    const float* aff = (const float*)(p.ws + WS_AFF);
    int* idx = (int*)(p.ws + WS_IDX); float* gate = (float*)(p.ws + WS_IDX + 65536); int* slot_of = (int*)(p.ws + WS_IDX + 131072);
    for (int u = blockIdx.x; u < 64; u += gridDim.x) {
        const int b = u >> 4, e = u & 15;
        const f32x4 a = *(const f32x4*)(aff + (size_t)u * 2048 + 4 * tid);
        unsigned k[4];
#pragma unroll
        for (int i = 0; i < 4; ++i) k[i] = __float_as_uint(a[i]);
        unsigned prefix = 0, krem = CAP;
#pragma unroll 1
        for (int pass = 0; pass < 4; ++pass) {
            const int shift = 24 - 8 * pass;
            if (tid < 256) hist[tid] = 0;
            __syncthreads();
#pragma unroll
            for (int i = 0; i < 4; ++i) if (pass == 0 || (k[i] >> (shift + 8)) == prefix) __hip_atomic_fetch_add(&hist[(k[i] >> shift) & 255u], 1u, __ATOMIC_RELAXED, __HIP_MEMORY_SCOPE_WORKGROUP);
            __syncthreads();
            { const unsigned cnt = (tid < 256) ? hist[255 - tid] : 0u;
              const unsigned Sn = block_excl_scan(cnt, wsum, tid), S = Sn + cnt;
              if (tid < 256 && S >= krem && Sn < krem) { misc[0] = (prefix << 8) | (unsigned)(255 - tid); misc[1] = krem - Sn; } }
            __syncthreads();
            prefix = misc[0]; krem = misc[1];
            __syncthreads();
        }
        unsigned neq = 0;
#pragma unroll
        for (int i = 0; i < 4; ++i) neq += (k[i] == prefix) ? 1u : 0u;
        unsigned eqbase = block_excl_scan(neq, wsum, tid);
        unsigned sel[4]; unsigned nsel = 0;
#pragma unroll
        for (int i = 0; i < 4; ++i) { const bool eq = k[i] == prefix; sel[i] = (k[i] > prefix || (eq && eqbase < krem)) ? 1u : 0u; eqbase += eq ? 1u : 0u; nsel += sel[i]; }
        unsigned sb = block_excl_scan(nsel, wsum, tid);
#pragma unroll
        for (int i = 0; i < 4; ++i) {
            const int s = 4 * tid + i, t = b * 2048 + s;
            if (sel[i]) { const int row = e * 1024 + b * 256 + (int)sb; idx[row] = t; gate[row] = a[i]; slot_of[(size_t)e * NT + t] = row; ++sb; }
            else slot_of[(size_t)e * NT + t] = -1;
        }
        __syncthreads();
    }
}

__device__ __forceinline__ bf16x8 pack8(float a0, float a1, float a2, float a3, float a4, float a5, float a6, float a7) {
    u32x4 p;
    asm volatile("v_cvt_pk_bf16_f32 %0, %4, %5\n\tv_cvt_pk_bf16_f32 %1, %6, %7\n\tv_cvt_pk_bf16_f32 %2, %8, %9\n\tv_cvt_pk_bf16_f32 %3, %10, %11\n\ts_nop 1"
                 : "=&v"(p[0]), "=&v"(p[1]), "=&v"(p[2]), "=&v"(p[3]) : "v"(a0), "v"(a1), "v"(a2), "v"(a3), "v"(a4), "v"(a5), "v"(a6), "v"(a7));
    return __builtin_bit_cast(bf16x8, p);
}
template <int CH>
__device__ __forceinline__ void attn_prefetch(const bf16_t* qp, const bf16_t* kb, const size_t kst, const int lk0, const int ls, const int r, bf16x8 (&qf)[4], bf16x8 (&kf0)[CH][4]) {
#pragma unroll
    for (int s = 0; s < 4; ++s) qf[s] = *(const bf16x8*)(qp + 16 * s);
#pragma unroll
    for (int i = 0; i < CH; ++i) {
        int lkr = lk0 + 32 * i + r; lkr = lkr < 0 ? 0 : (lkr >= ls ? ls - 1 : lkr);
        const bf16_t* kp = kb + (size_t)lkr * kst;
#pragma unroll
        for (int s = 0; s < 4; ++s) kf0[i][s] = *(const bf16x8*)(kp + 16 * s);
    }
}
template <int NTILES, int CH, bool SYNC = true, bool KLDS = false>
__device__ __forceinline__ void attn_wave(const bf16x8 (&qf)[4], const bf16x8 (&kf0)[CH][4], const bf16_t* kb, const size_t kst, const int lk0, const int ls, const LAS bf16_t* vt, const int vts,
                                          float m_run, float l_run, f32x16& O0, f32x16& O1, float& m_out, float& l_out, const int r, const int h, const LAS bf16_t* kl = nullptr, const int kls = 0) {
#pragma unroll
    for (int i = 0; i < 16; ++i) { O0[i] = 0.f; O1[i] = 0.f; }
#pragma unroll
    for (int c0 = 0; c0 < NTILES; c0 += CH) {
        constexpr int dummy = 0; (void)dummy;
        f32x16 S[CH];
#pragma unroll
        for (int ii = 0; ii < CH; ++ii) {
            const int i = c0 + ii;
            if (i < NTILES) {
                int lkr = lk0 + 32 * i + r; lkr = lkr < 0 ? 0 : (lkr >= ls ? ls - 1 : lkr);
                const bf16_t* kp = kb + (size_t)lkr * kst;
                f32x16 a;
#pragma unroll
                for (int q = 0; q < 16; ++q) a[q] = 0.f;
#pragma unroll
                for (int s = 0; s < 4; ++s) {
                    bf16x8 kf;
                    if constexpr (KLDS) kf = *(const LAS bf16x8*)(kl + i * 32 * kls + 16 * s);
                    else { if (c0 == 0) kf = kf0[ii][s]; else kf = *(const bf16x8*)(kp + 16 * s); }
                    a = __builtin_amdgcn_mfma_f32_32x32x16_bf16(kf, qf[s], a, 0, 0, 0);
                }
                S[ii] = a;
            }
        }
        float mx = m_run;
#pragma unroll
        for (int ii = 0; ii < CH; ++ii) {
            const int i = c0 + ii;
            if (i < NTILES) {
                const bool edge = (lk0 + 32 * i < 0) || (lk0 + 32 * i + 32 > ls);
                if (edge || i == 0 || i == NTILES - 1) {
#pragma unroll
                    for (int q = 0; q < 16; ++q) {
                        const int row = (q & 3) + 8 * (q >> 2) + 4 * h;
                        const int lk = lk0 + 32 * i + row;
                        bool valid = (lk >= 0) && (lk < ls);
                        if (i == 0) valid = valid && (row >= r);
                        if (i == NTILES - 1) valid = valid && (row <= r);
                        const float sv = valid ? S[ii][q] : -1e30f;
                        S[ii][q] = sv;
                        mx = fmaxf(mx, sv);
                    }
                } else {
#pragma unroll
                    for (int q = 0; q < 16; ++q) mx = fmaxf(mx, S[ii][q]);
                }
            }
        }
        mx = fmaxf(mx, __shfl_xor(mx, 32));
        const float corr = __builtin_amdgcn_exp2f((m_run - mx) * 1.442695041f);
        float psum = 0.f;
#pragma unroll
        for (int ii = 0; ii < CH; ++ii) {
            const int i = c0 + ii;
            if (i < NTILES) {
#pragma unroll
                for (int q = 0; q < 16; ++q) { const float pv = __builtin_amdgcn_exp2f((S[ii][q] - mx) * 1.442695041f); S[ii][q] = pv; psum += pv; }
            }
        }
        psum += __shfl_xor(psum, 32);
        l_run = l_run * corr + psum;
        m_run = mx;
        if (c0 > 0) {
#pragma unroll
            for (int q = 0; q < 16; ++q) { O0[q] *= corr; O1[q] *= corr; }
        } else { if (SYNC) __syncthreads(); }
#pragma unroll
        for (int ii = 0; ii < CH; ++ii) {
            const int i = c0 + ii;
            if (i < NTILES) {
#pragma unroll
                for (int sp = 0; sp < 2; ++sp) {
                    const bf16x8 pf = pack8(S[ii][8 * sp + 0], S[ii][8 * sp + 1], S[ii][8 * sp + 2], S[ii][8 * sp + 3], S[ii][8 * sp + 4], S[ii][8 * sp + 5], S[ii][8 * sp + 6], S[ii][8 * sp + 7]);
                    const LAS bf16_t* v0 = vt + 32 * i + 16 * sp;
                    { const u32x2 a0 = *(const LAS u32x2*)(v0), a1 = *(const LAS u32x2*)(v0 + 8);
                      const u32x4 vw = (u32x4){a0.x, a0.y, a1.x, a1.y};
                      O0 = __builtin_amdgcn_mfma_f32_32x32x16_bf16(__builtin_bit_cast(bf16x8, vw), pf, O0, 0, 0, 0); }
                    { const u32x2 a0 = *(const LAS u32x2*)(v0 + 32 * vts), a1 = *(const LAS u32x2*)(v0 + 32 * vts + 8);
                      const u32x4 vw = (u32x4){a0.x, a0.y, a1.x, a1.y};
                      O1 = __builtin_amdgcn_mfma_f32_32x32x16_bf16(__builtin_bit_cast(bf16x8, vw), pf, O1, 0, 0, 0); }
                }
            }
        }
    }
    m_out = m_run; l_out = l_run;
}
__device__ __forceinline__ void ph_mixers(const Params& p, const int l, LAS unsigned char* lds) {
    constexpr int VTS = 260, VTSS = 292, KSTR = 72, ARENA = 78848, KOFF = 37376;
    const int hw = (opaque_tid() >> 8) & 1;
    const bf16_t* PROJ = (const bf16_t*)(p.ws + WS_PROJ);
    int ufirst, ucount, ustep;
    if (gridDim.x == 256) { if (blockIdx.x < 128) { ufirst = blockIdx.x * 2; ucount = 2; } else { ufirst = 256 + (blockIdx.x - 128) * 4; ucount = 4; } ustep = 1; }
    else { ufirst = blockIdx.x; ustep = gridDim.x; ucount = (768 - (int)blockIdx.x + (int)gridDim.x - 1) / (int)gridDim.x; }
    const int nsw = (256 - (int)blockIdx.x + (int)gridDim.x - 1) / (int)gridDim.x;
    const int ngm = (int)blockIdx.x < 128 ? (128 - (int)blockIdx.x + (int)gridDim.x - 1) / (int)gridDim.x : 0;
    const int nitems = ngm + nsw + ucount;
    constexpr int VTSG = 136;
    const bf16_t* SW = (const bf16_t*)(p.ws + WS_SGUW) + (size_t)l * 8 * 128 * 128;
    bf16x8 qf[4]; bf16x8 kdummy[5][4];
    for (int k = 0; k <= 2 * nitems; ++k) {
        const int tid = opaque_tid(), lane = tid & 63, w4 = (tid >> 6) & 3, tl = tid & 255, r = lane & 31, h = lane >> 5;
        LAS bf16_t* Vt = (LAS bf16_t*)(lds + hw * ARENA);
        LAS unsigned* Vt32 = (LAS unsigned*)Vt;
        LAS bf16_t* Ks = (LAS bf16_t*)(lds + hw * ARENA + KOFF);
        const int kk = k - hw, it0 = kk >> 1;
        if (kk >= 0 && it0 < nitems) {
            if (it0 < ngm) {
                const int u = blockIdx.x + it0 * gridDim.x;
                const int hg = u & 1, t0 = (u >> 1) * 128, hh2 = w4 >> 1, ph = w4 & 1, habs = hg * 4 + 2 * hw + hh2;
                if (!(kk & 1)) {
                    const int kp = tl & 63, ta = t0 + 2 * kp;
                    const float* vs = (const float*)(p.ws + WS_VSS) + (size_t)ta * 8;
                    const f32x4 sa0 = *(const f32x4*)vs, sa1 = *(const f32x4*)(vs + 4), sb0 = *(const f32x4*)(vs + 8), sb1 = *(const f32x4*)(vs + 12);
                    u32x4 va[4], vb[4]; f32x4 g0[4], g1[4];
                    const float* sn = p.in[8] + (size_t)l * 512 + hg * 256 + hw * 128;
#pragma unroll
                    for (int i = 0; i < 4; ++i) { const int dc = (tl >> 6) + 4 * i;
                        const bf16_t* src = PROJ + (size_t)ta * NPROJ + PC_V + hg * 256 + hw * 128 + 8 * dc;
                        va[i] = *(const u32x4*)src; vb[i] = *(const u32x4*)(src + NPROJ);
                        g0[i] = *(const f32x4*)(sn + 8 * dc); g1[i] = *(const f32x4*)(sn + 8 * dc + 4); }
                    const float ra = 1.0f / sqrtf((((sa0[0] + sa0[1]) + (sa0[2] + sa0[3])) + ((sa1[0] + sa1[1]) + (sa1[2] + sa1[3]))) * (1.f / 512.f) + EPS);
                    const float rb = 1.0f / sqrtf((((sb0[0] + sb0[1]) + (sb0[2] + sb0[3])) + ((sb1[0] + sb1[1]) + (sb1[2] + sb1[3]))) * (1.f / 512.f) + EPS);
#pragma unroll
                    for (int i = 0; i < 4; ++i) { const int dc = (tl >> 6) + 4 * i;
                        LAS unsigned* o = Vt32 + (8 * dc) * (VTSG / 2) + kp;
                        o[0 * (VTSG / 2)] = pk2(bflo(va[i].x) * ra * g0[i][0], bflo(vb[i].x) * rb * g0[i][0]); o[1 * (VTSG / 2)] = pk2(bfhi(va[i].x) * ra * g0[i][1], bfhi(vb[i].x) * rb * g0[i][1]);
                        o[2 * (VTSG / 2)] = pk2(bflo(va[i].y) * ra * g0[i][2], bflo(vb[i].y) * rb * g0[i][2]); o[3 * (VTSG / 2)] = pk2(bfhi(va[i].y) * ra * g0[i][3], bfhi(vb[i].y) * rb * g0[i][3]);
                        o[4 * (VTSG / 2)] = pk2(bflo(va[i].z) * ra * g1[i][0], bflo(vb[i].z) * rb * g1[i][0]); o[5 * (VTSG / 2)] = pk2(bfhi(va[i].z) * ra * g1[i][1], bfhi(vb[i].z) * rb * g1[i][1]);
                        o[6 * (VTSG / 2)] = pk2(bflo(va[i].w) * ra * g1[i][2], bflo(vb[i].w) * rb * g1[i][2]); o[7 * (VTSG / 2)] = pk2(bfhi(va[i].w) * ra * g1[i][3], bfhi(vb[i].w) * rb * g1[i][3]); }
                } else {
                    f32x16 acc[2][2];
#pragma unroll
                    for (int ct = 0; ct < 2; ++ct)
#pragma unroll
                        for (int pt = 0; pt < 2; ++pt)
#pragma unroll
                            for (int q = 0; q < 16; ++q) acc[ct][pt][q] = 0.f;
                    const LAS bf16_t* ap = Vt + (hh2 * 64 + r) * VTSG + 8 * h;
                    const bf16_t* wp = SW + ((size_t)habs * 128 + 64 * ph + r) * 128 + 8 * h;
#pragma unroll
                    for (int s2 = 0; s2 < 8; ++s2) {
                        bf16x8 afr[2], bfr[2];
#pragma unroll
                        for (int pt = 0; pt < 2; ++pt) bfr[pt] = *(const bf16x8*)(wp + (size_t)pt * 32 * 128 + 16 * s2);
#pragma unroll
                        for (int ct = 0; ct < 2; ++ct) afr[ct] = *(const LAS bf16x8*)(ap + ct * 32 * VTSG + 16 * s2);
#pragma unroll
                        for (int ct = 0; ct < 2; ++ct)
#pragma unroll
                            for (int pt = 0; pt < 2; ++pt) acc[ct][pt] = __builtin_amdgcn_mfma_f32_32x32x16_bf16(afr[ct], bfr[pt], acc[ct][pt], 0, 0, 0);
                    }
                    bf16_t* YB = (bf16_t*)(p.ws + WS_YB);
#pragma unroll
                    for (int pt = 0; pt < 2; ++pt) {
                        const int pp = 64 * ph + 32 * pt + r;
                        const float bias = p.in[10][((size_t)l * 8 + habs) * 128 + pp];
                        const bf16_t* us = PROJ + (size_t)(t0 + pp) * NPROJ + PC_U + habs * 64 + 4 * h;
                        bf16_t* o = YB + (size_t)(t0 + pp) * 512 + habs * 64 + 4 * h;
#pragma unroll
                        for (int ct = 0; ct < 2; ++ct)
#pragma unroll
                            for (int gg = 0; gg < 4; ++gg) {
                                const u32x2 uw = *(const u32x2*)(us + 32 * ct + 8 * gg);
                                u32x2 w; w.x = pk2(bflo(uw.x) * (acc[ct][pt][4 * gg] + bias), bfhi(uw.x) * (acc[ct][pt][4 * gg + 1] + bias));
                                w.y = pk2(bflo(uw.y) * (acc[ct][pt][4 * gg + 2] + bias), bfhi(uw.y) * (acc[ct][pt][4 * gg + 3] + bias));
                                *(u32x2*)(o + 32 * ct + 8 * gg) = w;
                            }
                    }
                }
            } else if (it0 < ngm + nsw) {
                const int it = it0 - ngm;
                const int u = blockIdx.x + it * gridDim.x;
                const int b = u >> 6, kvh = (u >> 5) & 1, q0 = (u & 31) * 64 + 32 * hw;
                const bf16_t* base = PROJ + (size_t)b * SEQ * NPROJ;
                const int head = kvh * 4 + w4, qpos = q0 + r, lk0 = q0 - 128;
                if (!(kk & 1)) {
                    u32x4 va[5], vb[5], kc[9];
#pragma unroll
                    for (int i = 0; i < 5; ++i) {
                        const int task = tl + 256 * i;
                        if (task < 1152) { const int kp = task % 144, dc = task / 144;
                            int kA = lk0 + 2 * kp; kA = kA < 0 ? 0 : (kA > SEQ - 2 ? SEQ - 2 : kA);
                            va[i] = *(const u32x4*)(base + (size_t)kA * NPROJ + PC_VC + kvh * 64 + 8 * dc);
                            vb[i] = *(const u32x4*)(base + (size_t)(kA + 1) * NPROJ + PC_VC + kvh * 64 + 8 * dc); }
                    }
#pragma unroll
                    for (int i = 0; i < 9; ++i) { const int id = tl + 256 * i, j = id >> 3, c8 = id & 7;
                        int kp2 = lk0 + j; kp2 = kp2 < 0 ? 0 : (kp2 >= SEQ ? SEQ - 1 : kp2);
                        kc[i] = *(const u32x4*)(base + (size_t)kp2 * NPROJ + PC_KC + kvh * 64 + 8 * c8); }
                    { const bf16_t* qp = base + (size_t)qpos * NPROJ + PC_QC + head * 64 + 8 * h;
#pragma unroll
                      for (int s2 = 0; s2 < 4; ++s2) qf[s2] = *(const bf16x8*)(qp + 16 * s2); }
#pragma unroll
                    for (int i = 0; i < 5; ++i) {
                        const int task = tl + 256 * i;
                        if (task < 1152) { const int kp = task % 144, dc = task / 144;
                            LAS unsigned* o = Vt32 + (8 * dc) * (VTSS / 2) + kp;
                            o[0 * (VTSS / 2)] = (va[i].x & 0xffffu) | (vb[i].x << 16); o[1 * (VTSS / 2)] = (va[i].x >> 16) | (vb[i].x & 0xffff0000u);
                            o[2 * (VTSS / 2)] = (va[i].y & 0xffffu) | (vb[i].y << 16); o[3 * (VTSS / 2)] = (va[i].y >> 16) | (vb[i].y & 0xffff0000u);
                            o[4 * (VTSS / 2)] = (va[i].z & 0xffffu) | (vb[i].z << 16); o[5 * (VTSS / 2)] = (va[i].z >> 16) | (vb[i].z & 0xffff0000u);
                            o[6 * (VTSS / 2)] = (va[i].w & 0xffffu) | (vb[i].w << 16); o[7 * (VTSS / 2)] = (va[i].w >> 16) | (vb[i].w & 0xffff0000u); }
                    }
#pragma unroll
                    for (int i = 0; i < 9; ++i) { const int id = tl + 256 * i, j = id >> 3, c8 = id & 7; *(LAS u32x4*)(Ks + j * KSTR + 8 * c8) = kc[i]; }
                } else {
                    const LAS bf16_t* vt = Vt + r * VTSS + 4 * h;
                    const LAS bf16_t* kl = Ks + r * KSTR + 8 * h;
                    f32x16 O0, O1; float m, lsum;
                    attn_wave<9, 5, false, true>(qf, kdummy, nullptr, (size_t)NPROJ, lk0, SEQ, vt, VTSS, p.in[11][l * 8 + head], 1.f, O0, O1, m, lsum, r, h, kl, KSTR);
                    const float inv = 1.f / lsum;
                    bf16_t* o = (bf16_t*)(p.ws + WS_YC) + ((size_t)b * SEQ + qpos) * 512 + head * 64 + 4 * h;
#pragma unroll
                    for (int gg = 0; gg < 4; ++gg) {
                        u32x2 w0; w0.x = pk2(O0[4 * gg] * inv, O0[4 * gg + 1] * inv); w0.y = pk2(O0[4 * gg + 2] * inv, O0[4 * gg + 3] * inv);
                        u32x2 w1; w1.x = pk2(O1[4 * gg] * inv, O1[4 * gg + 1] * inv); w1.y = pk2(O1[4 * gg + 2] * inv, O1[4 * gg + 3] * inv);
                        *(u32x2*)(o + 8 * gg) = w0; *(u32x2*)(o + 32 + 8 * gg) = w1;
                    }
                }
            } else {
                const int u = ufirst + (it0 - ngm - nsw) * ustep;
                const int cfg = u >> 8, r8 = u & 255, b = r8 >> 6, head = (r8 >> 3) & 7, blk = (r8 & 7) * 2 + hw;
                const int dsh = 2 * cfg, dil = 1 << dsh, ls = SEQ >> dsh, nblk = ls >> 7;
                const int res = blk / nblk, l0 = (blk % nblk) * 128;
                const bf16_t* base = PROJ + ((size_t)b * SEQ + res) * NPROJ;
                const size_t kst = (size_t)dil * NPROJ;
                const int lq = l0 + 32 * w4 + r;
                const int lk0 = l0 + 32 * w4 - 64;
                if (!(kk & 1)) {
                    u32x4 va[4], vb[4], kc[8];
#pragma unroll
                    for (int i = 0; i < 4; ++i) {
                        const int task = tl + 256 * i, kp = task & 127, dc = task >> 7;
                        int lkA = l0 - 64 + 2 * kp; lkA = lkA < 0 ? 0 : (lkA > ls - 2 ? ls - 2 : lkA);
                        va[i] = *(const u32x4*)(base + (size_t)lkA * kst + PC_VD + head * 64 + 8 * dc);
                        vb[i] = *(const u32x4*)(base + (size_t)(lkA + 1) * kst + PC_VD + head * 64 + 8 * dc);
                    }
#pragma unroll
                    for (int i = 0; i < 8; ++i) {
                        const int id = tl + 256 * i, j = id >> 3, c8 = id & 7;
                        int lk = l0 - 64 + j; lk = lk < 0 ? 0 : (lk >= ls ? ls - 1 : lk);
                        kc[i] = *(const u32x4*)(base + (size_t)lk * kst + PC_KD + head * 64 + 8 * c8);
                    }
                    { const bf16_t* qp = base + (size_t)lq * kst + PC_QD + head * 64 + 8 * h;
#pragma unroll
                      for (int s2 = 0; s2 < 4; ++s2) qf[s2] = *(const bf16x8*)(qp + 16 * s2); }
#pragma unroll
                    for (int i = 0; i < 4; ++i) {
                        const int task = tl + 256 * i, kp = task & 127, dc = task >> 7;
                        LAS unsigned* o = Vt32 + (8 * dc) * (VTS / 2) + kp;
                        o[0 * (VTS / 2)] = (va[i].x & 0xffffu) | (vb[i].x << 16); o[1 * (VTS / 2)] = (va[i].x >> 16) | (vb[i].x & 0xffff0000u);
                        o[2 * (VTS / 2)] = (va[i].y & 0xffffu) | (vb[i].y << 16); o[3 * (VTS / 2)] = (va[i].y >> 16) | (vb[i].y & 0xffff0000u);
                        o[4 * (VTS / 2)] = (va[i].z & 0xffffu) | (vb[i].z << 16); o[5 * (VTS / 2)] = (va[i].z >> 16) | (vb[i].z & 0xffff0000u);
                        o[6 * (VTS / 2)] = (va[i].w & 0xffffu) | (vb[i].w << 16); o[7 * (VTS / 2)] = (va[i].w >> 16) | (vb[i].w & 0xffff0000u);
                    }
#pragma unroll
                    for (int i = 0; i < 8; ++i) { const int id = tl + 256 * i, j = id >> 3, c8 = id & 7; *(LAS u32x4*)(Ks + j * KSTR + 8 * c8) = kc[i]; }
                } else {
                    const LAS bf16_t* vt = Vt + r * VTS + 32 * w4 + 4 * h;
                    const LAS bf16_t* kl = Ks + (32 * w4 + r) * KSTR + 8 * h;
                    f32x16 O0, O1; float m, lsm;
                    attn_wave<5, 5, false, true>(qf, kdummy, nullptr, kst, lk0, ls, vt, VTS, -1e30f, 0.f, O0, O1, m, lsm, r, h, kl, KSTR);
                    const float inv = 1.f / lsm;
                    const size_t tq = (size_t)b * SEQ + (size_t)lq * dil + res;
                    bf16_t* o = (bf16_t*)(p.ws + WS_YD) + ((size_t)cfg * NT + tq) * 512 + head * 64 + 4 * h;
#pragma unroll
                    for (int g = 0; g < 4; ++g) {
                        u32x2 w0; w0.x = pk2(O0[4 * g] * inv, O0[4 * g + 1] * inv); w0.y = pk2(O0[4 * g + 2] * inv, O0[4 * g + 3] * inv);
                        u32x2 w1; w1.x = pk2(O1[4 * g] * inv, O1[4 * g + 1] * inv); w1.y = pk2(O1[4 * g + 2] * inv, O1[4 * g + 3] * inv);
                        *(u32x2*)(o + 8 * g) = w0; *(u32x2*)(o + 32 + 8 * g) = w1;
                    }
                    if (h == 0) ((float*)(p.ws + WS_LSE))[((size_t)cfg * NT + tq) * 8 + head] = m + __logf(lsm);
                }
            }
        }
        __syncthreads();
    }
}

__device__ __forceinline__ void ph_merge(const Params& p, int l, LAS unsigned char* lds) {
    const int tid = opaque_tid(), lane = tid & 63, wv = tid >> 6, r = lane & 31, h2 = lane >> 5;
    LAS float* ssA = (LAS float*)lds;
    const bf16_t* UV = (const bf16_t*)(p.ws + WS_YA); const bf16_t* YB = (const bf16_t*)(p.ws + WS_YB); const bf16_t* YC = (const bf16_t*)(p.ws + WS_YC); const bf16_t* YD = (const bf16_t*)(p.ws + WS_YD);
    const float* LSE = (const float*)(p.ws + WS_LSE); bf16_t* YN = (bf16_t*)(p.ws + WS_YN);
    const bf16_t* ABT = (const bf16_t*)(p.ws + WS_ABT) + ((size_t)l * 8 + wv) * 64 * 128;
    for (int blk = blockIdx.x; blk < NT / 32; blk += gridDim.x) {
        const int t0 = blk * 32, b = t0 >> 11, s0 = t0 & 2047;
        f32x16 O0, O1;
        {
#pragma unroll
            for (int q = 0; q < 16; ++q) { O0[q] = 0.f; O1[q] = 0.f; }
            const size_t row = ((size_t)b * 4096 + 2 * (s0 + r)) * 512 + wv * 64 + 8 * h2;
            u32x4 u0[8], u1[8];
#pragma unroll
            for (int s = 0; s < 8; ++s) { const size_t o = row + (s >> 2) * 512 + 16 * (s & 3); u0[s] = *(const u32x4*)(UV + o); u1[s] = *(const u32x4*)(UV + (size_t)4 * 4096 * 512 + o); }
            bf16x8 af0[8], af1[8];
#pragma unroll
            for (int s = 0; s < 8; ++s) { af0[s] = *(const bf16x8*)(ABT + (size_t)r * 128 + 16 * s + 8 * h2); af1[s] = *(const bf16x8*)(ABT + (size_t)(32 + r) * 128 + 16 * s + 8 * h2); }
#pragma unroll
            for (int s = 0; s < 8; ++s) {
                const bf16x8 bfr = pack8(bflo(u0[s].x) + bflo(u1[s].x), bfhi(u0[s].x) + bfhi(u1[s].x), bflo(u0[s].y) + bflo(u1[s].y), bfhi(u0[s].y) + bfhi(u1[s].y),
                                         bflo(u0[s].z) + bflo(u1[s].z), bfhi(u0[s].z) + bfhi(u1[s].z), bflo(u0[s].w) + bflo(u1[s].w), bfhi(u0[s].w) + bfhi(u1[s].w));
                O0 = __builtin_amdgcn_mfma_f32_32x32x16_bf16(af0[s], bfr, O0, 0, 0, 0);
                O1 = __builtin_amdgcn_mfma_f32_32x32x16_bf16(af1[s], bfr, O1, 0, 0, 0);
            }
            float ss = 0.f;
#pragma unroll
            for (int q = 0; q < 16; ++q) ss += O0[q] * O0[q] + O1[q] * O1[q];
            ss += __shfl_xor(ss, 32);
            if (h2 == 0) ssA[wv * 32 + r] = ss;
        }
        {
            u32x4 lb[4], lc[4], ld0[4], ld1[4], ld2[4]; float e0[4], e1[4], e2[4];
#pragma unroll
            for (int i = 0; i < 4; ++i) {
                const int t = t0 + 4 * wv + i, head = lane >> 3;
                lb[i] = *(const u32x4*)(YB + (size_t)t * 512 + 8 * lane); lc[i] = *(const u32x4*)(YC + (size_t)t * 512 + 8 * lane);
                ld0[i] = *(const u32x4*)(YD + (size_t)t * 512 + 8 * lane); ld1[i] = *(const u32x4*)(YD + ((size_t)NT + t) * 512 + 8 * lane); ld2[i] = *(const u32x4*)(YD + ((size_t)2 * NT + t) * 512 + 8 * lane);
                e0[i] = LSE[(size_t)t * 8 + head]; e1[i] = LSE[((size_t)NT + t) * 8 + head]; e2[i] = LSE[((size_t)2 * NT + t) * 8 + head];
            }
#pragma unroll
            for (int i = 0; i < 4; ++i) {
                const int t = t0 + 4 * wv + i;
                float y[3][8];
                { const u32x4 w = lb[i];
                    y[0][0] = bflo(w.x); y[0][1] = bfhi(w.x); y[0][2] = bflo(w.y); y[0][3] = bfhi(w.y); y[0][4] = bflo(w.z); y[0][5] = bfhi(w.z); y[0][6] = bflo(w.w); y[0][7] = bfhi(w.w); }
                { const u32x4 w = lc[i];
                    y[1][0] = bflo(w.x); y[1][1] = bfhi(w.x); y[1][2] = bflo(w.y); y[1][3] = bfhi(w.y); y[1][4] = bflo(w.z); y[1][5] = bfhi(w.z); y[1][6] = bflo(w.w); y[1][7] = bfhi(w.w); }
                { const float l0 = e0[i], l1 = e1[i], l2 = e2[i];
                  const float mx = fmaxf(l0, fmaxf(l1, l2)); float w0 = __expf(l0 - mx), w1 = __expf(l1 - mx), w2 = __expf(l2 - mx); const float iv = 1.f / (w0 + w1 + w2); w0 *= iv; w1 *= iv; w2 *= iv;
                  const u32x4 a = ld0[i], bq = ld1[i], c = ld2[i];
                  y[2][0] = w0 * bflo(a.x) + w1 * bflo(bq.x) + w2 * bflo(c.x); y[2][1] = w0 * bfhi(a.x) + w1 * bfhi(bq.x) + w2 * bfhi(c.x);
                  y[2][2] = w0 * bflo(a.y) + w1 * bflo(bq.y) + w2 * bflo(c.y); y[2][3] = w0 * bfhi(a.y) + w1 * bfhi(bq.y) + w2 * bfhi(c.y);
                  y[2][4] = w0 * bflo(a.z) + w1 * bflo(bq.z) + w2 * bflo(c.z); y[2][5] = w0 * bfhi(a.z) + w1 * bfhi(bq.z) + w2 * bfhi(c.z);
                  y[2][6] = w0 * bflo(a.w) + w1 * bflo(bq.w) + w2 * bflo(c.w); y[2][7] = w0 * bfhi(a.w) + w1 * bfhi(bq.w) + w2 * bfhi(c.w); }
#pragma unroll
                for (int g = 0; g < 3; ++g) {
                    float ss = 0.f;
#pragma unroll
                    for (int q = 0; q < 8; ++q) ss += y[g][q] * y[g][q];
                    const float rr = 1.0f / sqrtf(wave_sum(ss) * (1.f / 512.f) + EPS);
                    u32x4 w; w.x = pk2(y[g][0] * rr, y[g][1] * rr); w.y = pk2(y[g][2] * rr, y[g][3] * rr); w.z = pk2(y[g][4] * rr, y[g][5] * rr); w.w = pk2(y[g][6] * rr, y[g][7] * rr);
                    *(u32x4*)(YN + (size_t)t * DM + (g + 1) * 512 + 8 * lane) = w;
                }
            }
        }
        __syncthreads();
        {
            float tot = 0.f;
#pragma unroll
            for (int w = 0; w < 8; ++w) tot += ssA[w * 32 + r];
            const float rr = 1.0f / sqrtf(tot * (1.f / 512.f) + EPS);
            bf16_t* o = YN + (size_t)(t0 + r) * DM + wv * 64 + 4 * h2;
#pragma unroll
            for (int g = 0; g < 4; ++g) {
                u32x2 w0; w0.x = pk2(O0[4 * g] * rr, O0[4 * g + 1] * rr); w0.y = pk2(O0[4 * g + 2] * rr, O0[4 * g + 3] * rr);
                u32x2 w1; w1.x = pk2(O1[4 * g] * rr, O1[4 * g + 1] * rr); w1.y = pk2(O1[4 * g + 2] * rr, O1[4 * g + 3] * rr);
                *(u32x2*)(o + 8 * g) = w0; *(u32x2*)(o + 32 + 8 * g) = w1;
            }
        }
        __syncthreads();
    }
}

#ifndef PHASE_MASK
#define PHASE_MASK 0xFFFFFFu
#endif
#define EN(k) (((PHASE_MASK) >> (k)) & 1u)
#ifndef REP_MASK
#define REP_MASK 0u
#endif
#define REP(k) _Pragma("unroll") for (int rep_ = 0; rep_ < 1 + (int)(((REP_MASK) >> (k)) & 1u); ++rep_)
constexpr int MIX_GW = 128, MIX_A = 4400;
constexpr int NPHASE = 22;
__global__ void __launch_bounds__(512, 2) mk_fwd(Params p) {
    extern __shared__ __attribute__((aligned(16))) unsigned char lds_raw[];
    LAS unsigned char* lds = (LAS unsigned char*)lds_raw;
    const int tid = threadIdx.x, G = gridDim.x, bx = blockIdx.x;
    volatile LAS unsigned* misc = (volatile LAS unsigned*)(lds + MISC_OFF);
    if (tid < 16) misc[tid] = 0u;
    __syncthreads();
    const int lo = p.ph_lo, hi = p.ph_hi;
    XcdBarrier bar; bar.bar = (unsigned*)(p.ws + WS_CTL); bar.x = 0; bar.st = misc + 8;
    if (hi - lo > 1) bar = xcd_barrier_post((unsigned*)(p.ws + WS_CTL), misc + 8);
#define IN(k) (lo <= (k) && (k) < hi)
#define SEAM(k) do { if (IN(k) && IN((k) + 1)) xcd_barrier(bar); } while (0)
    if (IN(0)) { if (EN(0)) REP(0) ph_mod(p, lds); if (EN(1)) REP(1) ph_tables(p, lds); if (EN(2)) REP(2) { if (G == 256) { if (bx >= 192) ph_weights(p, lds, 0, 240, bx - 192, 64); } else ph_weights(p, lds, 0, 6880, bx, G); } }
    SEAM(0);
    for (int l = 0; l < 2; ++l) {
        const int pb = 1 + 10 * l;
        const char* H = (const char*)(p.ws + WS_H);
        if (EN(3) && IN(pb + 0)) REP(3) { ph_norm1(p, l); }
        SEAM(pb + 0);
        if (EN(4) && IN(pb + 1)) REP(4) {
            SchedProj S{H, (const char*)(p.ws + WS_WIN) + (size_t)l * NPROJ * 2048 * 2, (const char*)(p.ws + WS_WPQ) + (size_t)l * 512 * 2048 * 2, G, bx};
            EpiProj E{(bf16_t*)(p.ws + WS_PROJ), (bf16_t*)(p.ws + WS_PQT), (const float*)(p.ws + WS_ROPE), (const float*)(p.ws + WS_ROPE) + NT * 8};
            if (l == 0 && G == 256 && EN(2)) {
                if (bx < MIX_GW) { SchedProj S2{S.H, S.WIN, S.WPQ, MIX_GW, bx}; pg8::gemm_phase<EpiProj, SchedProj>(lds, 2048, 2048, 2048, S2, E); }
                else ph_weights(p, lds, 240, 240 + MIX_A, bx - MIX_GW, G - MIX_GW);
                __syncthreads();
                ph_weights(p, lds, 240 + MIX_A, 6880, bx, G);
            } else
            pg8::gemm_phase<EpiProj, SchedProj>(lds, 2048, 2048, 2048, S, E);
        }
        SEAM(pb + 1);
        if (IN(pb + 2)) {
            if (EN(5)) REP(5) { SchedDft S{(const char*)(p.ws + WS_DFT), (const char*)(p.ws + WS_PQT), G, bx};
              EpiBf16Plain E{(bf16_t*)(p.ws + WS_YA), 512, (size_t)4 * 4096 * 512};
              pg8::gemm_phase<EpiBf16Plain, SchedDft>(lds, 2048, 2048, 1024, S, E); }
            __syncthreads();
            if (EN(8)) REP(8) ph_mixers(p, l, lds);
        }
        SEAM(pb + 2);
        if (EN(9) && IN(pb + 3)) REP(9) { ph_merge(p, l, lds); }
        SEAM(pb + 3);
        if (EN(10) && IN(pb + 4)) REP(10) {
            SchedDense S{(const char*)(p.ws + WS_YN), (const char*)(p.ws + WS_WOUT) + (size_t)l * 2048 * 2048 * 2, 32, 8, 2048, G, bx};
            EpiWout E{l == 0 ? p.in[0] : nullptr, (const bf16_t*)(p.ws + WS_X), (bf16_t*)(p.ws + WS_X2), (const float*)(p.ws + WS_MOD) + (size_t)l * 4 * 12288 + 2 * 2048};
            pg8::gemm_phase<EpiWout, SchedDense>(lds, 2048, 2048, 2048, S, E);
        }
        SEAM(pb + 4);
        if (EN(11) && IN(pb + 5)) REP(11) { ph_norm2_router_mfma(p, l, lds); }
        SEAM(pb + 5);
        if (EN(12) && IN(pb + 6)) REP(12) { ph_topk(p, lds); }
        SEAM(pb + 6);
        if (EN(14) && IN(pb + 8)) REP(14) {
            SchedMoeG S{H, (const char*)(p.ws + WS_WGU) + (size_t)l * 16 * 2048 * 2048 * 2, 2048, G, bx};
            EpiGU E{(bf16_t*)(p.ws + WS_ACT)};
            pg8::gemm_phase<EpiGU, SchedMoeG, true>(lds, 2048, 2048, 2048, S, E, (const int*)(p.ws + WS_IDX));
        }
        SEAM(pb + 8);
        if (EN(15) && IN(pb + 9)) REP(15) {
            SchedMoe S{(const char*)(p.ws + WS_ACT), (const char*)(p.ws + WS_WD) + (size_t)l * 16 * 2048 * 1024 * 2, 1024, G, bx};
            EpiDown E{(bf16_t*)(p.ws + WS_EO), (const float*)(p.ws + WS_IDX + 65536)};
            pg8::gemm_phase<EpiDown, SchedMoe>(lds, 1024, 1024, 1024, S, E);
        }
        SEAM(pb + 9);
    }
    if (EN(16) && IN(21)) REP(16) { ph_norm1(p, 2); }
#undef IN
#undef SEAM
}

extern "C" void kernel_launch(void* const* d_in, const int* in_sizes, int n_in, void* d_out, int out_size, void* d_ws, size_t ws_size, hipStream_t stream) {
    static int grid = 0;
    if (grid == 0) {
        if (n_in != 20 || out_size != NT * DM || ws_size < WS_END) { fprintf(stderr, "kernel_launch: unexpected shapes (n_in %d out %d ws %zu)\n", n_in, out_size, ws_size); grid = -1; return; }
        int dev = 0, cus = 0, per_cu = 0;
        if (hipGetDevice(&dev) != hipSuccess || hipDeviceGetAttribute(&cus, hipDeviceAttributeMultiprocessorCount, dev) != hipSuccess) { grid = -1; return; }
        if (hipFuncSetAttribute((const void*)mk_fwd, hipFuncAttributeMaxDynamicSharedMemorySize, LDS_BYTES) != hipSuccess) { fprintf(stderr, "kernel_launch: hipFuncSetAttribute failed\n"); grid = -1; return; }
        if (hipOccupancyMaxActiveBlocksPerMultiprocessor(&per_cu, (const void*)mk_fwd, 512, LDS_BYTES) != hipSuccess || per_cu < 1) { fprintf(stderr, "kernel_launch: occupancy query says %d\n", per_cu); }
        (void)hipGetLastError();
        grid = cus;
    }
    if (grid < 0) return;
    (void)hipMemsetAsync((char*)d_ws + WS_CTL, 0, 64 * 1024, stream);
    Params p{};
    for (int i = 0; i < 20; ++i) p.in[i] = (const float*)d_in[i];
    p.out = (float*)d_out; p.ws = (unsigned char*)d_ws;
#if defined(MK_MULTI)
    for (int ph = 0; ph < NPHASE; ++ph) { p.ph_lo = ph; p.ph_hi = ph + 1; hipLaunchKernelGGL(mk_fwd, dim3(grid), dim3(512), LDS_BYTES, stream, p); }
#else
    p.ph_lo = 0; p.ph_hi = NPHASE; hipLaunchKernelGGL(mk_fwd, dim3(grid), dim3(512), LDS_BYTES, stream, p);
#endif
}
```

```cpp
#include <hip/hip_runtime.h>
#include <cstdio>
#include <cstdint>

#define LAS __attribute__((address_space(3)))
typedef unsigned short bf16_t;
typedef short bf16x8 __attribute__((ext_vector_type(8)));
typedef float f32x4 __attribute__((ext_vector_type(4)));
typedef float f32x2 __attribute__((ext_vector_type(2)));
typedef unsigned u32x4 __attribute__((ext_vector_type(4)));
typedef unsigned u32x2 __attribute__((ext_vector_type(2)));
typedef float f32x16 __attribute__((ext_vector_type(16)));

constexpr int NB = 4, SEQ = 2048, NT = NB * SEQ, DM = 2048, DIN = 3840, NPROJ = 3328, NE = 16, FF = 1024, CAP = 256;
constexpr float EPS = 1e-6f;
constexpr int PC_U = 0, PC_V = 512, PC_QC = 1024, PC_KC = 1536, PC_VC = 1664, PC_QD = 1792, PC_KD = 2304, PC_VD = 2816;

constexpr size_t MiB = (size_t)1 << 20;
constexpr size_t WS_CTL = 0;
constexpr size_t WS_MOD = 1 * MiB;
constexpr size_t WS_ROPE = WS_MOD + 512 * 1024;
constexpr size_t WS_DFT = 2 * MiB;
constexpr size_t WS_WIN = 18 * MiB;
constexpr size_t WS_WPQ = 44 * MiB;
constexpr size_t WS_WOUT = 52 * MiB;
constexpr size_t WS_WGU = 68 * MiB;
constexpr size_t WS_WD = 324 * MiB;
constexpr size_t WS_X = 452 * MiB;
constexpr size_t WS_X2 = 516 * MiB;
constexpr size_t WS_H = 580 * MiB;
constexpr size_t WS_PROJ = 612 * MiB;
constexpr size_t WS_PQT = 664 * MiB;
constexpr size_t WS_YA = 680 * MiB;
constexpr size_t WS_YB = 712 * MiB;
constexpr size_t WS_YC = 720 * MiB;
constexpr size_t WS_YD = 728 * MiB;
constexpr size_t WS_LSE = 752 * MiB;
constexpr size_t WS_YN = 753 * MiB;
constexpr size_t WS_AFF = 785 * MiB;
constexpr size_t WS_IDX = 786 * MiB;
constexpr size_t WS_XE = 787 * MiB;
constexpr size_t WS_ACT = 851 * MiB;
constexpr size_t WS_EO = 883 * MiB;
constexpr size_t WS_SGUW = 947 * MiB;
constexpr size_t WS_WRT = WS_SGUW + 512 * 1024;
constexpr size_t WS_ABT = WS_WRT + 128 * 1024;
constexpr size_t WS_VSS = WS_ABT + 256 * 1024;
constexpr size_t WS_END = 948 * MiB;

constexpr int LDS_BYTES = 163840;
constexpr int MISC_OFF = LDS_BYTES - 256;

struct Params { const float* in[20]; float* out; unsigned char* ws; int ph_lo, ph_hi; };

__device__ __forceinline__ unsigned pk2(float lo, float hi) { unsigned r; asm("v_cvt_pk_bf16_f32 %0, %1, %2" : "=v"(r) : "v"(lo), "v"(hi)); return r; }
__device__ __forceinline__ float bflo(unsigned u) { return __uint_as_float(u << 16); }
__device__ __forceinline__ float bfhi(unsigned u) { return __uint_as_float(u & 0xffff0000u); }
__device__ __forceinline__ float wave_sum(float v) {
#pragma unroll
    for (int o = 1; o < 64; o <<= 1) v += __shfl_xor(v, o);
    return v;
}
__device__ __forceinline__ float gelu_tanh(float x) { const float u = 0.7978845608f * (x + 0.044715f * x * x * x); return x * __builtin_amdgcn_rcpf(1.f + __builtin_amdgcn_exp2f(-2.885390082f * u)); }
__device__ __forceinline__ float silu_f(float x) { return x * __builtin_amdgcn_rcpf(1.f + __builtin_amdgcn_exp2f(-1.442695041f * x)); }

__device__ __forceinline__ int opaque_tid() { int t = threadIdx.x; asm volatile("" : "+v"(t)); return t; }
#define XB_TMO      128
#define XB_XCNT(j)  (256  + 64 * (j))
#define XB_XSUB(j)  (1280 + 64 * (j))
#define XB_XGEN(j)  (2304 + 64 * (j))
#define XB_TOP      3328
#define XB_TOPGEN   3392
#define XCD_BAR_WORDS 3456
#define XB_SPIN_CAP (1u << 18)
__device__ __forceinline__ unsigned xb_ld(unsigned* p)              { return __hip_atomic_load(p, __ATOMIC_RELAXED, __HIP_MEMORY_SCOPE_AGENT); }
__device__ __forceinline__ unsigned xb_add(unsigned* p, unsigned v) { return __hip_atomic_fetch_add(p, v, __ATOMIC_RELAXED, __HIP_MEMORY_SCOPE_AGENT); }
__device__ __forceinline__ unsigned xb_xcc_id() { return (unsigned)__builtin_amdgcn_s_getreg((3 << 11) | 20) & 0xFu; }
#define XB_SPIN(cond, bar) do { unsigned _sp = 0; while (cond) { __builtin_amdgcn_s_sleep(1); \
    if ((++_sp & 255u) == 0u) { if (xb_ld(&(bar)[XB_TMO])) break; if (_sp > XB_SPIN_CAP) { atomicAdd(&(bar)[XB_TMO], 1u); break; } } } } while (0)
struct XcdBarrier { unsigned* bar; unsigned x; volatile LAS unsigned* st; };
__device__ __forceinline__ XcdBarrier xcd_barrier_post(unsigned* bar, volatile LAS unsigned* st) {
    XcdBarrier b; b.bar = bar; b.x = xb_xcc_id(); b.st = st;
    if (threadIdx.x == 0) (void)xb_add(&bar[XB_XCNT(b.x)], 1u);
    return b;
}
__device__ __forceinline__ void xcd_barrier_complete(unsigned* bar, unsigned x, unsigned& nloc, unsigned& nx) {
    const unsigned G = gridDim.x * gridDim.y * gridDim.z;
    unsigned sum, cnt, mine, sp = 0u;
    for (;;) {
        sum = 0u; cnt = 0u; mine = 0u;
#pragma unroll
        for (unsigned j = 0; j < 16; ++j) { const unsigned c = xb_ld(&bar[XB_XCNT(j)]); sum += c; cnt += (c > 0u) ? 1u : 0u; mine = (j == x) ? c : mine; }
        if (sum == G) break;
        __builtin_amdgcn_s_sleep(1);
        if ((++sp & 255u) == 0u) { if (xb_ld(&bar[XB_TMO])) break; if (sp > XB_SPIN_CAP) { atomicAdd(&bar[XB_TMO], 1u); break; } }
    }
    nloc = mine > 0u ? mine : 1u; nx = cnt > 0u ? cnt : 1u;
}
__device__ __forceinline__ void xcd_barrier(const XcdBarrier& b) {
    asm volatile("s_waitcnt vmcnt(0)" ::: "memory");
    __syncthreads();
    if (threadIdx.x == 0) {
        unsigned* bar = b.bar;
        __builtin_amdgcn_s_waitcnt(0);
        unsigned nloc = b.st[0], nx = b.st[1];
        if (nloc == 0u) { xcd_barrier_complete(bar, b.x, nloc, nx); b.st[0] = nloc; b.st[1] = nx; }
        const unsigned old = xb_add(&bar[XB_XSUB(b.x)], 1u);
        const unsigned gen = old / nloc;
        if (old + 1u == (gen + 1u) * nloc) {
            __builtin_amdgcn_fence(__ATOMIC_RELEASE, "agent");
            asm volatile("s_waitcnt vmcnt(0)" ::: "memory");
            const unsigned og = xb_add(&bar[XB_TOP], 1u);
            const unsigned tg = og / nx;
            if (og + 1u == (tg + 1u) * nx) xb_add(&bar[XB_TOPGEN], 1u);
            else XB_SPIN(xb_ld(&bar[XB_TOPGEN]) == tg, bar);
            __builtin_amdgcn_fence(__ATOMIC_ACQUIRE, "agent");
            xb_add(&bar[XB_XGEN(b.x)], 1u);
            asm volatile("s_waitcnt vmcnt(0)" ::: "memory");
        } else {
            XB_SPIN(xb_ld(&bar[XB_XGEN(b.x)]) == gen, bar);
            __builtin_amdgcn_fence(__ATOMIC_ACQUIRE, "agent");
            asm volatile("s_waitcnt vmcnt(0)" ::: "memory");
        }
    }
    __syncthreads();
}

namespace pg8 {
constexpr int BM = 256, BK = 64, HALF = 128, HTB = HALF * BK * 2, STAGE_BYTES = 8 * HTB;
__host__ __device__ __forceinline__ int lds_byte(int r, int c) { const int st = (r >> 4) * 2 + (c >> 5), rr = r & 15, cc = c & 31, ob = rr * 64 + cc * 2; return st * 1024 + (ob ^ (((ob >> 9) & 1) << 5)); }
__host__ __device__ __forceinline__ void stage_rc(int b, int& R, int& C) { const int st = b / 1024, sb = b % 1024, swz = sb ^ (((sb >> 9) & 1) << 5); R = (st >> 1) * 16 + swz / 64; C = (st & 1) * 32 + (swz % 64) / 2; }
__host__ __device__ __forceinline__ int perm32(int rho) { const int n = rho >> 4, i = rho & 15; return 8 * (i >> 2) + 4 * n + (i & 3); }

struct GUnit { const char* a; const char* b; int pm, pn, z; };

__device__ __forceinline__ void dense_map(int L, int nM, int nN, int& pm, int& pn) {
    const int nwg = nM * nN;
    int wgid = L; { const int q = nwg / 8, r = nwg % 8, xcd = wgid % 8, off = wgid / 8; wgid = (xcd < r ? xcd * (q + 1) : r * (q + 1) + (xcd - r) * q) + off; }
    const int nig = 8 * nN, gid = wgid / nig, fm = gid * 8, gsz = (nM - fm) < 8 ? (nM - fm) : 8;
    pm = fm + ((wgid % nig) % gsz); pn = (wgid % nig) / gsz;
}

template <class Epi, class Sched, bool GATHER = false>
__device__ __forceinline__ void gemm_phase(LAS unsigned char* lds, const int lda, const int ldb, const int K, const Sched& S, const Epi& E, const int* gidx = nullptr) {
    int tid_ = threadIdx.x; asm volatile("" : "+v"(tid_));
    const int tid = tid_, wid = __builtin_amdgcn_readfirstlane(tid >> 6), lane = tid & 63, wr = wid >> 2, wc = wid & 3, fr = lane & 15, fq = lane >> 4;
    const int nt = K / BK;
    unsigned voffB[2]; int RA[2]; unsigned CA2[2];
#pragma unroll
    for (int i = 0; i < 2; ++i) { int R, C; stage_rc(tid * 16 + i * 8192, R, C); const int Rb = Epi::PERM ? ((R & ~31) + perm32(R & 31)) : R;
        RA[i] = R; CA2[i] = (unsigned)C * 2u; voffB[i] = (unsigned)(Rb * ldb + C) * 2u; }
    const size_t kstep = (size_t)(BK * 2);
    const size_t hstepB = (size_t)HALF * ldb * 2;
    const unsigned ldsw = (unsigned)wid * 1024u;
    const int aoff = lds_byte(wr * 64 + fr, fq * 8), boff = lds_byte(wc * 32 + fr, fq * 8);
#define PG8_AOFF(of, u) do { _Pragma("unroll") for (int hh_ = 0; hh_ < 2; ++hh_) _Pragma("unroll") for (int i_ = 0; i_ < 2; ++i_) { \
        if constexpr (GATHER) of[hh_][i_] = (unsigned)gidx[(u).pm * 256 + hh_ * 128 + RA[i_]] * (unsigned)(lda * 2) + CA2[i_]; \
        else of[hh_][i_] = (unsigned)((hh_ * HALF + RA[i_]) * lda) * 2u + CA2[i_]; } } while (0)
#define PG8_SA(b, h) (((b) * 2 + (h)) * HTB)
#define PG8_SB(b, h) ((4 + (b) * 2 + (h)) * HTB)
#define PG8_STAGE(bufoff, gbase, voff) do { _Pragma("unroll") for (int _i = 0; _i < 2; ++_i) \
        __builtin_amdgcn_global_load_lds((const unsigned*)((const char*)(gbase) + (voff)[_i]), (LAS unsigned*)(lds + (bufoff) + ldsw + _i * 8192), 16, 0, 0); } while (0)
#define PG8_LDA(dst, b, h) do { _Pragma("unroll") for (int m = 0; m < 4; ++m) _Pragma("unroll") for (int k = 0; k < 2; ++k) dst[m][k] = *(const LAS bf16x8*)(lds + PG8_SA(b, h) + aoff + m * 2048 + k * 1024); } while (0)
#define PG8_LDB(dst, b, h) do { _Pragma("unroll") for (int n = 0; n < 2; ++n) _Pragma("unroll") for (int k = 0; k < 2; ++k) dst[n][k] = *(const LAS bf16x8*)(lds + PG8_SB(b, h) + boff + n * 2048 + k * 1024); } while (0)
#define PG8_MMA(ai, bj, At, Bt) do { __builtin_amdgcn_s_setprio(1); _Pragma("unroll") for (int m = 0; m < 4; ++m) _Pragma("unroll") for (int n = 0; n < 2; ++n) _Pragma("unroll") for (int k = 0; k < 2; ++k) \
        acc[ai][bj][m][n] = __builtin_amdgcn_mfma_f32_16x16x32_bf16(Bt[n][k], At[m][k], acc[ai][bj][m][n], 0, 0, 0); __builtin_amdgcn_s_setprio(0); } while (0)
#define PG8_WAIT_V(n) asm volatile("s_waitcnt vmcnt(" #n ")" ::: "memory")
#define PG8_WAIT_L(n) asm volatile("s_waitcnt lgkmcnt(" #n ")" ::: "memory")
#define PG8_BAR __builtin_amdgcn_s_barrier()
#define PG8_SCHED __builtin_amdgcn_sched_barrier(0)
    GUnit cur, nxt; int ui = 0;
    if (!S.next(0, cur)) return;
    f32x4 acc[2][2][4][2];
#pragma unroll
    for (int a = 0; a < 2; ++a)
#pragma unroll
        for (int b = 0; b < 2; ++b)
#pragma unroll
            for (int m = 0; m < 4; ++m)
#pragma unroll
                for (int n = 0; n < 2; ++n) acc[a][b][m][n] = (f32x4){0.f, 0.f, 0.f, 0.f};
    bf16x8 At[4][2], B0[2][2], B1[2][2];
    unsigned ofc[2][2], ofn[2][2];
    PG8_AOFF(ofc, cur);
#pragma unroll
    for (int hh = 0; hh < 2; ++hh)
#pragma unroll
        for (int i = 0; i < 2; ++i) ofn[hh][i] = ofc[hh][i];
    const char* cA = cur.a; const char* cB = cur.b;
    PG8_STAGE(PG8_SB(0, 0), cB, voffB); PG8_STAGE(PG8_SB(0, 1), cB + hstepB, voffB); PG8_STAGE(PG8_SA(0, 0), cA, ofc[0]); PG8_STAGE(PG8_SA(0, 1), cA, ofc[1]);
    if (wr == 1) PG8_BAR;
    PG8_WAIT_V(2); PG8_BAR;
    PG8_STAGE(PG8_SB(1, 0), cB + kstep, voffB); PG8_STAGE(PG8_SA(1, 0), cA + kstep, ofc[0]); PG8_STAGE(PG8_SB(1, 1), cB + hstepB + kstep, voffB);
    PG8_WAIT_V(6); PG8_BAR;
    for (;;) {
        const bool has_next = S.next(ui + 1, nxt);
        const char* nA = has_next ? nxt.a : cA; const char* nB = has_next ? nxt.b : cB;
        for (int t = 0; t < nt; t += 2) {
            const bool last = (t == nt - 2);
            if constexpr (GATHER) { if (last && has_next) PG8_AOFF(ofn, nxt); }
            const char* a1 = cA + (size_t)(t + 1) * kstep;
            const char* a2 = last ? nA : cA + (size_t)(t + 2) * kstep; const char* b2 = last ? nB : cB + (size_t)(t + 2) * kstep;
            const char* a3 = a2 + kstep; const char* b3 = b2 + kstep;
            unsigned o2[2][2];
#pragma unroll
            for (int hh = 0; hh < 2; ++hh)
#pragma unroll
                for (int i = 0; i < 2; ++i) { if constexpr (GATHER) o2[hh][i] = last ? ofn[hh][i] : ofc[hh][i]; else o2[hh][i] = ofc[hh][i]; }
            PG8_LDB(B0, 0, 0); PG8_LDB(B1, 0, 1); PG8_SCHED; PG8_LDA(At, 0, 0); PG8_STAGE(PG8_SA(1, 1), a1, ofc[1]);
            PG8_WAIT_V(8); PG8_WAIT_L(0); PG8_BAR; PG8_MMA(0, 0, At, B0); PG8_MMA(0, 1, At, B1); PG8_BAR; PG8_SCHED;
            PG8_LDA(At, 0, 1); PG8_STAGE(PG8_SB(0, 0), b2, voffB); PG8_STAGE(PG8_SB(0, 1), b2 + hstepB, voffB); PG8_STAGE(PG8_SA(0, 0), a2, o2[0]);
            PG8_WAIT_V(8); PG8_WAIT_L(0); PG8_BAR; PG8_MMA(1, 0, At, B0); PG8_MMA(1, 1, At, B1); PG8_BAR; PG8_SCHED;
            PG8_LDB(B0, 1, 0); PG8_LDB(B1, 1, 1); PG8_SCHED; PG8_LDA(At, 1, 0); PG8_STAGE(PG8_SA(0, 1), a2, o2[1]);
            PG8_WAIT_V(8); PG8_WAIT_L(0); PG8_BAR; PG8_MMA(0, 0, At, B0); PG8_MMA(0, 1, At, B1); PG8_BAR; PG8_SCHED;
            PG8_LDA(At, 1, 1); PG8_STAGE(PG8_SB(1, 0), b3, voffB); PG8_STAGE(PG8_SB(1, 1), b3 + hstepB, voffB); PG8_STAGE(PG8_SA(1, 0), a3, o2[0]);
            PG8_WAIT_V(8); PG8_WAIT_L(0); PG8_BAR; PG8_MMA(1, 0, At, B0); PG8_MMA(1, 1, At, B1); PG8_BAR; PG8_SCHED;
        }
        if (wr == 0) PG8_BAR;
        E(acc, cur, wr, wc, fr, fq);
        if (!has_next) break;
#pragma unroll
        for (int a = 0; a < 2; ++a)
#pragma unroll
            for (int b = 0; b < 2; ++b)
#pragma unroll
                for (int m = 0; m < 4; ++m)
#pragma unroll
                    for (int n = 0; n < 2; ++n) acc[a][b][m][n] = (f32x4){0.f, 0.f, 0.f, 0.f};
        cur = nxt; cA = nA; cB = nB; ++ui;
        if constexpr (GATHER) {
#pragma unroll
            for (int hh = 0; hh < 2; ++hh)
#pragma unroll
                for (int i = 0; i < 2; ++i) ofc[hh][i] = ofn[hh][i];
        }
        if (wr == 1) PG8_BAR;
    }
    PG8_WAIT_V(0);
    PG8_BAR;
#undef PG8_AOFF
#undef PG8_SA
#undef PG8_SB
#undef PG8_STAGE
#undef PG8_LDA
#undef PG8_LDB
#undef PG8_MMA
#undef PG8_WAIT_V
#undef PG8_WAIT_L
#undef PG8_BAR
#undef PG8_SCHED
}
}
using pg8::GUnit;

struct SchedProj {
    const char* H; const char* WIN; const char* WPQ; int G, c;
    __device__ __forceinline__ bool next(int i, GUnit& u) const {
        const int L = i * G + c; if (L >= 480) return false;
        if (L < 416) { int pm, pn; pg8::dense_map(L, 32, 13, pm, pn); u.pm = pm; u.pn = pn; u.z = 0; u.a = H + (size_t)pm * 256 * 2048 * 2; u.b = WIN + (size_t)pn * 256 * 2048 * 2; }
        else { int pm, pn; pg8::dense_map(L - 416, 2, 32, pm, pn); u.pm = pm; u.pn = pn + 64; u.z = 0; u.a = WPQ + (size_t)pm * 256 * 2048 * 2; u.b = H + (size_t)pn * 256 * 2048 * 2; }
        return true;
    }
};
struct SchedDft {
    const char* DFT; const char* XAT; int G, c;
    __device__ __forceinline__ bool next(int i, GUnit& u) const {
        const int L = i * G + c; if (L >= 256) return false;
        const int Lp = (L & 7) * 32 + (L >> 3);
        const int ks = Lp & 1, pn = (Lp >> 1) & 1, pm = (Lp >> 2) & 15, b = Lp >> 6;
        u.pm = b * 16 + pm; u.pn = pn; u.z = ks;
        u.a = DFT + ((size_t)pm * 256 * 2048 + ks * 1024) * 2; u.b = XAT + (((size_t)b * 512 + pn * 256) * 2048 + ks * 1024) * 2;
        return true;
    }
};
struct SchedDense {
    const char* A; const char* B; int nM, nN, K, G, c;
    __device__ __forceinline__ bool next(int i, GUnit& u) const {
        const int L = i * G + c; if (L >= nM * nN) return false;
        int pm, pn; pg8::dense_map(L, nM, nN, pm, pn); u.pm = pm; u.pn = pn; u.z = 0;
        u.a = A + (size_t)pm * 256 * K * 2; u.b = B + (size_t)pn * 256 * K * 2; return true;
    }
};
struct SchedMoeG {
    const char* A; const char* B; int K, G, c;
    __device__ __forceinline__ bool next(int i, GUnit& u) const {
        const int L = i * G + c; if (L >= 512) return false;
        const int Lp = (L & 7) * 64 + (L >> 3);
        const int e = Lp >> 5, r = Lp & 31, pm = r & 3, pn = r >> 2;
        u.pm = e * 4 + pm; u.pn = pn; u.z = e;
        u.a = A; u.b = B + ((size_t)e * 2048 + pn * 256) * K * 2; return true;
    }
};
struct SchedMoe {
    const char* A; const char* B; int K, G, c;
    __device__ __forceinline__ bool next(int i, GUnit& u) const {
        const int L = i * G + c; if (L >= 512) return false;
        const int Lp = (L & 7) * 64 + (L >> 3);
        const int e = Lp >> 5, r = Lp & 31, pm = r & 3, pn = r >> 2;
        u.pm = e * 4 + pm; u.pn = pn; u.z = e;
        u.a = A + ((size_t)e * 1024 + pm * 256) * K * 2; u.b = B + ((size_t)e * 2048 + pn * 256) * K * 2; return true;
    }
};

typedef f32x4 AccT[2][2][4][2];
struct EpiProj {
    static constexpr bool PERM = true;
    bf16_t* PROJ; bf16_t* PQT; const float* ropec; const float* ropes;
    __device__ __forceinline__ void operator()(const AccT& acc, const GUnit& u, int wr, int wc, int fr, int fq) const {
        if (u.pn < 64) {
            const int pn = u.pn;
            const int row0 = u.pm * 256 + wr * 64 + fr;
#pragma unroll
            for (int ai = 0; ai < 2; ++ai)
#pragma unroll
                for (int m = 0; m < 4; ++m) {
                    const int row = row0 + ai * 128 + m * 16;
                    float vsq = 0.f;
#pragma unroll
                    for (int bj = 0; bj < 2; ++bj) {
                        f32x4 v0 = acc[ai][bj][m][0], v1 = acc[ai][bj][m][1];
                        const int colt = pn * 256 + bj * 128;
                        if (pn < 4) {
#pragma unroll
                            for (int j = 0; j < 4; ++j) { v0[j] = gelu_tanh(v0[j]); v1[j] = gelu_tanh(v1[j]); vsq += v0[j] * v0[j] + v1[j] * v1[j]; }
                        } else {
                            const bool isq = (colt >= PC_QC && colt < PC_KC) || (colt >= PC_QD && colt < PC_KD);
                            const bool isk = (colt >= PC_KC && colt < PC_VC) || (colt >= PC_KD && colt < PC_VD);
                            if (isq || isk) {
                                if ((wc & 1) == 0) {
                                    f32x4 o0, o1;
#pragma unroll
                                    for (int j = 0; j < 4; ++j) { o0[j] = __shfl_xor(v0[j], 16); o1[j] = __shfl_xor(v1[j], 16); }
                                    if (fq < 2) {
                                        const f32x4 c0 = *(const f32x4*)(ropec + (size_t)row * 8), c1 = *(const f32x4*)(ropec + (size_t)row * 8 + 4);
                                        const f32x4 s0 = *(const f32x4*)(ropes + (size_t)row * 8), s1 = *(const f32x4*)(ropes + (size_t)row * 8 + 4);
                                        const float sg = fq == 0 ? -1.f : 1.f;
#pragma unroll
                                        for (int j = 0; j < 4; ++j) { v0[j] = v0[j] * c0[j] + sg * o0[j] * s0[j]; v1[j] = v1[j] * c1[j] + sg * o1[j] * s1[j]; }
                                    }
                                }
                                if (isq) { v0 = v0 * 0.125f; v1 = v1 * 0.125f; }
                            }
                        }
                        u32x4 w; w.x = pk2(v0[0], v0[1]); w.y = pk2(v0[2], v0[3]); w.z = pk2(v1[0], v1[1]); w.w = pk2(v1[2], v1[3]);
                        *(u32x4*)(PROJ + (size_t)row * NPROJ + colt + wc * 32 + 8 * fq) = w;
                    }
                    if (pn == 2 || pn == 3) {
                        vsq += __shfl_xor(vsq, 16); vsq += __shfl_xor(vsq, 32);
                        if (fq == 0) ((float*)((char*)PROJ + (WS_VSS - WS_PROJ)))[(size_t)row * 8 + (pn - 2) * 4 + wc] = vsq;
                    }
                }
        } else {
#pragma unroll
            for (int ai = 0; ai < 2; ++ai)
#pragma unroll
                for (int m = 0; m < 4; ++m) {
                    const int c = u.pm * 256 + ai * 128 + wr * 64 + m * 16 + fr;
#pragma unroll
                    for (int bj = 0; bj < 2; ++bj) {
                        const int t = (u.pn - 64) * 256 + bj * 128 + wc * 32 + 8 * fq, b = t >> 11, s = t & 2047;
                        const f32x4 v0 = acc[ai][bj][m][0], v1 = acc[ai][bj][m][1];
                        u32x4 w; w.x = pk2(v0[0], v0[1]); w.y = pk2(v0[2], v0[3]); w.z = pk2(v1[0], v1[1]); w.w = pk2(v1[2], v1[3]);
                        *(u32x4*)(PQT + (((size_t)b * 512 + c) * 2048 + s)) = w;
                    }
                }
        }
    }
};
struct EpiBf16Plain {
    static constexpr bool PERM = true;
    bf16_t* O; int ldc; size_t zstride;
    __device__ __forceinline__ void operator()(const AccT& acc, const GUnit& u, int wr, int wc, int fr, int fq) const {
        bf16_t* base = O + (size_t)u.z * zstride;
#pragma unroll
        for (int ai = 0; ai < 2; ++ai)
#pragma unroll
            for (int m = 0; m < 4; ++m) {
                const int row = u.pm * 256 + ai * 128 + wr * 64 + m * 16 + fr;
#pragma unroll
                for (int bj = 0; bj < 2; ++bj) {
                    const f32x4 v0 = acc[ai][bj][m][0], v1 = acc[ai][bj][m][1];
                    u32x4 w; w.x = pk2(v0[0], v0[1]); w.y = pk2(v0[2], v0[3]); w.z = pk2(v1[0], v1[1]); w.w = pk2(v1[2], v1[3]);
                    *(u32x4*)(base + (size_t)row * ldc + u.pn * 256 + bj * 128 + wc * 32 + 8 * fq) = w;
                }
            }
    }
};
struct EpiWout {
    static constexpr bool PERM = true;
    const float* base32; const bf16_t* base16; bf16_t* X2; const float* gate;
    __device__ __forceinline__ void operator()(const AccT& acc, const GUnit& u, int wr, int wc, int fr, int fq) const {
        const int b = u.pm >> 3;
        const int col0 = u.pn * 256 + wc * 32 + 8 * fq;
        f32x4 g[2][2];
#pragma unroll
        for (int bj = 0; bj < 2; ++bj)
#pragma unroll
            for (int n = 0; n < 2; ++n) g[bj][n] = *(const f32x4*)(gate + (size_t)b * 12288 + col0 + bj * 128 + n * 4);
#pragma unroll
        for (int ai = 0; ai < 2; ++ai)
#pragma unroll
            for (int m = 0; m < 4; ++m) {
                const size_t ro = (size_t)(u.pm * 256 + ai * 128 + wr * 64 + m * 16 + fr) * DM + col0;
#pragma unroll
                for (int bj = 0; bj < 2; ++bj) {
                    f32x4 x0, x1;
                    if (base32) { x0 = *(const f32x4*)(base32 + ro + bj * 128); x1 = *(const f32x4*)(base32 + ro + bj * 128 + 4); }
                    else { const u32x4 w = *(const u32x4*)(base16 + ro + bj * 128); x0 = (f32x4){bflo(w.x), bfhi(w.x), bflo(w.y), bfhi(w.y)}; x1 = (f32x4){bflo(w.z), bfhi(w.z), bflo(w.w), bfhi(w.w)}; }
                    const f32x4 v0 = x0 + g[bj][0] * acc[ai][bj][m][0], v1 = x1 + g[bj][1] * acc[ai][bj][m][1];
                    u32x4 o; o.x = pk2(v0[0], v0[1]); o.y = pk2(v0[2], v0[3]); o.z = pk2(v1[0], v1[1]); o.w = pk2(v1[2], v1[3]);
                    *(u32x4*)(X2 + ro + bj * 128) = o;
                }
            }
    }
};
struct EpiGU {
    static constexpr bool PERM = true;
    bf16_t* ACT;
    __device__ __forceinline__ void operator()(const AccT& acc, const GUnit& u, int wr, int wc, int fr, int fq) const {
#pragma unroll
        for (int ai = 0; ai < 2; ++ai)
#pragma unroll
            for (int m = 0; m < 4; ++m) {
                const int row = u.pm * 256 + ai * 128 + wr * 64 + m * 16 + fr;
                f32x4 v0, v1;
#pragma unroll
                for (int j = 0; j < 4; ++j) { v0[j] = silu_f(acc[ai][0][m][0][j]) * acc[ai][1][m][0][j]; v1[j] = silu_f(acc[ai][0][m][1][j]) * acc[ai][1][m][1][j]; }
                u32x4 w; w.x = pk2(v0[0], v0[1]); w.y = pk2(v0[2], v0[3]); w.z = pk2(v1[0], v1[1]); w.w = pk2(v1[2], v1[3]);
                *(u32x4*)(ACT + (size_t)row * FF + u.pn * 128 + wc * 32 + 8 * fq) = w;
            }
    }
};
struct EpiDown {
    static constexpr bool PERM = true;
    bf16_t* EO; const float* gate;
    __device__ __forceinline__ void operator()(const AccT& acc, const GUnit& u, int wr, int wc, int fr, int fq) const {
#pragma unroll
        for (int ai = 0; ai < 2; ++ai)
#pragma unroll
            for (int m = 0; m < 4; ++m) {
                const int row = u.pm * 256 + ai * 128 + wr * 64 + m * 16 + fr;
                const float g = gate[row];
#pragma unroll
                for (int bj = 0; bj < 2; ++bj) {
                    const f32x4 v0 = acc[ai][bj][m][0] * g, v1 = acc[ai][bj][m][1] * g;
                    u32x4 w; w.x = pk2(v0[0], v0[1]); w.y = pk2(v0[2], v0[3]); w.z = pk2(v1[0], v1[1]); w.w = pk2(v1[2], v1[3]);
                    *(u32x4*)(EO + (size_t)row * DM + u.pn * 256 + bj * 128 + wc * 32 + 8 * fq) = w;
                }
            }
    }
};

__device__ __forceinline__ void ph_mod(const Params& p, LAS unsigned char* lds) {
    LAS float* sl = (LAS float*)lds;
    LAS float* red = (LAS float*)(lds + 32768);
    const int tid = opaque_tid();
    const float* c = p.in[1];
    float* mod = (float*)(p.ws + WS_MOD);
    for (int i = tid; i < 8192; i += 512) { const float v = c[i]; sl[i] = v / (1.f + expf(-v)); }
    __syncthreads();
    const int cl = tid & 31, ks = tid >> 5;
    for (int u = blockIdx.x; u < 192; u += gridDim.x) {
        const int l = u / 96, cc = u % 96;
        const float* W = p.in[3] + (size_t)l * 2048 * 12288 + cc * 128 + cl * 4;
        float acc[4][4];
#pragma unroll
        for (int b = 0; b < 4; ++b)
#pragma unroll
            for (int j = 0; j < 4; ++j) acc[b][j] = 0.f;
#pragma unroll 8
        for (int k = ks; k < 2048; k += 16) {
            const f32x4 w = __builtin_nontemporal_load((const f32x4*)(W + (size_t)k * 12288));
#pragma unroll
            for (int b = 0; b < 4; ++b) { const float s = sl[b * 2048 + k];
#pragma unroll
                for (int j = 0; j < 4; ++j) acc[b][j] += s * w[j]; }
        }
#pragma unroll
        for (int b = 0; b < 4; ++b)
#pragma unroll
            for (int j = 0; j < 4; ++j) red[((b * 4 + j) * 16 + ks) * 32 + cl] = acc[b][j];
        __syncthreads();
        { const int b = tid >> 7, col = tid & 127; float s = 0.f;
#pragma unroll
          for (int q = 0; q < 16; ++q) s += red[((b * 4 + (col & 3)) * 16 + q) * 32 + (col >> 2)];
          mod[(size_t)(l * 4 + b) * 12288 + cc * 128 + col] = s + p.in[4][(size_t)l * 12288 + cc * 128 + col]; }
        __syncthreads();
    }
}
__device__ __forceinline__ void ph_tables(const Params& p, LAS unsigned char* lds) {
    const int tid = opaque_tid();
    const int gt = blockIdx.x * 512 + tid, ngt = gridDim.x * 512;
    LAS float* ct = (LAS float*)lds;
    LAS float* c64 = ct + 2048;
    for (int m = tid; m < 2048; m += 512) ct[m] = cospif((float)m * (1.f / 1024.f));
    if (tid < 64) { c64[tid] = cospif((float)tid * (1.f / 32.f)); c64[64 + tid] = sinpif((float)tid * (1.f / 32.f)); }
    __syncthreads();
    float* rc = (float*)(p.ws + WS_ROPE); float* rs = rc + NT * 8;
    const int* pos = (const int*)p.in[2];
    for (int i = gt; i < NT * 8; i += ngt) {
        const int t = i >> 3, j = i & 7;
        float inv;
        switch (j) { case 0: inv = 1.0f; break; case 1: inv = 0.1939227432012558f; break; case 2: inv = 0.03760603070259094f; break; case 3: inv = 0.007292664609849453f; break;
                     case 4: inv = 0.0014142135623842478f; break; case 5: inv = 0.00027424818836152554f; break; case 6: inv = 5.318296098266728e-05f; break; default: inv = 1.0313386155758053e-05f; break; }
        const float ang = (float)pos[t] * inv;
        double r = (double)ang * 0.15915494309189535; r -= floor(r);
        const float a = (float)(2.0 * r);
        rc[i] = cospif(a); rs[i] = sinpif(a);
    }
    { bf16_t* sw = (bf16_t*)(p.ws + WS_SGUW);
      for (int i = gt; i < 2 * 8 * 128 * 128 / 4; i += ngt) { const f32x4 w = *(const f32x4*)(p.in[9] + (size_t)i * 4); u32x2 o; o.x = pk2(w[0], w[1]); o.y = pk2(w[2], w[3]); *(u32x2*)(sw + (size_t)i * 4) = o; } }
    { bf16_t* wrt = (bf16_t*)(p.ws + WS_WRT);
      for (int i = gt; i < 2 * 16 * 2048; i += ngt) { const int l = i >> 15, e = (i >> 11) & 15, k = i & 2047; wrt[i] = (bf16_t)(pk2(p.in[15][((size_t)l * 2048 + k) * 16 + e], 0.f) & 0xffffu); } }
    { bf16_t* abt = (bf16_t*)(p.ws + WS_ABT);
      for (int i = gt; i < 2 * 8 * 64 * 128; i += ngt) { const int k = i & 127, d = (i >> 7) & 63, lh = i >> 13, c = k & 63; const float* fw = p.in[7] + (size_t)lh * 4096;
          float sacc = 0.f;
          for (int cp = 0; cp < 64; ++cp) sacc += c64[(k < 64 ? 0 : 64) + ((c * cp) & 63)] * fw[cp * 64 + d];
          abt[i] = (bf16_t)(pk2(sacc * 0.125f, 0.f) & 0xffffu); } }
    bf16_t* dft = (bf16_t*)(p.ws + WS_DFT);
    for (int i = gt; i < 2048 * 512; i += ngt) {
        const int sp = i >> 9, k8 = (i & 511) * 8;
        float v[8];
#pragma unroll
        for (int e = 0; e < 8; ++e) { const int k = k8 + e, part = k >> 11, s = k & 2047, m = (s * sp + part * 512) & 2047;
            v[e] = ct[m] * 0.022097086912079608f; }
        u32x4 w; w.x = pk2(v[0], v[1]); w.y = pk2(v[2], v[3]); w.z = pk2(v[4], v[5]); w.w = pk2(v[6], v[7]);
        *(u32x4*)(dft + (size_t)sp * 4096 + k8) = w;
    }
    __syncthreads();
}
struct TDesc { const float* src; bf16_t* dst; const float* ksc; int lds_, ldd; };
__device__ __forceinline__ bool tdecode(const Params& p, int it, TDesc& d) {
    if (it >= 2 * 6880) return false;
    const int l = it / 6880; int r = it % 6880;
    d.ksc = nullptr;
    if (r < 480) { const int kt = r / 30, nt = r % 30;
        d.src = p.in[6] + ((size_t)l * 2048 + kt * 128) * DIN + nt * 128; d.lds_ = DIN;
        d.dst = (nt < 4 ? (bf16_t*)(p.ws + WS_WPQ) + ((size_t)l * 512 + nt * 128) * 2048 : (bf16_t*)(p.ws + WS_WIN) + ((size_t)l * NPROJ + (nt - 4) * 128) * 2048) + kt * 128; d.ldd = 2048; return true; }
    r -= 480;
    if (r < 256) { const int kt = r / 16, nt = r % 16;
        d.src = p.in[13] + ((size_t)l * 2048 + kt * 128) * 2048 + nt * 128; d.lds_ = 2048; d.ksc = p.in[12] + (size_t)l * 2048 + kt * 128;
        d.dst = (bf16_t*)(p.ws + WS_WOUT) + ((size_t)l * 2048 + nt * 128) * 2048 + kt * 128; d.ldd = 2048; return true; }
    r -= 256;
    if (r < 4096) { const int isup = r / 2048, r2 = r % 2048, e = r2 / 128, kt = (r2 % 128) / 8, nt = r2 % 8;
        d.src = p.in[isup ? 17 : 16] + (((size_t)l * 16 + e) * 2048 + kt * 128) * 1024 + nt * 128; d.lds_ = 1024;
        d.dst = (bf16_t*)(p.ws + WS_WGU) + (((size_t)l * 16 + e) * 2048 + nt * 256 + isup * 128) * 2048 + kt * 128; d.ldd = 2048; return true; }
    r -= 4096;
    { const int e = r / 128, kt = (r % 128) / 16, nt = r % 16;
        d.src = p.in[18] + (((size_t)l * 16 + e) * 1024 + kt * 128) * 2048 + nt * 128; d.lds_ = 2048;
        d.dst = (bf16_t*)(p.ws + WS_WD) + (((size_t)l * 16 + e) * 2048 + nt * 128) * 1024 + kt * 128; d.ldd = 1024; return true; }
}
__device__ __forceinline__ void ph_weights(const Params& p, LAS unsigned char* lds, const int p0, const int p1, const int wi, const int wn) {
    const int tid = opaque_tid();
    LAS unsigned* l32 = (LAS unsigned*)lds;
    LAS bf16_t* l16 = (LAS bf16_t*)lds;
    TDesc dA0, dA1, dB0, dB1; f32x4 a0[8], a1[8], b0[8], b1[8];
#define PW_LOAD(pi, D0, D1, V0, V1, HAVE) do { HAVE = (pi) < p1; if (HAVE) { tdecode(p, 2 * (pi), D0); tdecode(p, 2 * (pi) + 1, D1); \
        _Pragma("unroll") for (int i = 0; i < 8; ++i) { const int f = tid + 512 * i, k = f >> 5, c4 = f & 31; \
            V0[i] = __builtin_nontemporal_load((const f32x4*)(D0.src + (size_t)k * D0.lds_ + c4 * 4)); V1[i] = __builtin_nontemporal_load((const f32x4*)(D1.src + (size_t)k * D1.lds_ + c4 * 4)); } } } while (0)
#define PW_TOLDS(D0, V0, V1) do { _Pragma("unroll") for (int i = 0; i < 8; ++i) { const int f = tid + 512 * i, k = f >> 5, c4 = f & 31; const float sc = D0.ksc ? D0.ksc[k] : 1.f; \
        const int sw = ((k >> 3) & 15) * 2; u32x2 w; w.x = pk2(V0[i][0] * sc, V0[i][1] * sc); w.y = pk2(V0[i][2] * sc, V0[i][3] * sc); \
        *(LAS u32x2*)(l32 + k * 64 + ((2 * c4) ^ sw)) = w; \
        u32x2 w2; w2.x = pk2(V1[i][0] * sc, V1[i][1] * sc); w2.y = pk2(V1[i][2] * sc, V1[i][3] * sc); \
        *(LAS u32x2*)(l32 + 8192 + k * 64 + ((2 * c4) ^ sw)) = w2; } } while (0)
#define PW_STORE(DS0, DS1) do { _Pragma("unroll") for (int i = 0; i < 4; ++i) { \
        const int n = (tid >> 4) + 32 * i, kc = tid & 15, cd = (n >> 1) ^ (2 * kc), hf = n & 1; \
        unsigned short e[8], g[8]; \
        _Pragma("unroll") for (int q = 0; q < 8; ++q) { e[q] = l16[((8 * kc + q) * 64 + cd) * 2 + hf]; g[q] = l16[16384 + ((8 * kc + q) * 64 + cd) * 2 + hf]; } \
        u32x4 w; w.x = e[0] | ((unsigned)e[1] << 16); w.y = e[2] | ((unsigned)e[3] << 16); w.z = e[4] | ((unsigned)e[5] << 16); w.w = e[6] | ((unsigned)e[7] << 16); \
        __builtin_nontemporal_store(w, (u32x4*)(DS0.dst + (size_t)n * DS0.ldd + 8 * kc)); \
        u32x4 w2; w2.x = g[0] | ((unsigned)g[1] << 16); w2.y = g[2] | ((unsigned)g[3] << 16); w2.z = g[4] | ((unsigned)g[5] << 16); w2.w = g[6] | ((unsigned)g[7] << 16); \
        __builtin_nontemporal_store(w2, (u32x4*)(DS1.dst + (size_t)n * DS1.ldd + 8 * kc)); } } while (0)
    int pi = p0 + wi; bool hA, hB;
    PW_LOAD(pi, dA0, dA1, a0, a1, hA);
    PW_LOAD(pi + wn, dB0, dB1, b0, b1, hB);
    while (hA) {
        { PW_TOLDS(dA0, a0, a1); __syncthreads(); const TDesc s0 = dA0, s1 = dA1; PW_LOAD(pi + 2 * wn, dA0, dA1, a0, a1, hA); PW_STORE(s0, s1); __syncthreads(); }
        if (!hB) break;
        { PW_TOLDS(dB0, b0, b1); __syncthreads(); const TDesc s0 = dB0, s1 = dB1; PW_LOAD(pi + 3 * wn, dB0, dB1, b0, b1, hB); PW_STORE(s0, s1); __syncthreads(); }
        pi += 2 * wn;
    }
#undef PW_LOAD
#undef PW_TOLDS
#undef PW_STORE
}

__device__ __forceinline__ void ph_norm1(const Params& p, int mode) {
    const int tid = opaque_tid(), lane = tid & 63, wv = tid >> 6;
    const float* mod = (const float*)(p.ws + WS_MOD);
    const int* slot_of = (const int*)(p.ws + WS_IDX + 131072);
    const bf16_t* EO = (const bf16_t*)(p.ws + WS_EO);
    for (int t = blockIdx.x * 8 + wv; t < NT; t += gridDim.x * 8) {
        const int b = t >> 11;
        f32x4 v[8];
        if (mode == 0) { const float* xr = p.in[0] + (size_t)t * DM;
#pragma unroll
            for (int j = 0; j < 8; ++j) v[j] = *(const f32x4*)(xr + 4 * lane + 256 * j);
        } else { const bf16_t* xr = (const bf16_t*)(p.ws + WS_X2) + (size_t)t * DM;
#pragma unroll
            for (int j = 0; j < 8; ++j) { const u32x2 w = *(const u32x2*)(xr + 4 * lane + 256 * j); v[j] = (f32x4){bflo(w.x), bfhi(w.x), bflo(w.y), bfhi(w.y)}; }
        }
        if (mode != 0) {
            f32x4 macc[8];
#pragma unroll
            for (int j = 0; j < 8; ++j) macc[j] = (f32x4){0.f, 0.f, 0.f, 0.f};
            const int myslot = slot_of[(size_t)(lane & 15) * NT + t];
            unsigned m = (unsigned)(__ballot(myslot >= 0) & 0xffffull);
            while (m) {
                const int e0 = __builtin_ctz(m); m &= m - 1u;
                const bool two = m != 0u; const int e1 = two ? __builtin_ctz(m) : e0; if (two) m &= m - 1u;
                const int s0 = __builtin_amdgcn_readlane(myslot, e0), s1 = __builtin_amdgcn_readlane(myslot, e1);
                const float w1 = two ? 1.f : 0.f;
                const bf16_t* r0 = EO + (size_t)s0 * DM; const bf16_t* r1 = EO + (size_t)s1 * DM;
                u32x2 a[8], c[8];
#pragma unroll
                for (int j = 0; j < 8; ++j) { a[j] = *(const u32x2*)(r0 + 4 * lane + 256 * j); c[j] = *(const u32x2*)(r1 + 4 * lane + 256 * j); }
#pragma unroll
                for (int j = 0; j < 8; ++j) {
                    macc[j][0] += bflo(a[j].x) + w1 * bflo(c[j].x); macc[j][1] += bfhi(a[j].x) + w1 * bfhi(c[j].x);
                    macc[j][2] += bflo(a[j].y) + w1 * bflo(c[j].y); macc[j][3] += bfhi(a[j].y) + w1 * bfhi(c[j].y); }
            }
            const float* gf = mod + ((size_t)(mode - 1) * 4 + b) * 12288 + 5 * 2048;
#pragma unroll
            for (int j = 0; j < 8; ++j) { const f32x4 g = *(const f32x4*)(gf + 4 * lane + 256 * j); v[j] = v[j] + g * macc[j]; }
            if (mode == 1) {
                bf16_t* xo = (bf16_t*)(p.ws + WS_X) + (size_t)t * DM;
#pragma unroll
                for (int j = 0; j < 8; ++j) { u32x2 w; w.x = pk2(v[j][0], v[j][1]); w.y = pk2(v[j][2], v[j][3]); *(u32x2*)(xo + 4 * lane + 256 * j) = w;
                    v[j] = (f32x4){bflo(w.x), bfhi(w.x), bflo(w.y), bfhi(w.y)}; }
            }
        }
        float ss = 0.f;
#pragma unroll
        for (int j = 0; j < 8; ++j) ss += v[j][0] * v[j][0] + v[j][1] * v[j][1] + v[j][2] * v[j][2] + v[j][3] * v[j][3];
        const float r = 1.0f / sqrtf(wave_sum(ss) * (1.f / DM) + EPS);
        if (mode == 2) {
            float* o = p.out + (size_t)t * DM;
#pragma unroll
            for (int j = 0; j < 8; ++j) { const f32x4 g = *(const f32x4*)(p.in[19] + 4 * lane + 256 * j); *(f32x4*)(o + 4 * lane + 256 * j) = v[j] * r * g; }
        } else {
            const int l = mode;
            const float* g1 = p.in[5] + (size_t)l * DM;
            const float* sh = mod + ((size_t)l * 4 + b) * 12288;
            const float* sc = sh + 2048;
            bf16_t* ho = (bf16_t*)(p.ws + WS_H) + (size_t)t * DM;
#pragma unroll
            for (int j = 0; j < 8; ++j) {
                const f32x4 g = *(const f32x4*)(g1 + 4 * lane + 256 * j), s1 = *(const f32x4*)(sc + 4 * lane + 256 * j), s0 = *(const f32x4*)(sh + 4 * lane + 256 * j);
                const f32x4 h = (v[j] * r * g) * (s1 + 1.f) + s0;
                u32x2 w; w.x = pk2(h[0], h[1]); w.y = pk2(h[2], h[3]);
                *(u32x2*)(ho + 4 * lane + 256 * j) = w;
            }
        }
    }
}


__device__ __forceinline__ void ph_norm2_router_mfma(const Params& p, int l, LAS unsigned char* lds) {
    const int tid = opaque_tid(), lane = tid & 63, wv = tid >> 6, r = lane & 31, h = lane >> 5;
    LAS float* part = (LAS float*)lds;
    LAS float* lgs = (LAS float*)(lds + 8 * 32 * 17 * 4);
    const float* mod = (const float*)(p.ws + WS_MOD);
    const float* g2 = p.in[14] + (size_t)l * DM;
    const bf16_t* WRT = (const bf16_t*)(p.ws + WS_WRT) + (size_t)l * 16 * 2048;
    bf16_t* Hb = (bf16_t*)(p.ws + WS_H);
    float* aff = (float*)(p.ws + WS_AFF);
    for (int blk = blockIdx.x; blk < NT / 32; blk += gridDim.x) {
        const int t0 = blk * 32, b = t0 >> 11;
        const float* sh = mod + ((size_t)l * 4 + b) * 12288 + 3 * 2048;
        const float* sc = sh + 2048;
        {
            const int ta = t0 + 4 * wv;
            const bf16_t* xa = (const bf16_t*)(p.ws + WS_X2) + (size_t)ta * DM;
            u32x2 xw[4][8];
#pragma unroll
            for (int q = 0; q < 4; ++q)
#pragma unroll
                for (int j = 0; j < 8; ++j) xw[q][j] = *(const u32x2*)(xa + (size_t)q * DM + 4 * lane + 256 * j);
            float sq[4] = {0.f, 0.f, 0.f, 0.f};
#pragma unroll
            for (int q = 0; q < 4; ++q)
#pragma unroll
                for (int j = 0; j < 8; ++j) { const float x0 = bflo(xw[q][j].x), x1 = bfhi(xw[q][j].x), x2 = bflo(xw[q][j].y), x3 = bfhi(xw[q][j].y); sq[q] += x0 * x0 + x1 * x1 + x2 * x2 + x3 * x3; }
#pragma unroll
            for (int o = 1; o < 64; o <<= 1)
#pragma unroll
                for (int q = 0; q < 4; ++q) sq[q] += __shfl_xor(sq[q], o);
            float rq[4];
#pragma unroll
            for (int q = 0; q < 4; ++q) rq[q] = 1.0f / sqrtf(sq[q] * (1.f / DM) + EPS);
            bf16_t* ho = Hb + (size_t)ta * DM;
#pragma unroll
            for (int j = 0; j < 8; ++j) {
                const f32x4 g = *(const f32x4*)(g2 + 4 * lane + 256 * j), s1 = *(const f32x4*)(sc + 4 * lane + 256 * j), s0 = *(const f32x4*)(sh + 4 * lane + 256 * j);
                const f32x4 gg = g * (s1 + 1.f);
#pragma unroll
                for (int q = 0; q < 4; ++q) {
                    const f32x4 x = (f32x4){bflo(xw[q][j].x), bfhi(xw[q][j].x), bflo(xw[q][j].y), bfhi(xw[q][j].y)};
                    const f32x4 hq = (x * rq[q]) * gg + s0;
                    u32x2 w; w.x = pk2(hq[0], hq[1]); w.y = pk2(hq[2], hq[3]);
                    *(u32x2*)(ho + (size_t)q * DM + 4 * lane + 256 * j) = w;
                }
            }
        }
        asm volatile("s_waitcnt vmcnt(0)" ::: "memory");
        __syncthreads();
        {
            f32x16 acc;
#pragma unroll
            for (int q = 0; q < 16; ++q) acc[q] = 0.f;
            const bf16_t* bp = Hb + (size_t)(t0 + r) * DM + 256 * wv + 8 * h;
            const bf16_t* ap = WRT + (size_t)(r & 15) * 2048 + 256 * wv + 8 * h;
            bf16x8 bfr[16], afr[16];
#pragma unroll
            for (int s = 0; s < 16; ++s) { bfr[s] = *(const bf16x8*)(bp + 16 * s); afr[s] = *(const bf16x8*)(ap + 16 * s); }
#pragma unroll
            for (int s = 0; s < 16; ++s) { const bf16x8 a = (r < 16) ? afr[s] : (bf16x8){0, 0, 0, 0, 0, 0, 0, 0}; acc = __builtin_amdgcn_mfma_f32_32x32x16_bf16(a, bfr[s], acc, 0, 0, 0); }
#pragma unroll
            for (int q = 0; q < 8; ++q) { const int e = (q & 3) + 8 * (q >> 2) + 4 * h; part[(wv * 32 + r) * 17 + e] = acc[q]; }
        }
        __syncthreads();
        const int e = tid >> 5, tk = tid & 31;
        { float s = 0.f;
#pragma unroll
          for (int w = 0; w < 8; ++w) s += part[(w * 32 + tk) * 17 + e];
          lgs[e * 32 + tk] = s; }
        __syncthreads();
        { float lg[16]; float mx = -1e30f;
#pragma unroll
          for (int q = 0; q < 16; ++q) { lg[q] = lgs[q * 32 + tk]; mx = fmaxf(mx, lg[q]); }
          float den = 0.f, mine = 0.f;
#pragma unroll
          for (int q = 0; q < 16; ++q) { const float ex = expf(lg[q] - mx); den += ex; mine = (q == e) ? ex : mine; }
          aff[((size_t)b * 16 + e) * 2048 + (t0 & 2047) + tk] = mine / den; }
        __syncthreads();
    }
}

__device__ __forceinline__ unsigned block_excl_scan(unsigned cnt, LAS unsigned* wsum, int tid) {
    const int lane = tid & 63, wv = tid >> 6;
    unsigned inc = cnt;
#pragma unroll
    for (int o = 1; o < 64; o <<= 1) { const unsigned t = __shfl_up(inc, o); if (lane >= o) inc += t; }
    if (lane == 63) wsum[wv] = inc;
    __syncthreads();
    unsigned base = 0;
#pragma unroll
    for (int w = 0; w < 8; ++w) base += (w < wv) ? wsum[w] : 0u;
    __syncthreads();
    return base + inc - cnt;
}
__device__ __forceinline__ void ph_topk(const Params& p, LAS unsigned char* lds) {
    const int tid = opaque_tid();
    LAS unsigned* hist = (LAS unsigned*)lds;
    LAS unsigned* misc = hist + 256;
    LAS unsigned* wsum = hist + 320;
    const float* aff = (const float*)(p.ws + WS_AFF);
    int* idx = (int*)(p.ws + WS_IDX); float* gate = (float*)(p.ws + WS_IDX + 65536); int* slot_of = (int*)(p.ws + WS_IDX + 131072);
    for (int u = blockIdx.x; u < 64; u += gridDim.x) {
        const int b = u >> 4, e = u & 15;
        const f32x4 a = *(const f32x4*)(aff + (size_t)u * 2048 + 4 * tid);
        unsigned k[4];
#pragma unroll
        for (int i = 0; i < 4; ++i) k[i] = __float_as_uint(a[i]);
        unsigned prefix = 0, krem = CAP;
#pragma unroll 1
        for (int pass = 0; pass < 4; ++pass) {
            const int shift = 24 - 8 * pass;
            if (tid < 256) hist[tid] = 0;
            __syncthreads();
#pragma unroll
            for (int i = 0; i < 4; ++i) if (pass == 0 || (k[i] >> (shift + 8)) == prefix) __hip_atomic_fetch_add(&hist[(k[i] >> shift) & 255u], 1u, __ATOMIC_RELAXED, __HIP_MEMORY_SCOPE_WORKGROUP);
            __syncthreads();
            { const unsigned cnt = (tid < 256) ? hist[255 - tid] : 0u;
              const unsigned Sn = block_excl_scan(cnt, wsum, tid), S = Sn + cnt;
              if (tid < 256 && S >= krem && Sn < krem) { misc[0] = (prefix << 8) | (unsigned)(255 - tid); misc[1] = krem - Sn; } }
            __syncthreads();
            prefix = misc[0]; krem = misc[1];
            __syncthreads();
        }
        unsigned neq = 0;
#pragma unroll
        for (int i = 0; i < 4; ++i) neq += (k[i] == prefix) ? 1u : 0u;
        unsigned eqbase = block_excl_scan(neq, wsum, tid);
        unsigned sel[4]; unsigned nsel = 0;
#pragma unroll
        for (int i = 0; i < 4; ++i) { const bool eq = k[i] == prefix; sel[i] = (k[i] > prefix || (eq && eqbase < krem)) ? 1u : 0u; eqbase += eq ? 1u : 0u; nsel += sel[i]; }
        unsigned sb = block_excl_scan(nsel, wsum, tid);
#pragma unroll
        for (int i = 0; i < 4; ++i) {
            const int s = 4 * tid + i, t = b * 2048 + s;
            if (sel[i]) { const int row = e * 1024 + b * 256 + (int)sb; idx[row] = t; gate[row] = a[i]; slot_of[(size_t)e * NT + t] = row; ++sb; }
            else slot_of[(size_t)e * NT + t] = -1;
        }
        __syncthreads();
    }
}

__device__ __forceinline__ bf16x8 pack8(float a0, float a1, float a2, float a3, float a4, float a5, float a6, float a7) {
    u32x4 p;
    asm volatile("v_cvt_pk_bf16_f32 %0, %4, %5\n\tv_cvt_pk_bf16_f32 %1, %6, %7\n\tv_cvt_pk_bf16_f32 %2, %8, %9\n\tv_cvt_pk_bf16_f32 %3, %10, %11\n\ts_nop 1"
                 : "=&v"(p[0]), "=&v"(p[1]), "=&v"(p[2]), "=&v"(p[3]) : "v"(a0), "v"(a1), "v"(a2), "v"(a3), "v"(a4), "v"(a5), "v"(a6), "v"(a7));
    return __builtin_bit_cast(bf16x8, p);
}
template <int CH>
__device__ __forceinline__ void attn_prefetch(const bf16_t* qp, const bf16_t* kb, const size_t kst, const int lk0, const int ls, const int r, bf16x8 (&qf)[4], bf16x8 (&kf0)[CH][4]) {
#pragma unroll
    for (int s = 0; s < 4; ++s) qf[s] = *(const bf16x8*)(qp + 16 * s);
#pragma unroll
    for (int i = 0; i < CH; ++i) {
        int lkr = lk0 + 32 * i + r; lkr = lkr < 0 ? 0 : (lkr >= ls ? ls - 1 : lkr);
        const bf16_t* kp = kb + (size_t)lkr * kst;
#pragma unroll
        for (int s = 0; s < 4; ++s) kf0[i][s] = *(const bf16x8*)(kp + 16 * s);
    }
}
template <int NTILES, int CH, bool SYNC = true, bool KLDS = false>
__device__ __forceinline__ void attn_wave(const bf16x8 (&qf)[4], const bf16x8 (&kf0)[CH][4], const bf16_t* kb, const size_t kst, const int lk0, const int ls, const LAS bf16_t* vt, const int vts,
                                          float m_run, float l_run, f32x16& O0, f32x16& O1, float& m_out, float& l_out, const int r, const int h, const LAS bf16_t* kl = nullptr, const int kls = 0) {
#pragma unroll
    for (int i = 0; i < 16; ++i) { O0[i] = 0.f; O1[i] = 0.f; }
#pragma unroll
    for (int c0 = 0; c0 < NTILES; c0 += CH) {
        constexpr int dummy = 0; (void)dummy;
        f32x16 S[CH];
#pragma unroll
        for (int ii = 0; ii < CH; ++ii) {
            const int i = c0 + ii;
            if (i < NTILES) {
                int lkr = lk0 + 32 * i + r; lkr = lkr < 0 ? 0 : (lkr >= ls ? ls - 1 : lkr);
                const bf16_t* kp = kb + (size_t)lkr * kst;
                f32x16 a;
#pragma unroll
                for (int q = 0; q < 16; ++q) a[q] = 0.f;
#pragma unroll
                for (int s = 0; s < 4; ++s) {
                    bf16x8 kf;
                    if constexpr (KLDS) kf = *(const LAS bf16x8*)(kl + i * 32 * kls + 16 * s);
                    else { if (c0 == 0) kf = kf0[ii][s]; else kf = *(const bf16x8*)(kp + 16 * s); }
                    a = __builtin_amdgcn_mfma_f32_32x32x16_bf16(kf, qf[s], a, 0, 0, 0);
                }
                S[ii] = a;
            }
        }
        float mx = m_run;
#pragma unroll
        for (int ii = 0; ii < CH; ++ii) {
            const int i = c0 + ii;
            if (i < NTILES) {
                const bool edge = (lk0 + 32 * i < 0) || (lk0 + 32 * i + 32 > ls);
                if (edge || i == 0 || i == NTILES - 1) {
#pragma unroll
                    for (int q = 0; q < 16; ++q) {
                        const int row = (q & 3) + 8 * (q >> 2) + 4 * h;
                        const int lk = lk0 + 32 * i + row;
                        bool valid = (lk >= 0) && (lk < ls);
                        if (i == 0) valid = valid && (row >= r);
                        if (i == NTILES - 1) valid = valid && (row <= r);
                        const float sv = valid ? S[ii][q] : -1e30f;
                        S[ii][q] = sv;
                        mx = fmaxf(mx, sv);
                    }
                } else {
#pragma unroll
                    for (int q = 0; q < 16; ++q) mx = fmaxf(mx, S[ii][q]);
                }
            }
        }
        mx = fmaxf(mx, __shfl_xor(mx, 32));
        const float corr = __builtin_amdgcn_exp2f((m_run - mx) * 1.442695041f);
        float psum = 0.f;
#pragma unroll
        for (int ii = 0; ii < CH; ++ii) {
            const int i = c0 + ii;
            if (i < NTILES) {
#pragma unroll
                for (int q = 0; q < 16; ++q) { const float pv = __builtin_amdgcn_exp2f((S[ii][q] - mx) * 1.442695041f); S[ii][q] = pv; psum += pv; }
            }
        }
        psum += __shfl_xor(psum, 32);
        l_run = l_run * corr + psum;
        m_run = mx;
        if (c0 > 0) {
#pragma unroll
            for (int q = 0; q < 16; ++q) { O0[q] *= corr; O1[q] *= corr; }
        } else { if (SYNC) __syncthreads(); }
#pragma unroll
        for (int ii = 0; ii < CH; ++ii) {
            const int i = c0 + ii;
            if (i < NTILES) {
#pragma unroll
                for (int sp = 0; sp < 2; ++sp) {
                    const bf16x8 pf = pack8(S[ii][8 * sp + 0], S[ii][8 * sp + 1], S[ii][8 * sp + 2], S[ii][8 * sp + 3], S[ii][8 * sp + 4], S[ii][8 * sp + 5], S[ii][8 * sp + 6], S[ii][8 * sp + 7]);
                    const LAS bf16_t* v0 = vt + 32 * i + 16 * sp;
                    { const u32x2 a0 = *(const LAS u32x2*)(v0), a1 = *(const LAS u32x2*)(v0 + 8);
                      const u32x4 vw = (u32x4){a0.x, a0.y, a1.x, a1.y};
                      O0 = __builtin_amdgcn_mfma_f32_32x32x16_bf16(__builtin_bit_cast(bf16x8, vw), pf, O0, 0, 0, 0); }
                    { const u32x2 a0 = *(const LAS u32x2*)(v0 + 32 * vts), a1 = *(const LAS u32x2*)(v0 + 32 * vts + 8);
                      const u32x4 vw = (u32x4){a0.x, a0.y, a1.x, a1.y};
                      O1 = __builtin_amdgcn_mfma_f32_32x32x16_bf16(__builtin_bit_cast(bf16x8, vw), pf, O1, 0, 0, 0); }
                }
            }
        }
    }
    m_out = m_run; l_out = l_run;
}
__device__ __forceinline__ void ph_mixers(const Params& p, const int l, LAS unsigned char* lds) {
    constexpr int VTS = 260, VTSS = 292, KSTR = 72, ARENA = 78848, KOFF = 37376;
    const int hw = (opaque_tid() >> 8) & 1;
    const bf16_t* PROJ = (const bf16_t*)(p.ws + WS_PROJ);
    int ufirst, ucount, ustep;
    if (gridDim.x == 256) { if (blockIdx.x < 128) { ufirst = blockIdx.x * 2; ucount = 2; } else { ufirst = 256 + (blockIdx.x - 128) * 4; ucount = 4; } ustep = 1; }
    else { ufirst = blockIdx.x; ustep = gridDim.x; ucount = (768 - (int)blockIdx.x + (int)gridDim.x - 1) / (int)gridDim.x; }
    const int nsw = (256 - (int)blockIdx.x + (int)gridDim.x - 1) / (int)gridDim.x;
    const int ngm = (int)blockIdx.x < 128 ? (128 - (int)blockIdx.x + (int)gridDim.x - 1) / (int)gridDim.x : 0;
    const int nitems = ngm + nsw + ucount;
    constexpr int VTSG = 136;
    const bf16_t* SW = (const bf16_t*)(p.ws + WS_SGUW) + (size_t)l * 8 * 128 * 128;
    bf16x8 qf[4]; bf16x8 kdummy[5][4];
    for (int k = 0; k <= 2 * nitems; ++k) {
        const int tid = opaque_tid(), lane = tid & 63, w4 = (tid >> 6) & 3, tl = tid & 255, r = lane & 31, h = lane >> 5;
        LAS bf16_t* Vt = (LAS bf16_t*)(lds + hw * ARENA);
        LAS unsigned* Vt32 = (LAS unsigned*)Vt;
        LAS bf16_t* Ks = (LAS bf16_t*)(lds + hw * ARENA + KOFF);
        const int kk = k - hw, it0 = kk >> 1;
        if (kk >= 0 && it0 < nitems) {
            if (it0 < ngm) {
                const int u = blockIdx.x + it0 * gridDim.x;
                const int hg = u & 1, t0 = (u >> 1) * 128, hh2 = w4 >> 1, ph = w4 & 1, habs = hg * 4 + 2 * hw + hh2;
                if (!(kk & 1)) {
                    const int kp = tl & 63, ta = t0 + 2 * kp;
                    const float* vs = (const float*)(p.ws + WS_VSS) + (size_t)ta * 8;
                    const f32x4 sa0 = *(const f32x4*)vs, sa1 = *(const f32x4*)(vs + 4), sb0 = *(const f32x4*)(vs + 8), sb1 = *(const f32x4*)(vs + 12);
                    u32x4 va[4], vb[4]; f32x4 g0[4], g1[4];
                    const float* sn = p.in[8] + (size_t)l * 512 + hg * 256 + hw * 128;
#pragma unroll
                    for (int i = 0; i < 4; ++i) { const int dc = (tl >> 6) + 4 * i;
                        const bf16_t* src = PROJ + (size_t)ta * NPROJ + PC_V + hg * 256 + hw * 128 + 8 * dc;
                        va[i] = *(const u32x4*)src; vb[i] = *(const u32x4*)(src + NPROJ);
                        g0[i] = *(const f32x4*)(sn + 8 * dc); g1[i] = *(const f32x4*)(sn + 8 * dc + 4); }
                    const float ra = 1.0f / sqrtf((((sa0[0] + sa0[1]) + (sa0[2] + sa0[3])) + ((sa1[0] + sa1[1]) + (sa1[2] + sa1[3]))) * (1.f / 512.f) + EPS);
                    const float rb = 1.0f / sqrtf((((sb0[0] + sb0[1]) + (sb0[2] + sb0[3])) + ((sb1[0] + sb1[1]) + (sb1[2] + sb1[3]))) * (1.f / 512.f) + EPS);
#pragma unroll
                    for (int i = 0; i < 4; ++i) { const int dc = (tl >> 6) + 4 * i;
                        LAS unsigned* o = Vt32 + (8 * dc) * (VTSG / 2) + kp;
                        o[0 * (VTSG / 2)] = pk2(bflo(va[i].x) * ra * g0[i][0], bflo(vb[i].x) * rb * g0[i][0]); o[1 * (VTSG / 2)] = pk2(bfhi(va[i].x) * ra * g0[i][1], bfhi(vb[i].x) * rb * g0[i][1]);
                        o[2 * (VTSG / 2)] = pk2(bflo(va[i].y) * ra * g0[i][2], bflo(vb[i].y) * rb * g0[i][2]); o[3 * (VTSG / 2)] = pk2(bfhi(va[i].y) * ra * g0[i][3], bfhi(vb[i].y) * rb * g0[i][3]);
                        o[4 * (VTSG / 2)] = pk2(bflo(va[i].z) * ra * g1[i][0], bflo(vb[i].z) * rb * g1[i][0]); o[5 * (VTSG / 2)] = pk2(bfhi(va[i].z) * ra * g1[i][1], bfhi(vb[i].z) * rb * g1[i][1]);
                        o[6 * (VTSG / 2)] = pk2(bflo(va[i].w) * ra * g1[i][2], bflo(vb[i].w) * rb * g1[i][2]); o[7 * (VTSG / 2)] = pk2(bfhi(va[i].w) * ra * g1[i][3], bfhi(vb[i].w) * rb * g1[i][3]); }
                } else {
                    f32x16 acc[2][2];
#pragma unroll
                    for (int ct = 0; ct < 2; ++ct)
#pragma unroll
                        for (int pt = 0; pt < 2; ++pt)
#pragma unroll
                            for (int q = 0; q < 16; ++q) acc[ct][pt][q] = 0.f;
                    const LAS bf16_t* ap = Vt + (hh2 * 64 + r) * VTSG + 8 * h;
                    const bf16_t* wp = SW + ((size_t)habs * 128 + 64 * ph + r) * 128 + 8 * h;
#pragma unroll
                    for (int s2 = 0; s2 < 8; ++s2) {
                        bf16x8 afr[2], bfr[2];
#pragma unroll
                        for (int pt = 0; pt < 2; ++pt) bfr[pt] = *(const bf16x8*)(wp + (size_t)pt * 32 * 128 + 16 * s2);
#pragma unroll
                        for (int ct = 0; ct < 2; ++ct) afr[ct] = *(const LAS bf16x8*)(ap + ct * 32 * VTSG + 16 * s2);
#pragma unroll
                        for (int ct = 0; ct < 2; ++ct)
#pragma unroll
                            for (int pt = 0; pt < 2; ++pt) acc[ct][pt] = __builtin_amdgcn_mfma_f32_32x32x16_bf16(afr[ct], bfr[pt], acc[ct][pt], 0, 0, 0);
                    }
                    bf16_t* YB = (bf16_t*)(p.ws + WS_YB);
#pragma unroll
                    for (int pt = 0; pt < 2; ++pt) {
                        const int pp = 64 * ph + 32 * pt + r;
                        const float bias = p.in[10][((size_t)l * 8 + habs) * 128 + pp];
                        const bf16_t* us = PROJ + (size_t)(t0 + pp) * NPROJ + PC_U + habs * 64 + 4 * h;
                        bf16_t* o = YB + (size_t)(t0 + pp) * 512 + habs * 64 + 4 * h;
#pragma unroll
                        for (int ct = 0; ct < 2; ++ct)
#pragma unroll
                            for (int gg = 0; gg < 4; ++gg) {
                                const u32x2 uw = *(const u32x2*)(us + 32 * ct + 8 * gg);
                                u32x2 w; w.x = pk2(bflo(uw.x) * (acc[ct][pt][4 * gg] + bias), bfhi(uw.x) * (acc[ct][pt][4 * gg + 1] + bias));
                                w.y = pk2(bflo(uw.y) * (acc[ct][pt][4 * gg + 2] + bias), bfhi(uw.y) * (acc[ct][pt][4 * gg + 3] + bias));
                                *(u32x2*)(o + 32 * ct + 8 * gg) = w;
                            }
                    }
                }
            } else if (it0 < ngm + nsw) {
                const int it = it0 - ngm;
                const int u = blockIdx.x + it * gridDim.x;
                const int b = u >> 6, kvh = (u >> 5) & 1, q0 = (u & 31) * 64 + 32 * hw;
                const bf16_t* base = PROJ + (size_t)b * SEQ * NPROJ;
                const int head = kvh * 4 + w4, qpos = q0 + r, lk0 = q0 - 128;
                if (!(kk & 1)) {
                    u32x4 va[5], vb[5], kc[9];
#pragma unroll
                    for (int i = 0; i < 5; ++i) {
                        const int task = tl + 256 * i;
                        if (task < 1152) { const int kp = task % 144, dc = task / 144;
                            int kA = lk0 + 2 * kp; kA = kA < 0 ? 0 : (kA > SEQ - 2 ? SEQ - 2 : kA);
                            va[i] = *(const u32x4*)(base + (size_t)kA * NPROJ + PC_VC + kvh * 64 + 8 * dc);
                            vb[i] = *(const u32x4*)(base + (size_t)(kA + 1) * NPROJ + PC_VC + kvh * 64 + 8 * dc); }
                    }
#pragma unroll
                    for (int i = 0; i < 9; ++i) { const int id = tl + 256 * i, j = id >> 3, c8 = id & 7;
                        int kp2 = lk0 + j; kp2 = kp2 < 0 ? 0 : (kp2 >= SEQ ? SEQ - 1 : kp2);
                        kc[i] = *(const u32x4*)(base + (size_t)kp2 * NPROJ + PC_KC + kvh * 64 + 8 * c8); }
                    { const bf16_t* qp = base + (size_t)qpos * NPROJ + PC_QC + head * 64 + 8 * h;
#pragma unroll
                      for (int s2 = 0; s2 < 4; ++s2) qf[s2] = *(const bf16x8*)(qp + 16 * s2); }
#pragma unroll
                    for (int i = 0; i < 5; ++i) {
                        const int task = tl + 256 * i;
                        if (task < 1152) { const int kp = task % 144, dc = task / 144;
                            LAS unsigned* o = Vt32 + (8 * dc) * (VTSS / 2) + kp;
                            o[0 * (VTSS / 2)] = (va[i].x & 0xffffu) | (vb[i].x << 16); o[1 * (VTSS / 2)] = (va[i].x >> 16) | (vb[i].x & 0xffff0000u);
                            o[2 * (VTSS / 2)] = (va[i].y & 0xffffu) | (vb[i].y << 16); o[3 * (VTSS / 2)] = (va[i].y >> 16) | (vb[i].y & 0xffff0000u);
                            o[4 * (VTSS / 2)] = (va[i].z & 0xffffu) | (vb[i].z << 16); o[5 * (VTSS / 2)] = (va[i].z >> 16) | (vb[i].z & 0xffff0000u);
                            o[6 * (VTSS / 2)] = (va[i].w & 0xffffu) | (vb[i].w << 16); o[7 * (VTSS / 2)] = (va[i].w >> 16) | (vb[i].w & 0xffff0000u); }
                    }
#pragma unroll
                    for (int i = 0; i < 9; ++i) { const int id = tl + 256 * i, j = id >> 3, c8 = id & 7; *(LAS u32x4*)(Ks + j * KSTR + 8 * c8) = kc[i]; }
                } else {
                    const LAS bf16_t* vt = Vt + r * VTSS + 4 * h;
                    const LAS bf16_t* kl = Ks + r * KSTR + 8 * h;
                    f32x16 O0, O1; float m, lsum;
                    attn_wave<9, 5, false, true>(qf, kdummy, nullptr, (size_t)NPROJ, lk0, SEQ, vt, VTSS, p.in[11][l * 8 + head], 1.f, O0, O1, m, lsum, r, h, kl, KSTR);
                    const float inv = 1.f / lsum;
                    bf16_t* o = (bf16_t*)(p.ws + WS_YC) + ((size_t)b * SEQ + qpos) * 512 + head * 64 + 4 * h;
#pragma unroll
                    for (int gg = 0; gg < 4; ++gg) {
                        u32x2 w0; w0.x = pk2(O0[4 * gg] * inv, O0[4 * gg + 1] * inv); w0.y = pk2(O0[4 * gg + 2] * inv, O0[4 * gg + 3] * inv);
                        u32x2 w1; w1.x = pk2(O1[4 * gg] * inv, O1[4 * gg + 1] * inv); w1.y = pk2(O1[4 * gg + 2] * inv, O1[4 * gg + 3] * inv);
                        *(u32x2*)(o + 8 * gg) = w0; *(u32x2*)(o + 32 + 8 * gg) = w1;
                    }
                }
            } else {
                const int u = ufirst + (it0 - ngm - nsw) * ustep;
                const int cfg = u >> 8, r8 = u & 255, b = r8 >> 6, head = (r8 >> 3) & 7, blk = (r8 & 7) * 2 + hw;
                const int dsh = 2 * cfg, dil = 1 << dsh, ls = SEQ >> dsh, nblk = ls >> 7;
                const int res = blk / nblk, l0 = (blk % nblk) * 128;
                const bf16_t* base = PROJ + ((size_t)b * SEQ + res) * NPROJ;
                const size_t kst = (size_t)dil * NPROJ;
                const int lq = l0 + 32 * w4 + r;
                const int lk0 = l0 + 32 * w4 - 64;
                if (!(kk & 1)) {
                    u32x4 va[4], vb[4], kc[8];
#pragma unroll
                    for (int i = 0; i < 4; ++i) {
                        const int task = tl + 256 * i, kp = task & 127, dc = task >> 7;
                        int lkA = l0 - 64 + 2 * kp; lkA = lkA < 0 ? 0 : (lkA > ls - 2 ? ls - 2 : lkA);
                        va[i] = *(const u32x4*)(base + (size_t)lkA * kst + PC_VD + head * 64 + 8 * dc);
                        vb[i] = *(const u32x4*)(base + (size_t)(lkA + 1) * kst + PC_VD + head * 64 + 8 * dc);
                    }
#pragma unroll
                    for (int i = 0; i < 8; ++i) {
                        const int id = tl + 256 * i, j = id >> 3, c8 = id & 7;
                        int lk = l0 - 64 + j; lk = lk < 0 ? 0 : (lk >= ls ? ls - 1 : lk);
                        kc[i] = *(const u32x4*)(base + (size_t)lk * kst + PC_KD + head * 64 + 8 * c8);
                    }
                    { const bf16_t* qp = base + (size_t)lq * kst + PC_QD + head * 64 + 8 * h;
#pragma unroll
                      for (int s2 = 0; s2 < 4; ++s2) qf[s2] = *(const bf16x8*)(qp + 16 * s2); }
#pragma unroll
                    for (int i = 0; i < 4; ++i) {
                        const int task = tl + 256 * i, kp = task & 127, dc = task >> 7;
                        LAS unsigned* o = Vt32 + (8 * dc) * (VTS / 2) + kp;
                        o[0 * (VTS / 2)] = (va[i].x & 0xffffu) | (vb[i].x << 16); o[1 * (VTS / 2)] = (va[i].x >> 16) | (vb[i].x & 0xffff0000u);
                        o[2 * (VTS / 2)] = (va[i].y & 0xffffu) | (vb[i].y << 16); o[3 * (VTS / 2)] = (va[i].y >> 16) | (vb[i].y & 0xffff0000u);
                        o[4 * (VTS / 2)] = (va[i].z & 0xffffu) | (vb[i].z << 16); o[5 * (VTS / 2)] = (va[i].z >> 16) | (vb[i].z & 0xffff0000u);
                        o[6 * (VTS / 2)] = (va[i].w & 0xffffu) | (vb[i].w << 16); o[7 * (VTS / 2)] = (va[i].w >> 16) | (vb[i].w & 0xffff0000u);
                    }
#pragma unroll
                    for (int i = 0; i < 8; ++i) { const int id = tl + 256 * i, j = id >> 3, c8 = id & 7; *(LAS u32x4*)(Ks + j * KSTR + 8 * c8) = kc[i]; }
                } else {
                    const LAS bf16_t* vt = Vt + r * VTS + 32 * w4 + 4 * h;
                    const LAS bf16_t* kl = Ks + (32 * w4 + r) * KSTR + 8 * h;
                    f32x16 O0, O1; float m, lsm;
                    attn_wave<5, 5, false, true>(qf, kdummy, nullptr, kst, lk0, ls, vt, VTS, -1e30f, 0.f, O0, O1, m, lsm, r, h, kl, KSTR);
                    const float inv = 1.f / lsm;
                    const size_t tq = (size_t)b * SEQ + (size_t)lq * dil + res;
                    bf16_t* o = (bf16_t*)(p.ws + WS_YD) + ((size_t)cfg * NT + tq) * 512 + head * 64 + 4 * h;
#pragma unroll
                    for (int g = 0; g < 4; ++g) {
                        u32x2 w0; w0.x = pk2(O0[4 * g] * inv, O0[4 * g + 1] * inv); w0.y = pk2(O0[4 * g + 2] * inv, O0[4 * g + 3] * inv);
                        u32x2 w1; w1.x = pk2(O1[4 * g] * inv, O1[4 * g + 1] * inv); w1.y = pk2(O1[4 * g + 2] * inv, O1[4 * g + 3] * inv);
                        *(u32x2*)(o + 8 * g) = w0; *(u32x2*)(o + 32 + 8 * g) = w1;
                    }
                    if (h == 0) ((float*)(p.ws + WS_LSE))[((size_t)cfg * NT + tq) * 8 + head] = m + __logf(lsm);
                }
            }
        }
        __syncthreads();
    }
}

__device__ __forceinline__ void ph_merge(const Params& p, int l, LAS unsigned char* lds) {
    const int tid = opaque_tid(), lane = tid & 63, wv = tid >> 6, r = lane & 31, h2 = lane >> 5;
    LAS float* ssA = (LAS float*)lds;
    const bf16_t* UV = (const bf16_t*)(p.ws + WS_YA); const bf16_t* YB = (const bf16_t*)(p.ws + WS_YB); const bf16_t* YC = (const bf16_t*)(p.ws + WS_YC); const bf16_t* YD = (const bf16_t*)(p.ws + WS_YD);
    const float* LSE = (const float*)(p.ws + WS_LSE); bf16_t* YN = (bf16_t*)(p.ws + WS_YN);
    const bf16_t* ABT = (const bf16_t*)(p.ws + WS_ABT) + ((size_t)l * 8 + wv) * 64 * 128;
    for (int blk = blockIdx.x; blk < NT / 32; blk += gridDim.x) {
        const int t0 = blk * 32, b = t0 >> 11, s0 = t0 & 2047;
        f32x16 O0, O1;
        {
#pragma unroll
            for (int q = 0; q < 16; ++q) { O0[q] = 0.f; O1[q] = 0.f; }
            const size_t row = ((size_t)b * 4096 + 2 * (s0 + r)) * 512 + wv * 64 + 8 * h2;
            u32x4 u0[8], u1[8];
#pragma unroll
            for (int s = 0; s < 8; ++s) { const size_t o = row + (s >> 2) * 512 + 16 * (s & 3); u0[s] = *(const u32x4*)(UV + o); u1[s] = *(const u32x4*)(UV + (size_t)4 * 4096 * 512 + o); }
            bf16x8 af0[8], af1[8];
#pragma unroll
            for (int s = 0; s < 8; ++s) { af0[s] = *(const bf16x8*)(ABT + (size_t)r * 128 + 16 * s + 8 * h2); af1[s] = *(const bf16x8*)(ABT + (size_t)(32 + r) * 128 + 16 * s + 8 * h2); }
#pragma unroll
            for (int s = 0; s < 8; ++s) {
                const bf16x8 bfr = pack8(bflo(u0[s].x) + bflo(u1[s].x), bfhi(u0[s].x) + bfhi(u1[s].x), bflo(u0[s].y) + bflo(u1[s].y), bfhi(u0[s].y) + bfhi(u1[s].y),
                                         bflo(u0[s].z) + bflo(u1[s].z), bfhi(u0[s].z) + bfhi(u1[s].z), bflo(u0[s].w) + bflo(u1[s].w), bfhi(u0[s].w) + bfhi(u1[s].w));
                O0 = __builtin_amdgcn_mfma_f32_32x32x16_bf16(af0[s], bfr, O0, 0, 0, 0);
                O1 = __builtin_amdgcn_mfma_f32_32x32x16_bf16(af1[s], bfr, O1, 0, 0, 0);
            }
            float ss = 0.f;
#pragma unroll
            for (int q = 0; q < 16; ++q) ss += O0[q] * O0[q] + O1[q] * O1[q];
            ss += __shfl_xor(ss, 32);
            if (h2 == 0) ssA[wv * 32 + r] = ss;
        }
        {
            u32x4 lb[4], lc[4], ld0[4], ld1[4], ld2[4]; float e0[4], e1[4], e2[4];
#pragma unroll
            for (int i = 0; i < 4; ++i) {
                const int t = t0 + 4 * wv + i, head = lane >> 3;
                lb[i] = *(const u32x4*)(YB + (size_t)t * 512 + 8 * lane); lc[i] = *(const u32x4*)(YC + (size_t)t * 512 + 8 * lane);
                ld0[i] = *(const u32x4*)(YD + (size_t)t * 512 + 8 * lane); ld1[i] = *(const u32x4*)(YD + ((size_t)NT + t) * 512 + 8 * lane); ld2[i] = *(const u32x4*)(YD + ((size_t)2 * NT + t) * 512 + 8 * lane);
                e0[i] = LSE[(size_t)t * 8 + head]; e1[i] = LSE[((size_t)NT + t) * 8 + head]; e2[i] = LSE[((size_t)2 * NT + t) * 8 + head];
            }
#pragma unroll
            for (int i = 0; i < 4; ++i) {
                const int t = t0 + 4 * wv + i;
                float y[3][8];
                { const u32x4 w = lb[i];
                    y[0][0] = bflo(w.x); y[0][1] = bfhi(w.x); y[0][2] = bflo(w.y); y[0][3] = bfhi(w.y); y[0][4] = bflo(w.z); y[0][5] = bfhi(w.z); y[0][6] = bflo(w.w); y[0][7] = bfhi(w.w); }
                { const u32x4 w = lc[i];
                    y[1][0] = bflo(w.x); y[1][1] = bfhi(w.x); y[1][2] = bflo(w.y); y[1][3] = bfhi(w.y); y[1][4] = bflo(w.z); y[1][5] = bfhi(w.z); y[1][6] = bflo(w.w); y[1][7] = bfhi(w.w); }
                { const float l0 = e0[i], l1 = e1[i], l2 = e2[i];
                  const float mx = fmaxf(l0, fmaxf(l1, l2)); float w0 = __expf(l0 - mx), w1 = __expf(l1 - mx), w2 = __expf(l2 - mx); const float iv = 1.f / (w0 + w1 + w2); w0 *= iv; w1 *= iv; w2 *= iv;
                  const u32x4 a = ld0[i], bq = ld1[i], c = ld2[i];
                  y[2][0] = w0 * bflo(a.x) + w1 * bflo(bq.x) + w2 * bflo(c.x); y[2][1] = w0 * bfhi(a.x) + w1 * bfhi(bq.x) + w2 * bfhi(c.x);
                  y[2][2] = w0 * bflo(a.y) + w1 * bflo(bq.y) + w2 * bflo(c.y); y[2][3] = w0 * bfhi(a.y) + w1 * bfhi(bq.y) + w2 * bfhi(c.y);
                  y[2][4] = w0 * bflo(a.z) + w1 * bflo(bq.z) + w2 * bflo(c.z); y[2][5] = w0 * bfhi(a.z) + w1 * bfhi(bq.z) + w2 * bfhi(c.z);
                  y[2][6] = w0 * bflo(a.w) + w1 * bflo(bq.w) + w2 * bflo(c.w); y[2][7] = w0 * bfhi(a.w) + w1 * bfhi(bq.w) + w2 * bfhi(c.w); }
#pragma unroll
                for (int g = 0; g < 3; ++g) {
                    float ss = 0.f;
#pragma unroll
                    for (int q = 0; q < 8; ++q) ss += y[g][q] * y[g][q];
                    const float rr = 1.0f / sqrtf(wave_sum(ss) * (1.f / 512.f) + EPS);
                    u32x4 w; w.x = pk2(y[g][0] * rr, y[g][1] * rr); w.y = pk2(y[g][2] * rr, y[g][3] * rr); w.z = pk2(y[g][4] * rr, y[g][5] * rr); w.w = pk2(y[g][6] * rr, y[g][7] * rr);
                    *(u32x4*)(YN + (size_t)t * DM + (g + 1) * 512 + 8 * lane) = w;
                }
            }
        }
        __syncthreads();
        {
            float tot = 0.f;
#pragma unroll
            for (int w = 0; w < 8; ++w) tot += ssA[w * 32 + r];
            const float rr = 1.0f / sqrtf(tot * (1.f / 512.f) + EPS);
            bf16_t* o = YN + (size_t)(t0 + r) * DM + wv * 64 + 4 * h2;
#pragma unroll
            for (int g = 0; g < 4; ++g) {
                u32x2 w0; w0.x = pk2(O0[4 * g] * rr, O0[4 * g + 1] * rr); w0.y = pk2(O0[4 * g + 2] * rr, O0[4 * g + 3] * rr);
                u32x2 w1; w1.x = pk2(O1[4 * g] * rr, O1[4 * g + 1] * rr); w1.y = pk2(O1[4 * g + 2] * rr, O1[4 * g + 3] * rr);
                *(u32x2*)(o + 8 * g) = w0; *(u32x2*)(o + 32 + 8 * g) = w1;
            }
        }
        __syncthreads();
    }
}

#ifndef PHASE_MASK
#define PHASE_MASK 0xFFFFFFu
#endif
#define EN(k) (((PHASE_MASK) >> (k)) & 1u)
#ifndef REP_MASK
#define REP_MASK 0u
#endif
#define REP(k) _Pragma("unroll") for (int rep_ = 0; rep_ < 1 + (int)(((REP_MASK) >> (k)) & 1u); ++rep_)
constexpr int MIX_GW = 128, MIX_A = 4400;
constexpr int NPHASE = 22;
__global__ void __launch_bounds__(512, 2) mk_fwd(Params p) {
    extern __shared__ __attribute__((aligned(16))) unsigned char lds_raw[];
    LAS unsigned char* lds = (LAS unsigned char*)lds_raw;
    const int tid = threadIdx.x, G = gridDim.x, bx = blockIdx.x;
    volatile LAS unsigned* misc = (volatile LAS unsigned*)(lds + MISC_OFF);
    if (tid < 16) misc[tid] = 0u;
    __syncthreads();
    const int lo = p.ph_lo, hi = p.ph_hi;
    XcdBarrier bar; bar.bar = (unsigned*)(p.ws + WS_CTL); bar.x = 0; bar.st = misc + 8;
    if (hi - lo > 1) bar = xcd_barrier_post((unsigned*)(p.ws + WS_CTL), misc + 8);
#define IN(k) (lo <= (k) && (k) < hi)
#define SEAM(k) do { if (IN(k) && IN((k) + 1)) xcd_barrier(bar); } while (0)
    if (IN(0)) { if (EN(0)) REP(0) ph_mod(p, lds); if (EN(1)) REP(1) ph_tables(p, lds); if (EN(2)) REP(2) { if (G == 256) { if (bx >= 192) ph_weights(p, lds, 0, 240, bx - 192, 64); } else ph_weights(p, lds, 0, 6880, bx, G); } }
    SEAM(0);
    for (int l = 0; l < 2; ++l) {
        const int pb = 1 + 10 * l;
        const char* H = (const char*)(p.ws + WS_H);
        if (EN(3) && IN(pb + 0)) REP(3) { ph_norm1(p, l); }
        SEAM(pb + 0);
        if (EN(4) && IN(pb + 1)) REP(4) {
            SchedProj S{H, (const char*)(p.ws + WS_WIN) + (size_t)l * NPROJ * 2048 * 2, (const char*)(p.ws + WS_WPQ) + (size_t)l * 512 * 2048 * 2, G, bx};
            EpiProj E{(bf16_t*)(p.ws + WS_PROJ), (bf16_t*)(p.ws + WS_PQT), (const float*)(p.ws + WS_ROPE), (const float*)(p.ws + WS_ROPE) + NT * 8};
            if (l == 0 && G == 256 && EN(2)) {
                if (bx < MIX_GW) { SchedProj S2{S.H, S.WIN, S.WPQ, MIX_GW, bx}; pg8::gemm_phase<EpiProj, SchedProj>(lds, 2048, 2048, 2048, S2, E); }
                else ph_weights(p, lds, 240, 240 + MIX_A, bx - MIX_GW, G - MIX_GW);
                __syncthreads();
                ph_weights(p, lds, 240 + MIX_A, 6880, bx, G);
            } else
            pg8::gemm_phase<EpiProj, SchedProj>(lds, 2048, 2048, 2048, S, E);
        }
        SEAM(pb + 1);
        if (IN(pb + 2)) {
            if (EN(5)) REP(5) { SchedDft S{(const char*)(p.ws + WS_DFT), (const char*)(p.ws + WS_PQT), G, bx};
              EpiBf16Plain E{(bf16_t*)(p.ws + WS_YA), 512, (size_t)4 * 4096 * 512};
              pg8::gemm_phase<EpiBf16Plain, SchedDft>(lds, 2048, 2048, 1024, S, E); }
            __syncthreads();
            if (EN(8)) REP(8) ph_mixers(p, l, lds);
        }
        SEAM(pb + 2);
        if (EN(9) && IN(pb + 3)) REP(9) { ph_merge(p, l, lds); }
        SEAM(pb + 3);
        if (EN(10) && IN(pb + 4)) REP(10) {
            SchedDense S{(const char*)(p.ws + WS_YN), (const char*)(p.ws + WS_WOUT) + (size_t)l * 2048 * 2048 * 2, 32, 8, 2048, G, bx};
            EpiWout E{l == 0 ? p.in[0] : nullptr, (const bf16_t*)(p.ws + WS_X), (bf16_t*)(p.ws + WS_X2), (const float*)(p.ws + WS_MOD) + (size_t)l * 4 * 12288 + 2 * 2048};
            pg8::gemm_phase<EpiWout, SchedDense>(lds, 2048, 2048, 2048, S, E);
        }
        SEAM(pb + 4);
        if (EN(11) && IN(pb + 5)) REP(11) { ph_norm2_router_mfma(p, l, lds); }
        SEAM(pb + 5);
        if (EN(12) && IN(pb + 6)) REP(12) { ph_topk(p, lds); }
        SEAM(pb + 6);
        if (EN(14) && IN(pb + 8)) REP(14) {
            SchedMoeG S{H, (const char*)(p.ws + WS_WGU) + (size_t)l * 16 * 2048 * 2048 * 2, 2048, G, bx};
            EpiGU E{(bf16_t*)(p.ws + WS_ACT)};
            pg8::gemm_phase<EpiGU, SchedMoeG, true>(lds, 2048, 2048, 2048, S, E, (const int*)(p.ws + WS_IDX));
        }
        SEAM(pb + 8);
        if (EN(15) && IN(pb + 9)) REP(15) {
            SchedMoe S{(const char*)(p.ws + WS_ACT), (const char*)(p.ws + WS_WD) + (size_t)l * 16 * 2048 * 1024 * 2, 1024, G, bx};
            EpiDown E{(bf16_t*)(p.ws + WS_EO), (const float*)(p.ws + WS_IDX + 65536)};
            pg8::gemm_phase<EpiDown, SchedMoe>(lds, 1024, 1024, 1024, S, E);
        }
        SEAM(pb + 9);
    }
    if (EN(16) && IN(21)) REP(16) { ph_norm1(p, 2); }
#undef IN
#undef SEAM
}

extern "C" void kernel_launch(void* const* d_in, const int* in_sizes, int n_in, void* d_out, int out_size, void* d_ws, size_t ws_size, hipStream_t stream) {
    static int grid = 0;
    if (grid == 0) {
        if (n_in != 20 || out_size != NT * DM || ws_size < WS_END) { fprintf(stderr, "kernel_launch: unexpected shapes (n_in %d out %d ws %zu)\n", n_in, out_size, ws_size); grid = -1; return; }
        int dev = 0, cus = 0, per_cu = 0;
        if (hipGetDevice(&dev) != hipSuccess || hipDeviceGetAttribute(&cus, hipDeviceAttributeMultiprocessorCount, dev) != hipSuccess) { grid = -1; return; }
        if (hipFuncSetAttribute((const void*)mk_fwd, hipFuncAttributeMaxDynamicSharedMemorySize, LDS_BYTES) != hipSuccess) { fprintf(stderr, "kernel_launch: hipFuncSetAttribute failed\n"); grid = -1; return; }
        if (hipOccupancyMaxActiveBlocksPerMultiprocessor(&per_cu, (const void*)mk_fwd, 512, LDS_BYTES) != hipSuccess || per_cu < 1) { fprintf(stderr, "kernel_launch: occupancy query says %d\n", per_cu); }
        (void)hipGetLastError();
        grid = cus;
    }
    if (grid < 0) return;
    (void)hipMemsetAsync((char*)d_ws + WS_CTL, 0, 64 * 1024, stream);
    Params p{};
    for (int i = 0; i < 20; ++i) p.in[i] = (const float*)d_in[i];
    p.out = (float*)d_out; p.ws = (unsigned char*)d_ws;
#if defined(MK_MULTI)
    for (int ph = 0; ph < NPHASE; ++ph) { p.ph_lo = ph; p.ph_hi = ph + 1; hipLaunchKernelGGL(mk_fwd, dim3(grid), dim3(512), LDS_BYTES, stream, p); }
#else
    p.ph_lo = 0; p.ph_hi = NPHASE; hipLaunchKernelGGL(mk_fwd, dim3(grid), dim3(512), LDS_BYTES, stream, p);
#endif
}
```

```cpp
#include <hip/hip_runtime.h>
#include <cstdio>
#include <cstdint>

#define LAS __attribute__((address_space(3)))
typedef unsigned short bf16_t;
typedef short bf16x8 __attribute__((ext_vector_type(8)));
typedef float f32x4 __attribute__((ext_vector_type(4)));
typedef float f32x2 __attribute__((ext_vector_type(2)));
typedef unsigned u32x4 __attribute__((ext_vector_type(4)));
typedef unsigned u32x2 __attribute__((ext_vector_type(2)));
typedef float f32x16 __attribute__((ext_vector_type(16)));

constexpr int NB = 4, SEQ = 2048, NT = NB * SEQ, DM = 2048, DIN = 3840, NPROJ = 3328, NE = 16, FF = 1024, CAP = 256;
constexpr float EPS = 1e-6f;
constexpr int PC_U = 0, PC_V = 512, PC_QC = 1024, PC_KC = 1536, PC_VC = 1664, PC_QD = 1792, PC_KD = 2304, PC_VD = 2816;

constexpr size_t MiB = (size_t)1 << 20;
constexpr size_t WS_CTL = 0;
constexpr size_t WS_MOD = 1 * MiB;
constexpr size_t WS_ROPE = WS_MOD + 512 * 1024;
constexpr size_t WS_DFT = 2 * MiB;
constexpr size_t WS_WIN = 18 * MiB;
constexpr size_t WS_WPQ = 44 * MiB;
constexpr size_t WS_WOUT = 52 * MiB;
constexpr size_t WS_WGU = 68 * MiB;
constexpr size_t WS_WD = 324 * MiB;
constexpr size_t WS_X = 452 * MiB;
constexpr size_t WS_X2 = 516 * MiB;
constexpr size_t WS_H = 580 * MiB;
constexpr size_t WS_PROJ = 612 * MiB;
constexpr size_t WS_PQT = 664 * MiB;
constexpr size_t WS_YA = 680 * MiB;
constexpr size_t WS_YB = 712 * MiB;
constexpr size_t WS_YC = 720 * MiB;
constexpr size_t WS_YD = 728 * MiB;
constexpr size_t WS_LSE = 752 * MiB;
constexpr size_t WS_YN = 753 * MiB;
constexpr size_t WS_AFF = 785 * MiB;
constexpr size_t WS_IDX = 786 * MiB;
constexpr size_t WS_XE = 787 * MiB;
constexpr size_t WS_ACT = 851 * MiB;
constexpr size_t WS_EO = 883 * MiB;
constexpr size_t WS_SGUW = 947 * MiB;
constexpr size_t WS_WRT = WS_SGUW + 512 * 1024;
constexpr size_t WS_ABT = WS_WRT + 128 * 1024;
constexpr size_t WS_VSS = WS_ABT + 256 * 1024;
constexpr size_t WS_END = 948 * MiB;

constexpr int LDS_BYTES = 163840;
constexpr int MISC_OFF = LDS_BYTES - 256;

struct Params { const float* in[20]; float* out; unsigned char* ws; int ph_lo, ph_hi; };

__device__ __forceinline__ unsigned pk2(float lo, float hi) { unsigned r; asm("v_cvt_pk_bf16_f32 %0, %1, %2" : "=v"(r) : "v"(lo), "v"(hi)); return r; }
__device__ __forceinline__ float bflo(unsigned u) { return __uint_as_float(u << 16); }
__device__ __forceinline__ float bfhi(unsigned u) { return __uint_as_float(u & 0xffff0000u); }
__device__ __forceinline__ float wave_sum(float v) {
#pragma unroll
    for (int o = 1; o < 64; o <<= 1) v += __shfl_xor(v, o);
    return v;
}
__device__ __forceinline__ float gelu_tanh(float x) { const float u = 0.7978845608f * (x + 0.044715f * x * x * x); return x * __builtin_amdgcn_rcpf(1.f + __builtin_amdgcn_exp2f(-2.885390082f * u)); }
__device__ __forceinline__ float silu_f(float x) { return x * __builtin_amdgcn_rcpf(1.f + __builtin_amdgcn_exp2f(-1.442695041f * x)); }

__device__ __forceinline__ int opaque_tid() { int t = threadIdx.x; asm volatile("" : "+v"(t)); return t; }
#define XB_TMO      128
#define XB_XCNT(j)  (256  + 64 * (j))
#define XB_XSUB(j)  (1280 + 64 * (j))
#define XB_XGEN(j)  (2304 + 64 * (j))
#define XB_TOP      3328
#define XB_TOPGEN   3392
#define XCD_BAR_WORDS 3456
#define XB_SPIN_CAP (1u << 18)
__device__ __forceinline__ unsigned xb_ld(unsigned* p)              { return __hip_atomic_load(p, __ATOMIC_RELAXED, __HIP_MEMORY_SCOPE_AGENT); }
__device__ __forceinline__ unsigned xb_add(unsigned* p, unsigned v) { return __hip_atomic_fetch_add(p, v, __ATOMIC_RELAXED, __HIP_MEMORY_SCOPE_AGENT); }
__device__ __forceinline__ unsigned xb_xcc_id() { return (unsigned)__builtin_amdgcn_s_getreg((3 << 11) | 20) & 0xFu; }
#define XB_SPIN(cond, bar) do { unsigned _sp = 0; while (cond) { __builtin_amdgcn_s_sleep(1); \
    if ((++_sp & 255u) == 0u) { if (xb_ld(&(bar)[XB_TMO])) break; if (_sp > XB_SPIN_CAP) { atomicAdd(&(bar)[XB_TMO], 1u); break; } } } } while (0)
struct XcdBarrier { unsigned* bar; unsigned x; volatile LAS unsigned* st; };
__device__ __forceinline__ XcdBarrier xcd_barrier_post(unsigned* bar, volatile LAS unsigned* st) {
    XcdBarrier b; b.bar = bar; b.x = xb_xcc_id(); b.st = st;
    if (threadIdx.x == 0) (void)xb_add(&bar[XB_XCNT(b.x)], 1u);
    return b;
}
__device__ __forceinline__ void xcd_barrier_complete(unsigned* bar, unsigned x, unsigned& nloc, unsigned& nx) {
    const unsigned G = gridDim.x * gridDim.y * gridDim.z;
    unsigned sum, cnt, mine, sp = 0u;
    for (;;) {
        sum = 0u; cnt = 0u; mine = 0u;
#pragma unroll
        for (unsigned j = 0; j < 16; ++j) { const unsigned c = xb_ld(&bar[XB_XCNT(j)]); sum += c; cnt += (c > 0u) ? 1u : 0u; mine = (j == x) ? c : mine; }
        if (sum == G) break;
        __builtin_amdgcn_s_sleep(1);
        if ((++sp & 255u) == 0u) { if (xb_ld(&bar[XB_TMO])) break; if (sp > XB_SPIN_CAP) { atomicAdd(&bar[XB_TMO], 1u); break; } }
    }
    nloc = mine > 0u ? mine : 1u; nx = cnt > 0u ? cnt : 1u;
}
__device__ __forceinline__ void xcd_barrier(const XcdBarrier& b) {
    asm volatile("s_waitcnt vmcnt(0)" ::: "memory");
    __syncthreads();
    if (threadIdx.x == 0) {
        unsigned* bar = b.bar;
        __builtin_amdgcn_s_waitcnt(0);
        unsigned nloc = b.st[0], nx = b.st[1];
        if (nloc == 0u) { xcd_barrier_complete(bar, b.x, nloc, nx); b.st[0] = nloc; b.st[1] = nx; }
        const unsigned old = xb_add(&bar[XB_XSUB(b.x)], 1u);
        const unsigned gen = old / nloc;
        if (old + 1u == (gen + 1u) * nloc) {
            __builtin_amdgcn_fence(__ATOMIC_RELEASE, "agent");
            asm volatile("s_waitcnt vmcnt(0)" ::: "memory");
            const unsigned og = xb_add(&bar[XB_TOP], 1u);
            const unsigned tg = og / nx;
            if (og + 1u == (tg + 1u) * nx) xb_add(&bar[XB_TOPGEN], 1u);
            else XB_SPIN(xb_ld(&bar[XB_TOPGEN]) == tg, bar);
            __builtin_amdgcn_fence(__ATOMIC_ACQUIRE, "agent");
            xb_add(&bar[XB_XGEN(b.x)], 1u);
            asm volatile("s_waitcnt vmcnt(0)" ::: "memory");
        } else {
            XB_SPIN(xb_ld(&bar[XB_XGEN(b.x)]) == gen, bar);
            __builtin_amdgcn_fence(__ATOMIC_ACQUIRE, "agent");
            asm volatile("s_waitcnt vmcnt(0)" ::: "memory");
        }
    }
    __syncthreads();
}

namespace pg8 {
constexpr int BM = 256, BK = 64, HALF = 128, HTB = HALF * BK * 2, STAGE_BYTES = 8 * HTB;
__host__ __device__ __forceinline__ int lds_byte(int r, int c) { const int st = (r >> 4) * 2 + (c >> 5), rr = r & 15, cc = c & 31, ob = rr * 64 + cc * 2; return st * 1024 + (ob ^ (((ob >> 9) & 1) << 5)); }
__host__ __device__ __forceinline__ void stage_rc(int b, int& R, int& C) { const int st = b / 1024, sb = b % 1024, swz = sb ^ (((sb >> 9) & 1) << 5); R = (st >> 1) * 16 + swz / 64; C = (st & 1) * 32 + (swz % 64) / 2; }
__host__ __device__ __forceinline__ int perm32(int rho) { const int n = rho >> 4, i = rho & 15; return 8 * (i >> 2) + 4 * n + (i & 3); }

struct GUnit { const char* a; const char* b; int pm, pn, z; };

__device__ __forceinline__ void dense_map(int L, int nM, int nN, int& pm, int& pn) {
    const int nwg = nM * nN;
    int wgid = L; { const int q = nwg / 8, r = nwg % 8, xcd = wgid % 8, off = wgid / 8; wgid = (xcd < r ? xcd * (q + 1) : r * (q + 1) + (xcd - r) * q) + off; }
    const int nig = 8 * nN, gid = wgid / nig, fm = gid * 8, gsz = (nM - fm) < 8 ? (nM - fm) : 8;
    pm = fm + ((wgid % nig) % gsz); pn = (wgid % nig) / gsz;
}

template <class Epi, class Sched, bool GATHER = false>
__device__ __forceinline__ void gemm_phase(LAS unsigned char* lds, const int lda, const int ldb, const int K, const Sched& S, const Epi& E, const int* gidx = nullptr) {
    int tid_ = threadIdx.x; asm volatile("" : "+v"(tid_));
    const int tid = tid_, wid = __builtin_amdgcn_readfirstlane(tid >> 6), lane = tid & 63, wr = wid >> 2, wc = wid & 3, fr = lane & 15, fq = lane >> 4;
    const int nt = K / BK;
    unsigned voffB[2]; int RA[2]; unsigned CA2[2];
#pragma unroll
    for (int i = 0; i < 2; ++i) { int R, C; stage_rc(tid * 16 + i * 8192, R, C); const int Rb = Epi::PERM ? ((R & ~31) + perm32(R & 31)) : R;
        RA[i] = R; CA2[i] = (unsigned)C * 2u; voffB[i] = (unsigned)(Rb * ldb + C) * 2u; }
    const size_t kstep = (size_t)(BK * 2);
    const size_t hstepB = (size_t)HALF * ldb * 2;
    const unsigned ldsw = (unsigned)wid * 1024u;
    const int aoff = lds_byte(wr * 64 + fr, fq * 8), boff = lds_byte(wc * 32 + fr, fq * 8);
#define PG8_AOFF(of, u) do { _Pragma("unroll") for (int hh_ = 0; hh_ < 2; ++hh_) _Pragma("unroll") for (int i_ = 0; i_ < 2; ++i_) { \
        if constexpr (GATHER) of[hh_][i_] = (unsigned)gidx[(u).pm * 256 + hh_ * 128 + RA[i_]] * (unsigned)(lda * 2) + CA2[i_]; \
        else of[hh_][i_] = (unsigned)((hh_ * HALF + RA[i_]) * lda) * 2u + CA2[i_]; } } while (0)
#define PG8_SA(b, h) (((b) * 2 + (h)) * HTB)
#define PG8_SB(b, h) ((4 + (b) * 2 + (h)) * HTB)
#define PG8_STAGE(bufoff, gbase, voff) do { _Pragma("unroll") for (int _i = 0; _i < 2; ++_i) \
        __builtin_amdgcn_global_load_lds((const unsigned*)((const char*)(gbase) + (voff)[_i]), (LAS unsigned*)(lds + (bufoff) + ldsw + _i * 8192), 16, 0, 0); } while (0)
#define PG8_LDA(dst, b, h) do { _Pragma("unroll") for (int m = 0; m < 4; ++m) _Pragma("unroll") for (int k = 0; k < 2; ++k) dst[m][k] = *(const LAS bf16x8*)(lds + PG8_SA(b, h) + aoff + m * 2048 + k * 1024); } while (0)
#define PG8_LDB(dst, b, h) do { _Pragma("unroll") for (int n = 0; n < 2; ++n) _Pragma("unroll") for (int k = 0; k < 2; ++k) dst[n][k] = *(const LAS bf16x8*)(lds + PG8_SB(b, h) + boff + n * 2048 + k * 1024); } while (0)
#define PG8_MMA(ai, bj, At, Bt) do { __builtin_amdgcn_s_setprio(1); _Pragma("unroll") for (int m = 0; m < 4; ++m) _Pragma("unroll") for (int n = 0; n < 2; ++n) _Pragma("unroll") for (int k = 0; k < 2; ++k) \
        acc[ai][bj][m][n] = __builtin_amdgcn_mfma_f32_16x16x32_bf16(Bt[n][k], At[m][k], acc[ai][bj][m][n], 0, 0, 0); __builtin_amdgcn_s_setprio(0); } while (0)
#define PG8_WAIT_V(n) asm volatile("s_waitcnt vmcnt(" #n ")" ::: "memory")
#define PG8_WAIT_L(n) asm volatile("s_waitcnt lgkmcnt(" #n ")" ::: "memory")
#define PG8_BAR __builtin_amdgcn_s_barrier()
#define PG8_SCHED __builtin_amdgcn_sched_barrier(0)
    GUnit cur, nxt; int ui = 0;
    if (!S.next(0, cur)) return;
    f32x4 acc[2][2][4][2];
#pragma unroll
    for (int a = 0; a < 2; ++a)
#pragma unroll
        for (int b = 0; b < 2; ++b)
#pragma unroll
            for (int m = 0; m < 4; ++m)
#pragma unroll
                for (int n = 0; n < 2; ++n) acc[a][b][m][n] = (f32x4){0.f, 0.f, 0.f, 0.f};
    bf16x8 At[4][2], B0[2][2], B1[2][2];
    unsigned ofc[2][2], ofn[2][2];
    PG8_AOFF(ofc, cur);
#pragma unroll
    for (int hh = 0; hh < 2; ++hh)
#pragma unroll
        for (int i = 0; i < 2; ++i) ofn[hh][i] = ofc[hh][i];
    const char* cA = cur.a; const char* cB = cur.b;
    PG8_STAGE(PG8_SB(0, 0), cB, voffB); PG8_STAGE(PG8_SB(0, 1), cB + hstepB, voffB); PG8_STAGE(PG8_SA(0, 0), cA, ofc[0]); PG8_STAGE(PG8_SA(0, 1), cA, ofc[1]);
    if (wr == 1) PG8_BAR;
    PG8_WAIT_V(2); PG8_BAR;
    PG8_STAGE(PG8_SB(1, 0), cB + kstep, voffB); PG8_STAGE(PG8_SA(1, 0), cA + kstep, ofc[0]); PG8_STAGE(PG8_SB(1, 1), cB + hstepB + kstep, voffB);
    PG8_WAIT_V(6); PG8_BAR;
    for (;;) {
        const bool has_next = S.next(ui + 1, nxt);
        const char* nA = has_next ? nxt.a : cA; const char* nB = has_next ? nxt.b : cB;
        for (int t = 0; t < nt; t += 2) {
            const bool last = (t == nt - 2);
            if constexpr (GATHER) { if (last && has_next) PG8_AOFF(ofn, nxt); }
            const char* a1 = cA + (size_t)(t + 1) * kstep;
            const char* a2 = last ? nA : cA + (size_t)(t + 2) * kstep; const char* b2 = last ? nB : cB + (size_t)(t + 2) * kstep;
            const char* a3 = a2 + kstep; const char* b3 = b2 + kstep;
            unsigned o2[2][2];
#pragma unroll
            for (int hh = 0; hh < 2; ++hh)
#pragma unroll
                for (int i = 0; i < 2; ++i) { if constexpr (GATHER) o2[hh][i] = last ? ofn[hh][i] : ofc[hh][i]; else o2[hh][i] = ofc[hh][i]; }
            PG8_LDB(B0, 0, 0); PG8_LDB(B1, 0, 1); PG8_SCHED; PG8_LDA(At, 0, 0); PG8_STAGE(PG8_SA(1, 1), a1, ofc[1]);
            PG8_WAIT_V(8); PG8_WAIT_L(0); PG8_BAR; PG8_MMA(0, 0, At, B0); PG8_MMA(0, 1, At, B1); PG8_BAR; PG8_SCHED;
            PG8_LDA(At, 0, 1); PG8_STAGE(PG8_SB(0, 0), b2, voffB); PG8_STAGE(PG8_SB(0, 1), b2 + hstepB, voffB); PG8_STAGE(PG8_SA(0, 0), a2, o2[0]);
            PG8_WAIT_V(8); PG8_WAIT_L(0); PG8_BAR; PG8_MMA(1, 0, At, B0); PG8_MMA(1, 1, At, B1); PG8_BAR; PG8_SCHED;
            PG8_LDB(B0, 1, 0); PG8_LDB(B1, 1, 1); PG8_SCHED; PG8_LDA(At, 1, 0); PG8_STAGE(PG8_SA(0, 1), a2, o2[1]);
            PG8_WAIT_V(8); PG8_WAIT_L(0); PG8_BAR; PG8_MMA(0, 0, At, B0); PG8_MMA(0, 1, At, B1); PG8_BAR; PG8_SCHED;
            PG8_LDA(At, 1, 1); PG8_STAGE(PG8_SB(1, 0), b3, voffB); PG8_STAGE(PG8_SB(1, 1), b3 + hstepB, voffB); PG8_STAGE(PG8_SA(1, 0), a3, o2[0]);
            PG8_WAIT_V(8); PG8_WAIT_L(0); PG8_BAR; PG8_MMA(1, 0, At, B0); PG8_MMA(1, 1, At, B1); PG8_BAR; PG8_SCHED;
        }
        if (wr == 0) PG8_BAR;
        E(acc, cur, wr, wc, fr, fq);
        if (!has_next) break;
#pragma unroll
        for (int a = 0; a < 2; ++a)
#pragma unroll
            for (int b = 0; b < 2; ++b)
#pragma unroll
                for (int m = 0; m < 4; ++m)
#pragma unroll
                    for (int n = 0; n < 2; ++n) acc[a][b][m][n] = (f32x4){0.f, 0.f, 0.f, 0.f};
        cur = nxt; cA = nA; cB = nB; ++ui;
        if constexpr (GATHER) {
#pragma unroll
            for (int hh = 0; hh < 2; ++hh)
#pragma unroll
                for (int i = 0; i < 2; ++i) ofc[hh][i] = ofn[hh][i];
        }
        if (wr == 1) PG8_BAR;
    }
    PG8_WAIT_V(0);
    PG8_BAR;
#undef PG8_AOFF
#undef PG8_SA
#undef PG8_SB
#undef PG8_STAGE
#undef PG8_LDA
#undef PG8_LDB
#undef PG8_MMA
#undef PG8_WAIT_V
#undef PG8_WAIT_L
#undef PG8_BAR
#undef PG8_SCHED
}
}
using pg8::GUnit;

struct SchedProj {
    const char* H; const char* WIN; const char* WPQ; int G, c;
    __device__ __forceinline__ bool next(int i, GUnit& u) const {
        const int L = i * G + c; if (L >= 480) return false;
        if (L < 416) { int pm, pn; pg8::dense_map(L, 32, 13, pm, pn); u.pm = pm; u.pn = pn; u.z = 0; u.a = H + (size_t)pm * 256 * 2048 * 2; u.b = WIN + (size_t)pn * 256 * 2048 * 2; }
        else { int pm, pn; pg8::dense_map(L - 416, 2, 32, pm, pn); u.pm = pm; u.pn = pn + 64; u.z = 0; u.a = WPQ + (size_t)pm * 256 * 2048 * 2; u.b = H + (size_t)pn * 256 * 2048 * 2; }
        return true;
    }
};
struct SchedDft {
    const char* DFT; const char* XAT; int G, c;
    __device__ __forceinline__ bool next(int i, GUnit& u) const {
        const int L = i * G + c; if (L >= 256) return false;
        const int Lp = (L & 7) * 32 + (L >> 3);
        const int ks = Lp & 1, pn = (Lp >> 1) & 1, pm = (Lp >> 2) & 15, b = Lp >> 6;
        u.pm = b * 16 + pm; u.pn = pn; u.z = ks;
        u.a = DFT + ((size_t)pm * 256 * 2048 + ks * 1024) * 2; u.b = XAT + (((size_t)b * 512 + pn * 256) * 2048 + ks * 1024) * 2;
        return true;
    }
};
struct SchedDense {
    const char* A; const char* B; int nM, nN, K, G, c;
    __device__ __forceinline__ bool next(int i, GUnit& u) const {
        const int L = i * G + c; if (L >= nM * nN) return false;
        int pm, pn; pg8::dense_map(L, nM, nN, pm, pn); u.pm = pm; u.pn = pn; u.z = 0;
        u.a = A + (size_t)pm * 256 * K * 2; u.b = B + (size_t)pn * 256 * K * 2; return true;
    }
};
struct SchedMoeG {
    const char* A; const char* B; int K, G, c;
    __device__ __forceinline__ bool next(int i, GUnit& u) const {
        const int L = i * G + c; if (L >= 512) return false;
        const int Lp = (L & 7) * 64 + (L >> 3);
        const int e = Lp >> 5, r = Lp & 31, pm = r & 3, pn = r >> 2;
        u.pm = e * 4 + pm; u.pn = pn; u.z = e;
        u.a = A; u.b = B + ((size_t)e * 2048 + pn * 256) * K * 2; return true;
    }
};
struct SchedMoe {
    const char* A; const char* B; int K, G, c;
    __device__ __forceinline__ bool next(int i, GUnit& u) const {
        const int L = i * G + c; if (L >= 512) return false;
        const int Lp = (L & 7) * 64 + (L >> 3);
        const int e = Lp >> 5, r = Lp & 31, pm = r & 3, pn = r >> 2;
        u.pm = e * 4 + pm; u.pn = pn; u.z = e;
        u.a = A + ((size_t)e * 1024 + pm * 256) * K * 2; u.b = B + ((size_t)e * 2048 + pn * 256) * K * 2; return true;
    }
};

typedef f32x4 AccT[2][2][4][2];
struct EpiProj {
    static constexpr bool PERM = true;
    bf16_t* PROJ; bf16_t* PQT; const float* ropec; const float* ropes;
    __device__ __forceinline__ void operator()(const AccT& acc, const GUnit& u, int wr, int wc, int fr, int fq) const {
        if (u.pn < 64) {
            const int pn = u.pn;
            const int row0 = u.pm * 256 + wr * 64 + fr;
#pragma unroll
            for (int ai = 0; ai < 2; ++ai)
#pragma unroll
                for (int m = 0; m < 4; ++m) {
                    const int row = row0 + ai * 128 + m * 16;
                    float vsq = 0.f;
#pragma unroll
                    for (int bj = 0; bj < 2; ++bj) {
                        f32x4 v0 = acc[ai][bj][m][0], v1 = acc[ai][bj][m][1];
                        const int colt = pn * 256 + bj * 128;
                        if (pn < 4) {
#pragma unroll
                            for (int j = 0; j < 4; ++j) { v0[j] = gelu_tanh(v0[j]); v1[j] = gelu_tanh(v1[j]); vsq += v0[j] * v0[j] + v1[j] * v1[j]; }
                        } else {
                            const bool isq = (colt >= PC_QC && colt < PC_KC) || (colt >= PC_QD && colt < PC_KD);
                            const bool isk = (colt >= PC_KC && colt < PC_VC) || (colt >= PC_KD && colt < PC_VD);
                            if (isq || isk) {
                                if ((wc & 1) == 0) {
                                    f32x4 o0, o1;
#pragma unroll
                                    for (int j = 0; j < 4; ++j) { o0[j] = __shfl_xor(v0[j], 16); o1[j] = __shfl_xor(v1[j], 16); }
                                    if (fq < 2) {
                                        const f32x4 c0 = *(const f32x4*)(ropec + (size_t)row * 8), c1 = *(const f32x4*)(ropec + (size_t)row * 8 + 4);
                                        const f32x4 s0 = *(const f32x4*)(ropes + (size_t)row * 8), s1 = *(const f32x4*)(ropes + (size_t)row * 8 + 4);
                                        const float sg = fq == 0 ? -1.f : 1.f;
#pragma unroll
                                        for (int j = 0; j < 4; ++j) { v0[j] = v0[j] * c0[j] + sg * o0[j] * s0[j]; v1[j] = v1[j] * c1[j] + sg * o1[j] * s1[j]; }
                                    }
                                }
                                if (isq) { v0 = v0 * 0.125f; v1 = v1 * 0.125f; }
                            }
                        }
                        u32x4 w; w.x = pk2(v0[0], v0[1]); w.y = pk2(v0[2], v0[3]); w.z = pk2(v1[0], v1[1]); w.w = pk2(v1[2], v1[3]);
                        *(u32x4*)(PROJ + (size_t)row * NPROJ + colt + wc * 32 + 8 * fq) = w;
                    }
                    if (pn == 2 || pn == 3) {
                        vsq += __shfl_xor(vsq, 16); vsq += __shfl_xor(vsq, 32);
                        if (fq == 0) ((float*)((char*)PROJ + (WS_VSS - WS_PROJ)))[(size_t)row * 8 + (pn - 2) * 4 + wc] = vsq;
                    }
                }
        } else {
#pragma unroll
            for (int ai = 0; ai < 2; ++ai)
#pragma unroll
                for (int m = 0; m < 4; ++m) {
                    const int c = u.pm * 256 + ai * 128 + wr * 64 + m * 16 + fr;
#pragma unroll
                    for (int bj = 0; bj < 2; ++bj) {
                        const int t = (u.pn - 64) * 256 + bj * 128 + wc * 32 + 8 * fq, b = t >> 11, s = t & 2047;
                        const f32x4 v0 = acc[ai][bj][m][0], v1 = acc[ai][bj][m][1];
                        u32x4 w; w.x = pk2(v0[0], v0[1]); w.y = pk2(v0[2], v0[3]); w.z = pk2(v1[0], v1[1]); w.w = pk2(v1[2], v1[3]);
                        *(u32x4*)(PQT + (((size_t)b * 512 + c) * 2048 + s)) = w;
                    }
                }
        }
    }
};
struct EpiBf16Plain {
    static constexpr bool PERM = true;
    bf16_t* O; int ldc; size_t zstride;
    __device__ __forceinline__ void operator()(const AccT& acc, const GUnit& u, int wr, int wc, int fr, int fq) const {
        bf16_t* base = O + (size_t)u.z * zstride;
#pragma unroll
        for (int ai = 0; ai < 2; ++ai)
#pragma unroll
            for (int m = 0; m < 4; ++m) {
                const int row = u.pm * 256 + ai * 128 + wr * 64 + m * 16 + fr;
#pragma unroll
                for (int bj = 0; bj < 2; ++bj) {
                    const f32x4 v0 = acc[ai][bj][m][0], v1 = acc[ai][bj][m][1];
                    u32x4 w; w.x = pk2(v0[0], v0[1]); w.y = pk2(v0[2], v0[3]); w.z = pk2(v1[0], v1[1]); w.w = pk2(v1[2], v1[3]);
                    *(u32x4*)(base + (size_t)row * ldc + u.pn * 256 + bj * 128 + wc * 32 + 8 * fq) = w;
                }
            }
    }
};
struct EpiWout {
    static constexpr bool PERM = true;
    const float* base32; const bf16_t* base16; bf16_t* X2; const float* gate;
    __device__ __forceinline__ void operator()(const AccT& acc, const GUnit& u, int wr, int wc, int fr, int fq) const {
        const int b = u.pm >> 3;
        const int col0 = u.pn * 256 + wc * 32 + 8 * fq;
        f32x4 g[2][2];
#pragma unroll
        for (int bj = 0; bj < 2; ++bj)
#pragma unroll
            for (int n = 0; n < 2; ++n) g[bj][n] = *(const f32x4*)(gate + (size_t)b * 12288 + col0 + bj * 128 + n * 4);
#pragma unroll
        for (int ai = 0; ai < 2; ++ai)
#pragma unroll
            for (int m = 0; m < 4; ++m) {
                const size_t ro = (size_t)(u.pm * 256 + ai * 128 + wr * 64 + m * 16 + fr) * DM + col0;
#pragma unroll
                for (int bj = 0; bj < 2; ++bj) {
                    f32x4 x0, x1;
                    if (base32) { x0 = *(const f32x4*)(base32 + ro + bj * 128); x1 = *(const f32x4*)(base32 + ro + bj * 128 + 4); }
                    else { const u32x4 w = *(const u32x4*)(base16 + ro + bj * 128); x0 = (f32x4){bflo(w.x), bfhi(w.x), bflo(w.y), bfhi(w.y)}; x1 = (f32x4){bflo(w.z), bfhi(w.z), bflo(w.w), bfhi(w.w)}; }
                    const f32x4 v0 = x0 + g[bj][0] * acc[ai][bj][m][0], v1 = x1 + g[bj][1] * acc[ai][bj][m][1];
                    u32x4 o; o.x = pk2(v0[0], v0[1]); o.y = pk2(v0[2], v0[3]); o.z = pk2(v1[0], v1[1]); o.w = pk2(v1[2], v1[3]);
                    *(u32x4*)(X2 + ro + bj * 128) = o;
                }
            }
    }
};
struct EpiGU {
    static constexpr bool PERM = true;
    bf16_t* ACT;
    __device__ __forceinline__ void operator()(const AccT& acc, const GUnit& u, int wr, int wc, int fr, int fq) const {
#pragma unroll
        for (int ai = 0; ai < 2; ++ai)
#pragma unroll
            for (int m = 0; m < 4; ++m) {
                const int row = u.pm * 256 + ai * 128 + wr * 64 + m * 16 + fr;
                f32x4 v0, v1;
#pragma unroll
                for (int j = 0; j < 4; ++j) { v0[j] = silu_f(acc[ai][0][m][0][j]) * acc[ai][1][m][0][j]; v1[j] = silu_f(acc[ai][0][m][1][j]) * acc[ai][1][m][1][j]; }
                u32x4 w; w.x = pk2(v0[0], v0[1]); w.y = pk2(v0[2], v0[3]); w.z = pk2(v1[0], v1[1]); w.w = pk2(v1[2], v1[3]);
                *(u32x4*)(ACT + (size_t)row * FF + u.pn * 128 + wc * 32 + 8 * fq) = w;
            }
    }
};
struct EpiDown {
    static constexpr bool PERM = true;
    bf16_t* EO; const float* gate;
    __device__ __forceinline__ void operator()(const AccT& acc, const GUnit& u, int wr, int wc, int fr, int fq) const {
#pragma unroll
        for (int ai = 0; ai < 2; ++ai)
#pragma unroll
            for (int m = 0; m < 4; ++m) {
                const int row = u.pm * 256 + ai * 128 + wr * 64 + m * 16 + fr;
                const float g = gate[row];
#pragma unroll
                for (int bj = 0; bj < 2; ++bj) {
                    const f32x4 v0 = acc[ai][bj][m][0] * g, v1 = acc[ai][bj][m][1] * g;
                    u32x4 w; w.x = pk2(v0[0], v0[1]); w.y = pk2(v0[2], v0[3]); w.z = pk2(v1[0], v1[1]); w.w = pk2(v1[2], v1[3]);
                    *(u32x4*)(EO + (size_t)row * DM + u.pn * 256 + bj * 128 + wc * 32 + 8 * fq) = w;
                }
            }
    }
};

__device__ __forceinline__ void ph_mod(const Params& p, LAS unsigned char* lds) {
    LAS float* sl = (LAS float*)lds;
    LAS float* red = (LAS float*)(lds + 32768);
    const int tid = opaque_tid();
    const float* c = p.in[1];
    float* mod = (float*)(p.ws + WS_MOD);
    for (int i = tid; i < 8192; i += 512) { const float v = c[i]; sl[i] = v / (1.f + expf(-v)); }
    __syncthreads();
    const int cl = tid & 31, ks = tid >> 5;
    for (int u = blockIdx.x; u < 192; u += gridDim.x) {
        const int l = u / 96, cc = u % 96;
        const float* W = p.in[3] + (size_t)l * 2048 * 12288 + cc * 128 + cl * 4;
        float acc[4][4];
#pragma unroll
        for (int b = 0; b < 4; ++b)
#pragma unroll
            for (int j = 0; j < 4; ++j) acc[b][j] = 0.f;
#pragma unroll 8
        for (int k = ks; k < 2048; k += 16) {
            const f32x4 w = __builtin_nontemporal_load((const f32x4*)(W + (size_t)k * 12288));
#pragma unroll
            for (int b = 0; b < 4; ++b) { const float s = sl[b * 2048 + k];
#pragma unroll
                for (int j = 0; j < 4; ++j) acc[b][j] += s * w[j]; }
        }
#pragma unroll
        for (int b = 0; b < 4; ++b)
#pragma unroll
            for (int j = 0; j < 4; ++j) red[((b * 4 + j) * 16 + ks) * 32 + cl] = acc[b][j];
        __syncthreads();
        { const int b = tid >> 7, col = tid & 127; float s = 0.f;
#pragma unroll
          for (int q = 0; q < 16; ++q) s += red[((b * 4 + (col & 3)) * 16 + q) * 32 + (col >> 2)];
          mod[(size_t)(l * 4 + b) * 12288 + cc * 128 + col] = s + p.in[4][(size_t)l * 12288 + cc * 128 + col]; }
        __syncthreads();
    }
}
__device__ __forceinline__ void ph_tables(const Params& p, LAS unsigned char* lds) {
    const int tid = opaque_tid();
    const int gt = blockIdx.x * 512 + tid, ngt = gridDim.x * 512;
    LAS float* ct = (LAS float*)lds;
    LAS float* c64 = ct + 2048;
    for (int m = tid; m < 2048; m += 512) ct[m] = cospif((float)m * (1.f / 1024.f));
    if (tid < 64) { c64[tid] = cospif((float)tid * (1.f / 32.f)); c64[64 + tid] = sinpif((float)tid * (1.f / 32.f)); }
    __syncthreads();
    float* rc = (float*)(p.ws + WS_ROPE); float* rs = rc + NT * 8;
    const int* pos = (const int*)p.in[2];
    for (int i = gt; i < NT * 8; i += ngt) {
        const int t = i >> 3, j = i & 7;
        float inv;
        switch (j) { case 0: inv = 1.0f; break; case 1: inv = 0.1939227432012558f; break; case 2: inv = 0.03760603070259094f; break; case 3: inv = 0.007292664609849453f; break;
                     case 4: inv = 0.0014142135623842478f; break; case 5: inv = 0.00027424818836152554f; break; case 6: inv = 5.318296098266728e-05f; break; default: inv = 1.0313386155758053e-05f; break; }
        const float ang = (float)pos[t] * inv;
        double r = (double)ang * 0.15915494309189535; r -= floor(r);
        const float a = (float)(2.0 * r);
        rc[i] = cospif(a); rs[i] = sinpif(a);
    }
    { bf16_t* sw = (bf16_t*)(p.ws + WS_SGUW);
      for (int i = gt; i < 2 * 8 * 128 * 128 / 4; i += ngt) { const f32x4 w = *(const f32x4*)(p.in[9] + (size_t)i * 4); u32x2 o; o.x = pk2(w[0], w[1]); o.y = pk2(w[2], w[3]); *(u32x2*)(sw + (size_t)i * 4) = o; } }
    { bf16_t* wrt = (bf16_t*)(p.ws + WS_WRT);
      for (int i = gt; i < 2 * 16 * 2048; i += ngt) { const int l = i >> 15, e = (i >> 11) & 15, k = i & 2047; wrt[i] = (bf16_t)(pk2(p.in[15][((size_t)l * 2048 + k) * 16 + e], 0.f) & 0xffffu); } }
    { bf16_t* abt = (bf16_t*)(p.ws + WS_ABT);
      for (int i = gt; i < 2 * 8 * 64 * 128; i += ngt) { const int k = i & 127, d = (i >> 7) & 63, lh = i >> 13, c = k & 63; const float* fw = p.in[7] + (size_t)lh * 4096;
          float sacc = 0.f;
          for (int cp = 0; cp < 64; ++cp) sacc += c64[(k < 64 ? 0 : 64) + ((c * cp) & 63)] * fw[cp * 64 + d];
          abt[i] = (bf16_t)(pk2(sacc * 0.125f, 0.f) & 0xffffu); } }
    bf16_t* dft = (bf16_t*)(p.ws + WS_DFT);
    for (int i = gt; i < 2048 * 512; i += ngt) {
        const int sp = i >> 9, k8 = (i & 511) * 8;
        float v[8];
#pragma unroll
        for (int e = 0; e < 8; ++e) { const int k = k8 + e, part = k >> 11, s = k & 2047, m = (s * sp + part * 512) & 2047;
            v[e] = ct[m] * 0.022097086912079608f; }
        u32x4 w; w.x = pk2(v[0], v[1]); w.y = pk2(v[2], v[3]); w.z = pk2(v[4], v[5]); w.w = pk2(v[6], v[7]);
        *(u32x4*)(dft + (size_t)sp * 4096 + k8) = w;
    }
    __syncthreads();
}
struct TDesc { const float* src; bf16_t* dst; const float* ksc; int lds_, ldd; };
__device__ __forceinline__ bool tdecode(const Params& p, int it, TDesc& d) {
    if (it >= 2 * 6880) return false;
    const int l = it / 6880; int r = it % 6880;
    d.ksc = nullptr;
    if (r < 480) { const int kt = r / 30, nt = r % 30;
        d.src = p.in[6] + ((size_t)l * 2048 + kt * 128) * DIN + nt * 128; d.lds_ = DIN;
        d.dst = (nt < 4 ? (bf16_t*)(p.ws + WS_WPQ) + ((size_t)l * 512 + nt * 128) * 2048 : (bf16_t*)(p.ws + WS_WIN) + ((size_t)l * NPROJ + (nt - 4) * 128) * 2048) + kt * 128; d.ldd = 2048; return true; }
    r -= 480;
    if (r < 256) { const int kt = r / 16, nt = r % 16;
        d.src = p.in[13] + ((size_t)l * 2048 + kt * 128) * 2048 + nt * 128; d.lds_ = 2048; d.ksc = p.in[12] + (size_t)l * 2048 + kt * 128;
        d.dst = (bf16_t*)(p.ws + WS_WOUT) + ((size_t)l * 2048 + nt * 128) * 2048 + kt * 128; d.ldd = 2048; return true; }
    r -= 256;
    if (r < 4096) { const int isup = r / 2048, r2 = r % 2048, e = r2 / 128, kt = (r2 % 128) / 8, nt = r2 % 8;
        d.src = p.in[isup ? 17 : 16] + (((size_t)l * 16 + e) * 2048 + kt * 128) * 1024 + nt * 128; d.lds_ = 1024;
        d.dst = (bf16_t*)(p.ws + WS_WGU) + (((size_t)l * 16 + e) * 2048 + nt * 256 + isup * 128) * 2048 + kt * 128; d.ldd = 2048; return true; }
    r -= 4096;
    { const int e = r / 128, kt = (r % 128) / 16, nt = r % 16;
        d.src = p.in[18] + (((size_t)l * 16 + e) * 1024 + kt * 128) * 2048 + nt * 128; d.lds_ = 2048;
        d.dst = (bf16_t*)(p.ws + WS_WD) + (((size_t)l * 16 + e) * 2048 + nt * 128) * 1024 + kt * 128; d.ldd = 1024; return true; }
}
__device__ __forceinline__ void ph_weights(const Params& p, LAS unsigned char* lds, const int p0, const int p1, const int wi, const int wn) {
    const int tid = opaque_tid();
    LAS unsigned* l32 = (LAS unsigned*)lds;
    LAS bf16_t* l16 = (LAS bf16_t*)lds;
    TDesc dA0, dA1, dB0, dB1; f32x4 a0[8], a1[8], b0[8], b1[8];
#define PW_LOAD(pi, D0, D1, V0, V1, HAVE) do { HAVE = (pi) < p1; if (HAVE) { tdecode(p, 2 * (pi), D0); tdecode(p, 2 * (pi) + 1, D1); \
        _Pragma("unroll") for (int i = 0; i < 8; ++i) { const int f = tid + 512 * i, k = f >> 5, c4 = f & 31; \
            V0[i] = __builtin_nontemporal_load((const f32x4*)(D0.src + (size_t)k * D0.lds_ + c4 * 4)); V1[i] = __builtin_nontemporal_load((const f32x4*)(D1.src + (size_t)k * D1.lds_ + c4 * 4)); } } } while (0)
#define PW_TOLDS(D0, V0, V1) do { _Pragma("unroll") for (int i = 0; i < 8; ++i) { const int f = tid + 512 * i, k = f >> 5, c4 = f & 31; const float sc = D0.ksc ? D0.ksc[k] : 1.f; \
        const int sw = ((k >> 3) & 15) * 2; u32x2 w; w.x = pk2(V0[i][0] * sc, V0[i][1] * sc); w.y = pk2(V0[i][2] * sc, V0[i][3] * sc); \
        *(LAS u32x2*)(l32 + k * 64 + ((2 * c4) ^ sw)) = w; \
        u32x2 w2; w2.x = pk2(V1[i][0] * sc, V1[i][1] * sc); w2.y = pk2(V1[i][2] * sc, V1[i][3] * sc); \
        *(LAS u32x2*)(l32 + 8192 + k * 64 + ((2 * c4) ^ sw)) = w2; } } while (0)
#define PW_STORE(DS0, DS1) do { _Pragma("unroll") for (int i = 0; i < 4; ++i) { \
        const int n = (tid >> 4) + 32 * i, kc = tid & 15, cd = (n >> 1) ^ (2 * kc), hf = n & 1; \
        unsigned short e[8], g[8]; \
        _Pragma("unroll") for (int q = 0; q < 8; ++q) { e[q] = l16[((8 * kc + q) * 64 + cd) * 2 + hf]; g[q] = l16[16384 + ((8 * kc + q) * 64 + cd) * 2 + hf]; } \
        u32x4 w; w.x = e[0] | ((unsigned)e[1] << 16); w.y = e[2] | ((unsigned)e[3] << 16); w.z = e[4] | ((unsigned)e[5] << 16); w.w = e[6] | ((unsigned)e[7] << 16); \
        __builtin_nontemporal_store(w, (u32x4*)(DS0.dst + (size_t)n * DS0.ldd + 8 * kc)); \
        u32x4 w2; w2.x = g[0] | ((unsigned)g[1] << 16); w2.y = g[2] | ((unsigned)g[3] << 16); w2.z = g[4] | ((unsigned)g[5] << 16); w2.w = g[6] | ((unsigned)g[7] << 16); \
        __builtin_nontemporal_store(w2, (u32x4*)(DS1.dst + (size_t)n * DS1.ldd + 8 * kc)); } } while (0)
    int pi = p0 + wi; bool hA, hB;
    PW_LOAD(pi, dA0, dA1, a0, a1, hA);
    PW_LOAD(pi + wn, dB0, dB1, b0, b1, hB);
    while (hA) {
        { PW_TOLDS(dA0, a0, a1); __syncthreads(); const TDesc s0 = dA0, s1 = dA1; PW_LOAD(pi + 2 * wn, dA0, dA1, a0, a1, hA); PW_STORE(s0, s1); __syncthreads(); }
        if (!hB) break;
        { PW_TOLDS(dB0, b0, b1); __syncthreads(); const TDesc s0 = dB0, s1 = dB1; PW_LOAD(pi + 3 * wn, dB0, dB1, b0, b1, hB); PW_STORE(s0, s1); __syncthreads(); }
        pi += 2 * wn;
    }
#undef PW_LOAD
#undef PW_TOLDS
#undef PW_STORE
}

__device__ __forceinline__ void ph_norm1(const Params& p, int mode) {
    const int tid = opaque_tid(), lane = tid & 63, wv = tid >> 6;
    const float* mod = (const float*)(p.ws + WS_MOD);
    const int* slot_of = (const int*)(p.ws + WS_IDX + 131072);
    const bf16_t* EO = (const bf16_t*)(p.ws + WS_EO);
    for (int t4 = (blockIdx.x * 8 + wv) * 4; t4 < NT; t4 += gridDim.x * 32) {
        const int b = t4 >> 11;
        u32x2 xw[4][8]; int myslot[4];
        const bf16_t* xr = (const bf16_t*)(p.ws + WS_X2) + (size_t)t4 * DM;
#pragma unroll
        for (int q = 0; q < 4; ++q) {
            myslot[q] = slot_of[(size_t)(lane & 15) * NT + t4 + q];
#pragma unroll
            for (int j = 0; j < 8; ++j) xw[q][j] = *(const u32x2*)(xr + (size_t)q * DM + 4 * lane + 256 * j);
        }
        const float* gf = mod + ((size_t)(mode - 1) * 4 + b) * 12288 + 5 * 2048;
#pragma unroll
        for (int q = 0; q < 4; ++q) {
            const int t = t4 + q;
            f32x4 macc[8];
#pragma unroll
            for (int j = 0; j < 8; ++j) macc[j] = (f32x4){0.f, 0.f, 0.f, 0.f};
            unsigned m = (unsigned)(__ballot(myslot[q] >= 0) & 0xffffull);
            while (m) {
                const int e0 = __builtin_ctz(m); m &= m - 1u;
                const bool two = m != 0u; const int e1 = two ? __builtin_ctz(m) : e0; if (two) m &= m - 1u;
                const int s0 = __builtin_amdgcn_readlane(myslot[q], e0), s1 = __builtin_amdgcn_readlane(myslot[q], e1);
                const float w1 = two ? 1.f : 0.f;
                const bf16_t* r0 = EO + (size_t)s0 * DM; const bf16_t* r1 = EO + (size_t)s1 * DM;
                u32x2 a[8], c[8];
#pragma unroll
                for (int j = 0; j < 8; ++j) { a[j] = *(const u32x2*)(r0 + 4 * lane + 256 * j); c[j] = *(const u32x2*)(r1 + 4 * lane + 256 * j); }
#pragma unroll
                for (int j = 0; j < 8; ++j) {
                    macc[j][0] += bflo(a[j].x) + w1 * bflo(c[j].x); macc[j][1] += bfhi(a[j].x) + w1 * bfhi(c[j].x);
                    macc[j][2] += bflo(a[j].y) + w1 * bflo(c[j].y); macc[j][3] += bfhi(a[j].y) + w1 * bfhi(c[j].y); }
            }
            f32x4 v[8];
#pragma unroll
            for (int j = 0; j < 8; ++j) { const f32x4 g = *(const f32x4*)(gf + 4 * lane + 256 * j);
                v[j] = (f32x4){bflo(xw[q][j].x), bfhi(xw[q][j].x), bflo(xw[q][j].y), bfhi(xw[q][j].y)} + g * macc[j]; }
            if (mode == 1) {
                bf16_t* xo = (bf16_t*)(p.ws + WS_X) + (size_t)t * DM;
#pragma unroll
                for (int j = 0; j < 8; ++j) { u32x2 w; w.x = pk2(v[j][0], v[j][1]); w.y = pk2(v[j][2], v[j][3]); *(u32x2*)(xo + 4 * lane + 256 * j) = w;
                    v[j] = (f32x4){bflo(w.x), bfhi(w.x), bflo(w.y), bfhi(w.y)}; }
            }
            float ss = 0.f;
#pragma unroll
            for (int j = 0; j < 8; ++j) ss += v[j][0] * v[j][0] + v[j][1] * v[j][1] + v[j][2] * v[j][2] + v[j][3] * v[j][3];
            const float r = 1.0f / sqrtf(wave_sum(ss) * (1.f / DM) + EPS);
            if (mode == 2) {
                float* o = p.out + (size_t)t * DM;
#pragma unroll
                for (int j = 0; j < 8; ++j) { const f32x4 g = *(const f32x4*)(p.in[19] + 4 * lane + 256 * j); *(f32x4*)(o + 4 * lane + 256 * j) = v[j] * r * g; }
            } else {
                const float* g1 = p.in[5] + (size_t)DM;
                const float* sh = mod + ((size_t)4 + b) * 12288;
                const float* sc = sh + 2048;
                bf16_t* ho = (bf16_t*)(p.ws + WS_H) + (size_t)t * DM;
#pragma unroll
                for (int j = 0; j < 8; ++j) {
                    const f32x4 g = *(const f32x4*)(g1 + 4 * lane + 256 * j), s1 = *(const f32x4*)(sc + 4 * lane + 256 * j), s0 = *(const f32x4*)(sh + 4 * lane + 256 * j);
                    const f32x4 h = (v[j] * r * g) * (s1 + 1.f) + s0;
                    u32x2 w; w.x = pk2(h[0], h[1]); w.y = pk2(h[2], h[3]);
                    *(u32x2*)(ho + 4 * lane + 256 * j) = w;
                }
            }
        }
    }
}

__device__ __forceinline__ void ph_norm1_l0(const Params& p) {
    const int tid = opaque_tid(), lane = tid & 63, wv = tid >> 6;
    const float* mod = (const float*)(p.ws + WS_MOD);
    const float* g1 = p.in[5];
    for (int t4 = (blockIdx.x * 8 + wv) * 4; t4 < NT; t4 += gridDim.x * 32) {
        const int b = t4 >> 11;
        const float* xr = p.in[0] + (size_t)t4 * DM;
        f32x4 v[4][8];
#pragma unroll
        for (int q = 0; q < 4; ++q)
#pragma unroll
            for (int j = 0; j < 8; ++j) v[q][j] = *(const f32x4*)(xr + (size_t)q * DM + 4 * lane + 256 * j);
        float sq[4] = {0.f, 0.f, 0.f, 0.f};
#pragma unroll
        for (int q = 0; q < 4; ++q)
#pragma unroll
            for (int j = 0; j < 8; ++j) sq[q] += v[q][j][0] * v[q][j][0] + v[q][j][1] * v[q][j][1] + v[q][j][2] * v[q][j][2] + v[q][j][3] * v[q][j][3];
#pragma unroll
        for (int o = 1; o < 64; o <<= 1)
#pragma unroll
            for (int q = 0; q < 4; ++q) sq[q] += __shfl_xor(sq[q], o);
        float rq[4];
#pragma unroll
        for (int q = 0; q < 4; ++q) rq[q] = 1.0f / sqrtf(sq[q] * (1.f / DM) + EPS);
        const float* sh = mod + (size_t)b * 12288;
        const float* sc = sh + 2048;
        bf16_t* ho = (bf16_t*)(p.ws + WS_H) + (size_t)t4 * DM;
#pragma unroll
        for (int j = 0; j < 8; ++j) {
            const f32x4 g = *(const f32x4*)(g1 + 4 * lane + 256 * j), s1 = *(const f32x4*)(sc + 4 * lane + 256 * j), s0 = *(const f32x4*)(sh + 4 * lane + 256 * j);
            const f32x4 gg = g * (s1 + 1.f);
#pragma unroll
            for (int q = 0; q < 4; ++q) {
                const f32x4 hq = (v[q][j] * rq[q]) * gg + s0;
                u32x2 w; w.x = pk2(hq[0], hq[1]); w.y = pk2(hq[2], hq[3]);
                *(u32x2*)(ho + (size_t)q * DM + 4 * lane + 256 * j) = w;
            }
        }
    }
}

__device__ __forceinline__ void ph_norm2_router_mfma(const Params& p, int l, LAS unsigned char* lds) {
    const int tid = opaque_tid(), lane = tid & 63, wv = tid >> 6, r = lane & 31, h = lane >> 5;
    LAS float* part = (LAS float*)lds;
    LAS float* lgs = (LAS float*)(lds + 8 * 32 * 17 * 4);
    const float* mod = (const float*)(p.ws + WS_MOD);
    const float* g2 = p.in[14] + (size_t)l * DM;
    const bf16_t* WRT = (const bf16_t*)(p.ws + WS_WRT) + (size_t)l * 16 * 2048;
    bf16_t* Hb = (bf16_t*)(p.ws + WS_H);
    float* aff = (float*)(p.ws + WS_AFF);
    for (int blk = blockIdx.x; blk < NT / 32; blk += gridDim.x) {
        const int t0 = blk * 32, b = t0 >> 11;
        const float* sh = mod + ((size_t)l * 4 + b) * 12288 + 3 * 2048;
        const float* sc = sh + 2048;
        {
            const int ta = t0 + 4 * wv;
            const bf16_t* xa = (const bf16_t*)(p.ws + WS_X2) + (size_t)ta * DM;
            u32x2 xw[4][8];
#pragma unroll
            for (int q = 0; q < 4; ++q)
#pragma unroll
                for (int j = 0; j < 8; ++j) xw[q][j] = *(const u32x2*)(xa + (size_t)q * DM + 4 * lane + 256 * j);
            float sq[4] = {0.f, 0.f, 0.f, 0.f};
#pragma unroll
            for (int q = 0; q < 4; ++q)
#pragma unroll
                for (int j = 0; j < 8; ++j) { const float x0 = bflo(xw[q][j].x), x1 = bfhi(xw[q][j].x), x2 = bflo(xw[q][j].y), x3 = bfhi(xw[q][j].y); sq[q] += x0 * x0 + x1 * x1 + x2 * x2 + x3 * x3; }
#pragma unroll
            for (int o = 1; o < 64; o <<= 1)
#pragma unroll
                for (int q = 0; q < 4; ++q) sq[q] += __shfl_xor(sq[q], o);
            float rq[4];
#pragma unroll
            for (int q = 0; q < 4; ++q) rq[q] = 1.0f / sqrtf(sq[q] * (1.f / DM) + EPS);
            bf16_t* ho = Hb + (size_t)ta * DM;
#pragma unroll
            for (int j = 0; j < 8; ++j) {
                const f32x4 g = *(const f32x4*)(g2 + 4 * lane + 256 * j), s1 = *(const f32x4*)(sc + 4 * lane + 256 * j), s0 = *(const f32x4*)(sh + 4 * lane + 256 * j);
                const f32x4 gg = g * (s1 + 1.f);
#pragma unroll
                for (int q = 0; q < 4; ++q) {
                    const f32x4 x = (f32x4){bflo(xw[q][j].x), bfhi(xw[q][j].x), bflo(xw[q][j].y), bfhi(xw[q][j].y)};
                    const f32x4 hq = (x * rq[q]) * gg + s0;
                    u32x2 w; w.x = pk2(hq[0], hq[1]); w.y = pk2(hq[2], hq[3]);
                    *(u32x2*)(ho + (size_t)q * DM + 4 * lane + 256 * j) = w;
                }
            }
        }
        asm volatile("s_waitcnt vmcnt(0)" ::: "memory");
        __syncthreads();
        {
            f32x16 acc;
#pragma unroll
            for (int q = 0; q < 16; ++q) acc[q] = 0.f;
            const bf16_t* bp = Hb + (size_t)(t0 + r) * DM + 256 * wv + 8 * h;
            const bf16_t* ap = WRT + (size_t)(r & 15) * 2048 + 256 * wv + 8 * h;
            bf16x8 bfr[16], afr[16];
#pragma unroll
            for (int s = 0; s < 16; ++s) { bfr[s] = *(const bf16x8*)(bp + 16 * s); afr[s] = *(const bf16x8*)(ap + 16 * s); }
#pragma unroll
            for (int s = 0; s < 16; ++s) { const bf16x8 a = (r < 16) ? afr[s] : (bf16x8){0, 0, 0, 0, 0, 0, 0, 0}; acc = __builtin_amdgcn_mfma_f32_32x32x16_bf16(a, bfr[s], acc, 0, 0, 0); }
#pragma unroll
            for (int q = 0; q < 8; ++q) { const int e = (q & 3) + 8 * (q >> 2) + 4 * h; part[(wv * 32 + r) * 17 + e] = acc[q]; }
        }
        __syncthreads();
        const int e = tid >> 5, tk = tid & 31;
        { float s = 0.f;
#pragma unroll
          for (int w = 0; w < 8; ++w) s += part[(w * 32 + tk) * 17 + e];
          lgs[e * 32 + tk] = s; }
        __syncthreads();
        { float lg[16]; float mx = -1e30f;
#pragma unroll
          for (int q = 0; q < 16; ++q) { lg[q] = lgs[q * 32 + tk]; mx = fmaxf(mx, lg[q]); }
          float den = 0.f, mine = 0.f;
#pragma unroll
          for (int q = 0; q < 16; ++q) { const float ex = expf(lg[q] - mx); den += ex; mine = (q == e) ? ex : mine; }
          aff[((size_t)b * 16 + e) * 2048 + (t0 & 2047) + tk] = mine / den; }
        __syncthreads();
    }
}

__device__ __forceinline__ unsigned block_excl_scan(unsigned cnt, LAS unsigned* wsum, int tid) {
    const int lane = tid & 63, wv = tid >> 6;
    unsigned inc = cnt;
#pragma unroll
    for (int o = 1; o < 64; o <<= 1) { const unsigned t = __shfl_up(inc, o); if (lane >= o) inc += t; }
    if (lane == 63) wsum[wv] = inc;
    __syncthreads();
    unsigned base = 0;
#pragma unroll
    for (int w = 0; w < 8; ++w) base += (w < wv) ? wsum[w] : 0u;
    __syncthreads();
    return base + inc - cnt;
}
__device__ __forceinline__ void ph_topk(const Params& p, LAS unsigned char* lds) {
    const int tid = opaque_tid();
    LAS unsigned* hist = (LAS unsigned*)lds;
    LAS unsigned* misc = hist + 256;
    LAS unsigned* wsum = hist + 320;
    const float* aff = (const float*)(p.ws + WS_AFF);
    int* idx = (int*)(p.ws + WS_IDX); float* gate = (float*)(p.ws + WS_IDX + 65536); int* slot_of = (int*)(p.ws + WS_IDX + 131072);
    for (int u = blockIdx.x; u < 64; u += gridDim.x) {
        const int b = u >> 4, e = u & 15;
        const f32x4 a = *(const f32x4*)(aff + (size_t)u * 2048 + 4 * tid);
        unsigned k[4];
#pragma unroll
        for (int i = 0; i < 4; ++i) k[i] = __float_as_uint(a[i]);
        unsigned prefix = 0, krem = CAP;
#pragma unroll 1
        for (int pass = 0; pass < 4; ++pass) {
            const int shift = 24 - 8 * pass;
            if (tid < 256) hist[tid] = 0;
            __syncthreads();
#pragma unroll
            for (int i = 0; i < 4; ++i) if (pass == 0 || (k[i] >> (shift + 8)) == prefix) __hip_atomic_fetch_add(&hist[(k[i] >> shift) & 255u], 1u, __ATOMIC_RELAXED, __HIP_MEMORY_SCOPE_WORKGROUP);
            __syncthreads();
            { const unsigned cnt = (tid < 256) ? hist[255 - tid] : 0u;
              const unsigned Sn = block_excl_scan(cnt, wsum, tid), S = Sn + cnt;
              if (tid < 256 && S >= krem && Sn < krem) { misc[0] = (prefix << 8) | (unsigned)(255 - tid); misc[1] = krem - Sn; } }
            __syncthreads();
            prefix = misc[0]; krem = misc[1];
            __syncthreads();
        }
        unsigned neq = 0;
#pragma unroll
        for (int i = 0; i < 4; ++i) neq += (k[i] == prefix) ? 1u : 0u;
        unsigned eqbase = block_excl_scan(neq, wsum, tid);
        unsigned sel[4]; unsigned nsel = 0;
#pragma unroll
        for (int i = 0; i < 4; ++i) { const bool eq = k[i] == prefix; sel[i] = (k[i] > prefix || (eq && eqbase < krem)) ? 1u : 0u; eqbase += eq ? 1u : 0u; nsel += sel[i]; }
        unsigned sb = block_excl_scan(nsel, wsum, tid);
#pragma unroll
        for (int i = 0; i < 4; ++i) {
            const int s = 4 * tid + i, t = b * 2048 + s;
            if (sel[i]) { const int row = e * 1024 + b * 256 + (int)sb; idx[row] = t; gate[row] = a[i]; slot_of[(size_t)e * NT + t] = row; ++sb; }
            else slot_of[(size_t)e * NT + t] = -1;
        }
        __syncthreads();
    }
}

__device__ __forceinline__ bf16x8 pack8(float a0, float a1, float a2, float a3, float a4, float a5, float a6, float a7) {
    u32x4 p;
    asm volatile("v_cvt_pk_bf16_f32 %0, %4, %5\n\tv_cvt_pk_bf16_f32 %1, %6, %7\n\tv_cvt_pk_bf16_f32 %2, %8, %9\n\tv_cvt_pk_bf16_f32 %3, %10, %11\n\ts_nop 1"
                 : "=&v"(p[0]), "=&v"(p[1]), "=&v"(p[2]), "=&v"(p[3]) : "v"(a0), "v"(a1), "v"(a2), "v"(a3), "v"(a4), "v"(a5), "v"(a6), "v"(a7));
    return __builtin_bit_cast(bf16x8, p);
}
template <int CH>
__device__ __forceinline__ void attn_prefetch(const bf16_t* qp, const bf16_t* kb, const size_t kst, const int lk0, const int ls, const int r, bf16x8 (&qf)[4], bf16x8 (&kf0)[CH][4]) {
#pragma unroll
    for (int s = 0; s < 4; ++s) qf[s] = *(const bf16x8*)(qp + 16 * s);
#pragma unroll
    for (int i = 0; i < CH; ++i) {
        int lkr = lk0 + 32 * i + r; lkr = lkr < 0 ? 0 : (lkr >= ls ? ls - 1 : lkr);
        const bf16_t* kp = kb + (size_t)lkr * kst;
#pragma unroll
        for (int s = 0; s < 4; ++s) kf0[i][s] = *(const bf16x8*)(kp + 16 * s);
    }
}
template <int NTILES, int CH, bool SYNC = true, bool KLDS = false>
__device__ __forceinline__ void attn_wave(const bf16x8 (&qf)[4], const bf16x8 (&kf0)[CH][4], const bf16_t* kb, const size_t kst, const int lk0, const int ls, const LAS bf16_t* vt, const int vts,
                                          float m_run, float l_run, f32x16& O0, f32x16& O1, float& m_out, float& l_out, const int r, const int h, const LAS bf16_t* kl = nullptr, const int kls = 0) {
#pragma unroll
    for (int i = 0; i < 16; ++i) { O0[i] = 0.f; O1[i] = 0.f; }
#pragma unroll
    for (int c0 = 0; c0 < NTILES; c0 += CH) {
        constexpr int dummy = 0; (void)dummy;
        f32x16 S[CH];
#pragma unroll
        for (int ii = 0; ii < CH; ++ii) {
            const int i = c0 + ii;
            if (i < NTILES) {
                int lkr = lk0 + 32 * i + r; lkr = lkr < 0 ? 0 : (lkr >= ls ? ls - 1 : lkr);
                const bf16_t* kp = kb + (size_t)lkr * kst;
                f32x16 a;
#pragma unroll
                for (int q = 0; q < 16; ++q) a[q] = 0.f;
#pragma unroll
                for (int s = 0; s < 4; ++s) {
                    bf16x8 kf;
                    if constexpr (KLDS) kf = *(const LAS bf16x8*)(kl + i * 32 * kls + 16 * s);
                    else { if (c0 == 0) kf = kf0[ii][s]; else kf = *(const bf16x8*)(kp + 16 * s); }
                    a = __builtin_amdgcn_mfma_f32_32x32x16_bf16(kf, qf[s], a, 0, 0, 0);
                }
                S[ii] = a;
            }
        }
        float mx = m_run;
#pragma unroll
        for (int ii = 0; ii < CH; ++ii) {
            const int i = c0 + ii;
            if (i < NTILES) {
                const bool edge = (lk0 + 32 * i < 0) || (lk0 + 32 * i + 32 > ls);
                if (edge || i == 0 || i == NTILES - 1) {
#pragma unroll
                    for (int q = 0; q < 16; ++q) {
                        const int row = (q & 3) + 8 * (q >> 2) + 4 * h;
                        const int lk = lk0 + 32 * i + row;
                        bool valid = (lk >= 0) && (lk < ls);
                        if (i == 0) valid = valid && (row >= r);
                        if (i == NTILES - 1) valid = valid && (row <= r);
                        const float sv = valid ? S[ii][q] : -1e30f;
                        S[ii][q] = sv;
                        mx = fmaxf(mx, sv);
                    }
                } else {
#pragma unroll
                    for (int q = 0; q < 16; ++q) mx = fmaxf(mx, S[ii][q]);
                }
            }
        }
        mx = fmaxf(mx, __shfl_xor(mx, 32));
        const float corr = __builtin_amdgcn_exp2f((m_run - mx) * 1.442695041f);
        float psum = 0.f;
#pragma unroll
        for (int ii = 0; ii < CH; ++ii) {
            const int i = c0 + ii;
            if (i < NTILES) {
#pragma unroll
                for (int q = 0; q < 16; ++q) { const float pv = __builtin_amdgcn_exp2f((S[ii][q] - mx) * 1.442695041f); S[ii][q] = pv; psum += pv; }
            }
        }
        psum += __shfl_xor(psum, 32);
        l_run = l_run * corr + psum;
        m_run = mx;
        if (c0 > 0) {
#pragma unroll
            for (int q = 0; q < 16; ++q) { O0[q] *= corr; O1[q] *= corr; }
        } else { if (SYNC) __syncthreads(); }
#pragma unroll
        for (int ii = 0; ii < CH; ++ii) {
            const int i = c0 + ii;
            if (i < NTILES) {
#pragma unroll
                for (int sp = 0; sp < 2; ++sp) {
                    const bf16x8 pf = pack8(S[ii][8 * sp + 0], S[ii][8 * sp + 1], S[ii][8 * sp + 2], S[ii][8 * sp + 3], S[ii][8 * sp + 4], S[ii][8 * sp + 5], S[ii][8 * sp + 6], S[ii][8 * sp + 7]);
                    const LAS bf16_t* v0 = vt + 32 * i + 16 * sp;
                    { const u32x2 a0 = *(const LAS u32x2*)(v0), a1 = *(const LAS u32x2*)(v0 + 8);
                      const u32x4 vw = (u32x4){a0.x, a0.y, a1.x, a1.y};
                      O0 = __builtin_amdgcn_mfma_f32_32x32x16_bf16(__builtin_bit_cast(bf16x8, vw), pf, O0, 0, 0, 0); }
                    { const u32x2 a0 = *(const LAS u32x2*)(v0 + 32 * vts), a1 = *(const LAS u32x2*)(v0 + 32 * vts + 8);
                      const u32x4 vw = (u32x4){a0.x, a0.y, a1.x, a1.y};
                      O1 = __builtin_amdgcn_mfma_f32_32x32x16_bf16(__builtin_bit_cast(bf16x8, vw), pf, O1, 0, 0, 0); }
                }
            }
        }
    }
    m_out = m_run; l_out = l_run;
}
__device__ __forceinline__ void ph_mixers(const Params& p, const int l, LAS unsigned char* lds) {
    constexpr int VTS = 260, VTSS = 292, KSTR = 72, ARENA = 78848, KOFF = 37376;
    const int hw = (opaque_tid() >> 8) & 1;
    const bf16_t* PROJ = (const bf16_t*)(p.ws + WS_PROJ);
    int ufirst, ucount, ustep;
    if (gridDim.x == 256) { if (blockIdx.x < 128) { ufirst = blockIdx.x * 2; ucount = 2; } else { ufirst = 256 + (blockIdx.x - 128) * 4; ucount = 4; } ustep = 1; }
    else { ufirst = blockIdx.x; ustep = gridDim.x; ucount = (768 - (int)blockIdx.x + (int)gridDim.x - 1) / (int)gridDim.x; }
    const int nsw = (256 - (int)blockIdx.x + (int)gridDim.x - 1) / (int)gridDim.x;
    const int ngm = (int)blockIdx.x < 128 ? (128 - (int)blockIdx.x + (int)gridDim.x - 1) / (int)gridDim.x : 0;
    const int nitems = ngm + nsw + ucount;
    constexpr int VTSG = 136;
    const bf16_t* SW = (const bf16_t*)(p.ws + WS_SGUW) + (size_t)l * 8 * 128 * 128;
    bf16x8 qf[4]; bf16x8 kdummy[5][4];
    for (int k = 0; k <= 2 * nitems; ++k) {
        const int tid = opaque_tid(), lane = tid & 63, w4 = (tid >> 6) & 3, tl = tid & 255, r = lane & 31, h = lane >> 5;
        LAS bf16_t* Vt = (LAS bf16_t*)(lds + hw * ARENA);
        LAS unsigned* Vt32 = (LAS unsigned*)Vt;
        LAS bf16_t* Ks = (LAS bf16_t*)(lds + hw * ARENA + KOFF);
        const int kk = k - hw, it0 = kk >> 1;
        if (kk >= 0 && it0 < nitems) {
            if (it0 < ngm) {
                const int u = blockIdx.x + it0 * gridDim.x;
                const int hg = u & 1, t0 = (u >> 1) * 128, hh2 = w4 >> 1, ph = w4 & 1, habs = hg * 4 + 2 * hw + hh2;
                if (!(kk & 1)) {
                    const int kp = tl & 63, ta = t0 + 2 * kp;
                    const float* vs = (const float*)(p.ws + WS_VSS) + (size_t)ta * 8;
                    const f32x4 sa0 = *(const f32x4*)vs, sa1 = *(const f32x4*)(vs + 4), sb0 = *(const f32x4*)(vs + 8), sb1 = *(const f32x4*)(vs + 12);
                    u32x4 va[4], vb[4]; f32x4 g0[4], g1[4];
                    const float* sn = p.in[8] + (size_t)l * 512 + hg * 256 + hw * 128;
#pragma unroll
                    for (int i = 0; i < 4; ++i) { const int dc = (tl >> 6) + 4 * i;
                        const bf16_t* src = PROJ + (size_t)ta * NPROJ + PC_V + hg * 256 + hw * 128 + 8 * dc;
                        va[i] = *(const u32x4*)src; vb[i] = *(const u32x4*)(src + NPROJ);
                        g0[i] = *(const f32x4*)(sn + 8 * dc); g1[i] = *(const f32x4*)(sn + 8 * dc + 4); }
                    const float ra = 1.0f / sqrtf((((sa0[0] + sa0[1]) + (sa0[2] + sa0[3])) + ((sa1[0] + sa1[1]) + (sa1[2] + sa1[3]))) * (1.f / 512.f) + EPS);
                    const float rb = 1.0f / sqrtf((((sb0[0] + sb0[1]) + (sb0[2] + sb0[3])) + ((sb1[0] + sb1[1]) + (sb1[2] + sb1[3]))) * (1.f / 512.f) + EPS);
#pragma unroll
                    for (int i = 0; i < 4; ++i) { const int dc = (tl >> 6) + 4 * i;
                        LAS unsigned* o = Vt32 + (8 * dc) * (VTSG / 2) + kp;
                        o[0 * (VTSG / 2)] = pk2(bflo(va[i].x) * ra * g0[i][0], bflo(vb[i].x) * rb * g0[i][0]); o[1 * (VTSG / 2)] = pk2(bfhi(va[i].x) * ra * g0[i][1], bfhi(vb[i].x) * rb * g0[i][1]);
                        o[2 * (VTSG / 2)] = pk2(bflo(va[i].y) * ra * g0[i][2], bflo(vb[i].y) * rb * g0[i][2]); o[3 * (VTSG / 2)] = pk2(bfhi(va[i].y) * ra * g0[i][3], bfhi(vb[i].y) * rb * g0[i][3]);
                        o[4 * (VTSG / 2)] = pk2(bflo(va[i].z) * ra * g1[i][0], bflo(vb[i].z) * rb * g1[i][0]); o[5 * (VTSG / 2)] = pk2(bfhi(va[i].z) * ra * g1[i][1], bfhi(vb[i].z) * rb * g1[i][1]);
                        o[6 * (VTSG / 2)] = pk2(bflo(va[i].w) * ra * g1[i][2], bflo(vb[i].w) * rb * g1[i][2]); o[7 * (VTSG / 2)] = pk2(bfhi(va[i].w) * ra * g1[i][3], bfhi(vb[i].w) * rb * g1[i][3]); }
                } else {
                    f32x16 acc[2][2];
#pragma unroll
                    for (int ct = 0; ct < 2; ++ct)
#pragma unroll
                        for (int pt = 0; pt < 2; ++pt)
#pragma unroll
                            for (int q = 0; q < 16; ++q) acc[ct][pt][q] = 0.f;
                    const LAS bf16_t* ap = Vt + (hh2 * 64 + r) * VTSG + 8 * h;
                    const bf16_t* wp = SW + ((size_t)habs * 128 + 64 * ph + r) * 128 + 8 * h;
#pragma unroll
                    for (int s2 = 0; s2 < 8; ++s2) {
                        bf16x8 afr[2], bfr[2];
#pragma unroll
                        for (int pt = 0; pt < 2; ++pt) bfr[pt] = *(const bf16x8*)(wp + (size_t)pt * 32 * 128 + 16 * s2);
#pragma unroll
                        for (int ct = 0; ct < 2; ++ct) afr[ct] = *(const LAS bf16x8*)(ap + ct * 32 * VTSG + 16 * s2);
#pragma unroll
                        for (int ct = 0; ct < 2; ++ct)
#pragma unroll
                            for (int pt = 0; pt < 2; ++pt) acc[ct][pt] = __builtin_amdgcn_mfma_f32_32x32x16_bf16(afr[ct], bfr[pt], acc[ct][pt], 0, 0, 0);
                    }
                    bf16_t* YB = (bf16_t*)(p.ws + WS_YB);
#pragma unroll
                    for (int pt = 0; pt < 2; ++pt) {
                        const int pp = 64 * ph + 32 * pt + r;
                        const float bias = p.in[10][((size_t)l * 8 + habs) * 128 + pp];
                        const bf16_t* us = PROJ + (size_t)(t0 + pp) * NPROJ + PC_U + habs * 64 + 4 * h;
                        bf16_t* o = YB + (size_t)(t0 + pp) * 512 + habs * 64 + 4 * h;
#pragma unroll
                        for (int ct = 0; ct < 2; ++ct)
#pragma unroll
                            for (int gg = 0; gg < 4; ++gg) {
                                const u32x2 uw = *(const u32x2*)(us + 32 * ct + 8 * gg);
                                u32x2 w; w.x = pk2(bflo(uw.x) * (acc[ct][pt][4 * gg] + bias), bfhi(uw.x) * (acc[ct][pt][4 * gg + 1] + bias));
                                w.y = pk2(bflo(uw.y) * (acc[ct][pt][4 * gg + 2] + bias), bfhi(uw.y) * (acc[ct][pt][4 * gg + 3] + bias));
                                *(u32x2*)(o + 32 * ct + 8 * gg) = w;
                            }
                    }
                }
            } else if (it0 < ngm + nsw) {
                const int it = it0 - ngm;
                const int u = blockIdx.x + it * gridDim.x;
                const int b = u >> 6, kvh = (u >> 5) & 1, q0 = (u & 31) * 64 + 32 * hw;
                const bf16_t* base = PROJ + (size_t)b * SEQ * NPROJ;
                const int head = kvh * 4 + w4, qpos = q0 + r, lk0 = q0 - 128;
                if (!(kk & 1)) {
                    u32x4 va[5], vb[5], kc[9];
#pragma unroll
                    for (int i = 0; i < 5; ++i) {
                        const int task = tl + 256 * i;
                        if (task < 1152) { const int kp = task % 144, dc = task / 144;
                            int kA = lk0 + 2 * kp; kA = kA < 0 ? 0 : (kA > SEQ - 2 ? SEQ - 2 : kA);
                            va[i] = *(const u32x4*)(base + (size_t)kA * NPROJ + PC_VC + kvh * 64 + 8 * dc);
                            vb[i] = *(const u32x4*)(base + (size_t)(kA + 1) * NPROJ + PC_VC + kvh * 64 + 8 * dc); }
                    }
#pragma unroll
                    for (int i = 0; i < 9; ++i) { const int id = tl + 256 * i, j = id >> 3, c8 = id & 7;
                        int kp2 = lk0 + j; kp2 = kp2 < 0 ? 0 : (kp2 >= SEQ ? SEQ - 1 : kp2);
                        kc[i] = *(const u32x4*)(base + (size_t)kp2 * NPROJ + PC_KC + kvh * 64 + 8 * c8); }
                    { const bf16_t* qp = base + (size_t)qpos * NPROJ + PC_QC + head * 64 + 8 * h;
#pragma unroll
                      for (int s2 = 0; s2 < 4; ++s2) qf[s2] = *(const bf16x8*)(qp + 16 * s2); }
#pragma unroll
                    for (int i = 0; i < 5; ++i) {
                        const int task = tl + 256 * i;
                        if (task < 1152) { const int kp = task % 144, dc = task / 144;
                            LAS unsigned* o = Vt32 + (8 * dc) * (VTSS / 2) + kp;
                            o[0 * (VTSS / 2)] = (va[i].x & 0xffffu) | (vb[i].x << 16); o[1 * (VTSS / 2)] = (va[i].x >> 16) | (vb[i].x & 0xffff0000u);
                            o[2 * (VTSS / 2)] = (va[i].y & 0xffffu) | (vb[i].y << 16); o[3 * (VTSS / 2)] = (va[i].y >> 16) | (vb[i].y & 0xffff0000u);
                            o[4 * (VTSS / 2)] = (va[i].z & 0xffffu) | (vb[i].z << 16); o[5 * (VTSS / 2)] = (va[i].z >> 16) | (vb[i].z & 0xffff0000u);
                            o[6 * (VTSS / 2)] = (va[i].w & 0xffffu) | (vb[i].w << 16); o[7 * (VTSS / 2)] = (va[i].w >> 16) | (vb[i].w & 0xffff0000u); }
                    }
#pragma unroll
                    for (int i = 0; i < 9; ++i) { const int id = tl + 256 * i, j = id >> 3, c8 = id & 7; *(LAS u32x4*)(Ks + j * KSTR + 8 * c8) = kc[i]; }
                } else {
                    const LAS bf16_t* vt = Vt + r * VTSS + 4 * h;
                    const LAS bf16_t* kl = Ks + r * KSTR + 8 * h;
                    f32x16 O0, O1; float m, lsum;
                    attn_wave<9, 5, false, true>(qf, kdummy, nullptr, (size_t)NPROJ, lk0, SEQ, vt, VTSS, p.in[11][l * 8 + head], 1.f, O0, O1, m, lsum, r, h, kl, KSTR);
                    const float inv = 1.f / lsum;
                    bf16_t* o = (bf16_t*)(p.ws + WS_YC) + ((size_t)b * SEQ + qpos) * 512 + head * 64 + 4 * h;
#pragma unroll
                    for (int gg = 0; gg < 4; ++gg) {
                        u32x2 w0; w0.x = pk2(O0[4 * gg] * inv, O0[4 * gg + 1] * inv); w0.y = pk2(O0[4 * gg + 2] * inv, O0[4 * gg + 3] * inv);
                        u32x2 w1; w1.x = pk2(O1[4 * gg] * inv, O1[4 * gg + 1] * inv); w1.y = pk2(O1[4 * gg + 2] * inv, O1[4 * gg + 3] * inv);
                        *(u32x2*)(o + 8 * gg) = w0; *(u32x2*)(o + 32 + 8 * gg) = w1;
                    }
                }
            } else {
                const int u = ufirst + (it0 - ngm - nsw) * ustep;
                const int cfg = u >> 8, r8 = u & 255, b = r8 >> 6, head = (r8 >> 3) & 7, blk = (r8 & 7) * 2 + hw;
                const int dsh = 2 * cfg, dil = 1 << dsh, ls = SEQ >> dsh, nblk = ls >> 7;
                const int res = blk / nblk, l0 = (blk % nblk) * 128;
                const bf16_t* base = PROJ + ((size_t)b * SEQ + res) * NPROJ;
                const size_t kst = (size_t)dil * NPROJ;
                const int lq = l0 + 32 * w4 + r;
                const int lk0 = l0 + 32 * w4 - 64;
                if (!(kk & 1)) {
                    u32x4 va[4], vb[4], kc[8];
#pragma unroll
                    for (int i = 0; i < 4; ++i) {
                        const int task = tl + 256 * i, kp = task & 127, dc = task >> 7;
                        int lkA = l0 - 64 + 2 * kp; lkA = lkA < 0 ? 0 : (lkA > ls - 2 ? ls - 2 : lkA);
                        va[i] = *(const u32x4*)(base + (size_t)lkA * kst + PC_VD + head * 64 + 8 * dc);
                        vb[i] = *(const u32x4*)(base + (size_t)(lkA + 1) * kst + PC_VD + head * 64 + 8 * dc);
                    }
#pragma unroll
                    for (int i = 0; i < 8; ++i) {
                        const int id = tl + 256 * i, j = id >> 3, c8 = id & 7;
                        int lk = l0 - 64 + j; lk = lk < 0 ? 0 : (lk >= ls ? ls - 1 : lk);
                        kc[i] = *(const u32x4*)(base + (size_t)lk * kst + PC_KD + head * 64 + 8 * c8);
                    }
                    { const bf16_t* qp = base + (size_t)lq * kst + PC_QD + head * 64 + 8 * h;
#pragma unroll
                      for (int s2 = 0; s2 < 4; ++s2) qf[s2] = *(const bf16x8*)(qp + 16 * s2); }
#pragma unroll
                    for (int i = 0; i < 4; ++i) {
                        const int task = tl + 256 * i, kp = task & 127, dc = task >> 7;
                        LAS unsigned* o = Vt32 + (8 * dc) * (VTS / 2) + kp;
                        o[0 * (VTS / 2)] = (va[i].x & 0xffffu) | (vb[i].x << 16); o[1 * (VTS / 2)] = (va[i].x >> 16) | (vb[i].x & 0xffff0000u);
                        o[2 * (VTS / 2)] = (va[i].y & 0xffffu) | (vb[i].y << 16); o[3 * (VTS / 2)] = (va[i].y >> 16) | (vb[i].y & 0xffff0000u);
                        o[4 * (VTS / 2)] = (va[i].z & 0xffffu) | (vb[i].z << 16); o[5 * (VTS / 2)] = (va[i].z >> 16) | (vb[i].z & 0xffff0000u);
                        o[6 * (VTS / 2)] = (va[i].w & 0xffffu) | (vb[i].w << 16); o[7 * (VTS / 2)] = (va[i].w >> 16) | (vb[i].w & 0xffff0000u);
                    }
#pragma unroll
                    for (int i = 0; i < 8; ++i) { const int id = tl + 256 * i, j = id >> 3, c8 = id & 7; *(LAS u32x4*)(Ks + j * KSTR + 8 * c8) = kc[i]; }
                } else {
                    const LAS bf16_t* vt = Vt + r * VTS + 32 * w4 + 4 * h;
                    const LAS bf16_t* kl = Ks + (32 * w4 + r) * KSTR + 8 * h;
                    f32x16 O0, O1; float m, lsm;
                    attn_wave<5, 5, false, true>(qf, kdummy, nullptr, kst, lk0, ls, vt, VTS, -1e30f, 0.f, O0, O1, m, lsm, r, h, kl, KSTR);
                    const float inv = 1.f / lsm;
                    const size_t tq = (size_t)b * SEQ + (size_t)lq * dil + res;
                    bf16_t* o = (bf16_t*)(p.ws + WS_YD) + ((size_t)cfg * NT + tq) * 512 + head * 64 + 4 * h;
#pragma unroll
                    for (int g = 0; g < 4; ++g) {
                        u32x2 w0; w0.x = pk2(O0[4 * g] * inv, O0[4 * g + 1] * inv); w0.y = pk2(O0[4 * g + 2] * inv, O0[4 * g + 3] * inv);
                        u32x2 w1; w1.x = pk2(O1[4 * g] * inv, O1[4 * g + 1] * inv); w1.y = pk2(O1[4 * g + 2] * inv, O1[4 * g + 3] * inv);
                        *(u32x2*)(o + 8 * g) = w0; *(u32x2*)(o + 32 + 8 * g) = w1;
                    }
                    if (h == 0) ((float*)(p.ws + WS_LSE))[((size_t)cfg * NT + tq) * 8 + head] = m + __logf(lsm);
                }
            }
        }
        __syncthreads();
    }
}

__device__ __forceinline__ void ph_merge(const Params& p, int l, LAS unsigned char* lds) {
    const int tid = opaque_tid(), lane = tid & 63, wv = tid >> 6, r = lane & 31, h2 = lane >> 5;
    LAS float* ssA = (LAS float*)lds;
    const bf16_t* UV = (const bf16_t*)(p.ws + WS_YA); const bf16_t* YB = (const bf16_t*)(p.ws + WS_YB); const bf16_t* YC = (const bf16_t*)(p.ws + WS_YC); const bf16_t* YD = (const bf16_t*)(p.ws + WS_YD);
    const float* LSE = (const float*)(p.ws + WS_LSE); bf16_t* YN = (bf16_t*)(p.ws + WS_YN);
    const bf16_t* ABT = (const bf16_t*)(p.ws + WS_ABT) + ((size_t)l * 8 + wv) * 64 * 128;
    for (int blk = blockIdx.x; blk < NT / 32; blk += gridDim.x) {
        const int t0 = blk * 32, b = t0 >> 11, s0 = t0 & 2047;
        f32x16 O0, O1;
        {
#pragma unroll
            for (int q = 0; q < 16; ++q) { O0[q] = 0.f; O1[q] = 0.f; }
            const size_t row = ((size_t)b * 4096 + 2 * (s0 + r)) * 512 + wv * 64 + 8 * h2;
            u32x4 u0[8], u1[8];
#pragma unroll
            for (int s = 0; s < 8; ++s) { const size_t o = row + (s >> 2) * 512 + 16 * (s & 3); u0[s] = *(const u32x4*)(UV + o); u1[s] = *(const u32x4*)(UV + (size_t)4 * 4096 * 512 + o); }
            bf16x8 af0[8], af1[8];
#pragma unroll
            for (int s = 0; s < 8; ++s) { af0[s] = *(const bf16x8*)(ABT + (size_t)r * 128 + 16 * s + 8 * h2); af1[s] = *(const bf16x8*)(ABT + (size_t)(32 + r) * 128 + 16 * s + 8 * h2); }
#pragma unroll
            for (int s = 0; s < 8; ++s) {
                const bf16x8 bfr = pack8(bflo(u0[s].x) + bflo(u1[s].x), bfhi(u0[s].x) + bfhi(u1[s].x), bflo(u0[s].y) + bflo(u1[s].y), bfhi(u0[s].y) + bfhi(u1[s].y),
                                         bflo(u0[s].z) + bflo(u1[s].z), bfhi(u0[s].z) + bfhi(u1[s].z), bflo(u0[s].w) + bflo(u1[s].w), bfhi(u0[s].w) + bfhi(u1[s].w));
                O0 = __builtin_amdgcn_mfma_f32_32x32x16_bf16(af0[s], bfr, O0, 0, 0, 0);
                O1 = __builtin_amdgcn_mfma_f32_32x32x16_bf16(af1[s], bfr, O1, 0, 0, 0);
            }
            float ss = 0.f;
#pragma unroll
            for (int q = 0; q < 16; ++q) ss += O0[q] * O0[q] + O1[q] * O1[q];
            ss += __shfl_xor(ss, 32);
            if (h2 == 0) ssA[wv * 32 + r] = ss;
        }
        {
            u32x4 lb[4], lc[4], ld0[4], ld1[4], ld2[4]; float e0[4], e1[4], e2[4];
#pragma unroll
            for (int i = 0; i < 4; ++i) {
                const int t = t0 + 4 * wv + i, head = lane >> 3;
                lb[i] = *(const u32x4*)(YB + (size_t)t * 512 + 8 * lane); lc[i] = *(const u32x4*)(YC + (size_t)t * 512 + 8 * lane);
                ld0[i] = *(const u32x4*)(YD + (size_t)t * 512 + 8 * lane); ld1[i] = *(const u32x4*)(YD + ((size_t)NT + t) * 512 + 8 * lane); ld2[i] = *(const u32x4*)(YD + ((size_t)2 * NT + t) * 512 + 8 * lane);
                e0[i] = LSE[(size_t)t * 8 + head]; e1[i] = LSE[((size_t)NT + t) * 8 + head]; e2[i] = LSE[((size_t)2 * NT + t) * 8 + head];
            }
#pragma unroll
            for (int i = 0; i < 4; ++i) {
                const int t = t0 + 4 * wv + i;
                float y[3][8];
                { const u32x4 w = lb[i];
                    y[0][0] = bflo(w.x); y[0][1] = bfhi(w.x); y[0][2] = bflo(w.y); y[0][3] = bfhi(w.y); y[0][4] = bflo(w.z); y[0][5] = bfhi(w.z); y[0][6] = bflo(w.w); y[0][7] = bfhi(w.w); }
                { const u32x4 w = lc[i];
                    y[1][0] = bflo(w.x); y[1][1] = bfhi(w.x); y[1][2] = bflo(w.y); y[1][3] = bfhi(w.y); y[1][4] = bflo(w.z); y[1][5] = bfhi(w.z); y[1][6] = bflo(w.w); y[1][7] = bfhi(w.w); }
                { const float l0 = e0[i], l1 = e1[i], l2 = e2[i];
                  const float mx = fmaxf(l0, fmaxf(l1, l2)); float w0 = __expf(l0 - mx), w1 = __expf(l1 - mx), w2 = __expf(l2 - mx); const float iv = 1.f / (w0 + w1 + w2); w0 *= iv; w1 *= iv; w2 *= iv;
                  const u32x4 a = ld0[i], bq = ld1[i], c = ld2[i];
                  y[2][0] = w0 * bflo(a.x) + w1 * bflo(bq.x) + w2 * bflo(c.x); y[2][1] = w0 * bfhi(a.x) + w1 * bfhi(bq.x) + w2 * bfhi(c.x);
                  y[2][2] = w0 * bflo(a.y) + w1 * bflo(bq.y) + w2 * bflo(c.y); y[2][3] = w0 * bfhi(a.y) + w1 * bfhi(bq.y) + w2 * bfhi(c.y);
                  y[2][4] = w0 * bflo(a.z) + w1 * bflo(bq.z) + w2 * bflo(c.z); y[2][5] = w0 * bfhi(a.z) + w1 * bfhi(bq.z) + w2 * bfhi(c.z);
                  y[2][6] = w0 * bflo(a.w) + w1 * bflo(bq.w) + w2 * bflo(c.w); y[2][7] = w0 * bfhi(a.w) + w1 * bfhi(bq.w) + w2 * bfhi(c.w); }
#pragma unroll
                for (int g = 0; g < 3; ++g) {
                    float ss = 0.f;
#pragma unroll
                    for (int q = 0; q < 8; ++q) ss += y[g][q] * y[g][q];
                    const float rr = 1.0f / sqrtf(wave_sum(ss) * (1.f / 512.f) + EPS);
                    u32x4 w; w.x = pk2(y[g][0] * rr, y[g][1] * rr); w.y = pk2(y[g][2] * rr, y[g][3] * rr); w.z = pk2(y[g][4] * rr, y[g][5] * rr); w.w = pk2(y[g][6] * rr, y[g][7] * rr);
                    *(u32x4*)(YN + (size_t)t * DM + (g + 1) * 512 + 8 * lane) = w;
                }
            }
        }
        __syncthreads();
        {
            float tot = 0.f;
#pragma unroll
            for (int w = 0; w < 8; ++w) tot += ssA[w * 32 + r];
            const float rr = 1.0f / sqrtf(tot * (1.f / 512.f) + EPS);
            bf16_t* o = YN + (size_t)(t0 + r) * DM + wv * 64 + 4 * h2;
#pragma unroll
            for (int g = 0; g < 4; ++g) {
                u32x2 w0; w0.x = pk2(O0[4 * g] * rr, O0[4 * g + 1] * rr); w0.y = pk2(O0[4 * g + 2] * rr, O0[4 * g + 3] * rr);
                u32x2 w1; w1.x = pk2(O1[4 * g] * rr, O1[4 * g + 1] * rr); w1.y = pk2(O1[4 * g + 2] * rr, O1[4 * g + 3] * rr);
                *(u32x2*)(o + 8 * g) = w0; *(u32x2*)(o + 32 + 8 * g) = w1;
            }
        }
        __syncthreads();
    }
}

#ifndef PHASE_MASK
#define PHASE_MASK 0xFFFFFFu
#endif
#define EN(k) (((PHASE_MASK) >> (k)) & 1u)
#ifndef REP_MASK
#define REP_MASK 0u
#endif
#define REP(k) _Pragma("unroll") for (int rep_ = 0; rep_ < 1 + (int)(((REP_MASK) >> (k)) & 1u); ++rep_)
constexpr int MIX_GW = 128, MIX_A = 4400;
constexpr int NPHASE = 22;
__global__ void __launch_bounds__(512, 2) mk_fwd(Params p) {
    extern __shared__ __attribute__((aligned(16))) unsigned char lds_raw[];
    LAS unsigned char* lds = (LAS unsigned char*)lds_raw;
    const int tid = threadIdx.x, G = gridDim.x, bx = blockIdx.x;
    volatile LAS unsigned* misc = (volatile LAS unsigned*)(lds + MISC_OFF);
    if (tid < 16) misc[tid] = 0u;
    __syncthreads();
    const int lo = p.ph_lo, hi = p.ph_hi;
    XcdBarrier bar; bar.bar = (unsigned*)(p.ws + WS_CTL); bar.x = 0; bar.st = misc + 8;
    if (hi - lo > 1) bar = xcd_barrier_post((unsigned*)(p.ws + WS_CTL), misc + 8);
#define IN(k) (lo <= (k) && (k) < hi)
#define SEAM(k) do { if (IN(k) && IN((k) + 1)) xcd_barrier(bar); } while (0)
    if (IN(0)) { if (EN(0)) REP(0) ph_mod(p, lds); if (EN(1)) REP(1) ph_tables(p, lds); if (EN(2)) REP(2) { if (G == 256) { if (bx >= 192) ph_weights(p, lds, 0, 240, bx - 192, 64); } else ph_weights(p, lds, 0, 6880, bx, G); } }
    SEAM(0);
    for (int l = 0; l < 2; ++l) {
        const int pb = 1 + 10 * l;
        const char* H = (const char*)(p.ws + WS_H);
        if (EN(3) && IN(pb + 0)) REP(3) { if (l == 0) ph_norm1_l0(p); else ph_norm1(p, 1); }
        SEAM(pb + 0);
        if (EN(4) && IN(pb + 1)) REP(4) {
            SchedProj S{H, (const char*)(p.ws + WS_WIN) + (size_t)l * NPROJ * 2048 * 2, (const char*)(p.ws + WS_WPQ) + (size_t)l * 512 * 2048 * 2, G, bx};
            EpiProj E{(bf16_t*)(p.ws + WS_PROJ), (bf16_t*)(p.ws + WS_PQT), (const float*)(p.ws + WS_ROPE), (const float*)(p.ws + WS_ROPE) + NT * 8};
            if (l == 0 && G == 256 && EN(2)) {
                if (bx < MIX_GW) { SchedProj S2{S.H, S.WIN, S.WPQ, MIX_GW, bx}; pg8::gemm_phase<EpiProj, SchedProj>(lds, 2048, 2048, 2048, S2, E); }
                else ph_weights(p, lds, 240, 240 + MIX_A, bx - MIX_GW, G - MIX_GW);
                __syncthreads();
                ph_weights(p, lds, 240 + MIX_A, 6880, bx, G);
            } else
            pg8::gemm_phase<EpiProj, SchedProj>(lds, 2048, 2048, 2048, S, E);
        }
        SEAM(pb + 1);
        if (IN(pb + 2)) {
            if (EN(5)) REP(5) { SchedDft S{(const char*)(p.ws + WS_DFT), (const char*)(p.ws + WS_PQT), G, bx};
              EpiBf16Plain E{(bf16_t*)(p.ws + WS_YA), 512, (size_t)4 * 4096 * 512};
              pg8::gemm_phase<EpiBf16Plain, SchedDft>(lds, 2048, 2048, 1024, S, E); }
            __syncthreads();
            if (EN(8)) REP(8) ph_mixers(p, l, lds);
        }
        SEAM(pb + 2);
        if (EN(9) && IN(pb + 3)) REP(9) { ph_merge(p, l, lds); }
        SEAM(pb + 3);
        if (EN(10) && IN(pb + 4)) REP(10) {
            SchedDense S{(const char*)(p.ws + WS_YN), (const char*)(p.ws + WS_WOUT) + (size_t)l * 2048 * 2048 * 2, 32, 8, 2048, G, bx};
            EpiWout E{l == 0 ? p.in[0] : nullptr, (const bf16_t*)(p.ws + WS_X), (bf16_t*)(p.ws + WS_X2), (const float*)(p.ws + WS_MOD) + (size_t)l * 4 * 12288 + 2 * 2048};
            pg8::gemm_phase<EpiWout, SchedDense>(lds, 2048, 2048, 2048, S, E);
        }
        SEAM(pb + 4);
        if (EN(11) && IN(pb + 5)) REP(11) { ph_norm2_router_mfma(p, l, lds); }
        SEAM(pb + 5);
        if (EN(12) && IN(pb + 6)) REP(12) { ph_topk(p, lds); }
        SEAM(pb + 6);
        if (EN(14) && IN(pb + 8)) REP(14) {
            SchedMoeG S{H, (const char*)(p.ws + WS_WGU) + (size_t)l * 16 * 2048 * 2048 * 2, 2048, G, bx};
            EpiGU E{(bf16_t*)(p.ws + WS_ACT)};
            pg8::gemm_phase<EpiGU, SchedMoeG, true>(lds, 2048, 2048, 2048, S, E, (const int*)(p.ws + WS_IDX));
        }
        SEAM(pb + 8);
        if (EN(15) && IN(pb + 9)) REP(15) {
            SchedMoe S{(const char*)(p.ws + WS_ACT), (const char*)(p.ws + WS_WD) + (size_t)l * 16 * 2048 * 1024 * 2, 1024, G, bx};
            EpiDown E{(bf16_t*)(p.ws + WS_EO), (const float*)(p.ws + WS_IDX + 65536)};
            pg8::gemm_phase<EpiDown, SchedMoe>(lds, 1024, 1024, 1024, S, E);
        }
        SEAM(pb + 9);
    }
    if (EN(16) && IN(21)) REP(16) { ph_norm1(p, 2); }
#undef IN
#undef SEAM
}

extern "C" void kernel_launch(void* const* d_in, const int* in_sizes, int n_in, void* d_out, int out_size, void* d_ws, size_t ws_size, hipStream_t stream) {
    static int grid = 0;
    if (grid == 0) {
        if (n_in != 20 || out_size != NT * DM || ws_size < WS_END) { fprintf(stderr, "kernel_launch: unexpected shapes (n_in %d out %d ws %zu)\n", n_in, out_size, ws_size); grid = -1; return; }
        int dev = 0, cus = 0, per_cu = 0;
        if (hipGetDevice(&dev) != hipSuccess || hipDeviceGetAttribute(&cus, hipDeviceAttributeMultiprocessorCount, dev) != hipSuccess) { grid = -1; return; }
        if (hipFuncSetAttribute((const void*)mk_fwd, hipFuncAttributeMaxDynamicSharedMemorySize, LDS_BYTES) != hipSuccess) { fprintf(stderr, "kernel_launch: hipFuncSetAttribute failed\n"); grid = -1; return; }
        if (hipOccupancyMaxActiveBlocksPerMultiprocessor(&per_cu, (const void*)mk_fwd, 512, LDS_BYTES) != hipSuccess || per_cu < 1) { fprintf(stderr, "kernel_launch: occupancy query says %d\n", per_cu); }
        (void)hipGetLastError();
        grid = cus;
    }
    if (grid < 0) return;
    (void)hipMemsetAsync((char*)d_ws + WS_CTL, 0, 64 * 1024, stream);
    Params p{};
    for (int i = 0; i < 20; ++i) p.in[i] = (const float*)d_in[i];
    p.out = (float*)d_out; p.ws = (unsigned char*)d_ws;
#if defined(MK_MULTI)
    for (int ph = 0; ph < NPHASE; ++ph) { p.ph_lo = ph; p.ph_hi = ph + 1; hipLaunchKernelGGL(mk_fwd, dim3(grid), dim3(512), LDS_BYTES, stream, p); }
#else
    p.ph_lo = 0; p.ph_hi = NPHASE; hipLaunchKernelGGL(mk_fwd, dim3(grid), dim3(512), LDS_BYTES, stream, p);
#endif
}
```

```cpp
#include <hip/hip_runtime.h>
#include <cstdio>
#include <cstdint>

#define LAS __attribute__((address_space(3)))
typedef unsigned short bf16_t;
typedef short bf16x8 __attribute__((ext_vector_type(8)));
typedef float f32x4 __attribute__((ext_vector_type(4)));
typedef float f32x2 __attribute__((ext_vector_type(2)));
typedef unsigned u32x4 __attribute__((ext_vector_type(4)));
typedef unsigned u32x2 __attribute__((ext_vector_type(2)));
typedef float f32x16 __attribute__((ext_vector_type(16)));

constexpr int NB = 4, SEQ = 2048, NT = NB * SEQ, DM = 2048, DIN = 3840, NPROJ = 3328, NE = 16, FF = 1024, CAP = 256;
constexpr float EPS = 1e-6f;
constexpr int PC_U = 0, PC_V = 512, PC_QC = 1024, PC_KC = 1536, PC_VC = 1664, PC_QD = 1792, PC_KD = 2304, PC_VD = 2816;

constexpr size_t MiB = (size_t)1 << 20;
constexpr size_t WS_CTL = 0;
constexpr size_t WS_MOD = 1 * MiB;
constexpr size_t WS_ROPE = WS_MOD + 512 * 1024;
constexpr size_t WS_DFT = 2 * MiB;
constexpr size_t WS_WIN = 18 * MiB;
constexpr size_t WS_WPQ = 44 * MiB;
constexpr size_t WS_WOUT = 52 * MiB;
constexpr size_t WS_WGU = 68 * MiB;
constexpr size_t WS_WD = 324 * MiB;
constexpr size_t WS_X = 452 * MiB;
constexpr size_t WS_X2 = 516 * MiB;
constexpr size_t WS_H = 580 * MiB;
constexpr size_t WS_PROJ = 612 * MiB;
constexpr size_t WS_PQT = 664 * MiB;
constexpr size_t WS_YA = 680 * MiB;
constexpr size_t WS_YB = 712 * MiB;
constexpr size_t WS_YC = 720 * MiB;
constexpr size_t WS_YD = 728 * MiB;
constexpr size_t WS_LSE = 752 * MiB;
constexpr size_t WS_YN = 753 * MiB;
constexpr size_t WS_AFF = 785 * MiB;
constexpr size_t WS_IDX = 786 * MiB;
constexpr size_t WS_XE = 787 * MiB;
constexpr size_t WS_ACT = 851 * MiB;
constexpr size_t WS_EO = 883 * MiB;
constexpr size_t WS_SGUW = 947 * MiB;
constexpr size_t WS_WRT = WS_SGUW + 512 * 1024;
constexpr size_t WS_ABT = WS_WRT + 128 * 1024;
constexpr size_t WS_VSS = WS_ABT + 256 * 1024;
constexpr size_t WS_END = 948 * MiB;

constexpr int LDS_BYTES = 163840;
constexpr int MISC_OFF = LDS_BYTES - 256;

struct Params { const float* in[20]; float* out; unsigned char* ws; int ph_lo, ph_hi; };

__device__ __forceinline__ unsigned pk2(float lo, float hi) { unsigned r; asm("v_cvt_pk_bf16_f32 %0, %1, %2" : "=v"(r) : "v"(lo), "v"(hi)); return r; }
__device__ __forceinline__ float bflo(unsigned u) { return __uint_as_float(u << 16); }
__device__ __forceinline__ float bfhi(unsigned u) { return __uint_as_float(u & 0xffff0000u); }
__device__ __forceinline__ float wave_sum(float v) {
#pragma unroll
    for (int o = 1; o < 64; o <<= 1) v += __shfl_xor(v, o);
    return v;
}
__device__ __forceinline__ float gelu_tanh(float x) { const float u = 0.7978845608f * (x + 0.044715f * x * x * x); return x * __builtin_amdgcn_rcpf(1.f + __builtin_amdgcn_exp2f(-2.885390082f * u)); }
__device__ __forceinline__ float silu_f(float x) { return x * __builtin_amdgcn_rcpf(1.f + __builtin_amdgcn_exp2f(-1.442695041f * x)); }

__device__ __forceinline__ int opaque_tid() { int t = threadIdx.x; asm volatile("" : "+v"(t)); return t; }
#define XB_TMO      128
#define XB_XCNT(j)  (256  + 64 * (j))
#define XB_XSUB(j)  (1280 + 64 * (j))
#define XB_XGEN(j)  (2304 + 64 * (j))
#define XB_TOP      3328
#define XB_TOPGEN   3392
#define XCD_BAR_WORDS 3456
#define XB_SPIN_CAP (1u << 18)
__device__ __forceinline__ unsigned xb_ld(unsigned* p)              { return __hip_atomic_load(p, __ATOMIC_RELAXED, __HIP_MEMORY_SCOPE_AGENT); }
__device__ __forceinline__ unsigned xb_add(unsigned* p, unsigned v) { return __hip_atomic_fetch_add(p, v, __ATOMIC_RELAXED, __HIP_MEMORY_SCOPE_AGENT); }
__device__ __forceinline__ unsigned xb_xcc_id() { return (unsigned)__builtin_amdgcn_s_getreg((3 << 11) | 20) & 0xFu; }
#define XB_SPIN(cond, bar) do { unsigned _sp = 0; while (cond) { __builtin_amdgcn_s_sleep(1); \
    if ((++_sp & 255u) == 0u) { if (xb_ld(&(bar)[XB_TMO])) break; if (_sp > XB_SPIN_CAP) { atomicAdd(&(bar)[XB_TMO], 1u); break; } } } } while (0)
struct XcdBarrier { unsigned* bar; unsigned x; volatile LAS unsigned* st; };
__device__ __forceinline__ XcdBarrier xcd_barrier_post(unsigned* bar, volatile LAS unsigned* st) {
    XcdBarrier b; b.bar = bar; b.x = xb_xcc_id(); b.st = st;
    if (threadIdx.x == 0) (void)xb_add(&bar[XB_XCNT(b.x)], 1u);
    return b;
}
__device__ __forceinline__ void xcd_barrier_complete(unsigned* bar, unsigned x, unsigned& nloc, unsigned& nx) {
    const unsigned G = gridDim.x * gridDim.y * gridDim.z;
    unsigned sum, cnt, mine, sp = 0u;
    for (;;) {
        sum = 0u; cnt = 0u; mine = 0u;
#pragma unroll
        for (unsigned j = 0; j < 16; ++j) { const unsigned c = xb_ld(&bar[XB_XCNT(j)]); sum += c; cnt += (c > 0u) ? 1u : 0u; mine = (j == x) ? c : mine; }
        if (sum == G) break;
        __builtin_amdgcn_s_sleep(1);
        if ((++sp & 255u) == 0u) { if (xb_ld(&bar[XB_TMO])) break; if (sp > XB_SPIN_CAP) { atomicAdd(&bar[XB_TMO], 1u); break; } }
    }
    nloc = mine > 0u ? mine : 1u; nx = cnt > 0u ? cnt : 1u;
}
__device__ __forceinline__ void xcd_barrier(const XcdBarrier& b) {
    asm volatile("s_waitcnt vmcnt(0)" ::: "memory");
    __syncthreads();
    if (threadIdx.x == 0) {
        unsigned* bar = b.bar;
        __builtin_amdgcn_s_waitcnt(0);
        unsigned nloc = b.st[0], nx = b.st[1];
        if (nloc == 0u) { xcd_barrier_complete(bar, b.x, nloc, nx); b.st[0] = nloc; b.st[1] = nx; }
        const unsigned old = xb_add(&bar[XB_XSUB(b.x)], 1u);
        const unsigned gen = old / nloc;
        if (old + 1u == (gen + 1u) * nloc) {
            __builtin_amdgcn_fence(__ATOMIC_RELEASE, "agent");
            asm volatile("s_waitcnt vmcnt(0)" ::: "memory");
            const unsigned og = xb_add(&bar[XB_TOP], 1u);
            const unsigned tg = og / nx;
            if (og + 1u == (tg + 1u) * nx) xb_add(&bar[XB_TOPGEN], 1u);
            else XB_SPIN(xb_ld(&bar[XB_TOPGEN]) == tg, bar);
            __builtin_amdgcn_fence(__ATOMIC_ACQUIRE, "agent");
            xb_add(&bar[XB_XGEN(b.x)], 1u);
            asm volatile("s_waitcnt vmcnt(0)" ::: "memory");
        } else {
            XB_SPIN(xb_ld(&bar[XB_XGEN(b.x)]) == gen, bar);
            __builtin_amdgcn_fence(__ATOMIC_ACQUIRE, "agent");
            asm volatile("s_waitcnt vmcnt(0)" ::: "memory");
        }
    }
    __syncthreads();
}

namespace pg8 {
constexpr int BM = 256, BK = 64, HALF = 128, HTB = HALF * BK * 2, STAGE_BYTES = 8 * HTB;
__host__ __device__ __forceinline__ int lds_byte(int r, int c) { const int st = (r >> 4) * 2 + (c >> 5), rr = r & 15, cc = c & 31, ob = rr * 64 + cc * 2; return st * 1024 + (ob ^ (((ob >> 9) & 1) << 5)); }
__host__ __device__ __forceinline__ void stage_rc(int b, int& R, int& C) { const int st = b / 1024, sb = b % 1024, swz = sb ^ (((sb >> 9) & 1) << 5); R = (st >> 1) * 16 + swz / 64; C = (st & 1) * 32 + (swz % 64) / 2; }
__host__ __device__ __forceinline__ int perm32(int rho) { const int n = rho >> 4, i = rho & 15; return 8 * (i >> 2) + 4 * n + (i & 3); }

struct GUnit { const char* a; const char* b; int pm, pn, z; };

__device__ __forceinline__ void dense_map(int L, int nM, int nN, int& pm, int& pn) {
    const int nwg = nM * nN;
    int wgid = L; { const int q = nwg / 8, r = nwg % 8, xcd = wgid % 8, off = wgid / 8; wgid = (xcd < r ? xcd * (q + 1) : r * (q + 1) + (xcd - r) * q) + off; }
    const int nig = 8 * nN, gid = wgid / nig, fm = gid * 8, gsz = (nM - fm) < 8 ? (nM - fm) : 8;
    pm = fm + ((wgid % nig) % gsz); pn = (wgid % nig) / gsz;
}

template <class Epi, class Sched, bool GATHER = false>
__device__ __forceinline__ void gemm_phase(LAS unsigned char* lds, const int lda, const int ldb, const int K, const Sched& S, const Epi& E, const int* gidx = nullptr) {
    int tid_ = threadIdx.x; asm volatile("" : "+v"(tid_));
    const int tid = tid_, wid = __builtin_amdgcn_readfirstlane(tid >> 6), lane = tid & 63, wr = wid >> 2, wc = wid & 3, fr = lane & 15, fq = lane >> 4;
    const int nt = K / BK;
    unsigned voffB[2]; int RA[2]; unsigned CA2[2];
#pragma unroll
    for (int i = 0; i < 2; ++i) { int R, C; stage_rc(tid * 16 + i * 8192, R, C); const int Rb = Epi::PERM ? ((R & ~31) + perm32(R & 31)) : R;
        RA[i] = R; CA2[i] = (unsigned)C * 2u; voffB[i] = (unsigned)(Rb * ldb + C) * 2u; }
    const size_t kstep = (size_t)(BK * 2);
    const size_t hstepB = (size_t)HALF * ldb * 2;
    const unsigned ldsw = (unsigned)wid * 1024u;
    const int aoff = lds_byte(wr * 64 + fr, fq * 8), boff = lds_byte(wc * 32 + fr, fq * 8);
#define PG8_AOFF(of, u) do { _Pragma("unroll") for (int hh_ = 0; hh_ < 2; ++hh_) _Pragma("unroll") for (int i_ = 0; i_ < 2; ++i_) { \
        if constexpr (GATHER) of[hh_][i_] = (unsigned)gidx[(u).pm * 256 + hh_ * 128 + RA[i_]] * (unsigned)(lda * 2) + CA2[i_]; \
        else of[hh_][i_] = (unsigned)((hh_ * HALF + RA[i_]) * lda) * 2u + CA2[i_]; } } while (0)
#define PG8_SA(b, h) (((b) * 2 + (h)) * HTB)
#define PG8_SB(b, h) ((4 + (b) * 2 + (h)) * HTB)
#define PG8_STAGE(bufoff, gbase, voff) do { _Pragma("unroll") for (int _i = 0; _i < 2; ++_i) \
        __builtin_amdgcn_global_load_lds((const unsigned*)((const char*)(gbase) + (voff)[_i]), (LAS unsigned*)(lds + (bufoff) + ldsw + _i * 8192), 16, 0, 0); } while (0)
#define PG8_LDA(dst, b, h) do { _Pragma("unroll") for (int m = 0; m < 4; ++m) _Pragma("unroll") for (int k = 0; k < 2; ++k) dst[m][k] = *(const LAS bf16x8*)(lds + PG8_SA(b, h) + aoff + m * 2048 + k * 1024); } while (0)
#define PG8_LDB(dst, b, h) do { _Pragma("unroll") for (int n = 0; n < 2; ++n) _Pragma("unroll") for (int k = 0; k < 2; ++k) dst[n][k] = *(const LAS bf16x8*)(lds + PG8_SB(b, h) + boff + n * 2048 + k * 1024); } while (0)
#define PG8_MMA(ai, bj, At, Bt) do { __builtin_amdgcn_s_setprio(1); _Pragma("unroll") for (int m = 0; m < 4; ++m) _Pragma("unroll") for (int n = 0; n < 2; ++n) _Pragma("unroll") for (int k = 0; k < 2; ++k) \
        acc[ai][bj][m][n] = __builtin_amdgcn_mfma_f32_16x16x32_bf16(Bt[n][k], At[m][k], acc[ai][bj][m][n], 0, 0, 0); __builtin_amdgcn_s_setprio(0); } while (0)
#define PG8_WAIT_V(n) asm volatile("s_waitcnt vmcnt(" #n ")" ::: "memory")
#define PG8_WAIT_L(n) asm volatile("s_waitcnt lgkmcnt(" #n ")" ::: "memory")
#define PG8_BAR __builtin_amdgcn_s_barrier()
#define PG8_SCHED __builtin_amdgcn_sched_barrier(0)
    GUnit cur, nxt; int ui = 0;
    if (!S.next(0, cur)) return;
    f32x4 acc[2][2][4][2];
#pragma unroll
    for (int a = 0; a < 2; ++a)
#pragma unroll
        for (int b = 0; b < 2; ++b)
#pragma unroll
            for (int m = 0; m < 4; ++m)
#pragma unroll
                for (int n = 0; n < 2; ++n) acc[a][b][m][n] = (f32x4){0.f, 0.f, 0.f, 0.f};
    bf16x8 At[4][2], B0[2][2], B1[2][2];
    unsigned ofc[2][2], ofn[2][2];
    PG8_AOFF(ofc, cur);
#pragma unroll
    for (int hh = 0; hh < 2; ++hh)
#pragma unroll
        for (int i = 0; i < 2; ++i) ofn[hh][i] = ofc[hh][i];
    const char* cA = cur.a; const char* cB = cur.b;
    PG8_STAGE(PG8_SB(0, 0), cB, voffB); PG8_STAGE(PG8_SB(0, 1), cB + hstepB, voffB); PG8_STAGE(PG8_SA(0, 0), cA, ofc[0]); PG8_STAGE(PG8_SA(0, 1), cA, ofc[1]);
    if (wr == 1) PG8_BAR;
    PG8_WAIT_V(2); PG8_BAR;
    PG8_STAGE(PG8_SB(1, 0), cB + kstep, voffB); PG8_STAGE(PG8_SA(1, 0), cA + kstep, ofc[0]); PG8_STAGE(PG8_SB(1, 1), cB + hstepB + kstep, voffB);
    PG8_WAIT_V(6); PG8_BAR;
    for (;;) {
        const bool has_next = S.next(ui + 1, nxt);
        const char* nA = has_next ? nxt.a : cA; const char* nB = has_next ? nxt.b : cB;
        for (int t = 0; t < nt; t += 2) {
            const bool last = (t == nt - 2);
            if constexpr (GATHER) { if (last && has_next) PG8_AOFF(ofn, nxt); }
            const char* a1 = cA + (size_t)(t + 1) * kstep;
            const char* a2 = last ? nA : cA + (size_t)(t + 2) * kstep; const char* b2 = last ? nB : cB + (size_t)(t + 2) * kstep;
            const char* a3 = a2 + kstep; const char* b3 = b2 + kstep;
            unsigned o2[2][2];
#pragma unroll
            for (int hh = 0; hh < 2; ++hh)
#pragma unroll
                for (int i = 0; i < 2; ++i) { if constexpr (GATHER) o2[hh][i] = last ? ofn[hh][i] : ofc[hh][i]; else o2[hh][i] = ofc[hh][i]; }
            PG8_LDB(B0, 0, 0); PG8_LDB(B1, 0, 1); PG8_SCHED; PG8_LDA(At, 0, 0); PG8_STAGE(PG8_SA(1, 1), a1, ofc[1]);
            PG8_WAIT_V(8); PG8_WAIT_L(0); PG8_BAR; PG8_MMA(0, 0, At, B0); PG8_MMA(0, 1, At, B1); PG8_BAR; PG8_SCHED;
            PG8_LDA(At, 0, 1); PG8_STAGE(PG8_SB(0, 0), b2, voffB); PG8_STAGE(PG8_SB(0, 1), b2 + hstepB, voffB); PG8_STAGE(PG8_SA(0, 0), a2, o2[0]);
            PG8_WAIT_V(8); PG8_WAIT_L(0); PG8_BAR; PG8_MMA(1, 0, At, B0); PG8_MMA(1, 1, At, B1); PG8_BAR; PG8_SCHED;
            PG8_LDB(B0, 1, 0); PG8_LDB(B1, 1, 1); PG8_SCHED; PG8_LDA(At, 1, 0); PG8_STAGE(PG8_SA(0, 1), a2, o2[1]);
            PG8_WAIT_V(8); PG8_WAIT_L(0); PG8_BAR; PG8_MMA(0, 0, At, B0); PG8_MMA(0, 1, At, B1); PG8_BAR; PG8_SCHED;
            PG8_LDA(At, 1, 1); PG8_STAGE(PG8_SB(1, 0), b3, voffB); PG8_STAGE(PG8_SB(1, 1), b3 + hstepB, voffB); PG8_STAGE(PG8_SA(1, 0), a3, o2[0]);
            PG8_WAIT_V(8); PG8_WAIT_L(0); PG8_BAR; PG8_MMA(1, 0, At, B0); PG8_MMA(1, 1, At, B1); PG8_BAR; PG8_SCHED;
        }
        if (wr == 0) PG8_BAR;
        E(acc, cur, wr, wc, fr, fq);
        if (!has_next) break;
#pragma unroll
        for (int a = 0; a < 2; ++a)
#pragma unroll
            for (int b = 0; b < 2; ++b)
#pragma unroll
                for (int m = 0; m < 4; ++m)
#pragma unroll
                    for (int n = 0; n < 2; ++n) acc[a][b][m][n] = (f32x4){0.f, 0.f, 0.f, 0.f};
        cur = nxt; cA = nA; cB = nB; ++ui;
        if constexpr (GATHER) {
#pragma unroll
            for (int hh = 0; hh < 2; ++hh)
#pragma unroll
                for (int i = 0; i < 2; ++i) ofc[hh][i] = ofn[hh][i];
        }
        if (wr == 1) PG8_BAR;
    }
    PG8_WAIT_V(0);
    PG8_BAR;
#undef PG8_AOFF
#undef PG8_SA
#undef PG8_SB
#undef PG8_STAGE
#undef PG8_LDA
#undef PG8_LDB
#undef PG8_MMA
#undef PG8_WAIT_V
#undef PG8_WAIT_L
#undef PG8_BAR
#undef PG8_SCHED
}
}
using pg8::GUnit;

struct SchedProj {
    const char* H; const char* WIN; const char* WPQ; int G, c;
    __device__ __forceinline__ bool next(int i, GUnit& u) const {
        const int L = i * G + c; if (L >= 480) return false;
        if (L < 416) { int pm, pn; pg8::dense_map(L, 32, 13, pm, pn); u.pm = pm; u.pn = pn; u.z = 0; u.a = H + (size_t)pm * 256 * 2048 * 2; u.b = WIN + (size_t)pn * 256 * 2048 * 2; }
        else { int pm, pn; pg8::dense_map(L - 416, 2, 32, pm, pn); u.pm = pm; u.pn = pn + 64; u.z = 0; u.a = WPQ + (size_t)pm * 256 * 2048 * 2; u.b = H + (size_t)pn * 256 * 2048 * 2; }
        return true;
    }
};
struct SchedDft {
    const char* DFT; const char* XAT; int G, c;
    __device__ __forceinline__ bool next(int i, GUnit& u) const {
        const int L = i * G + c; if (L >= 256) return false;
        const int Lp = (L & 7) * 32 + (L >> 3);
        const int ks = Lp & 1, pn = (Lp >> 1) & 1, pm = (Lp >> 2) & 15, b = Lp >> 6;
        u.pm = b * 16 + pm; u.pn = pn; u.z = ks;
        u.a = DFT + ((size_t)pm * 256 * 2048 + ks * 1024) * 2; u.b = XAT + (((size_t)b * 512 + pn * 256) * 2048 + ks * 1024) * 2;
        return true;
    }
};
struct SchedDense {
    const char* A; const char* B; int nM, nN, K, G, c;
    __device__ __forceinline__ bool next(int i, GUnit& u) const {
        const int L = i * G + c; if (L >= nM * nN) return false;
        int pm, pn; pg8::dense_map(L, nM, nN, pm, pn); u.pm = pm; u.pn = pn; u.z = 0;
        u.a = A + (size_t)pm * 256 * K * 2; u.b = B + (size_t)pn * 256 * K * 2; return true;
    }
};
struct SchedMoeG {
    const char* A; const char* B; int K, G, c;
    __device__ __forceinline__ bool next(int i, GUnit& u) const {
        const int L = i * G + c; if (L >= 512) return false;
        const int Lp = (L & 7) * 64 + (L >> 3);
        const int e = Lp >> 5, r = Lp & 31, pm = r & 3, pn = r >> 2;
        u.pm = e * 4 + pm; u.pn = pn; u.z = e;
        u.a = A; u.b = B + ((size_t)e * 2048 + pn * 256) * K * 2; return true;
    }
};
struct SchedMoe {
    const char* A; const char* B; int K, G, c;
    __device__ __forceinline__ bool next(int i, GUnit& u) const {
        const int L = i * G + c; if (L >= 512) return false;
        const int Lp = (L & 7) * 64 + (L >> 3);
        const int e = Lp >> 5, r = Lp & 31, pm = r & 3, pn = r >> 2;
        u.pm = e * 4 + pm; u.pn = pn; u.z = e;
        u.a = A + ((size_t)e * 1024 + pm * 256) * K * 2; u.b = B + ((size_t)e * 2048 + pn * 256) * K * 2; return true;
    }
};

typedef f32x4 AccT[2][2][4][2];
struct EpiProj {
    static constexpr bool PERM = true;
    bf16_t* PROJ; bf16_t* PQT; const float* ropec; const float* ropes;
    __device__ __forceinline__ void operator()(const AccT& acc, const GUnit& u, int wr, int wc, int fr, int fq) const {
        if (u.pn < 64) {
            const int pn = u.pn;
            const int row0 = u.pm * 256 + wr * 64 + fr;
#pragma unroll
            for (int ai = 0; ai < 2; ++ai)
#pragma unroll
                for (int m = 0; m < 4; ++m) {
                    const int row = row0 + ai * 128 + m * 16;
                    float vsq = 0.f;
#pragma unroll
                    for (int bj = 0; bj < 2; ++bj) {
                        f32x4 v0 = acc[ai][bj][m][0], v1 = acc[ai][bj][m][1];
                        const int colt = pn * 256 + bj * 128;
                        if (pn < 4) {
#pragma unroll
                            for (int j = 0; j < 4; ++j) { v0[j] = gelu_tanh(v0[j]); v1[j] = gelu_tanh(v1[j]); vsq += v0[j] * v0[j] + v1[j] * v1[j]; }
                        } else {
                            const bool isq = (colt >= PC_QC && colt < PC_KC) || (colt >= PC_QD && colt < PC_KD);
                            const bool isk = (colt >= PC_KC && colt < PC_VC) || (colt >= PC_KD && colt < PC_VD);
                            if (isq || isk) {
                                if ((wc & 1) == 0) {
                                    f32x4 o0, o1;
#pragma unroll
                                    for (int j = 0; j < 4; ++j) { o0[j] = __shfl_xor(v0[j], 16); o1[j] = __shfl_xor(v1[j], 16); }
                                    if (fq < 2) {
                                        const f32x4 c0 = *(const f32x4*)(ropec + (size_t)row * 8), c1 = *(const f32x4*)(ropec + (size_t)row * 8 + 4);
                                        const f32x4 s0 = *(const f32x4*)(ropes + (size_t)row * 8), s1 = *(const f32x4*)(ropes + (size_t)row * 8 + 4);
                                        const float sg = fq == 0 ? -1.f : 1.f;
#pragma unroll
                                        for (int j = 0; j < 4; ++j) { v0[j] = v0[j] * c0[j] + sg * o0[j] * s0[j]; v1[j] = v1[j] * c1[j] + sg * o1[j] * s1[j]; }
                                    }
                                }
                                if (isq) { v0 = v0 * 0.125f; v1 = v1 * 0.125f; }
                            }
                        }
                        u32x4 w; w.x = pk2(v0[0], v0[1]); w.y = pk2(v0[2], v0[3]); w.z = pk2(v1[0], v1[1]); w.w = pk2(v1[2], v1[3]);
                        *(u32x4*)(PROJ + (size_t)row * NPROJ + colt + wc * 32 + 8 * fq) = w;
                    }
                    if (pn == 2 || pn == 3) {
                        vsq += __shfl_xor(vsq, 16); vsq += __shfl_xor(vsq, 32);
                        if (fq == 0) ((float*)((char*)PROJ + (WS_VSS - WS_PROJ)))[(size_t)row * 8 + (pn - 2) * 4 + wc] = vsq;
                    }
                }
        } else {
#pragma unroll
            for (int ai = 0; ai < 2; ++ai)
#pragma unroll
                for (int m = 0; m < 4; ++m) {
                    const int c = u.pm * 256 + ai * 128 + wr * 64 + m * 16 + fr;
#pragma unroll
                    for (int bj = 0; bj < 2; ++bj) {
                        const int t = (u.pn - 64) * 256 + bj * 128 + wc * 32 + 8 * fq, b = t >> 11, s = t & 2047;
                        const f32x4 v0 = acc[ai][bj][m][0], v1 = acc[ai][bj][m][1];
                        u32x4 w; w.x = pk2(v0[0], v0[1]); w.y = pk2(v0[2], v0[3]); w.z = pk2(v1[0], v1[1]); w.w = pk2(v1[2], v1[3]);
                        *(u32x4*)(PQT + (((size_t)b * 512 + c) * 2048 + s)) = w;
                    }
                }
        }
    }
};
struct EpiBf16Plain {
    static constexpr bool PERM = true;
    bf16_t* O; int ldc; size_t zstride;
    __device__ __forceinline__ void operator()(const AccT& acc, const GUnit& u, int wr, int wc, int fr, int fq) const {
        bf16_t* base = O + (size_t)u.z * zstride;
#pragma unroll
        for (int ai = 0; ai < 2; ++ai)
#pragma unroll
            for (int m = 0; m < 4; ++m) {
                const int row = u.pm * 256 + ai * 128 + wr * 64 + m * 16 + fr;
#pragma unroll
                for (int bj = 0; bj < 2; ++bj) {
                    const f32x4 v0 = acc[ai][bj][m][0], v1 = acc[ai][bj][m][1];
                    u32x4 w; w.x = pk2(v0[0], v0[1]); w.y = pk2(v0[2], v0[3]); w.z = pk2(v1[0], v1[1]); w.w = pk2(v1[2], v1[3]);
                    *(u32x4*)(base + (size_t)row * ldc + u.pn * 256 + bj * 128 + wc * 32 + 8 * fq) = w;
                }
            }
    }
};
struct EpiWout {
    static constexpr bool PERM = true;
    const float* base32; const bf16_t* base16; bf16_t* X2; const float* gate;
    __device__ __forceinline__ void operator()(const AccT& acc, const GUnit& u, int wr, int wc, int fr, int fq) const {
        const int b = u.pm >> 3;
        const int col0 = u.pn * 256 + wc * 32 + 8 * fq;
        f32x4 g[2][2];
#pragma unroll
        for (int bj = 0; bj < 2; ++bj)
#pragma unroll
            for (int n = 0; n < 2; ++n) g[bj][n] = *(const f32x4*)(gate + (size_t)b * 12288 + col0 + bj * 128 + n * 4);
#pragma unroll
        for (int ai = 0; ai < 2; ++ai)
#pragma unroll
            for (int m = 0; m < 4; ++m) {
                const size_t ro = (size_t)(u.pm * 256 + ai * 128 + wr * 64 + m * 16 + fr) * DM + col0;
#pragma unroll
                for (int bj = 0; bj < 2; ++bj) {
                    f32x4 x0, x1;
                    if (base32) { x0 = *(const f32x4*)(base32 + ro + bj * 128); x1 = *(const f32x4*)(base32 + ro + bj * 128 + 4); }
                    else { const u32x4 w = *(const u32x4*)(base16 + ro + bj * 128); x0 = (f32x4){bflo(w.x), bfhi(w.x), bflo(w.y), bfhi(w.y)}; x1 = (f32x4){bflo(w.z), bfhi(w.z), bflo(w.w), bfhi(w.w)}; }
                    const f32x4 v0 = x0 + g[bj][0] * acc[ai][bj][m][0], v1 = x1 + g[bj][1] * acc[ai][bj][m][1];
                    u32x4 o; o.x = pk2(v0[0], v0[1]); o.y = pk2(v0[2], v0[3]); o.z = pk2(v1[0], v1[1]); o.w = pk2(v1[2], v1[3]);
                    *(u32x4*)(X2 + ro + bj * 128) = o;
                }
            }
    }
};
struct EpiGU {
    static constexpr bool PERM = true;
    bf16_t* ACT;
    __device__ __forceinline__ void operator()(const AccT& acc, const GUnit& u, int wr, int wc, int fr, int fq) const {
#pragma unroll
        for (int ai = 0; ai < 2; ++ai)
#pragma unroll
            for (int m = 0; m < 4; ++m) {
                const int row = u.pm * 256 + ai * 128 + wr * 64 + m * 16 + fr;
                f32x4 v0, v1;
#pragma unroll
                for (int j = 0; j < 4; ++j) { v0[j] = silu_f(acc[ai][0][m][0][j]) * acc[ai][1][m][0][j]; v1[j] = silu_f(acc[ai][0][m][1][j]) * acc[ai][1][m][1][j]; }
                u32x4 w; w.x = pk2(v0[0], v0[1]); w.y = pk2(v0[2], v0[3]); w.z = pk2(v1[0], v1[1]); w.w = pk2(v1[2], v1[3]);
                *(u32x4*)(ACT + (size_t)row * FF + u.pn * 128 + wc * 32 + 8 * fq) = w;
            }
    }
};
struct EpiDown {
    static constexpr bool PERM = true;
    bf16_t* EO; const float* gate;
    __device__ __forceinline__ void operator()(const AccT& acc, const GUnit& u, int wr, int wc, int fr, int fq) const {
#pragma unroll
        for (int ai = 0; ai < 2; ++ai)
#pragma unroll
            for (int m = 0; m < 4; ++m) {
                const int row = u.pm * 256 + ai * 128 + wr * 64 + m * 16 + fr;
                const float g = gate[row];
#pragma unroll
                for (int bj = 0; bj < 2; ++bj) {
                    const f32x4 v0 = acc[ai][bj][m][0] * g, v1 = acc[ai][bj][m][1] * g;
                    u32x4 w; w.x = pk2(v0[0], v0[1]); w.y = pk2(v0[2], v0[3]); w.z = pk2(v1[0], v1[1]); w.w = pk2(v1[2], v1[3]);
                    *(u32x4*)(EO + (size_t)row * DM + u.pn * 256 + bj * 128 + wc * 32 + 8 * fq) = w;
                }
            }
    }
};

__device__ __forceinline__ void ph_mod(const Params& p, LAS unsigned char* lds) {
    LAS float* sl = (LAS float*)lds;
    LAS float* red = (LAS float*)(lds + 32768);
    const int tid = opaque_tid();
    const float* c = p.in[1];
    float* mod = (float*)(p.ws + WS_MOD);
    for (int i = tid; i < 8192; i += 512) { const float v = c[i]; sl[i] = v / (1.f + expf(-v)); }
    __syncthreads();
    const int cl = tid & 31, ks = tid >> 5;
    for (int u = blockIdx.x; u < 192; u += gridDim.x) {
        const int l = u / 96, cc = u % 96;
        const float* W = p.in[3] + (size_t)l * 2048 * 12288 + cc * 128 + cl * 4;
        float acc[4][4];
#pragma unroll
        for (int b = 0; b < 4; ++b)
#pragma unroll
            for (int j = 0; j < 4; ++j) acc[b][j] = 0.f;
#pragma unroll 8
        for (int k = ks; k < 2048; k += 16) {
            const f32x4 w = __builtin_nontemporal_load((const f32x4*)(W + (size_t)k * 12288));
#pragma unroll
            for (int b = 0; b < 4; ++b) { const float s = sl[b * 2048 + k];
#pragma unroll
                for (int j = 0; j < 4; ++j) acc[b][j] += s * w[j]; }
        }
#pragma unroll
        for (int b = 0; b < 4; ++b)
#pragma unroll
            for (int j = 0; j < 4; ++j) red[((b * 4 + j) * 16 + ks) * 32 + cl] = acc[b][j];
        __syncthreads();
        { const int b = tid >> 7, col = tid & 127; float s = 0.f;
#pragma unroll
          for (int q = 0; q < 16; ++q) s += red[((b * 4 + (col & 3)) * 16 + q) * 32 + (col >> 2)];
          mod[(size_t)(l * 4 + b) * 12288 + cc * 128 + col] = s + p.in[4][(size_t)l * 12288 + cc * 128 + col]; }
        __syncthreads();
    }
}
__device__ __forceinline__ void ph_tables(const Params& p, LAS unsigned char* lds) {
    const int tid = opaque_tid();
    const int gt = blockIdx.x * 512 + tid, ngt = gridDim.x * 512;
    LAS float* ct = (LAS float*)lds;
    LAS float* c64 = ct + 2048;
    for (int m = tid; m < 2048; m += 512) ct[m] = cospif((float)m * (1.f / 1024.f));
    if (tid < 64) { c64[tid] = cospif((float)tid * (1.f / 32.f)); c64[64 + tid] = sinpif((float)tid * (1.f / 32.f)); }
    __syncthreads();
    float* rc = (float*)(p.ws + WS_ROPE); float* rs = rc + NT * 8;
    const int* pos = (const int*)p.in[2];
    for (int i = gt; i < NT * 8; i += ngt) {
        const int t = i >> 3, j = i & 7;
        float inv;
        switch (j) { case 0: inv = 1.0f; break; case 1: inv = 0.1939227432012558f; break; case 2: inv = 0.03760603070259094f; break; case 3: inv = 0.007292664609849453f; break;
                     case 4: inv = 0.0014142135623842478f; break; case 5: inv = 0.00027424818836152554f; break; case 6: inv = 5.318296098266728e-05f; break; default: inv = 1.0313386155758053e-05f; break; }
        const float ang = (float)pos[t] * inv;
        double r = (double)ang * 0.15915494309189535; r -= floor(r);
        const float a = (float)(2.0 * r);
        rc[i] = cospif(a); rs[i] = sinpif(a);
    }
    { bf16_t* sw = (bf16_t*)(p.ws + WS_SGUW);
      for (int i = gt; i < 2 * 8 * 128 * 128 / 4; i += ngt) { const f32x4 w = *(const f32x4*)(p.in[9] + (size_t)i * 4); u32x2 o; o.x = pk2(w[0], w[1]); o.y = pk2(w[2], w[3]); *(u32x2*)(sw + (size_t)i * 4) = o; } }
    { bf16_t* wrt = (bf16_t*)(p.ws + WS_WRT);
      for (int i = gt; i < 2 * 16 * 2048; i += ngt) { const int l = i >> 15, e = (i >> 11) & 15, k = i & 2047; wrt[i] = (bf16_t)(pk2(p.in[15][((size_t)l * 2048 + k) * 16 + e], 0.f) & 0xffffu); } }
    { bf16_t* abt = (bf16_t*)(p.ws + WS_ABT);
      for (int i = gt; i < 2 * 8 * 64 * 128; i += ngt) { const int k = i & 127, d = (i >> 7) & 63, lh = i >> 13, c = k & 63; const float* fw = p.in[7] + (size_t)lh * 4096;
          float sacc = 0.f;
          for (int cp = 0; cp < 64; ++cp) sacc += c64[(k < 64 ? 0 : 64) + ((c * cp) & 63)] * fw[cp * 64 + d];
          abt[i] = (bf16_t)(pk2(sacc * 0.125f, 0.f) & 0xffffu); } }
    { bf16_t* a1 = (bf16_t*)(p.ws + WS_DFT);
      for (int i = gt; i < 128 * 64; i += ngt) { const int aa = i & 63, row = i >> 6, part = row >> 6, cc = row & 63; const int m = (aa * cc * 32 + part * 512) & 2047;
          a1[i] = (bf16_t)(pk2(ct[m], 0.f) & 0xffffu); }
      bf16_t* gt_ = (bf16_t*)(p.ws + WS_DFT + 16384);
      for (int i = gt; i < 64 * 64; i += ngt) { const int k = i & 63, n = i >> 6, pp = n >> 5, d = n & 31, pq = k >> 5, bb = k & 31; const int m0 = (bb * d * 64) & 2047;
          const float cs = ct[m0], sn = ct[(m0 - 512) & 2047];
          const float v = pp == 0 ? (pq == 0 ? cs : sn) : (pq == 0 ? -sn : cs);
          gt_[i] = (bf16_t)(pk2(v * 0.022097086912079608f, 0.f) & 0xffffu); }
      float* tw = (float*)(p.ws + WS_DFT + 32768);
      for (int i = gt; i < 64 * 32; i += ngt) { const int bb = i & 31, cc = i >> 5, m = bb * cc; tw[i] = ct[m & 2047]; tw[2048 + i] = ct[(m - 512) & 2047]; } }
    __syncthreads();
}
struct TDesc { const float* src; bf16_t* dst; const float* ksc; int lds_, ldd; };
__device__ __forceinline__ bool tdecode(const Params& p, int it, TDesc& d) {
    if (it >= 2 * 6880) return false;
    const int l = it / 6880; int r = it % 6880;
    d.ksc = nullptr;
    if (r < 480) { const int kt = r / 30, nt = r % 30;
        d.src = p.in[6] + ((size_t)l * 2048 + kt * 128) * DIN + nt * 128; d.lds_ = DIN;
        d.dst = (nt < 4 ? (bf16_t*)(p.ws + WS_WPQ) + ((size_t)l * 512 + nt * 128) * 2048 : (bf16_t*)(p.ws + WS_WIN) + ((size_t)l * NPROJ + (nt - 4) * 128) * 2048) + kt * 128; d.ldd = 2048; return true; }
    r -= 480;
    if (r < 256) { const int kt = r / 16, nt = r % 16;
        d.src = p.in[13] + ((size_t)l * 2048 + kt * 128) * 2048 + nt * 128; d.lds_ = 2048; d.ksc = p.in[12] + (size_t)l * 2048 + kt * 128;
        d.dst = (bf16_t*)(p.ws + WS_WOUT) + ((size_t)l * 2048 + nt * 128) * 2048 + kt * 128; d.ldd = 2048; return true; }
    r -= 256;
    if (r < 4096) { const int isup = r / 2048, r2 = r % 2048, e = r2 / 128, kt = (r2 % 128) / 8, nt = r2 % 8;
        d.src = p.in[isup ? 17 : 16] + (((size_t)l * 16 + e) * 2048 + kt * 128) * 1024 + nt * 128; d.lds_ = 1024;
        d.dst = (bf16_t*)(p.ws + WS_WGU) + (((size_t)l * 16 + e) * 2048 + nt * 256 + isup * 128) * 2048 + kt * 128; d.ldd = 2048; return true; }
    r -= 4096;
    { const int e = r / 128, kt = (r % 128) / 16, nt = r % 16;
        d.src = p.in[18] + (((size_t)l * 16 + e) * 1024 + kt * 128) * 2048 + nt * 128; d.lds_ = 2048;
        d.dst = (bf16_t*)(p.ws + WS_WD) + (((size_t)l * 16 + e) * 2048 + nt * 128) * 1024 + kt * 128; d.ldd = 1024; return true; }
}
__device__ __forceinline__ void ph_weights(const Params& p, LAS unsigned char* lds, const int p0, const int p1, const int wi, const int wn) {
    const int tid = opaque_tid();
    LAS unsigned* l32 = (LAS unsigned*)lds;
    LAS bf16_t* l16 = (LAS bf16_t*)lds;
    TDesc dA0, dA1, dB0, dB1; f32x4 a0[8], a1[8], b0[8], b1[8];
#define PW_LOAD(pi, D0, D1, V0, V1, HAVE) do { HAVE = (pi) < p1; if (HAVE) { tdecode(p, 2 * (pi), D0); tdecode(p, 2 * (pi) + 1, D1); \
        _Pragma("unroll") for (int i = 0; i < 8; ++i) { const int f = tid + 512 * i, k = f >> 5, c4 = f & 31; \
            V0[i] = __builtin_nontemporal_load((const f32x4*)(D0.src + (size_t)k * D0.lds_ + c4 * 4)); V1[i] = __builtin_nontemporal_load((const f32x4*)(D1.src + (size_t)k * D1.lds_ + c4 * 4)); } } } while (0)
#define PW_TOLDS(D0, V0, V1) do { _Pragma("unroll") for (int i = 0; i < 8; ++i) { const int f = tid + 512 * i, k = f >> 5, c4 = f & 31; const float sc = D0.ksc ? D0.ksc[k] : 1.f; \
        const int sw = ((k >> 3) & 15) * 2; u32x2 w; w.x = pk2(V0[i][0] * sc, V0[i][1] * sc); w.y = pk2(V0[i][2] * sc, V0[i][3] * sc); \
        *(LAS u32x2*)(l32 + k * 64 + ((2 * c4) ^ sw)) = w; \
        u32x2 w2; w2.x = pk2(V1[i][0] * sc, V1[i][1] * sc); w2.y = pk2(V1[i][2] * sc, V1[i][3] * sc); \
        *(LAS u32x2*)(l32 + 8192 + k * 64 + ((2 * c4) ^ sw)) = w2; } } while (0)
#define PW_STORE(DS0, DS1) do { _Pragma("unroll") for (int i = 0; i < 4; ++i) { \
        const int n = (tid >> 4) + 32 * i, kc = tid & 15, cd = (n >> 1) ^ (2 * kc), hf = n & 1; \
        unsigned short e[8], g[8]; \
        _Pragma("unroll") for (int q = 0; q < 8; ++q) { e[q] = l16[((8 * kc + q) * 64 + cd) * 2 + hf]; g[q] = l16[16384 + ((8 * kc + q) * 64 + cd) * 2 + hf]; } \
        u32x4 w; w.x = e[0] | ((unsigned)e[1] << 16); w.y = e[2] | ((unsigned)e[3] << 16); w.z = e[4] | ((unsigned)e[5] << 16); w.w = e[6] | ((unsigned)e[7] << 16); \
        __builtin_nontemporal_store(w, (u32x4*)(DS0.dst + (size_t)n * DS0.ldd + 8 * kc)); \
        u32x4 w2; w2.x = g[0] | ((unsigned)g[1] << 16); w2.y = g[2] | ((unsigned)g[3] << 16); w2.z = g[4] | ((unsigned)g[5] << 16); w2.w = g[6] | ((unsigned)g[7] << 16); \
        __builtin_nontemporal_store(w2, (u32x4*)(DS1.dst + (size_t)n * DS1.ldd + 8 * kc)); } } while (0)
    int pi = p0 + wi; bool hA, hB;
    PW_LOAD(pi, dA0, dA1, a0, a1, hA);
    PW_LOAD(pi + wn, dB0, dB1, b0, b1, hB);
    while (hA) {
        { PW_TOLDS(dA0, a0, a1); __syncthreads(); const TDesc s0 = dA0, s1 = dA1; PW_LOAD(pi + 2 * wn, dA0, dA1, a0, a1, hA); PW_STORE(s0, s1); __syncthreads(); }
        if (!hB) break;
        { PW_TOLDS(dB0, b0, b1); __syncthreads(); const TDesc s0 = dB0, s1 = dB1; PW_LOAD(pi + 3 * wn, dB0, dB1, b0, b1, hB); PW_STORE(s0, s1); __syncthreads(); }
        pi += 2 * wn;
    }
#undef PW_LOAD
#undef PW_TOLDS
#undef PW_STORE
}

__device__ __forceinline__ void ph_norm1(const Params& p, int mode) {
    const int tid = opaque_tid(), lane = tid & 63, wv = tid >> 6;
    const float* mod = (const float*)(p.ws + WS_MOD);
    const int* slot_of = (const int*)(p.ws + WS_IDX + 131072);
    const bf16_t* EO = (const bf16_t*)(p.ws + WS_EO);
    for (int t4 = (blockIdx.x * 8 + wv) * 4; t4 < NT; t4 += gridDim.x * 32) {
        const int b = t4 >> 11;
        u32x2 xw[4][8]; int myslot[4];
        const bf16_t* xr = (const bf16_t*)(p.ws + WS_X2) + (size_t)t4 * DM;
#pragma unroll
        for (int q = 0; q < 4; ++q) {
            myslot[q] = slot_of[(size_t)(lane & 15) * NT + t4 + q];
#pragma unroll
            for (int j = 0; j < 8; ++j) xw[q][j] = *(const u32x2*)(xr + (size_t)q * DM + 4 * lane + 256 * j);
        }
        const float* gf = mod + ((size_t)(mode - 1) * 4 + b) * 12288 + 5 * 2048;
#pragma unroll
        for (int q = 0; q < 4; ++q) {
            const int t = t4 + q;
            f32x4 macc[8];
#pragma unroll
            for (int j = 0; j < 8; ++j) macc[j] = (f32x4){0.f, 0.f, 0.f, 0.f};
            unsigned m = (unsigned)(__ballot(myslot[q] >= 0) & 0xffffull);
            while (m) {
                const int e0 = __builtin_ctz(m); m &= m - 1u;
                const bool two = m != 0u; const int e1 = two ? __builtin_ctz(m) : e0; if (two) m &= m - 1u;
                const int s0 = __builtin_amdgcn_readlane(myslot[q], e0), s1 = __builtin_amdgcn_readlane(myslot[q], e1);
                const float w1 = two ? 1.f : 0.f;
                const bf16_t* r0 = EO + (size_t)s0 * DM; const bf16_t* r1 = EO + (size_t)s1 * DM;
                u32x2 a[8], c[8];
#pragma unroll
                for (int j = 0; j < 8; ++j) { a[j] = *(const u32x2*)(r0 + 4 * lane + 256 * j); c[j] = *(const u32x2*)(r1 + 4 * lane + 256 * j); }
#pragma unroll
                for (int j = 0; j < 8; ++j) {
                    macc[j][0] += bflo(a[j].x) + w1 * bflo(c[j].x); macc[j][1] += bfhi(a[j].x) + w1 * bfhi(c[j].x);
                    macc[j][2] += bflo(a[j].y) + w1 * bflo(c[j].y); macc[j][3] += bfhi(a[j].y) + w1 * bfhi(c[j].y); }
            }
            f32x4 v[8];
#pragma unroll
            for (int j = 0; j < 8; ++j) { const f32x4 g = *(const f32x4*)(gf + 4 * lane + 256 * j);
                v[j] = (f32x4){bflo(xw[q][j].x), bfhi(xw[q][j].x), bflo(xw[q][j].y), bfhi(xw[q][j].y)} + g * macc[j]; }
            if (mode == 1) {
                bf16_t* xo = (bf16_t*)(p.ws + WS_X) + (size_t)t * DM;
#pragma unroll
                for (int j = 0; j < 8; ++j) { u32x2 w; w.x = pk2(v[j][0], v[j][1]); w.y = pk2(v[j][2], v[j][3]); *(u32x2*)(xo + 4 * lane + 256 * j) = w;
                    v[j] = (f32x4){bflo(w.x), bfhi(w.x), bflo(w.y), bfhi(w.y)}; }
            }
            float ss = 0.f;
#pragma unroll
            for (int j = 0; j < 8; ++j) ss += v[j][0] * v[j][0] + v[j][1] * v[j][1] + v[j][2] * v[j][2] + v[j][3] * v[j][3];
            const float r = 1.0f / sqrtf(wave_sum(ss) * (1.f / DM) + EPS);
            if (mode == 2) {
                float* o = p.out + (size_t)t * DM;
#pragma unroll
                for (int j = 0; j < 8; ++j) { const f32x4 g = *(const f32x4*)(p.in[19] + 4 * lane + 256 * j); *(f32x4*)(o + 4 * lane + 256 * j) = v[j] * r * g; }
            } else {
                const float* g1 = p.in[5] + (size_t)DM;
                const float* sh = mod + ((size_t)4 + b) * 12288;
                const float* sc = sh + 2048;
                bf16_t* ho = (bf16_t*)(p.ws + WS_H) + (size_t)t * DM;
#pragma unroll
                for (int j = 0; j < 8; ++j) {
                    const f32x4 g = *(const f32x4*)(g1 + 4 * lane + 256 * j), s1 = *(const f32x4*)(sc + 4 * lane + 256 * j), s0 = *(const f32x4*)(sh + 4 * lane + 256 * j);
                    const f32x4 h = (v[j] * r * g) * (s1 + 1.f) + s0;
                    u32x2 w; w.x = pk2(h[0], h[1]); w.y = pk2(h[2], h[3]);
                    *(u32x2*)(ho + 4 * lane + 256 * j) = w;
                }
            }
        }
    }
}

__device__ __forceinline__ void ph_norm1_l0(const Params& p) {
    const int tid = opaque_tid(), lane = tid & 63, wv = tid >> 6;
    const float* mod = (const float*)(p.ws + WS_MOD);
    const float* g1 = p.in[5];
    for (int t4 = (blockIdx.x * 8 + wv) * 4; t4 < NT; t4 += gridDim.x * 32) {
        const int b = t4 >> 11;
        const float* xr = p.in[0] + (size_t)t4 * DM;
        f32x4 v[4][8];
#pragma unroll
        for (int q = 0; q < 4; ++q)
#pragma unroll
            for (int j = 0; j < 8; ++j) v[q][j] = *(const f32x4*)(xr + (size_t)q * DM + 4 * lane + 256 * j);
        float sq[4] = {0.f, 0.f, 0.f, 0.f};
#pragma unroll
        for (int q = 0; q < 4; ++q)
#pragma unroll
            for (int j = 0; j < 8; ++j) sq[q] += v[q][j][0] * v[q][j][0] + v[q][j][1] * v[q][j][1] + v[q][j][2] * v[q][j][2] + v[q][j][3] * v[q][j][3];
#pragma unroll
        for (int o = 1; o < 64; o <<= 1)
#pragma unroll
            for (int q = 0; q < 4; ++q) sq[q] += __shfl_xor(sq[q], o);
        float rq[4];
#pragma unroll
        for (int q = 0; q < 4; ++q) rq[q] = 1.0f / sqrtf(sq[q] * (1.f / DM) + EPS);
        const float* sh = mod + (size_t)b * 12288;
        const float* sc = sh + 2048;
        bf16_t* ho = (bf16_t*)(p.ws + WS_H) + (size_t)t4 * DM;
#pragma unroll
        for (int j = 0; j < 8; ++j) {
            const f32x4 g = *(const f32x4*)(g1 + 4 * lane + 256 * j), s1 = *(const f32x4*)(sc + 4 * lane + 256 * j), s0 = *(const f32x4*)(sh + 4 * lane + 256 * j);
            const f32x4 gg = g * (s1 + 1.f);
#pragma unroll
            for (int q = 0; q < 4; ++q) {
                const f32x4 hq = (v[q][j] * rq[q]) * gg + s0;
                u32x2 w; w.x = pk2(hq[0], hq[1]); w.y = pk2(hq[2], hq[3]);
                *(u32x2*)(ho + (size_t)q * DM + 4 * lane + 256 * j) = w;
            }
        }
    }
}

__device__ __forceinline__ void ph_norm2_router_mfma(const Params& p, int l, LAS unsigned char* lds) {
    const int tid = opaque_tid(), lane = tid & 63, wv = tid >> 6, r = lane & 31, h = lane >> 5;
    LAS float* part = (LAS float*)lds;
    LAS float* lgs = (LAS float*)(lds + 8 * 32 * 17 * 4);
    const float* mod = (const float*)(p.ws + WS_MOD);
    const float* g2 = p.in[14] + (size_t)l * DM;
    const bf16_t* WRT = (const bf16_t*)(p.ws + WS_WRT) + (size_t)l * 16 * 2048;
    bf16_t* Hb = (bf16_t*)(p.ws + WS_H);
    float* aff = (float*)(p.ws + WS_AFF);
    for (int blk = blockIdx.x; blk < NT / 32; blk += gridDim.x) {
        const int t0 = blk * 32, b = t0 >> 11;
        const float* sh = mod + ((size_t)l * 4 + b) * 12288 + 3 * 2048;
        const float* sc = sh + 2048;
        {
            const int ta = t0 + 4 * wv;
            const bf16_t* xa = (const bf16_t*)(p.ws + WS_X2) + (size_t)ta * DM;
            u32x2 xw[4][8];
#pragma unroll
            for (int q = 0; q < 4; ++q)
#pragma unroll
                for (int j = 0; j < 8; ++j) xw[q][j] = *(const u32x2*)(xa + (size_t)q * DM + 4 * lane + 256 * j);
            float sq[4] = {0.f, 0.f, 0.f, 0.f};
#pragma unroll
            for (int q = 0; q < 4; ++q)
#pragma unroll
                for (int j = 0; j < 8; ++j) { const float x0 = bflo(xw[q][j].x), x1 = bfhi(xw[q][j].x), x2 = bflo(xw[q][j].y), x3 = bfhi(xw[q][j].y); sq[q] += x0 * x0 + x1 * x1 + x2 * x2 + x3 * x3; }
#pragma unroll
            for (int o = 1; o < 64; o <<= 1)
#pragma unroll
                for (int q = 0; q < 4; ++q) sq[q] += __shfl_xor(sq[q], o);
            float rq[4];
#pragma unroll
            for (int q = 0; q < 4; ++q) rq[q] = 1.0f / sqrtf(sq[q] * (1.f / DM) + EPS);
            bf16_t* ho = Hb + (size_t)ta * DM;
#pragma unroll
            for (int j = 0; j < 8; ++j) {
                const f32x4 g = *(const f32x4*)(g2 + 4 * lane + 256 * j), s1 = *(const f32x4*)(sc + 4 * lane + 256 * j), s0 = *(const f32x4*)(sh + 4 * lane + 256 * j);
                const f32x4 gg = g * (s1 + 1.f);
#pragma unroll
                for (int q = 0; q < 4; ++q) {
                    const f32x4 x = (f32x4){bflo(xw[q][j].x), bfhi(xw[q][j].x), bflo(xw[q][j].y), bfhi(xw[q][j].y)};
                    const f32x4 hq = (x * rq[q]) * gg + s0;
                    u32x2 w; w.x = pk2(hq[0], hq[1]); w.y = pk2(hq[2], hq[3]);
                    *(u32x2*)(ho + (size_t)q * DM + 4 * lane + 256 * j) = w;
                }
            }
        }
        asm volatile("s_waitcnt vmcnt(0)" ::: "memory");
        __syncthreads();
        {
            f32x16 acc;
#pragma unroll
            for (int q = 0; q < 16; ++q) acc[q] = 0.f;
            const bf16_t* bp = Hb + (size_t)(t0 + r) * DM + 256 * wv + 8 * h;
            const bf16_t* ap = WRT + (size_t)(r & 15) * 2048 + 256 * wv + 8 * h;
            bf16x8 bfr[16], afr[16];
#pragma unroll
            for (int s = 0; s < 16; ++s) { bfr[s] = *(const bf16x8*)(bp + 16 * s); afr[s] = *(const bf16x8*)(ap + 16 * s); }
#pragma unroll
            for (int s = 0; s < 16; ++s) { const bf16x8 a = (r < 16) ? afr[s] : (bf16x8){0, 0, 0, 0, 0, 0, 0, 0}; acc = __builtin_amdgcn_mfma_f32_32x32x16_bf16(a, bfr[s], acc, 0, 0, 0); }
#pragma unroll
            for (int q = 0; q < 8; ++q) { const int e = (q & 3) + 8 * (q >> 2) + 4 * h; part[(wv * 32 + r) * 17 + e] = acc[q]; }
        }
        __syncthreads();
        const int e = tid >> 5, tk = tid & 31;
        { float s = 0.f;
#pragma unroll
          for (int w = 0; w < 8; ++w) s += part[(w * 32 + tk) * 17 + e];
          lgs[e * 32 + tk] = s; }
        __syncthreads();
        { float lg[16]; float mx = -1e30f;
#pragma unroll
          for (int q = 0; q < 16; ++q) { lg[q] = lgs[q * 32 + tk]; mx = fmaxf(mx, lg[q]); }
          float den = 0.f, mine = 0.f;
#pragma unroll
          for (int q = 0; q < 16; ++q) { const float ex = expf(lg[q] - mx); den += ex; mine = (q == e) ? ex : mine; }
          aff[((size_t)b * 16 + e) * 2048 + (t0 & 2047) + tk] = mine / den; }
        __syncthreads();
    }
}

__device__ __forceinline__ unsigned block_excl_scan(unsigned cnt, LAS unsigned* wsum, int tid) {
    const int lane = tid & 63, wv = tid >> 6;
    unsigned inc = cnt;
#pragma unroll
    for (int o = 1; o < 64; o <<= 1) { const unsigned t = __shfl_up(inc, o); if (lane >= o) inc += t; }
    if (lane == 63) wsum[wv] = inc;
    __syncthreads();
    unsigned base = 0;
#pragma unroll
    for (int w = 0; w < 8; ++w) base += (w < wv) ? wsum[w] : 0u;
    __syncthreads();
    return base + inc - cnt;
}
__device__ __forceinline__ void ph_topk(const Params& p, LAS unsigned char* lds) {
    const int tid = opaque_tid();
    LAS unsigned* hist = (LAS unsigned*)lds;
    LAS unsigned* misc = hist + 256;
    LAS unsigned* wsum = hist + 320;
    const float* aff = (const float*)(p.ws + WS_AFF);
    int* idx = (int*)(p.ws + WS_IDX); float* gate = (float*)(p.ws + WS_IDX + 65536); int* slot_of = (int*)(p.ws + WS_IDX + 131072);
    for (int u = blockIdx.x; u < 64; u += gridDim.x) {
        const int b = u >> 4, e = u & 15;
        const f32x4 a = *(const f32x4*)(aff + (size_t)u * 2048 + 4 * tid);
        unsigned k[4];
#pragma unroll
        for (int i = 0; i < 4; ++i) k[i] = __float_as_uint(a[i]);
        unsigned prefix = 0, krem = CAP;
#pragma unroll 1
        for (int pass = 0; pass < 4; ++pass) {
            const int shift = 24 - 8 * pass;
            if (tid < 256) hist[tid] = 0;
            __syncthreads();
#pragma unroll
            for (int i = 0; i < 4; ++i) if (pass == 0 || (k[i] >> (shift + 8)) == prefix) __hip_atomic_fetch_add(&hist[(k[i] >> shift) & 255u], 1u, __ATOMIC_RELAXED, __HIP_MEMORY_SCOPE_WORKGROUP);
            __syncthreads();
            { const unsigned cnt = (tid < 256) ? hist[255 - tid] : 0u;
              const unsigned Sn = block_excl_scan(cnt, wsum, tid), S = Sn + cnt;
              if (tid < 256 && S >= krem && Sn < krem) { misc[0] = (prefix << 8) | (unsigned)(255 - tid); misc[1] = krem - Sn; } }
            __syncthreads();
            prefix = misc[0]; krem = misc[1];
            __syncthreads();
        }
        unsigned neq = 0;
#pragma unroll
        for (int i = 0; i < 4; ++i) neq += (k[i] == prefix) ? 1u : 0u;
        unsigned eqbase = block_excl_scan(neq, wsum, tid);
        unsigned sel[4]; unsigned nsel = 0;
#pragma unroll
        for (int i = 0; i < 4; ++i) { const bool eq = k[i] == prefix; sel[i] = (k[i] > prefix || (eq && eqbase < krem)) ? 1u : 0u; eqbase += eq ? 1u : 0u; nsel += sel[i]; }
        unsigned sb = block_excl_scan(nsel, wsum, tid);
#pragma unroll
        for (int i = 0; i < 4; ++i) {
            const int s = 4 * tid + i, t = b * 2048 + s;
            if (sel[i]) { const int row = e * 1024 + b * 256 + (int)sb; idx[row] = t; gate[row] = a[i]; slot_of[(size_t)e * NT + t] = row; ++sb; }
            else slot_of[(size_t)e * NT + t] = -1;
        }
        __syncthreads();
    }
}


__device__ __forceinline__ void ph_fft(const Params& p, LAS unsigned char* lds) {
    const int tid = opaque_tid(), lane = tid & 63, wv = tid >> 6, r = lane & 31, h = lane >> 5;
    LAS bf16_t* XIN = (LAS bf16_t*)lds;
    constexpr int YS = 72;
    LAS bf16_t* YP = (LAS bf16_t*)(lds + 32768);
    LAS float* TW = (LAS float*)(lds + 32768 + 8 * 64 * YS * 2);
    const bf16_t* XAT = (const bf16_t*)(p.ws + WS_PQT);
    const bf16_t* A1 = (const bf16_t*)(p.ws + WS_DFT); const bf16_t* GT = (const bf16_t*)(p.ws + WS_DFT + 16384); const float* TWg = (const float*)(p.ws + WS_DFT + 32768);
    bf16_t* UV = (bf16_t*)(p.ws + WS_YA);
    for (int u = blockIdx.x; u < 256; u += gridDim.x) {
        const int b = u >> 6, c0 = (u & 63) * 8;
        { const u32x4* src = (const u32x4*)(XAT + ((size_t)b * 512 + c0) * 2048);
          u32x4 x[4];
#pragma unroll
          for (int i = 0; i < 4; ++i) x[i] = src[tid + 512 * i];
          const f32x4 t0 = *(const f32x4*)(TWg + 4 * tid), t1 = *(const f32x4*)(TWg + 2048 + 4 * tid);
#pragma unroll
          for (int i = 0; i < 4; ++i) *(LAS u32x4*)(XIN + (size_t)(tid + 512 * i) * 8) = x[i];
          *(LAS f32x4*)(TW + 4 * tid) = t0; *(LAS f32x4*)(TW + 2048 + 4 * tid) = t1; }
        __syncthreads();
        {
            f32x16 acc[4];
#pragma unroll
            for (int mt = 0; mt < 4; ++mt)
#pragma unroll
                for (int q = 0; q < 16; ++q) acc[mt][q] = 0.f;
            const LAS bf16_t* xc = XIN + wv * 2048 + r;
#pragma unroll
            for (int s = 0; s < 4; ++s) {
                unsigned short e[8];
#pragma unroll
                for (int j = 0; j < 8; ++j) e[j] = xc[32 * (16 * s + 8 * h + j)];
                u32x4 bw; bw.x = e[0] | ((unsigned)e[1] << 16); bw.y = e[2] | ((unsigned)e[3] << 16); bw.z = e[4] | ((unsigned)e[5] << 16); bw.w = e[6] | ((unsigned)e[7] << 16);
                const bf16x8 bfr = __builtin_bit_cast(bf16x8, bw);
#pragma unroll
                for (int mt = 0; mt < 4; ++mt) {
                    const bf16x8 afr = *(const bf16x8*)(A1 + (size_t)(32 * mt + r) * 64 + 16 * s + 8 * h);
                    acc[mt] = __builtin_amdgcn_mfma_f32_32x32x16_bf16(afr, bfr, acc[mt], 0, 0, 0);
                }
            }
#pragma unroll
            for (int m2 = 0; m2 < 2; ++m2)
#pragma unroll
                for (int q = 0; q < 16; ++q) {
                    const int cc = 32 * m2 + (q & 3) + 8 * (q >> 2) + 4 * h;
                    const float yr = acc[m2][q], yi = acc[m2 + 2][q];
                    const float c = TW[cc * 32 + r], sn = TW[2048 + cc * 32 + r];
                    const float pr = yr * c + yi * sn, pi = yi * c - yr * sn;
                    LAS bf16_t* o = YP + (size_t)(wv * 64 + cc) * YS + r;
                    o[0] = (bf16_t)(pk2(pr, 0.f) & 0xffffu); o[32] = (bf16_t)(pk2(pi, 0.f) & 0xffffu);
                }
        }
        __syncthreads();
        {
            const int tp = wv & 3, mt = tp >> 1, nt = tp & 1, cg = wv >> 2;
            bf16x8 gfr[4];
#pragma unroll
            for (int s = 0; s < 4; ++s) gfr[s] = *(const bf16x8*)(GT + (size_t)(32 * nt + r) * 64 + 16 * s + 8 * h);
            f32x16 acc2[4];
#pragma unroll
            for (int ci = 0; ci < 4; ++ci) {
#pragma unroll
                for (int q = 0; q < 16; ++q) acc2[ci][q] = 0.f;
                const LAS bf16_t* bp = YP + (size_t)((4 * cg + ci) * 64 + 32 * mt + r) * YS + 8 * h;
#pragma unroll
                for (int s = 0; s < 4; ++s) acc2[ci] = __builtin_amdgcn_mfma_f32_32x32x16_bf16(gfr[s], *(const LAS bf16x8*)(bp + 16 * s), acc2[ci], 0, 0, 0);
            }
            bf16_t* ob = UV + ((((size_t)b * 128 + (u & 63) * 2 + cg) * 2 + nt) * 2048 + 32 * mt + r) * 4;
#pragma unroll
            for (int q = 0; q < 16; ++q) {
                const int d = (q & 3) + 8 * (q >> 2) + 4 * h;
                u32x2 w; w.x = pk2(acc2[0][q], acc2[1][q]); w.y = pk2(acc2[2][q], acc2[3][q]);
                *(u32x2*)(ob + (size_t)d * 256) = w;
            }
        }
        __syncthreads();
    }
}

__device__ __forceinline__ bf16x8 pack8(float a0, float a1, float a2, float a3, float a4, float a5, float a6, float a7) {
    u32x4 p;
    asm volatile("v_cvt_pk_bf16_f32 %0, %4, %5\n\tv_cvt_pk_bf16_f32 %1, %6, %7\n\tv_cvt_pk_bf16_f32 %2, %8, %9\n\tv_cvt_pk_bf16_f32 %3, %10, %11\n\ts_nop 1"
                 : "=&v"(p[0]), "=&v"(p[1]), "=&v"(p[2]), "=&v"(p[3]) : "v"(a0), "v"(a1), "v"(a2), "v"(a3), "v"(a4), "v"(a5), "v"(a6), "v"(a7));
    return __builtin_bit_cast(bf16x8, p);
}
template <int CH>
__device__ __forceinline__ void attn_prefetch(const bf16_t* qp, const bf16_t* kb, const size_t kst, const int lk0, const int ls, const int r, bf16x8 (&qf)[4], bf16x8 (&kf0)[CH][4]) {
#pragma unroll
    for (int s = 0; s < 4; ++s) qf[s] = *(const bf16x8*)(qp + 16 * s);
#pragma unroll
    for (int i = 0; i < CH; ++i) {
        int lkr = lk0 + 32 * i + r; lkr = lkr < 0 ? 0 : (lkr >= ls ? ls - 1 : lkr);
        const bf16_t* kp = kb + (size_t)lkr * kst;
#pragma unroll
        for (int s = 0; s < 4; ++s) kf0[i][s] = *(const bf16x8*)(kp + 16 * s);
    }
}
template <int NTILES, int CH, bool SYNC = true, bool KLDS = false>
__device__ __forceinline__ void attn_wave(const bf16x8 (&qf)[4], const bf16x8 (&kf0)[CH][4], const bf16_t* kb, const size_t kst, const int lk0, const int ls, const LAS bf16_t* vt, const int vts,
                                          float m_run, float l_run, f32x16& O0, f32x16& O1, float& m_out, float& l_out, const int r, const int h, const LAS bf16_t* kl = nullptr, const int kls = 0) {
#pragma unroll
    for (int i = 0; i < 16; ++i) { O0[i] = 0.f; O1[i] = 0.f; }
#pragma unroll
    for (int c0 = 0; c0 < NTILES; c0 += CH) {
        constexpr int dummy = 0; (void)dummy;
        f32x16 S[CH];
#pragma unroll
        for (int ii = 0; ii < CH; ++ii) {
            const int i = c0 + ii;
            if (i < NTILES) {
                int lkr = lk0 + 32 * i + r; lkr = lkr < 0 ? 0 : (lkr >= ls ? ls - 1 : lkr);
                const bf16_t* kp = kb + (size_t)lkr * kst;
                f32x16 a;
#pragma unroll
                for (int q = 0; q < 16; ++q) a[q] = 0.f;
#pragma unroll
                for (int s = 0; s < 4; ++s) {
                    bf16x8 kf;
                    if constexpr (KLDS) kf = *(const LAS bf16x8*)(kl + i * 32 * kls + 16 * s);
                    else { if (c0 == 0) kf = kf0[ii][s]; else kf = *(const bf16x8*)(kp + 16 * s); }
                    a = __builtin_amdgcn_mfma_f32_32x32x16_bf16(kf, qf[s], a, 0, 0, 0);
                }
                S[ii] = a;
            }
        }
        float mx = m_run;
#pragma unroll
        for (int ii = 0; ii < CH; ++ii) {
            const int i = c0 + ii;
            if (i < NTILES) {
                const bool edge = (lk0 + 32 * i < 0) || (lk0 + 32 * i + 32 > ls);
                if (edge || i == 0 || i == NTILES - 1) {
#pragma unroll
                    for (int q = 0; q < 16; ++q) {
                        const int row = (q & 3) + 8 * (q >> 2) + 4 * h;
                        const int lk = lk0 + 32 * i + row;
                        bool valid = (lk >= 0) && (lk < ls);
                        if (i == 0) valid = valid && (row >= r);
                        if (i == NTILES - 1) valid = valid && (row <= r);
                        const float sv = valid ? S[ii][q] : -1e30f;
                        S[ii][q] = sv;
                        mx = fmaxf(mx, sv);
                    }
                } else {
#pragma unroll
                    for (int q = 0; q < 16; ++q) mx = fmaxf(mx, S[ii][q]);
                }
            }
        }
        mx = fmaxf(mx, __shfl_xor(mx, 32));
        const float corr = __builtin_amdgcn_exp2f((m_run - mx) * 1.442695041f);
        float psum = 0.f;
#pragma unroll
        for (int ii = 0; ii < CH; ++ii) {
            const int i = c0 + ii;
            if (i < NTILES) {
#pragma unroll
                for (int q = 0; q < 16; ++q) { const float pv = __builtin_amdgcn_exp2f((S[ii][q] - mx) * 1.442695041f); S[ii][q] = pv; psum += pv; }
            }
        }
        psum += __shfl_xor(psum, 32);
        l_run = l_run * corr + psum;
        m_run = mx;
        if (c0 > 0) {
#pragma unroll
            for (int q = 0; q < 16; ++q) { O0[q] *= corr; O1[q] *= corr; }
        } else { if (SYNC) __syncthreads(); }
#pragma unroll
        for (int ii = 0; ii < CH; ++ii) {
            const int i = c0 + ii;
            if (i < NTILES) {
#pragma unroll
                for (int sp = 0; sp < 2; ++sp) {
                    const bf16x8 pf = pack8(S[ii][8 * sp + 0], S[ii][8 * sp + 1], S[ii][8 * sp + 2], S[ii][8 * sp + 3], S[ii][8 * sp + 4], S[ii][8 * sp + 5], S[ii][8 * sp + 6], S[ii][8 * sp + 7]);
                    const LAS bf16_t* v0 = vt + 32 * i + 16 * sp;
                    { const u32x2 a0 = *(const LAS u32x2*)(v0), a1 = *(const LAS u32x2*)(v0 + 8);
                      const u32x4 vw = (u32x4){a0.x, a0.y, a1.x, a1.y};
                      O0 = __builtin_amdgcn_mfma_f32_32x32x16_bf16(__builtin_bit_cast(bf16x8, vw), pf, O0, 0, 0, 0); }
                    { const u32x2 a0 = *(const LAS u32x2*)(v0 + 32 * vts), a1 = *(const LAS u32x2*)(v0 + 32 * vts + 8);
                      const u32x4 vw = (u32x4){a0.x, a0.y, a1.x, a1.y};
                      O1 = __builtin_amdgcn_mfma_f32_32x32x16_bf16(__builtin_bit_cast(bf16x8, vw), pf, O1, 0, 0, 0); }
                }
            }
        }
    }
    m_out = m_run; l_out = l_run;
}
__device__ __forceinline__ void ph_mixers(const Params& p, const int l, LAS unsigned char* lds) {
    constexpr int VTS = 260, VTSS = 292, KSTR = 72, ARENA = 78848, KOFF = 37376;
    const int hw = (opaque_tid() >> 8) & 1;
    const bf16_t* PROJ = (const bf16_t*)(p.ws + WS_PROJ);
    int ufirst, ucount, ustep;
    if (gridDim.x == 256) { if (blockIdx.x < 128) { ufirst = blockIdx.x * 2; ucount = 2; } else { ufirst = 256 + (blockIdx.x - 128) * 4; ucount = 4; } ustep = 1; }
    else { ufirst = blockIdx.x; ustep = gridDim.x; ucount = (768 - (int)blockIdx.x + (int)gridDim.x - 1) / (int)gridDim.x; }
    const int nsw = (256 - (int)blockIdx.x + (int)gridDim.x - 1) / (int)gridDim.x;
    const int ngm = (int)blockIdx.x < 128 ? (128 - (int)blockIdx.x + (int)gridDim.x - 1) / (int)gridDim.x : 0;
    const int nitems = ngm + nsw + ucount;
    constexpr int VTSG = 136;
    const bf16_t* SW = (const bf16_t*)(p.ws + WS_SGUW) + (size_t)l * 8 * 128 * 128;
    bf16x8 qf[4]; bf16x8 kdummy[5][4];
    for (int k = 0; k <= 2 * nitems; ++k) {
        const int tid = opaque_tid(), lane = tid & 63, w4 = (tid >> 6) & 3, tl = tid & 255, r = lane & 31, h = lane >> 5;
        LAS bf16_t* Vt = (LAS bf16_t*)(lds + hw * ARENA);
        LAS unsigned* Vt32 = (LAS unsigned*)Vt;
        LAS bf16_t* Ks = (LAS bf16_t*)(lds + hw * ARENA + KOFF);
        const int kk = k - hw, it0 = kk >> 1;
        if (kk >= 0 && it0 < nitems) {
            if (it0 < ngm) {
                const int u = blockIdx.x + it0 * gridDim.x;
                const int hg = u & 1, t0 = (u >> 1) * 128, hh2 = w4 >> 1, ph = w4 & 1, habs = hg * 4 + 2 * hw + hh2;
                if (!(kk & 1)) {
                    const int kp = tl & 63, ta = t0 + 2 * kp;
                    const float* vs = (const float*)(p.ws + WS_VSS) + (size_t)ta * 8;
                    const f32x4 sa0 = *(const f32x4*)vs, sa1 = *(const f32x4*)(vs + 4), sb0 = *(const f32x4*)(vs + 8), sb1 = *(const f32x4*)(vs + 12);
                    u32x4 va[4], vb[4]; f32x4 g0[4], g1[4];
                    const float* sn = p.in[8] + (size_t)l * 512 + hg * 256 + hw * 128;
#pragma unroll
                    for (int i = 0; i < 4; ++i) { const int dc = (tl >> 6) + 4 * i;
                        const bf16_t* src = PROJ + (size_t)ta * NPROJ + PC_V + hg * 256 + hw * 128 + 8 * dc;
                        va[i] = *(const u32x4*)src; vb[i] = *(const u32x4*)(src + NPROJ);
                        g0[i] = *(const f32x4*)(sn + 8 * dc); g1[i] = *(const f32x4*)(sn + 8 * dc + 4); }
                    const float ra = 1.0f / sqrtf((((sa0[0] + sa0[1]) + (sa0[2] + sa0[3])) + ((sa1[0] + sa1[1]) + (sa1[2] + sa1[3]))) * (1.f / 512.f) + EPS);
                    const float rb = 1.0f / sqrtf((((sb0[0] + sb0[1]) + (sb0[2] + sb0[3])) + ((sb1[0] + sb1[1]) + (sb1[2] + sb1[3]))) * (1.f / 512.f) + EPS);
#pragma unroll
                    for (int i = 0; i < 4; ++i) { const int dc = (tl >> 6) + 4 * i;
                        LAS unsigned* o = Vt32 + (8 * dc) * (VTSG / 2) + kp;
                        o[0 * (VTSG / 2)] = pk2(bflo(va[i].x) * ra * g0[i][0], bflo(vb[i].x) * rb * g0[i][0]); o[1 * (VTSG / 2)] = pk2(bfhi(va[i].x) * ra * g0[i][1], bfhi(vb[i].x) * rb * g0[i][1]);
                        o[2 * (VTSG / 2)] = pk2(bflo(va[i].y) * ra * g0[i][2], bflo(vb[i].y) * rb * g0[i][2]); o[3 * (VTSG / 2)] = pk2(bfhi(va[i].y) * ra * g0[i][3], bfhi(vb[i].y) * rb * g0[i][3]);
                        o[4 * (VTSG / 2)] = pk2(bflo(va[i].z) * ra * g1[i][0], bflo(vb[i].z) * rb * g1[i][0]); o[5 * (VTSG / 2)] = pk2(bfhi(va[i].z) * ra * g1[i][1], bfhi(vb[i].z) * rb * g1[i][1]);
                        o[6 * (VTSG / 2)] = pk2(bflo(va[i].w) * ra * g1[i][2], bflo(vb[i].w) * rb * g1[i][2]); o[7 * (VTSG / 2)] = pk2(bfhi(va[i].w) * ra * g1[i][3], bfhi(vb[i].w) * rb * g1[i][3]); }
                } else {
                    f32x16 acc[2][2];
#pragma unroll
                    for (int ct = 0; ct < 2; ++ct)
#pragma unroll
                        for (int pt = 0; pt < 2; ++pt)
#pragma unroll
                            for (int q = 0; q < 16; ++q) acc[ct][pt][q] = 0.f;
                    const LAS bf16_t* ap = Vt + (hh2 * 64 + r) * VTSG + 8 * h;
                    const bf16_t* wp = SW + ((size_t)habs * 128 + 64 * ph + r) * 128 + 8 * h;
#pragma unroll
                    for (int s2 = 0; s2 < 8; ++s2) {
                        bf16x8 afr[2], bfr[2];
#pragma unroll
                        for (int pt = 0; pt < 2; ++pt) bfr[pt] = *(const bf16x8*)(wp + (size_t)pt * 32 * 128 + 16 * s2);
#pragma unroll
                        for (int ct = 0; ct < 2; ++ct) afr[ct] = *(const LAS bf16x8*)(ap + ct * 32 * VTSG + 16 * s2);
#pragma unroll
                        for (int ct = 0; ct < 2; ++ct)
#pragma unroll
                            for (int pt = 0; pt < 2; ++pt) acc[ct][pt] = __builtin_amdgcn_mfma_f32_32x32x16_bf16(afr[ct], bfr[pt], acc[ct][pt], 0, 0, 0);
                    }
                    bf16_t* YB = (bf16_t*)(p.ws + WS_YB);
#pragma unroll
                    for (int pt = 0; pt < 2; ++pt) {
                        const int pp = 64 * ph + 32 * pt + r;
                        const float bias = p.in[10][((size_t)l * 8 + habs) * 128 + pp];
                        const bf16_t* us = PROJ + (size_t)(t0 + pp) * NPROJ + PC_U + habs * 64 + 4 * h;
                        bf16_t* o = YB + (size_t)(t0 + pp) * 512 + habs * 64 + 4 * h;
#pragma unroll
                        for (int ct = 0; ct < 2; ++ct)
#pragma unroll
                            for (int gg = 0; gg < 4; ++gg) {
                                const u32x2 uw = *(const u32x2*)(us + 32 * ct + 8 * gg);
                                u32x2 w; w.x = pk2(bflo(uw.x) * (acc[ct][pt][4 * gg] + bias), bfhi(uw.x) * (acc[ct][pt][4 * gg + 1] + bias));
                                w.y = pk2(bflo(uw.y) * (acc[ct][pt][4 * gg + 2] + bias), bfhi(uw.y) * (acc[ct][pt][4 * gg + 3] + bias));
                                *(u32x2*)(o + 32 * ct + 8 * gg) = w;
                            }
                    }
                }
            } else if (it0 < ngm + nsw) {
                const int it = it0 - ngm;
                const int u = blockIdx.x + it * gridDim.x;
                const int b = u >> 6, kvh = (u >> 5) & 1, q0 = (u & 31) * 64 + 32 * hw;
                const bf16_t* base = PROJ + (size_t)b * SEQ * NPROJ;
                const int head = kvh * 4 + w4, qpos = q0 + r, lk0 = q0 - 128;
                if (!(kk & 1)) {
                    u32x4 va[5], vb[5], kc[9];
#pragma unroll
                    for (int i = 0; i < 5; ++i) {
                        const int task = tl + 256 * i;
                        if (task < 1152) { const int kp = task % 144, dc = task / 144;
                            int kA = lk0 + 2 * kp; kA = kA < 0 ? 0 : (kA > SEQ - 2 ? SEQ - 2 : kA);
                            va[i] = *(const u32x4*)(base + (size_t)kA * NPROJ + PC_VC + kvh * 64 + 8 * dc);
                            vb[i] = *(const u32x4*)(base + (size_t)(kA + 1) * NPROJ + PC_VC + kvh * 64 + 8 * dc); }
                    }
#pragma unroll
                    for (int i = 0; i < 9; ++i) { const int id = tl + 256 * i, j = id >> 3, c8 = id & 7;
                        int kp2 = lk0 + j; kp2 = kp2 < 0 ? 0 : (kp2 >= SEQ ? SEQ - 1 : kp2);
                        kc[i] = *(const u32x4*)(base + (size_t)kp2 * NPROJ + PC_KC + kvh * 64 + 8 * c8); }
                    { const bf16_t* qp = base + (size_t)qpos * NPROJ + PC_QC + head * 64 + 8 * h;
#pragma unroll
                      for (int s2 = 0; s2 < 4; ++s2) qf[s2] = *(const bf16x8*)(qp + 16 * s2); }
#pragma unroll
                    for (int i = 0; i < 5; ++i) {
                        const int task = tl + 256 * i;
                        if (task < 1152) { const int kp = task % 144, dc = task / 144;
                            LAS unsigned* o = Vt32 + (8 * dc) * (VTSS / 2) + kp;
                            o[0 * (VTSS / 2)] = (va[i].x & 0xffffu) | (vb[i].x << 16); o[1 * (VTSS / 2)] = (va[i].x >> 16) | (vb[i].x & 0xffff0000u);
                            o[2 * (VTSS / 2)] = (va[i].y & 0xffffu) | (vb[i].y << 16); o[3 * (VTSS / 2)] = (va[i].y >> 16) | (vb[i].y & 0xffff0000u);
                            o[4 * (VTSS / 2)] = (va[i].z & 0xffffu) | (vb[i].z << 16); o[5 * (VTSS / 2)] = (va[i].z >> 16) | (vb[i].z & 0xffff0000u);
                            o[6 * (VTSS / 2)] = (va[i].w & 0xffffu) | (vb[i].w << 16); o[7 * (VTSS / 2)] = (va[i].w >> 16) | (vb[i].w & 0xffff0000u); }
                    }
#pragma unroll
                    for (int i = 0; i < 9; ++i) { const int id = tl + 256 * i, j = id >> 3, c8 = id & 7; *(LAS u32x4*)(Ks + j * KSTR + 8 * c8) = kc[i]; }
                } else {
                    const LAS bf16_t* vt = Vt + r * VTSS + 4 * h;
                    const LAS bf16_t* kl = Ks + r * KSTR + 8 * h;
                    f32x16 O0, O1; float m, lsum;
                    attn_wave<9, 5, false, true>(qf, kdummy, nullptr, (size_t)NPROJ, lk0, SEQ, vt, VTSS, p.in[11][l * 8 + head], 1.f, O0, O1, m, lsum, r, h, kl, KSTR);
                    const float inv = 1.f / lsum;
                    bf16_t* o = (bf16_t*)(p.ws + WS_YC) + ((size_t)b * SEQ + qpos) * 512 + head * 64 + 4 * h;
#pragma unroll
                    for (int gg = 0; gg < 4; ++gg) {
                        u32x2 w0; w0.x = pk2(O0[4 * gg] * inv, O0[4 * gg + 1] * inv); w0.y = pk2(O0[4 * gg + 2] * inv, O0[4 * gg + 3] * inv);
                        u32x2 w1; w1.x = pk2(O1[4 * gg] * inv, O1[4 * gg + 1] * inv); w1.y = pk2(O1[4 * gg + 2] * inv, O1[4 * gg + 3] * inv);
                        *(u32x2*)(o + 8 * gg) = w0; *(u32x2*)(o + 32 + 8 * gg) = w1;
                    }
                }
            } else {
                const int u = ufirst + (it0 - ngm - nsw) * ustep;
                const int cfg = u >> 8, r8 = u & 255, b = r8 >> 6, head = (r8 >> 3) & 7, blk = (r8 & 7) * 2 + hw;
                const int dsh = 2 * cfg, dil = 1 << dsh, ls = SEQ >> dsh, nblk = ls >> 7;
                const int res = blk / nblk, l0 = (blk % nblk) * 128;
                const bf16_t* base = PROJ + ((size_t)b * SEQ + res) * NPROJ;
                const size_t kst = (size_t)dil * NPROJ;
                const int lq = l0 + 32 * w4 + r;
                const int lk0 = l0 + 32 * w4 - 64;
                if (!(kk & 1)) {
                    u32x4 va[4], vb[4], kc[8];
#pragma unroll
                    for (int i = 0; i < 4; ++i) {
                        const int task = tl + 256 * i, kp = task & 127, dc = task >> 7;
                        int lkA = l0 - 64 + 2 * kp; lkA = lkA < 0 ? 0 : (lkA > ls - 2 ? ls - 2 : lkA);
                        va[i] = *(const u32x4*)(base + (size_t)lkA * kst + PC_VD + head * 64 + 8 * dc);
                        vb[i] = *(const u32x4*)(base + (size_t)(lkA + 1) * kst + PC_VD + head * 64 + 8 * dc);
                    }
#pragma unroll
                    for (int i = 0; i < 8; ++i) {
                        const int id = tl + 256 * i, j = id >> 3, c8 = id & 7;
                        int lk = l0 - 64 + j; lk = lk < 0 ? 0 : (lk >= ls ? ls - 1 : lk);
                        kc[i] = *(const u32x4*)(base + (size_t)lk * kst + PC_KD + head * 64 + 8 * c8);
                    }
                    { const bf16_t* qp = base + (size_t)lq * kst + PC_QD + head * 64 + 8 * h;
#pragma unroll
                      for (int s2 = 0; s2 < 4; ++s2) qf[s2] = *(const bf16x8*)(qp + 16 * s2); }
#pragma unroll
                    for (int i = 0; i < 4; ++i) {
                        const int task = tl + 256 * i, kp = task & 127, dc = task >> 7;
                        LAS unsigned* o = Vt32 + (8 * dc) * (VTS / 2) + kp;
                        o[0 * (VTS / 2)] = (va[i].x & 0xffffu) | (vb[i].x << 16); o[1 * (VTS / 2)] = (va[i].x >> 16) | (vb[i].x & 0xffff0000u);
                        o[2 * (VTS / 2)] = (va[i].y & 0xffffu) | (vb[i].y << 16); o[3 * (VTS / 2)] = (va[i].y >> 16) | (vb[i].y & 0xffff0000u);
                        o[4 * (VTS / 2)] = (va[i].z & 0xffffu) | (vb[i].z << 16); o[5 * (VTS / 2)] = (va[i].z >> 16) | (vb[i].z & 0xffff0000u);
                        o[6 * (VTS / 2)] = (va[i].w & 0xffffu) | (vb[i].w << 16); o[7 * (VTS / 2)] = (va[i].w >> 16) | (vb[i].w & 0xffff0000u);
                    }
#pragma unroll
                    for (int i = 0; i < 8; ++i) { const int id = tl + 256 * i, j = id >> 3, c8 = id & 7; *(LAS u32x4*)(Ks + j * KSTR + 8 * c8) = kc[i]; }
                } else {
                    const LAS bf16_t* vt = Vt + r * VTS + 32 * w4 + 4 * h;
                    const LAS bf16_t* kl = Ks + (32 * w4 + r) * KSTR + 8 * h;
                    f32x16 O0, O1; float m, lsm;
                    attn_wave<5, 5, false, true>(qf, kdummy, nullptr, kst, lk0, ls, vt, VTS, -1e30f, 0.f, O0, O1, m, lsm, r, h, kl, KSTR);
                    const float inv = 1.f / lsm;
                    const size_t tq = (size_t)b * SEQ + (size_t)lq * dil + res;
                    bf16_t* o = (bf16_t*)(p.ws + WS_YD) + ((size_t)cfg * NT + tq) * 512 + head * 64 + 4 * h;
#pragma unroll
                    for (int g = 0; g < 4; ++g) {
                        u32x2 w0; w0.x = pk2(O0[4 * g] * inv, O0[4 * g + 1] * inv); w0.y = pk2(O0[4 * g + 2] * inv, O0[4 * g + 3] * inv);
                        u32x2 w1; w1.x = pk2(O1[4 * g] * inv, O1[4 * g + 1] * inv); w1.y = pk2(O1[4 * g + 2] * inv, O1[4 * g + 3] * inv);
                        *(u32x2*)(o + 8 * g) = w0; *(u32x2*)(o + 32 + 8 * g) = w1;
                    }
                    if (h == 0) ((float*)(p.ws + WS_LSE))[((size_t)cfg * NT + tq) * 8 + head] = m + __logf(lsm);
                }
            }
        }
        __syncthreads();
    }
}

__device__ __forceinline__ void ph_merge(const Params& p, int l, LAS unsigned char* lds) {
    const int tid = opaque_tid(), lane = tid & 63, wv = tid >> 6, r = lane & 31, h2 = lane >> 5;
    LAS float* ssA = (LAS float*)lds;
    const bf16_t* UV = (const bf16_t*)(p.ws + WS_YA); const bf16_t* YB = (const bf16_t*)(p.ws + WS_YB); const bf16_t* YC = (const bf16_t*)(p.ws + WS_YC); const bf16_t* YD = (const bf16_t*)(p.ws + WS_YD);
    const float* LSE = (const float*)(p.ws + WS_LSE); bf16_t* YN = (bf16_t*)(p.ws + WS_YN);
    const bf16_t* ABT = (const bf16_t*)(p.ws + WS_ABT) + ((size_t)l * 8 + wv) * 64 * 128;
    for (int blk = blockIdx.x; blk < NT / 32; blk += gridDim.x) {
        const int t0 = blk * 32, b = t0 >> 11, s0 = t0 & 2047;
        f32x16 O0, O1;
        {
#pragma unroll
            for (int q = 0; q < 16; ++q) { O0[q] = 0.f; O1[q] = 0.f; }
            const size_t row = ((((size_t)b * 128 + wv * 16 + 2 * h2) * 2) * 2048 + s0 + r) * 4;
            u32x4 u0[8];
#pragma unroll
            for (int s = 0; s < 8; ++s) { const size_t o = row + (size_t)(s & 3) * (4 * 2 * 2048 * 4) + (size_t)(s >> 2) * (2048 * 4);
                const u32x2 lo = *(const u32x2*)(UV + o), hi = *(const u32x2*)(UV + o + 2 * 2048 * 4); u0[s].x = lo.x; u0[s].y = lo.y; u0[s].z = hi.x; u0[s].w = hi.y; }
            bf16x8 af0[8], af1[8];
#pragma unroll
            for (int s = 0; s < 8; ++s) { af0[s] = *(const bf16x8*)(ABT + (size_t)r * 128 + 16 * s + 8 * h2); af1[s] = *(const bf16x8*)(ABT + (size_t)(32 + r) * 128 + 16 * s + 8 * h2); }
#pragma unroll
            for (int s = 0; s < 8; ++s) {
                const bf16x8 bfr = __builtin_bit_cast(bf16x8, u0[s]);
                O0 = __builtin_amdgcn_mfma_f32_32x32x16_bf16(af0[s], bfr, O0, 0, 0, 0);
                O1 = __builtin_amdgcn_mfma_f32_32x32x16_bf16(af1[s], bfr, O1, 0, 0, 0);
            }
            float ss = 0.f;
#pragma unroll
            for (int q = 0; q < 16; ++q) ss += O0[q] * O0[q] + O1[q] * O1[q];
            ss += __shfl_xor(ss, 32);
            if (h2 == 0) ssA[wv * 32 + r] = ss;
        }
        {
            u32x4 lb[4], lc[4], ld0[4], ld1[4], ld2[4]; float e0[4], e1[4], e2[4];
#pragma unroll
            for (int i = 0; i < 4; ++i) {
                const int t = t0 + 4 * wv + i, head = lane >> 3;
                lb[i] = *(const u32x4*)(YB + (size_t)t * 512 + 8 * lane); lc[i] = *(const u32x4*)(YC + (size_t)t * 512 + 8 * lane);
                ld0[i] = *(const u32x4*)(YD + (size_t)t * 512 + 8 * lane); ld1[i] = *(const u32x4*)(YD + ((size_t)NT + t) * 512 + 8 * lane); ld2[i] = *(const u32x4*)(YD + ((size_t)2 * NT + t) * 512 + 8 * lane);
                e0[i] = LSE[(size_t)t * 8 + head]; e1[i] = LSE[((size_t)NT + t) * 8 + head]; e2[i] = LSE[((size_t)2 * NT + t) * 8 + head];
            }
#pragma unroll
            for (int i = 0; i < 4; ++i) {
                const int t = t0 + 4 * wv + i;
                float y[3][8];
                { const u32x4 w = lb[i];
                    y[0][0] = bflo(w.x); y[0][1] = bfhi(w.x); y[0][2] = bflo(w.y); y[0][3] = bfhi(w.y); y[0][4] = bflo(w.z); y[0][5] = bfhi(w.z); y[0][6] = bflo(w.w); y[0][7] = bfhi(w.w); }
                { const u32x4 w = lc[i];
                    y[1][0] = bflo(w.x); y[1][1] = bfhi(w.x); y[1][2] = bflo(w.y); y[1][3] = bfhi(w.y); y[1][4] = bflo(w.z); y[1][5] = bfhi(w.z); y[1][6] = bflo(w.w); y[1][7] = bfhi(w.w); }
                { const float l0 = e0[i], l1 = e1[i], l2 = e2[i];
                  const float mx = fmaxf(l0, fmaxf(l1, l2)); float w0 = __expf(l0 - mx), w1 = __expf(l1 - mx), w2 = __expf(l2 - mx); const float iv = 1.f / (w0 + w1 + w2); w0 *= iv; w1 *= iv; w2 *= iv;
                  const u32x4 a = ld0[i], bq = ld1[i], c = ld2[i];
                  y[2][0] = w0 * bflo(a.x) + w1 * bflo(bq.x) + w2 * bflo(c.x); y[2][1] = w0 * bfhi(a.x) + w1 * bfhi(bq.x) + w2 * bfhi(c.x);
                  y[2][2] = w0 * bflo(a.y) + w1 * bflo(bq.y) + w2 * bflo(c.y); y[2][3] = w0 * bfhi(a.y) + w1 * bfhi(bq.y) + w2 * bfhi(c.y);
                  y[2][4] = w0 * bflo(a.z) + w1 * bflo(bq.z) + w2 * bflo(c.z); y[2][5] = w0 * bfhi(a.z) + w1 * bfhi(bq.z) + w2 * bfhi(c.z);
                  y[2][6] = w0 * bflo(a.w) + w1 * bflo(bq.w) + w2 * bflo(c.w); y[2][7] = w0 * bfhi(a.w) + w1 * bfhi(bq.w) + w2 * bfhi(c.w); }
#pragma unroll
                for (int g = 0; g < 3; ++g) {
                    float ss = 0.f;
#pragma unroll
                    for (int q = 0; q < 8; ++q) ss += y[g][q] * y[g][q];
                    const float rr = 1.0f / sqrtf(wave_sum(ss) * (1.f / 512.f) + EPS);
                    u32x4 w; w.x = pk2(y[g][0] * rr, y[g][1] * rr); w.y = pk2(y[g][2] * rr, y[g][3] * rr); w.z = pk2(y[g][4] * rr, y[g][5] * rr); w.w = pk2(y[g][6] * rr, y[g][7] * rr);
                    *(u32x4*)(YN + (size_t)t * DM + (g + 1) * 512 + 8 * lane) = w;
                }
            }
        }
        __syncthreads();
        {
            float tot = 0.f;
#pragma unroll
            for (int w = 0; w < 8; ++w) tot += ssA[w * 32 + r];
            const float rr = 1.0f / sqrtf(tot * (1.f / 512.f) + EPS);
            bf16_t* o = YN + (size_t)(t0 + r) * DM + wv * 64 + 4 * h2;
#pragma unroll
            for (int g = 0; g < 4; ++g) {
                u32x2 w0; w0.x = pk2(O0[4 * g] * rr, O0[4 * g + 1] * rr); w0.y = pk2(O0[4 * g + 2] * rr, O0[4 * g + 3] * rr);
                u32x2 w1; w1.x = pk2(O1[4 * g] * rr, O1[4 * g + 1] * rr); w1.y = pk2(O1[4 * g + 2] * rr, O1[4 * g + 3] * rr);
                *(u32x2*)(o + 8 * g) = w0; *(u32x2*)(o + 32 + 8 * g) = w1;
            }
        }
        __syncthreads();
    }
}

#ifndef PHASE_MASK
#define PHASE_MASK 0xFFFFFFu
#endif
#define EN(k) (((PHASE_MASK) >> (k)) & 1u)
#ifndef REP_MASK
#define REP_MASK 0u
#endif
#define REP(k) _Pragma("unroll") for (int rep_ = 0; rep_ < 1 + (int)(((REP_MASK) >> (k)) & 1u); ++rep_)
constexpr int MIX_GW = 128, MIX_A = 4400;
constexpr int NPHASE = 22;
__global__ void __launch_bounds__(512, 2) mk_fwd(Params p) {
    extern __shared__ __attribute__((aligned(16))) unsigned char lds_raw[];
    LAS unsigned char* lds = (LAS unsigned char*)lds_raw;
    const int tid = threadIdx.x, G = gridDim.x, bx = blockIdx.x;
    volatile LAS unsigned* misc = (volatile LAS unsigned*)(lds + MISC_OFF);
    if (tid < 16) misc[tid] = 0u;
    __syncthreads();
    const int lo = p.ph_lo, hi = p.ph_hi;
    XcdBarrier bar; bar.bar = (unsigned*)(p.ws + WS_CTL); bar.x = 0; bar.st = misc + 8;
    if (hi - lo > 1) bar = xcd_barrier_post((unsigned*)(p.ws + WS_CTL), misc + 8);
#define IN(k) (lo <= (k) && (k) < hi)
#define SEAM(k) do { if (IN(k) && IN((k) + 1)) xcd_barrier(bar); } while (0)
    if (IN(0)) { if (EN(0)) REP(0) ph_mod(p, lds); if (EN(1)) REP(1) ph_tables(p, lds); if (EN(2)) REP(2) { if (G == 256) { if (bx >= 192) ph_weights(p, lds, 0, 240, bx - 192, 64); } else ph_weights(p, lds, 0, 6880, bx, G); } }
    SEAM(0);
    for (int l = 0; l < 2; ++l) {
        const int pb = 1 + 10 * l;
        const char* H = (const char*)(p.ws + WS_H);
        if (EN(3) && IN(pb + 0)) REP(3) { if (l == 0) ph_norm1_l0(p); else ph_norm1(p, 1); }
        SEAM(pb + 0);
        if (EN(4) && IN(pb + 1)) REP(4) {
            SchedProj S{H, (const char*)(p.ws + WS_WIN) + (size_t)l * NPROJ * 2048 * 2, (const char*)(p.ws + WS_WPQ) + (size_t)l * 512 * 2048 * 2, G, bx};
            EpiProj E{(bf16_t*)(p.ws + WS_PROJ), (bf16_t*)(p.ws + WS_PQT), (const float*)(p.ws + WS_ROPE), (const float*)(p.ws + WS_ROPE) + NT * 8};
            if (l == 0 && G == 256 && EN(2)) {
                if (bx < MIX_GW) { SchedProj S2{S.H, S.WIN, S.WPQ, MIX_GW, bx}; pg8::gemm_phase<EpiProj, SchedProj>(lds, 2048, 2048, 2048, S2, E); }
                else ph_weights(p, lds, 240, 240 + MIX_A, bx - MIX_GW, G - MIX_GW);
                __syncthreads();
                ph_weights(p, lds, 240 + MIX_A, 6880, bx, G);
            } else
            pg8::gemm_phase<EpiProj, SchedProj>(lds, 2048, 2048, 2048, S, E);
        }
        SEAM(pb + 1);
        if (IN(pb + 2)) {
            if (EN(5)) REP(5) ph_fft(p, lds);
            __syncthreads();
            if (EN(8)) REP(8) ph_mixers(p, l, lds);
        }
        SEAM(pb + 2);
        if (EN(9) && IN(pb + 3)) REP(9) { ph_merge(p, l, lds); }
        SEAM(pb + 3);
        if (EN(10) && IN(pb + 4)) REP(10) {
            SchedDense S{(const char*)(p.ws + WS_YN), (const char*)(p.ws + WS_WOUT) + (size_t)l * 2048 * 2048 * 2, 32, 8, 2048, G, bx};
            EpiWout E{l == 0 ? p.in[0] : nullptr, (const bf16_t*)(p.ws + WS_X), (bf16_t*)(p.ws + WS_X2), (const float*)(p.ws + WS_MOD) + (size_t)l * 4 * 12288 + 2 * 2048};
            pg8::gemm_phase<EpiWout, SchedDense>(lds, 2048, 2048, 2048, S, E);
        }
        SEAM(pb + 4);
        if (EN(11) && IN(pb + 5)) REP(11) { ph_norm2_router_mfma(p, l, lds); }
        SEAM(pb + 5);
        if (EN(12) && IN(pb + 6)) REP(12) { ph_topk(p, lds); }
        SEAM(pb + 6);
        if (EN(14) && IN(pb + 8)) REP(14) {
            SchedMoeG S{H, (const char*)(p.ws + WS_WGU) + (size_t)l * 16 * 2048 * 2048 * 2, 2048, G, bx};
            EpiGU E{(bf16_t*)(p.ws + WS_ACT)};
            pg8::gemm_phase<EpiGU, SchedMoeG, true>(lds, 2048, 2048, 2048, S, E, (const int*)(p.ws + WS_IDX));
        }
        SEAM(pb + 8);
        if (EN(15) && IN(pb + 9)) REP(15) {
            SchedMoe S{(const char*)(p.ws + WS_ACT), (const char*)(p.ws + WS_WD) + (size_t)l * 16 * 2048 * 1024 * 2, 1024, G, bx};
            EpiDown E{(bf16_t*)(p.ws + WS_EO), (const float*)(p.ws + WS_IDX + 65536)};
            pg8::gemm_phase<EpiDown, SchedMoe>(lds, 1024, 1024, 1024, S, E);
        }
        SEAM(pb + 9);
    }
    if (EN(16) && IN(21)) REP(16) { ph_norm1(p, 2); }
#undef IN
#undef SEAM
}

extern "C" void kernel_launch(void* const* d_in, const int* in_sizes, int n_in, void* d_out, int out_size, void* d_ws, size_t ws_size, hipStream_t stream) {
    static int grid = 0;
    if (grid == 0) {
        if (n_in != 20 || out_size != NT * DM || ws_size < WS_END) { fprintf(stderr, "kernel_launch: unexpected shapes (n_in %d out %d ws %zu)\n", n_in, out_size, ws_size); grid = -1; return; }
        int dev = 0, cus = 0, per_cu = 0;
        if (hipGetDevice(&dev) != hipSuccess || hipDeviceGetAttribute(&cus, hipDeviceAttributeMultiprocessorCount, dev) != hipSuccess) { grid = -1; return; }
        if (hipFuncSetAttribute((const void*)mk_fwd, hipFuncAttributeMaxDynamicSharedMemorySize, LDS_BYTES) != hipSuccess) { fprintf(stderr, "kernel_launch: hipFuncSetAttribute failed\n"); grid = -1; return; }
        if (hipOccupancyMaxActiveBlocksPerMultiprocessor(&per_cu, (const void*)mk_fwd, 512, LDS_BYTES) != hipSuccess || per_cu < 1) { fprintf(stderr, "kernel_launch: occupancy query says %d\n", per_cu); }
        (void)hipGetLastError();
        grid = cus;
    }
    if (grid < 0) return;
    (void)hipMemsetAsync((char*)d_ws + WS_CTL, 0, 64 * 1024, stream);
    Params p{};
    for (int i = 0; i < 20; ++i) p.in[i] = (const float*)d_in[i];
    p.out = (float*)d_out; p.ws = (unsigned char*)d_ws;
#if defined(MK_MULTI)
    for (int ph = 0; ph < NPHASE; ++ph) { p.ph_lo = ph; p.ph_hi = ph + 1; hipLaunchKernelGGL(mk_fwd, dim3(grid), dim3(512), LDS_BYTES, stream, p); }
#else
    p.ph_lo = 0; p.ph_hi = NPHASE; hipLaunchKernelGGL(mk_fwd, dim3(grid), dim3(512), LDS_BYTES, stream, p);
#endif
}
```
